# Optimizing an MI355X kernel written in HIP

```python
import jax, jax.numpy as jnp
from jax import lax
import numpy as np

D_MODEL = 2048
BATCH = 8
SEQ = 4096
DEPTH = 4

CHUNK = 64
N_A_LAYERS = DEPTH // 2
N_B_LAYERS = DEPTH - N_A_LAYERS
GMLP_BLOCK = 128
GMLP_HALF = 3 * D_MODEL
GMLP_GROUPS = 8
GMLP_GROUP_DIM = GMLP_HALF // GMLP_GROUPS
N_HEADS = 16
HEAD_DIM = D_MODEL // N_HEADS
Q_BLOCK = 128
D_FF = 4 * D_MODEL
N_MOD = 6
EPS = 1e-6

kernel_name = "yoco_gmlp_forgetting_attn_adaln_trunk"


def rms_norm(x, g):
    xf = x.astype(jnp.float32)
    y = xf * lax.rsqrt(jnp.mean(xf * xf, axis=-1, keepdims=True) + EPS)
    return y.astype(x.dtype) * g


def layer_norm(x, g, b):
    xf = x.astype(jnp.float32)
    mu = jnp.mean(xf, axis=-1, keepdims=True)
    var = jnp.mean(jnp.square(xf - mu), axis=-1, keepdims=True)
    y = (xf - mu) * lax.rsqrt(var + EPS)
    return y.astype(x.dtype) * g + b


def modulate(h, shift, scale):
    return h * (1.0 + scale[:, None, :]) + shift[:, None, :]


def split_heads(t):
    b, s, _ = t.shape
    return t.reshape(b, s, N_HEADS, HEAD_DIM)


def gmlp_block_mask():
    idx = np.arange(GMLP_BLOCK) // CHUNK
    return jnp.asarray(idx[None, :] <= idx[:, None])


def gmlp_mixer(h, w_in, ln_g, ln_b, ws, bs, w_out):
    b, s, _ = h.shape
    z = jax.nn.gelu(h @ w_in, approximate=False)
    u, v = jnp.split(z, 2, axis=-1)
    v = layer_norm(v, ln_g, ln_b)
    n_blk = s // GMLP_BLOCK
    v = v.reshape(b, n_blk, GMLP_BLOCK, GMLP_GROUPS, GMLP_GROUP_DIM)
    w = jnp.where(gmlp_block_mask()[None], ws, jnp.zeros((), ws.dtype))
    sv = jnp.einsum('gij,bnjgc->bnigc', w, v) + bs.T[:, :, None]
    sv = sv.reshape(b, s, GMLP_HALF)
    return (u * sv) @ w_out


def squared_relu_mlp(h, w1, w2):
    return jnp.square(jax.nn.relu(h @ w1)) @ w2


def shared_kv(x, sc, kv_norm_g, kv_ada_w, kv_ada_b, w_kv, k_norm_g, w_f, b_f):
    shift, scale = jnp.split(sc @ kv_ada_w + kv_ada_b, 2, axis=-1)
    h = modulate(rms_norm(x, kv_norm_g), shift, scale)
    k, v = jnp.split(h @ w_kv, 2, axis=-1)
    k = rms_norm(split_heads(k), k_norm_g).transpose(0, 2, 1, 3)
    v = split_heads(v).transpose(0, 2, 1, 3)
    logf = jax.nn.log_sigmoid((h @ w_f).astype(jnp.float32) + b_f.astype(jnp.float32))
    fcum = jnp.cumsum(logf, axis=1).transpose(0, 2, 1)
    return k, v, fcum


def forgetting_attention(q, k, v, fcum):
    b, nh, s, dh = q.shape
    n_blk = s // Q_BLOCK
    qb = q.reshape(b, nh, n_blk, Q_BLOCK, dh).transpose(2, 0, 1, 3, 4)
    fq = fcum.reshape(b, nh, n_blk, Q_BLOCK).transpose(2, 0, 1, 3)
    key_pos = jnp.arange(s)
    inv_sqrt = 1.0 / float(np.sqrt(dh))

    def one_block(args):
        i, q_i, f_i = args
        logits = jnp.einsum('bhqd,bhkd->bhqk', q_i, k,
                            preferred_element_type=jnp.float32) * inv_sqrt
        logits = logits + (f_i[..., :, None] - fcum[..., None, :])
        q_pos = i * Q_BLOCK + jnp.arange(Q_BLOCK)
        logits = jnp.where(key_pos[None, :] <= q_pos[:, None], logits, -jnp.inf)
        p = jax.nn.softmax(logits, axis=-1)
        return jnp.einsum('bhqk,bhkd->bhqd', p.astype(v.dtype), v)

    out = lax.map(one_block, (jnp.arange(n_blk), qb, fq))
    return out.transpose(1, 2, 0, 3, 4).reshape(b, nh, s, dh)


def attention_mixer(h, k, v, fcum, wq, q_norm_g, wo):
    b, s, _ = h.shape
    q = rms_norm(split_heads(h @ wq), q_norm_g).transpose(0, 2, 1, 3)
    o = forgetting_attention(q, k, v, fcum)
    return o.transpose(0, 2, 1, 3).reshape(b, s, D_MODEL) @ wo


def setup_inputs(seed: int = 0) -> dict:
    key = jax.random.key(seed)
    ks = jax.random.split(key, 24)
    f32 = jnp.float32
    nrm = lambda k, shape, s: jax.random.normal(k, shape, f32) * s
    d = D_MODEL
    return {
        "x": nrm(ks[0], (BATCH, SEQ, d), 1.0),
        "c": nrm(ks[1], (BATCH, d), 1.0),
        "ada_w": nrm(ks[2], (DEPTH, d, N_MOD * d), d ** -0.5),
        "ada_b": nrm(ks[3], (DEPTH, N_MOD * d), 0.02),
        "norm_g": 1.0 + nrm(ks[4], (DEPTH, 2, d), 0.02),
        "mlp_w1": nrm(ks[5], (DEPTH, d, D_FF), d ** -0.5),
        "mlp_w2": nrm(ks[6], (DEPTH, D_FF, d), D_FF ** -0.5),
        "gmlp_w_in": nrm(ks[7], (N_A_LAYERS, d, 2 * GMLP_HALF), d ** -0.5),
        "gmlp_ln_g": 1.0 + nrm(ks[8], (N_A_LAYERS, GMLP_HALF), 0.02),
        "gmlp_ln_b": nrm(ks[9], (N_A_LAYERS, GMLP_HALF), 0.02),
        "gmlp_ws": nrm(ks[10], (N_A_LAYERS, GMLP_GROUPS, GMLP_BLOCK, GMLP_BLOCK), GMLP_BLOCK ** -0.5),
        "gmlp_bs": 1.0 + nrm(ks[11], (N_A_LAYERS, GMLP_GROUPS, GMLP_BLOCK), 0.1),
        "gmlp_w_out": nrm(ks[12], (N_A_LAYERS, GMLP_HALF, d), GMLP_HALF ** -0.5),
        "kv_norm_g": 1.0 + nrm(ks[13], (d,), 0.02),
        "kv_ada_w": nrm(ks[14], (d, 2 * d), d ** -0.5),
        "kv_ada_b": nrm(ks[15], (2 * d,), 0.02),
        "w_kv": nrm(ks[16], (d, 2 * d), d ** -0.5),
        "k_norm_g": 1.0 + nrm(ks[17], (HEAD_DIM,), 0.02),
        "w_f": nrm(ks[18], (d, N_HEADS), 0.1 * d ** -0.5),
        "b_f": jax.random.uniform(ks[19], (N_HEADS,), f32, 0.5, 5.0),
        "attn_wq": nrm(ks[20], (N_B_LAYERS, d, d), d ** -0.5),
        "q_norm_g": 1.0 + nrm(ks[21], (N_B_LAYERS, HEAD_DIM), 0.02),
        "attn_wo": nrm(ks[22], (N_B_LAYERS, d, d), d ** -0.5),
    }


def reference(x, c, ada_w, ada_b, norm_g, mlp_w1, mlp_w2, gmlp_w_in, gmlp_ln_g,
              gmlp_ln_b, gmlp_ws, gmlp_bs, gmlp_w_out, kv_norm_g, kv_ada_w, kv_ada_b,
              w_kv, k_norm_g, w_f, b_f, attn_wq, q_norm_g, attn_wo):
    sc = jax.nn.silu(c)
    k = v = fcum = None
    for layer in range(DEPTH):
        mod = sc @ ada_w[layer] + ada_b[layer]
        sh1, sc1, g1, sh2, sc2, g2 = jnp.split(mod, N_MOD, axis=-1)
        h = modulate(rms_norm(x, norm_g[layer, 0]), sh1, sc1)
        if layer < N_A_LAYERS:
            a = layer
            y = gmlp_mixer(h, gmlp_w_in[a], gmlp_ln_g[a], gmlp_ln_b[a],
                           gmlp_ws[a], gmlp_bs[a], gmlp_w_out[a])
        else:
            if layer == N_A_LAYERS:
                k, v, fcum = shared_kv(x, sc, kv_norm_g, kv_ada_w, kv_ada_b,
                                       w_kv, k_norm_g, w_f, b_f)
            bl = layer - N_A_LAYERS
            y = attention_mixer(h, k, v, fcum, attn_wq[bl], q_norm_g[bl], attn_wo[bl])
        x = x + g1[:, None, :] * y
        h = modulate(rms_norm(x, norm_g[layer, 1]), sh2, sc2)
        x = x + g2[:, None, :] * squared_relu_mlp(h, mlp_w1[layer], mlp_w2[layer])
    return x
```

```cpp
#include <hip/hip_runtime.h>
#include <cstdio>
#include <cstdint>

namespace pg8 {
#define PG8_LAS __attribute__((address_space(3)))
typedef unsigned short bf16_t;
typedef short bf16x8 __attribute__((ext_vector_type(8)));
typedef float f32x4 __attribute__((ext_vector_type(4)));
typedef unsigned u32x4 __attribute__((ext_vector_type(4)));
constexpr int BM = 256, BK = 64, HALF = 128, HTB = HALF * BK * 2  , STAGE_BYTES = 8 * HTB, NXCD = 8, WGM = 8;

__host__ __device__ __forceinline__ int lds_byte(int r, int c) { const int st = (r >> 4) * 2 + (c >> 5), rr = r & 15, cc = c & 31, ob = rr * 64 + cc * 2; return st * 1024 + (ob ^ (((ob >> 9) & 1) << 5)); }
__host__ __device__ __forceinline__ void stage_rc(int b, int& R, int& C) { const int st = b / 1024, sb = b % 1024, swz = sb ^ (((sb >> 9) & 1) << 5); R = (st >> 1) * 16 + swz / 64; C = (st & 1) * 32 + (swz % 64) / 2; }
__host__ __device__ __forceinline__ int perm32(int rho) { const int n = rho >> 4, i = rho & 15; return 8 * (i >> 2) + 4 * n + (i & 3); }

struct Unit { int pm, pn; };
struct Gemm { const bf16_t* A; const bf16_t* Bt; int M, N, K; };

struct StaticOrder {
    int nM, nN, nwg, G, c;
    __host__ __device__ void init(int M, int N, int G_, int c_) { nM = M / BM; nN = N / BM; nwg = nM * nN; G = G_; c = c_; }
    __host__ __device__ bool next(int i, Unit& u) const {
        const long L = (long)i * G + c; if (L >= nwg) return false;
        int wgid = (int)L; { const int q = nwg / NXCD, r = nwg % NXCD, xcd = wgid % NXCD, off = wgid / NXCD; wgid = (xcd < r ? xcd * (q + 1) : r * (q + 1) + (xcd - r) * q) + off; }
        const int nig = WGM * nN, gid = wgid / nig, fm = gid * WGM, gsz = (nM - fm) < WGM ? (nM - fm) : WGM;
        u.pm = fm + ((wgid % nig) % gsz); u.pn = (wgid % nig) / gsz; return true;
    }
    __device__ __forceinline__ void a_ready(const Unit&) const {}
    __device__ __forceinline__ void done(const Unit&) const {}
};

__device__ __forceinline__ unsigned cvt_pk_bf16(float lo, float hi) { unsigned r; asm volatile("v_cvt_pk_bf16_f32 %0, %1, %2" : "=v"(r) : "v"(lo), "v"(hi)); return r; }
typedef float f32x2 __attribute__((ext_vector_type(2)));
__device__ __forceinline__ f32x2 gelu_pk(f32x2 v) {
    const f32x2 av = __builtin_elementwise_abs(v), d = av * 0.2316418882f + 1.0f;
    f32x2 t; t.x = __builtin_amdgcn_rcpf(d.x); t.y = __builtin_amdgcn_rcpf(d.y);
    f32x2 q = t * 0.5307027145f + (-0.7265760135f); q = q * t + 0.7107068705f; q = q * t + (-0.142248368f); q = q * t + 0.127414796f; q = q * t;
    const f32x2 s = (v * v) * (-0.72134752044f);
    f32x2 e; e.x = __builtin_amdgcn_exp2f(s.x); e.y = __builtin_amdgcn_exp2f(s.y);
    const f32x2 m = v * (q * e), r = v - m;
    f32x2 o; o.x = v.x < 0.f ? m.x : r.x; o.y = v.y < 0.f ? m.y : r.y; return o;
}


typedef float f32x2v __attribute__((ext_vector_type(2)));
template <int ACT, bool VSTAT> struct EpiBf16 {
    static constexpr bool PERM = true, AFTER_DRAIN = false;
    bf16_t* O; int ldc; int split_cols; size_t split_stride; f32x2v* vstat; int Mrows;
    __device__ __forceinline__ void operator()(const f32x4 (&acc)[2][2][4][2], const Unit& u, int wr, int wc, int fr, int fq) const {
        const int row0 = u.pm * BM + wr * 64 + fr; int colt = u.pn * BM; bf16_t* base = O; int t = 0;
        if (split_cols) { t = colt / split_cols; base += (size_t)t * split_stride; colt -= t * split_cols; }
        const int col0 = colt + wc * 32 + 8 * fq;
#pragma unroll
        for (int ai = 0; ai < 2; ++ai)
#pragma unroll
            for (int m = 0; m < 4; ++m) { const int row = row0 + ai * HALF + m * 16; bf16_t* rowp = base + (size_t)row * ldc + col0;
                float s = 0.f, ss = 0.f;
#pragma unroll
                for (int bj = 0; bj < 2; ++bj) { f32x4 v0 = acc[ai][bj][m][0], v1 = acc[ai][bj][m][1];
                    if (ACT == 1) { f32x2 a = gelu_pk((f32x2){v0[0], v0[1]}), b = gelu_pk((f32x2){v0[2], v0[3]}), c = gelu_pk((f32x2){v1[0], v1[1]}), d = gelu_pk((f32x2){v1[2], v1[3]});
                        v0 = (f32x4){a.x, a.y, b.x, b.y}; v1 = (f32x4){c.x, c.y, d.x, d.y}; }
                    if (ACT == 2) {
#pragma unroll
                        for (int e = 0; e < 4; ++e) { const float a = fmaxf(v0[e], 0.f), b = fmaxf(v1[e], 0.f); v0[e] = a * a; v1[e] = b * b; } }
                    if (VSTAT) { s += ((v0[0] + v0[1]) + (v0[2] + v0[3])) + ((v1[0] + v1[1]) + (v1[2] + v1[3]));
                        ss += ((v0[0] * v0[0] + v0[1] * v0[1]) + (v0[2] * v0[2] + v0[3] * v0[3])) + ((v1[0] * v1[0] + v1[1] * v1[1]) + (v1[2] * v1[2] + v1[3] * v1[3])); }
                    u32x4 w; w.x = cvt_pk_bf16(v0[0], v0[1]); w.y = cvt_pk_bf16(v0[2], v0[3]); w.z = cvt_pk_bf16(v1[0], v1[1]); w.w = cvt_pk_bf16(v1[2], v1[3]);
                    *(u32x4*)(rowp + bj * HALF) = w; }
                if (VSTAT) { if (t == 1) { s += __shfl_xor(s, 16); s += __shfl_xor(s, 32); ss += __shfl_xor(ss, 16); ss += __shfl_xor(ss, 32);
                    if (fq == 0) vstat[(size_t)((colt >> 8) * 4 + wc) * Mrows + row] = (f32x2v){s, ss}; } } }
    }
};
struct EpiResid {
    static constexpr bool PERM = false, AFTER_DRAIN = false;
    const float* base; float* out; int ldc; const float* gate; int gstride; int tiles_per_batch;
    __device__ __forceinline__ void operator()(const f32x4 (&acc)[2][2][4][2], const Unit& u, int wr, int wc, int fr, int fq) const {
        const int col0 = u.pn * BM + wc * 32 + 4 * fq; const float* g = gate + (size_t)(u.pm / tiles_per_batch) * gstride + col0;
        f32x4 gv[2][2];
#pragma unroll
        for (int bj = 0; bj < 2; ++bj)
#pragma unroll
            for (int n = 0; n < 2; ++n) gv[bj][n] = *(const f32x4*)(g + bj * HALF + n * 16);
#pragma unroll
        for (int ai = 0; ai < 2; ++ai)
#pragma unroll
            for (int m = 0; m < 4; ++m) { const size_t off = (size_t)(u.pm * BM + ai * HALF + wr * 64 + m * 16 + fr) * ldc + col0;
#pragma unroll
                for (int bj = 0; bj < 2; ++bj)
#pragma unroll
                    for (int n = 0; n < 2; ++n) { const f32x4 bs = *(const f32x4*)(base + off + bj * HALF + n * 16); const f32x4 o = bs + gv[bj][n] * acc[ai][bj][m][n];
                        *(f32x4*)(out + off + bj * HALF + n * 16) = o; }
                if (m & 1) asm volatile("" ::: "memory"); }
    }
};


template <class Epi, class Sched, bool ALIGN_EPI = false, bool SP2 = false>
__device__ __forceinline__ void gemm_phase(PG8_LAS unsigned char* lds, const Gemm g, const Sched& S, const Epi& E) {
    int tid_ = threadIdx.x; asm volatile("" : "+v"(tid_));
    const int tid = tid_, wid = __builtin_amdgcn_readfirstlane(tid >> 6), lane = tid & 63, wr = wid >> 2, wc = wid & 3, fr = lane & 15, fq = lane >> 4;
    const int K = g.K, nt = K / BK;
    unsigned voffA[2], voffB[2];
#pragma unroll
    for (int i = 0; i < 2; ++i) { int R, C; stage_rc(tid * 16 + i * 8192, R, C); const int Rb = Epi::PERM ? ((R & ~31) + perm32(R & 31)) : R;
        voffA[i] = (unsigned)(R * K + C) * 2u; voffB[i] = (unsigned)(Rb * K + C) * 2u; }
    const size_t kstep = (size_t)(BK * 2);
    const size_t hstep = (size_t)HALF * K * 2;
    const size_t tstep = 2 * hstep;
    const unsigned ldsw = (unsigned)wid * 1024u;
    const int aoff = lds_byte(wr * 64 + fr, fq * 8), boff = lds_byte(wc * 32 + fr, fq * 8);
#define PG8_SA(b, h) (((b) * 2 + (h)) * HTB)
#define PG8_SB(b, h) ((4 + (b) * 2 + (h)) * HTB)
#define PG8_STAGE(bufoff, gbase, voff) do { _Pragma("unroll") for (int _i = 0; _i < 2; ++_i) \
        __builtin_amdgcn_global_load_lds((const unsigned*)((const char*)(gbase) + (voff)[_i]), (PG8_LAS unsigned*)(lds + (bufoff) + ldsw + _i * 8192), 16, 0, 0); } while (0)
#define PG8_LDA(dst, b, h) do { _Pragma("unroll") for (int m = 0; m < 4; ++m) _Pragma("unroll") for (int k = 0; k < 2; ++k) dst[m][k] = *(const PG8_LAS bf16x8*)(lds + PG8_SA(b, h) + aoff + m * 2048 + k * 1024); } while (0)
#define PG8_LDB(dst, b, h) do { _Pragma("unroll") for (int n = 0; n < 2; ++n) _Pragma("unroll") for (int k = 0; k < 2; ++k) dst[n][k] = *(const PG8_LAS bf16x8*)(lds + PG8_SB(b, h) + boff + n * 2048 + k * 1024); } while (0)
#define PG8_MMA(ai, bj, At, Bt) do { __builtin_amdgcn_s_setprio(1); _Pragma("unroll") for (int m = 0; m < 4; ++m) _Pragma("unroll") for (int n = 0; n < 2; ++n) _Pragma("unroll") for (int k = 0; k < 2; ++k) \
        acc[ai][bj][m][n] = __builtin_amdgcn_mfma_f32_16x16x32_bf16(Bt[n][k], At[m][k], acc[ai][bj][m][n], 0, 0, 0); __builtin_amdgcn_s_setprio(0); } while (0)
#define PG8_WAIT_V(n) asm volatile("s_waitcnt vmcnt(" #n ")" ::: "memory")
#define PG8_WAIT_L(n) asm volatile("s_waitcnt lgkmcnt(" #n ")" ::: "memory")
#define PG8_BAR __builtin_amdgcn_s_barrier()
#define PG8_SCHED __builtin_amdgcn_sched_barrier(0)
    Unit cur, nxt; int ui = 0;
    if (!S.next(0, cur)) return;
    f32x4 acc[2][2][4][2];
#pragma unroll
    for (int a = 0; a < 2; ++a)
#pragma unroll
        for (int b = 0; b < 2; ++b)
#pragma unroll
            for (int m = 0; m < 4; ++m)
#pragma unroll
                for (int n = 0; n < 2; ++n) acc[a][b][m][n] = (f32x4){0.f, 0.f, 0.f, 0.f};
    bf16x8 At[4][2], B0[2][2], B1[2][2];
    const char* cA = (const char*)g.A + (size_t)cur.pm * tstep; const char* cB = (const char*)g.Bt + (size_t)cur.pn * tstep;
    S.a_ready(cur);
    if constexpr (SP2) {
        PG8_STAGE(PG8_SB(0, 0), cB, voffB); PG8_STAGE(PG8_SB(0, 1), cB + hstep, voffB); PG8_STAGE(PG8_SA(0, 0), cA, voffA); PG8_STAGE(PG8_SA(0, 1), cA + hstep, voffA);
        if (wr == 1) PG8_BAR;
        PG8_WAIT_V(2); PG8_BAR;
        PG8_STAGE(PG8_SB(1, 0), cB + kstep, voffB); PG8_STAGE(PG8_SA(1, 0), cA + kstep, voffA); PG8_STAGE(PG8_SB(1, 1), cB + hstep + kstep, voffB);
        PG8_WAIT_V(6); PG8_BAR;
    } else {
        PG8_STAGE(PG8_SB(0, 0), cB, voffB); PG8_STAGE(PG8_SA(0, 0), cA, voffA); PG8_STAGE(PG8_SB(0, 1), cB + hstep, voffB); PG8_STAGE(PG8_SA(0, 1), cA + hstep, voffA);
        if (wr == 1) PG8_BAR;
        PG8_WAIT_V(4); PG8_BAR;
        PG8_STAGE(PG8_SB(1, 0), cB + kstep, voffB); PG8_STAGE(PG8_SA(1, 0), cA + kstep, voffA); PG8_STAGE(PG8_SB(1, 1), cB + hstep + kstep, voffB);
        PG8_WAIT_V(6); PG8_BAR;
    }
    for (;;) {
        const bool has_next = S.next(ui + 1, nxt);
        const char* nA = has_next ? (const char*)g.A + (size_t)nxt.pm * tstep : cA; const char* nB = has_next ? (const char*)g.Bt + (size_t)nxt.pn * tstep : cB;
        for (int t = 0; t < nt; t += 2) {
            const bool last = (t == nt - 2);
            const char* a1 = cA + (size_t)(t + 1) * kstep;
            const char* a2 = last ? nA : cA + (size_t)(t + 2) * kstep; const char* b2 = last ? nB : cB + (size_t)(t + 2) * kstep;
            const char* a3 = a2 + kstep; const char* b3 = b2 + kstep;
            if (last && has_next) S.a_ready(nxt);
            if constexpr (SP2) {
            PG8_LDB(B0, 0, 0); PG8_LDB(B1, 0, 1); PG8_SCHED; PG8_LDA(At, 0, 0); PG8_STAGE(PG8_SA(1, 1), a1 + hstep, voffA);
            PG8_WAIT_V(8); PG8_WAIT_L(0); PG8_BAR; PG8_MMA(0, 0, At, B0); PG8_MMA(0, 1, At, B1); PG8_BAR; PG8_SCHED;
            PG8_LDA(At, 0, 1); PG8_STAGE(PG8_SB(0, 0), b2, voffB); PG8_STAGE(PG8_SB(0, 1), b2 + hstep, voffB); PG8_STAGE(PG8_SA(0, 0), a2, voffA);
            PG8_WAIT_V(8); PG8_WAIT_L(0); PG8_BAR; PG8_MMA(1, 0, At, B0); PG8_MMA(1, 1, At, B1); PG8_BAR; PG8_SCHED;
            PG8_LDB(B0, 1, 0); PG8_LDB(B1, 1, 1); PG8_SCHED; PG8_LDA(At, 1, 0); PG8_STAGE(PG8_SA(0, 1), a2 + hstep, voffA);
            PG8_WAIT_V(8); PG8_WAIT_L(0); PG8_BAR; PG8_MMA(0, 0, At, B0); PG8_MMA(0, 1, At, B1); PG8_BAR; PG8_SCHED;
            PG8_LDA(At, 1, 1); PG8_STAGE(PG8_SB(1, 0), b3, voffB); PG8_STAGE(PG8_SB(1, 1), b3 + hstep, voffB); PG8_STAGE(PG8_SA(1, 0), a3, voffA);
            PG8_WAIT_V(8); PG8_WAIT_L(0); PG8_BAR; PG8_MMA(1, 0, At, B0); PG8_MMA(1, 1, At, B1); PG8_BAR; PG8_SCHED;
            } else {
            PG8_LDB(B0, 0, 0); PG8_SCHED; PG8_LDA(At, 0, 0); PG8_STAGE(PG8_SA(1, 1), a1 + hstep, voffA);
            PG8_WAIT_L(8); PG8_BAR; PG8_WAIT_L(0); PG8_MMA(0, 0, At, B0); PG8_BAR; PG8_SCHED;
            PG8_LDB(B1, 0, 1); PG8_STAGE(PG8_SB(0, 0), b2, voffB);
            PG8_BAR; PG8_WAIT_L(0); PG8_MMA(0, 1, At, B1); PG8_BAR;
            PG8_LDA(At, 0, 1); PG8_STAGE(PG8_SA(0, 0), a2, voffA);
            PG8_BAR; PG8_WAIT_L(0); PG8_MMA(1, 0, At, B0); PG8_BAR; PG8_SCHED;
            PG8_STAGE(PG8_SB(0, 1), b2 + hstep, voffB);
            PG8_WAIT_V(6); PG8_BAR; PG8_MMA(1, 1, At, B1); PG8_BAR;
            PG8_LDB(B0, 1, 0); PG8_SCHED; PG8_LDA(At, 1, 0); PG8_STAGE(PG8_SA(0, 1), a2 + hstep, voffA);
            PG8_WAIT_L(8); PG8_BAR; PG8_WAIT_L(0); PG8_MMA(0, 0, At, B0); PG8_BAR; PG8_SCHED;
            PG8_LDB(B1, 1, 1); PG8_STAGE(PG8_SB(1, 0), b3, voffB);
            PG8_BAR; PG8_WAIT_L(0); PG8_MMA(0, 1, At, B1); PG8_BAR;
            PG8_LDA(At, 1, 1); PG8_STAGE(PG8_SA(1, 0), a3, voffA);
            PG8_BAR; PG8_WAIT_L(0); PG8_MMA(1, 0, At, B0); PG8_BAR; PG8_SCHED;
            PG8_STAGE(PG8_SB(1, 1), b3 + hstep, voffB);
            PG8_WAIT_V(6); PG8_BAR; PG8_MMA(1, 1, At, B1); PG8_BAR;
            }
        }
        if constexpr (ALIGN_EPI) { if (wr == 0) PG8_BAR; }
        if constexpr (!Epi::AFTER_DRAIN) { E(acc, cur, wr, wc, fr, fq); S.done(cur); }
        if (!has_next) break;
#pragma unroll
        for (int a = 0; a < 2; ++a)
#pragma unroll
            for (int b = 0; b < 2; ++b)
#pragma unroll
                for (int m = 0; m < 4; ++m)
#pragma unroll
                    for (int n = 0; n < 2; ++n) acc[a][b][m][n] = (f32x4){0.f, 0.f, 0.f, 0.f};
        cur = nxt; cA = nA; cB = nB; ++ui;
        if constexpr (ALIGN_EPI) { if (wr == 1) PG8_BAR; }
    }
    PG8_WAIT_V(0);
    if constexpr (!ALIGN_EPI) { if (wr == 0) PG8_BAR; }
    PG8_BAR;
    if constexpr (Epi::AFTER_DRAIN) { E.fused(acc, cur, wr, wc, fr, fq, lds, wid, lane); S.done(cur); }
#undef PG8_SA
#undef PG8_SB
#undef PG8_STAGE
#undef PG8_LDA
#undef PG8_LDB
#undef PG8_MMA
#undef PG8_WAIT_V
#undef PG8_WAIT_L
#undef PG8_BAR
#undef PG8_SCHED
}
}

namespace att {
typedef unsigned short bf16;
typedef short bf16x8 __attribute__((ext_vector_type(8)));
typedef short s16x4 __attribute__((ext_vector_type(4)));
typedef float f32x16 __attribute__((ext_vector_type(16)));
typedef float f32x4 __attribute__((ext_vector_type(4)));
typedef unsigned u32x4 __attribute__((ext_vector_type(4)));
typedef unsigned u32x2 __attribute__((ext_vector_type(2)));
constexpr int D = 128, PITCH = 2048, SEQ = 4096, NH = 16, NB = 8;
constexpr float THR = 8.f;
constexpr float SCALE = 0.08838834764831845f;
constexpr float INV_SCALE = 11.313708498984761f;
constexpr int NW = 8, QBLK = 32, KVBLK = 64, QB = NW * QBLK;
constexpr int SHM_V = KVBLK * D * 2, SHM_K = KVBLK * D * 2;
constexpr int LDS_WS = 2 * SHM_V + 2 * SHM_K;
constexpr int LDS_FB = LDS_WS + NW * 64 * 4;
constexpr int LDS_BYTES = LDS_FB + SEQ * 8;
constexpr int W = 1 << 30;

#define KSWZ(row, colB) ((row) * 256 + ((colB) ^ (((row) & 7) << 4)))
#define SBAR() __builtin_amdgcn_sched_barrier(0)
__device__ __forceinline__ int v_st(int k, int c) { const int kk = (k & ~0xC) | ((k & 4) << 1) | ((k & 8) >> 1); return ((kk >> 3) * 4 + (c >> 5)) * 512 + ((kk & 7) * 32 + (c & 31)) * 2; }
__device__ __forceinline__ int v_rd_base(int lane) { return ((lane & 3) << 3) | (((lane >> 2) & 3) << 6) | (((lane >> 4) & 1) << 5) | (((lane >> 5) & 1) << 8); }
constexpr int v_rd_off(int d0, int ks, int half) { return d0 * 512 + ks * 4096 + half * 2048; }
__device__ __forceinline__ int crow(int r, int hi) { return (r & 3) + 8 * (r >> 2) + 4 * hi; }
__device__ __forceinline__ unsigned cvtpk(float lo, float hi) { unsigned r; asm volatile("v_cvt_pk_bf16_f32 %0, %1, %2" : "=v"(r) : "v"(lo), "v"(hi)); return r; }
__device__ __forceinline__ bf16x8 load8(const bf16* p) { return *reinterpret_cast<const bf16x8*>(p); }
__device__ __forceinline__ void mask_tile(f32x16& p0, f32x16& p1, int dq, unsigned Wm) {
    const float NEG = -__builtin_inff();
#pragma unroll
    for (int r = 0; r < 16; ++r) {
        const int c = (r & 3) + 8 * (r >> 2);
        if ((unsigned)(dq - c) >= Wm) p0[r] = NEG;
        if ((unsigned)(dq - c - 32) >= Wm) p1[r] = NEG;
    }
}
__device__ __forceinline__ void partialSM(f32x16& p0, f32x16& p1, float& m_reg, float& mn, float& alpha) {
    float pmax = p0[0]; for (int r = 1; r < 16; ++r) pmax = fmaxf(pmax, p0[r]); for (int r = 0; r < 16; ++r) pmax = fmaxf(pmax, p1[r]);
    { auto rr = __builtin_amdgcn_permlane32_swap(__float_as_uint(pmax), __float_as_uint(pmax), false, false);
      pmax = fmaxf(__uint_as_float(rr[0]), __uint_as_float(rr[1])); }
    constexpr float C2 = 1.4426950408889634f * SCALE;
    if (__builtin_expect(__all((pmax - m_reg) * SCALE <= THR), 1)) { mn = m_reg; alpha = 1.f; }
    else { mn = fmaxf(m_reg, pmax); alpha = __builtin_amdgcn_exp2f((m_reg - mn) * C2); m_reg = mn; }
    const float mnL = -mn * C2;
    for (int r = 0; r < 16; ++r) p0[r] = fmaf(p0[r], C2, mnL); for (int r = 0; r < 16; ++r) p1[r] = fmaf(p1[r], C2, mnL);
    for (int r = 0; r < 16; ++r) p0[r] = __builtin_amdgcn_exp2f(p0[r]);
}
__device__ __forceinline__ void finishSM(f32x16& p0, f32x16& p1, float alpha, float& l_reg, bf16x8& pa0, bf16x8& pa1, bf16x8& pa2, bf16x8& pa3) {
    for (int r = 0; r < 16; ++r) p1[r] = __builtin_amdgcn_exp2f(p1[r]);
    float ps = 0; for (int r = 0; r < 16; ++r) ps += p0[r]; for (int r = 0; r < 16; ++r) ps += p1[r];
    { auto rr = __builtin_amdgcn_permlane32_swap(__float_as_uint(ps), __float_as_uint(ps), false, false);
      ps = __uint_as_float(rr[0]) + __uint_as_float(rr[1]); }
    l_reg = l_reg * alpha + ps;
#define PK4(P, B_, OUT) do { unsigned a0 = cvtpk(P[B_+0], P[B_+1]), a1 = cvtpk(P[B_+2], P[B_+3]);                          \
        unsigned b0 = cvtpk(P[B_+4], P[B_+5]), b1 = cvtpk(P[B_+6], P[B_+7]);                                             \
        auto r0 = __builtin_amdgcn_permlane32_swap(a0, b0, false, false); auto r1 = __builtin_amdgcn_permlane32_swap(a1, b1, false, false); \
        u32x4 w = {r0[0], r1[0], r0[1], r1[1]}; OUT = *reinterpret_cast<bf16x8*>(&w); } while (0)
    PK4(p0, 0, pa0); PK4(p0, 8, pa1); PK4(p1, 0, pa2); PK4(p1, 8, pa3);
#undef PK4
}
template <int KB>
__device__ __forceinline__ void qkt(f32x16& p0, f32x16& p1, const char* K_lds, int r32, int hi, const bf16x8* qr, const char* fb, bf16x8 ones) {
    p0 = f32x16{}; p1 = f32x16{};
    const char* kb[4];
#pragma unroll
    for (int dd = 0; dd < 4; ++dd) kb[dd] = K_lds + KB * SHM_K + KSWZ(r32, (dd * 16 + hi * 8) * 2);
#pragma unroll
    for (int d0 = 0; d0 < 8; ++d0) { const char* a = kb[d0 & 3] + (d0 >> 2) * 128;
        bf16x8 b0 = *reinterpret_cast<const bf16x8*>(a);
        bf16x8 b1 = *reinterpret_cast<const bf16x8*>(a + 32 * 256);
        p0 = __builtin_amdgcn_mfma_f32_32x32x16_bf16(b0, qr[d0], p0, 0, 0, 0);
        p1 = __builtin_amdgcn_mfma_f32_32x32x16_bf16(b1, qr[d0], p1, 0, 0, 0); }
    { const u32x2 t0 = *reinterpret_cast<const u32x2*>(fb), t1 = *reinterpret_cast<const u32x2*>(fb + 32 * 8);
      u32x4 w0 = {t0.x, t0.y, 0u, 0u}, w1 = {t1.x, t1.y, 0u, 0u};
      p0 = __builtin_amdgcn_mfma_f32_32x32x16_bf16(*reinterpret_cast<bf16x8*>(&w0), ones, p0, 0, 0, 0);
      p1 = __builtin_amdgcn_mfma_f32_32x32x16_bf16(*reinterpret_cast<bf16x8*>(&w1), ones, p1, 0, 0, 0); }
}
template <int VB>
__device__ __forceinline__ void pv_tile(f32x16* o, int vb0, bf16x8 pa0, bf16x8 pa1, bf16x8 pa2, bf16x8 pa3) {
#define TRRD(dst, off) asm volatile("ds_read_b64_tr_b16 %0, %1 offset:%2" : "=&v"(dst) : "v"(vb0), "i"(off) : "memory")
#define PV_D0(d0) do { s16x4 l0, l1, l2, l3, h0, h1, h2, h3; constexpr int b_ = VB * SHM_V + v_rd_off(d0, 0, 0); \
        TRRD(l0, b_); TRRD(h0, b_ + 2048); TRRD(l1, b_ + 4096); TRRD(h1, b_ + 6144); TRRD(l2, b_ + 8192); TRRD(h2, b_ + 10240); TRRD(l3, b_ + 12288); TRRD(h3, b_ + 14336); \
        asm volatile("s_waitcnt lgkmcnt(0)" ::: "memory"); SBAR();   \
        o[d0] = __builtin_amdgcn_mfma_f32_32x32x16_bf16(pa0, (bf16x8){l0[0], l0[1], l0[2], l0[3], h0[0], h0[1], h0[2], h0[3]}, o[d0], 0, 0, 0);   \
        o[d0] = __builtin_amdgcn_mfma_f32_32x32x16_bf16(pa1, (bf16x8){l1[0], l1[1], l1[2], l1[3], h1[0], h1[1], h1[2], h1[3]}, o[d0], 0, 0, 0);   \
        o[d0] = __builtin_amdgcn_mfma_f32_32x32x16_bf16(pa2, (bf16x8){l2[0], l2[1], l2[2], l2[3], h2[0], h2[1], h2[2], h2[3]}, o[d0], 0, 0, 0);   \
        o[d0] = __builtin_amdgcn_mfma_f32_32x32x16_bf16(pa3, (bf16x8){l3[0], l3[1], l3[2], l3[3], h3[0], h3[1], h3[2], h3[3]}, o[d0], 0, 0, 0); } while (0)
    PV_D0(0); PV_D0(1); PV_D0(2); PV_D0(3);
#undef PV_D0
#undef TRRD
}
struct BlockRef { const bf16* Q; const bf16* K; const bf16* V; bf16* O; int P0; };
struct Seam { bf16x8 qr[8]; bf16x8 st_v0, st_v1, st_k0, st_k1; };
#define ROW(p, k0, rr) ((p) + (size_t)((k0) + (rr)) * PITCH + sc)
#define VMW() asm volatile("s_waitcnt vmcnt(0)" ::: "memory")
#define VMWN(n) asm volatile("s_waitcnt vmcnt(%0)" :: "i"(n) : "memory")
#define SLOAD_H(Kp, Vp, k0) do { S.st_v0 = load8(ROW(Vp, k0, sr)); S.st_v1 = load8(ROW(Vp, k0, 32 + sr));              \
                         S.st_k0 = load8(ROW(Kp, k0, sr)); S.st_k1 = load8(ROW(Kp, k0, 32 + sr)); } while (0)
#define SWRITE_HK(bf) do { *(bf16x8*)(K_lds + (bf) * SHM_K + kws) = S.st_k0; *(bf16x8*)(K_lds + (bf) * SHM_K + kws + 32 * 256) = S.st_k1; } while (0)
#define SWRITE_HV(bf) do { *(bf16x8*)(V_lds + (bf) * SHM_V + vst0) = S.st_v0; *(bf16x8*)(V_lds + (bf) * SHM_V + vst1) = S.st_v1; } while (0)
#define SWRITE_H(bf) do { SWRITE_HV(bf); SWRITE_HK(bf); } while (0)
__device__ __forceinline__ void prime(const BlockRef& cur, char* lds, Seam& S) {
    int tid_ = threadIdx.x; asm volatile("" : "+v"(tid_));
    const int tid = tid_, wid = __builtin_amdgcn_readfirstlane(tid >> 6), lane = tid & 63, r32 = lane & 31, hi = lane >> 5;
    const int sr = tid >> 4, sc = (tid & 15) * 8, kws = KSWZ(sr, sc * 2); char* K_lds = lds + 2 * SHM_V;
    for (int d0 = 0; d0 < 8; ++d0) S.qr[d0] = load8(cur.Q + (size_t)(wid * QBLK + r32) * PITCH + d0 * 16 + hi * 8);
    SLOAD_H(cur.K, cur.V, 0); VMW(); SWRITE_HK(0);
    __syncthreads();
}
__device__ __forceinline__ void block(const BlockRef& cur, const BlockRef& nxt, const float* Fcum, char* lds, Seam& S) {
    int tid_ = threadIdx.x; asm volatile("" : "+v"(tid_));
    const int tid = tid_, wid = __builtin_amdgcn_readfirstlane(tid >> 6), lane = tid & 63, r32 = lane & 31, hi = lane >> 5;
    const int NT = cur.P0 / KVBLK + 4;
    const int qlo = cur.P0 + wid * QBLK, qm = qlo + r32 - 4 * hi;
    char* V_lds = lds; char* K_lds = lds + 2 * SHM_V;
    float* ws = (float*)(lds + LDS_WS) + wid * 64; float* li_l = ws, * al_l = ws + 32;
    const char* FBl = lds + LDS_FB + r32 * 8;
    if (Fcum) {
#pragma unroll
        for (int i = 0; i < SEQ / 512; ++i) { const int s = tid + 512 * i; const float x = -Fcum[s] * INV_SCALE;
            const unsigned xh = cvtpk(x, 0.f) & 0xffffu; const float r1 = x - __uint_as_float(xh << 16);
            const unsigned xm = cvtpk(r1, 0.f) & 0xffffu; const float r2 = r1 - __uint_as_float(xm << 16);
            const unsigned xl = cvtpk(r2, 0.f) & 0xffffu;
            *(u32x2*)(lds + LDS_FB + s * 8) = (u32x2){xh | (xm << 16), xl}; }
        __syncthreads();
    }
    u32x4 onesw = {hi == 0 ? 0x3F803F80u : 0u, hi == 0 ? 0x00003F80u : 0u, 0u, 0u};
    const bf16x8 ones = *reinterpret_cast<bf16x8*>(&onesw);
    float m_reg = -1e30f, l_reg = 0; f32x16 o[4] = {};
    const int sr = tid >> 4, sc = (tid & 15) * 8, vst0 = v_st(sr, sc), vst1 = v_st(32 + sr, sc), kws = KSWZ(sr, sc * 2);
    const int vb0 = (int)(uintptr_t)V_lds + v_rd_base(lane);
    const bf16* Kh = cur.K; const bf16* Vh = cur.V;
#define RESC(a) do { if (__any((a) < 1.f)) { if (hi == 0) al_l[r32] = (a); asm volatile("s_waitcnt lgkmcnt(0)" ::: "memory");              \
                     for (int d_ = 0; d_ < 4; ++d_) for (int r = 0; r < 16; ++r) o[d_][r] *= al_l[crow(r, hi)]; } } while (0)
#define KBASE(t) ((t) * KVBLK)
#define MASKT(P0_, P1_, t) do { const int kb_ = KBASE(t); if (kb_ + KVBLK - 1 > qlo) mask_tile(P0_, P1_, qm - kb_, (unsigned)W); } while (0)
    constexpr int NQL = 8;
#define SEAM_K0() do { VMWN(NQL); SWRITE_HK(0); SBAR(); } while (0)
    f32x16 pA0, pA1, pB0, pB1; float mnA, mnB, alA, alB; bf16x8 pa0, pa1, pa2, pa3;
    SWRITE_HV(0); SBAR();
    if (NT > 1) { SLOAD_H(Kh, Vh, KBASE(1)); }
    SBAR(); qkt<0>(pA0, pA1, K_lds, r32, hi, S.qr, FBl + KBASE(0) * 8, ones);
    MASKT(pA0, pA1, 0); partialSM(pA0, pA1, m_reg, mnA, alA);
    if (NT > 1) { VMW(); SWRITE_H(1); }
    __syncthreads();
#define HALF_STEP(PX0, PX1, mnX, alX, PY0, PY1, alY, t, KB, VB, SB) do {                                                      \
        SBAR(); qkt<KB>(PX0, PX1, K_lds, r32, hi, S.qr, FBl + KBASE(t) * 8, ones);                                             \
        finishSM(PY0, PY1, alY, l_reg, pa0, pa1, pa2, pa3); SBAR();                                                           \
        if ((t) + 1 < NT) { SLOAD_H(Kh, Vh, KBASE((t) + 1)); SBAR(); }                                               \
        pv_tile<VB>(o, vb0, pa0, pa1, pa2, pa3); MASKT(PX0, PX1, (t)); partialSM(PX0, PX1, m_reg, mnX, alX);                                        \
        __syncthreads();                                                                                                      \
        if ((t) + 1 < NT) { VMW(); SWRITE_H(SB); }                                                                          \
        RESC(alX); __syncthreads(); } while (0)
    for (int t = 1; t + 1 < NT; t += 2) {
        HALF_STEP(pB0, pB1, mnB, alB, pA0, pA1, alA, t, 1, 0, 0);
        HALF_STEP(pA0, pA1, mnA, alA, pB0, pB1, alB, t + 1, 0, 1, 1);
    }
    const bool even = (NT & 1) == 0;
    if (even) { SBAR(); qkt<1>(pB0, pB1, K_lds, r32, hi, S.qr, FBl + KBASE(NT - 1) * 8, ones); SBAR(); }
    SLOAD_H(nxt.K, nxt.V, 0); SBAR();
#pragma unroll
    for (int d0 = 0; d0 < 8; ++d0) S.qr[d0] = load8(nxt.Q + (size_t)(wid * QBLK + r32) * PITCH + d0 * 16 + hi * 8);
    SBAR();
    finishSM(pA0, pA1, alA, l_reg, pa0, pa1, pa2, pa3); SBAR();
    pv_tile<0>(o, vb0, pa0, pa1, pa2, pa3);
    if (even) { MASKT(pB0, pB1, NT - 1); partialSM(pB0, pB1, m_reg, mnB, alB); __syncthreads(); RESC(alB);
        finishSM(pB0, pB1, alB, l_reg, pa0, pa1, pa2, pa3); SBAR(); pv_tile<1>(o, vb0, pa0, pa1, pa2, pa3); }
    SBAR(); SEAM_K0();
    if (hi == 0) li_l[r32] = l_reg; asm volatile("s_waitcnt lgkmcnt(0)" ::: "memory");
    float rli[16];
#pragma unroll
    for (int r = 0; r < 16; ++r) rli[r] = __builtin_amdgcn_rcpf(li_l[crow(r, hi)]);
    bf16* Ow = cur.O + (size_t)(wid * QBLK) * PITCH;
#pragma unroll
    for (int r = 0; r < 16; ++r) { const int orow = crow(r, hi);
#pragma unroll
        for (int d0 = 0; d0 < 4; ++d0) { const float v = o[d0][r] * rli[r];
            const float vn = __shfl_xor(v, 1);
            if ((r32 & 1) == 0) *(unsigned*)(Ow + (size_t)orow * PITCH + d0 * 32 + r32) = cvtpk(v, vn); } }
    __syncthreads();
#undef RESC
#undef KBASE
#undef MASKT
#undef SEAM_K0
#undef HALF_STEP
}
#undef ROW
#undef VMW
#undef VMWN
#undef SLOAD_H
#undef SWRITE_HK
#undef SWRITE_HV
#undef SWRITE_H
}


constexpr int NWAVES = 8;
#ifndef MK_N_LAUNCHES
#define MK_N_LAUNCHES 1
#endif
constexpr int BATCH = 8, SEQ = 4096, D = 2048, M = BATCH * SEQ, DEPTH = 4, NA = 2;
constexpr int GH = 3 * D  , GN = 2 * GH  , NG = 8, GD = GH / NG  , GB = 128;
constexpr int NH = 16, HD = 128, FF = 4 * D, NMOD = 6 * D;
constexpr float EPS = 1e-6f;
constexpr size_t MiB = 1u << 20;
constexpr size_t WS_CTL = 0, CTL_ZERO_BYTES = 1 * MiB;
constexpr size_t WS_MOD = 1 * MiB;
constexpr size_t WS_KVMOD = WS_MOD + (size_t)DEPTH * BATCH * NMOD * 4;
constexpr size_t WS_WSM = 3 * MiB;
constexpr size_t WS_LOGF = 4 * MiB, WS_FB = 6 * MiB;
constexpr size_t WS_VSTAT = 8 * MiB;
constexpr size_t WS_WT = 40 * MiB;
constexpr size_t WT_WIN = 0, WT_WOUT = WT_WIN + (size_t)2 * GN * D, WT_W1 = WT_WOUT + (size_t)2 * D * GH, WT_W2 = WT_W1 + (size_t)4 * FF * D,
                 WT_WKV = WT_W2 + (size_t)4 * D * FF, WT_WQ = WT_WKV + (size_t)2 * D * D, WT_WO = WT_WQ + (size_t)2 * D * D, WT_END = WT_WO + (size_t)2 * D * D;
static_assert(WT_END * 2 == 448 * MiB, "weights");
constexpr size_t WS_H = 488 * MiB;
constexpr size_t WS_Z = 616 * MiB;
constexpr size_t WS_U = WS_Z, WS_V = WS_Z + 384 * MiB;
constexpr size_t WS_HID = WS_Z;
constexpr size_t WS_Q = WS_Z, WS_O = WS_Z + 128 * MiB, WS_HKV = WS_Z + 256 * MiB, WS_KB = WS_Z + 512 * MiB, WS_VB = WS_Z + 640 * MiB;
constexpr size_t WS_END = WS_Z + 768 * MiB;
constexpr int CW_BAR = 4096;
constexpr int RING_BYTES = 131072, LDSCTL_OFF = RING_BYTES, MISC_OFF = LDSCTL_OFF + 320, LDS_BYTES = 147456;

#define GAS __attribute__((address_space(1)))
#define LAS __attribute__((address_space(3)))
typedef unsigned short bf16;
typedef unsigned v4u __attribute__((ext_vector_type(4)));
typedef unsigned v2u __attribute__((ext_vector_type(2)));
typedef float f32x4 __attribute__((ext_vector_type(4)));
typedef float f32x2 __attribute__((ext_vector_type(2)));
typedef short bf16x8 __attribute__((ext_vector_type(8)));
typedef short s16x4 __attribute__((ext_vector_type(4)));
typedef float f32x16 __attribute__((ext_vector_type(16)));
typedef GAS unsigned gu32;
#define RLX_AGENT __ATOMIC_RELAXED, __HIP_MEMORY_SCOPE_AGENT
#define LDS_WAIT() asm volatile("s_waitcnt lgkmcnt(0)" ::: "memory")
#define VM_WAIT() asm volatile("s_waitcnt vmcnt(0)" ::: "memory")
#define RAW_BAR() do { asm volatile("s_waitcnt lgkmcnt(0)" ::: "memory"); __builtin_amdgcn_s_barrier(); asm volatile("" ::: "memory"); } while (0)
__device__ __forceinline__ unsigned f2bf(float f) { unsigned u = __builtin_bit_cast(unsigned, f); return (u + 0x7fffu + ((u >> 16) & 1u)) >> 16; }
__device__ __forceinline__ unsigned pk2(float lo, float hi) { unsigned r; asm volatile("v_cvt_pk_bf16_f32 %0, %1, %2" : "=v"(r) : "v"(lo), "v"(hi)); return r; }
__device__ __forceinline__ float bflo(unsigned w) { return __uint_as_float(w << 16); }
__device__ __forceinline__ float bfhi(unsigned w) { return __uint_as_float(w & 0xffff0000u); }

#define XB_TMO      128
#define XB_XCNT(j)  (256  + 64 * (j))
#define XB_XSUB(j)  (1280 + 64 * (j))
#define XB_XGEN(j)  (2304 + 64 * (j))
#define XB_TOP      3328
#define XB_TOPGEN   3392
#define XCD_BAR_WORDS 3456
#define XB_SPIN_CAP (1u << 18)
__device__ __forceinline__ unsigned xb_ld(unsigned* p)              { return __hip_atomic_load(p, __ATOMIC_RELAXED, __HIP_MEMORY_SCOPE_AGENT); }
__device__ __forceinline__ unsigned xb_add(unsigned* p, unsigned v) { return __hip_atomic_fetch_add(p, v, __ATOMIC_RELAXED, __HIP_MEMORY_SCOPE_AGENT); }
__device__ __forceinline__ unsigned xb_xcc_id() { return (unsigned)__builtin_amdgcn_s_getreg((3 << 11) | 20) & 0xFu; }
#define XB_SPIN(cond, bar) do { unsigned _sp = 0; while (cond) { __builtin_amdgcn_s_sleep(1); \
    if ((++_sp & 255u) == 0u) { if (xb_ld(&(bar)[XB_TMO])) break; if (_sp > XB_SPIN_CAP) { atomicAdd(&(bar)[XB_TMO], 1u); break; } } } } while (0)
struct XcdBarrier { unsigned* bar; unsigned x; volatile LAS unsigned* st; };
__device__ __forceinline__ XcdBarrier xcd_barrier_post(unsigned* bar, volatile LAS unsigned* st) {
    XcdBarrier b; b.bar = bar; b.x = xb_xcc_id(); b.st = st;
    if (threadIdx.x == 0) (void)xb_add(&bar[XB_XCNT(b.x)], 1u);
    return b;
}
__device__ __forceinline__ void xcd_barrier_complete(unsigned* bar, unsigned x, unsigned& nloc, unsigned& nx) {
    const unsigned G = gridDim.x * gridDim.y * gridDim.z;
    unsigned sum, cnt, mine, sp = 0u;
    for (;;) {
        sum = 0u; cnt = 0u; mine = 0u;
#pragma unroll
        for (unsigned j = 0; j < 16; ++j) { const unsigned c = xb_ld(&bar[XB_XCNT(j)]); sum += c; cnt += (c > 0u) ? 1u : 0u; mine = (j == x) ? c : mine; }
        if (sum == G) break;
        __builtin_amdgcn_s_sleep(1);
        if ((++sp & 255u) == 0u) { if (xb_ld(&bar[XB_TMO])) break; if (sp > XB_SPIN_CAP) { atomicAdd(&bar[XB_TMO], 1u); break; } }
    }
    nloc = mine > 0u ? mine : 1u; nx = cnt > 0u ? cnt : 1u;
}
__device__ __forceinline__ void xcd_barrier(const XcdBarrier& b) {
    asm volatile("s_waitcnt vmcnt(0)" ::: "memory");
    __syncthreads();
    if (threadIdx.x == 0) {
        unsigned* bar = b.bar;
        __builtin_amdgcn_s_waitcnt(0);
        unsigned nloc = b.st[0], nx = b.st[1];
        if (nloc == 0u) { xcd_barrier_complete(bar, b.x, nloc, nx); b.st[0] = nloc; b.st[1] = nx; }
        const unsigned old = xb_add(&bar[XB_XSUB(b.x)], 1u);
        const unsigned gen = old / nloc;
        if (old + 1u == (gen + 1u) * nloc) {
            __builtin_amdgcn_fence(__ATOMIC_RELEASE, "agent");
            asm volatile("s_waitcnt vmcnt(0)" ::: "memory");
            const unsigned og = xb_add(&bar[XB_TOP], 1u);
            const unsigned tg = og / nx;
            if (og + 1u == (tg + 1u) * nx) xb_add(&bar[XB_TOPGEN], 1u);
            else XB_SPIN(xb_ld(&bar[XB_TOPGEN]) == tg, bar);
            __builtin_amdgcn_fence(__ATOMIC_ACQUIRE, "agent");
            xb_add(&bar[XB_XGEN(b.x)], 1u);
            asm volatile("s_waitcnt vmcnt(0)" ::: "memory");
        } else {
            XB_SPIN(xb_ld(&bar[XB_XGEN(b.x)]) == gen, bar);
            __builtin_amdgcn_fence(__ATOMIC_ACQUIRE, "agent");
            asm volatile("s_waitcnt vmcnt(0)" ::: "memory");
        }
    }
    __syncthreads();
}

struct Frame {
    LAS unsigned char* lds;
    int vcu, G;
    unsigned char* ws;
};
#define PHASE_IDS int tid_ = threadIdx.x; asm volatile("" : "+v"(tid_)); const int tid = tid_, lane = tid & 63, wave = __builtin_amdgcn_readfirstlane(tid >> 6); (void)lane; (void)wave;
__device__ __forceinline__ float wave_sum(float v) {
#pragma unroll
    for (int o = 1; o < 64; o <<= 1) v += __shfl_xor(v, o);
    return v;
}
__device__ __forceinline__ void p0_transpose_item(const float* W, int K, int N, bf16* WT, LAS float* scr, int item, int lane) {
    const int nblk = N / 32, kb = item / nblk, nb = item % nblk, k0 = 64 * kb, n0 = 32 * nb;
#pragma unroll 8
    for (int i = 0; i < 32; ++i) { const int kk = 2 * i + (lane >> 5); scr[kk * 33 + (lane & 31)] = W[(size_t)(k0 + kk) * N + n0 + (lane & 31)]; }
    LDS_WAIT(); asm volatile("" ::: "memory");
    const int c = lane & 7;
#pragma unroll
    for (int j = 0; j < 4; ++j) { const int n = (lane >> 3) + 8 * j; const LAS float* s = scr + (8 * c) * 33 + n;
        v4u o; o.x = pk2(s[0 * 33], s[1 * 33]); o.y = pk2(s[2 * 33], s[3 * 33]); o.z = pk2(s[4 * 33], s[5 * 33]); o.w = pk2(s[6 * 33], s[7 * 33]);
        *(GAS v4u*)(WT + (size_t)(n0 + n) * K + k0 + 8 * c) = o; }
    LDS_WAIT(); asm volatile("" ::: "memory");
}

struct Args { const float* in[23]; float* out; unsigned char* ws; int ph_lo, ph_hi, li, pad; };
enum { I_X = 0, I_C, I_ADAW, I_ADAB, I_NORMG, I_W1, I_W2, I_WIN, I_LNG, I_LNB, I_WS, I_BS, I_WOUT, I_KVNG, I_KVADAW, I_KVADAB, I_WKV, I_KNG, I_WF, I_BF, I_WQ, I_QNG, I_WO };

__device__ __forceinline__ void p0_prologue(Frame& F, const Args& a) {
    PHASE_IDS
    bf16* WT = (bf16*)(F.ws + WS_WT);
    const int NSTRIP = DEPTH * (NMOD / 256) + (2 * D) / 256;
    for (int it = blockIdx.x; it < NSTRIP; it += F.G) {
        LAS float* SC = (LAS float*)F.lds;
        LAS float* RED = (LAS float*)(F.lds + 65536);
        const float* c = a.in[I_C];
        for (int i = tid; i < BATCH * D; i += NWAVES * 64) { const int b = i / D, k = i % D; const float x = c[i]; SC[k * 8 + b] = x / (1.f + __expf(-x)); }
        __syncthreads();
        const float* W; const float* bias; float* out; int N, n0;
        if (it < DEPTH * (NMOD / 256)) { const int l = it / (NMOD / 256), s = it % (NMOD / 256); W = a.in[I_ADAW] + (size_t)l * D * NMOD; N = NMOD; n0 = s * 256; bias = a.in[I_ADAB] + l * NMOD; out = (float*)(F.ws + WS_MOD) + (size_t)l * BATCH * NMOD; }
        else { const int s = it - DEPTH * (NMOD / 256); W = a.in[I_KVADAW]; N = 2 * D; n0 = s * 256; bias = a.in[I_KVADAB]; out = (float*)(F.ws + WS_KVMOD); }
        f32x4 acc[8];
#pragma unroll
        for (int b = 0; b < 8; ++b) acc[b] = (f32x4){0.f, 0.f, 0.f, 0.f};
        const float* wp = W + (size_t)(wave * 256) * N + n0 + 4 * lane;
#pragma unroll 8
        for (int k = 0; k < 256; ++k) { const f32x4 wv = *(const f32x4*)(wp + (size_t)k * N);
            const f32x4 s0 = *(const LAS f32x4*)(SC + (wave * 256 + k) * 8), s1 = *(const LAS f32x4*)(SC + (wave * 256 + k) * 8 + 4);
            acc[0] += s0.x * wv; acc[1] += s0.y * wv; acc[2] += s0.z * wv; acc[3] += s0.w * wv; acc[4] += s1.x * wv; acc[5] += s1.y * wv; acc[6] += s1.z * wv; acc[7] += s1.w * wv; }
#pragma unroll
        for (int b = 0; b < 8; ++b) *(LAS f32x4*)(RED + (wave * 8 + b) * 256 + 4 * lane) = acc[b];
        __syncthreads();
#pragma unroll
        for (int i = 0; i < 4; ++i) { const int idx = tid + 512 * i, b = idx >> 8, col = idx & 255; float s = bias[n0 + col];
#pragma unroll
            for (int w = 0; w < 8; ++w) s += RED[(w * 8 + b) * 256 + col];
            out[(size_t)b * N + n0 + col] = s; }
        __syncthreads();
    }
    { bf16* WSM = (bf16*)(F.ws + WS_WSM); const float* ws_in = a.in[I_WS];
      for (int i = blockIdx.x * 512 + tid; i < NA * NG * GB * GB; i += F.G * 512) { const int col = i & 127, row = (i >> 7) & 127; WSM[i] = (bf16)f2bf(((col >> 6) <= (row >> 6)) ? ws_in[i] : 0.f); } }
    LAS float* scr = (LAS float*)(F.lds + wave * 16384);
    const int gw = F.vcu * NWAVES + wave, NGW = F.G * NWAVES;
    constexpr int UNIT = 2048;
    for (int it = gw; it < 56 * UNIT; it += NGW) {
        const int u = it / UNIT, r = it % UNIT;
        if (u < 12)      { const int l = u / 6, s = u % 6;            p0_transpose_item(a.in[I_WIN] + (size_t)l * D * GN, D, GN, WT + WT_WIN + (size_t)l * GN * D, scr, s * UNIT + r, lane); }
        else if (u < 18) { const int l = (u - 12) / 3, s = (u - 12) % 3; p0_transpose_item(a.in[I_WOUT] + (size_t)l * GH * D, GH, D, WT + WT_WOUT + (size_t)l * D * GH, scr, s * UNIT + r, lane); }
        else if (u < 34) { const int l = (u - 18) / 4, s = (u - 18) % 4; p0_transpose_item(a.in[I_W1] + (size_t)l * D * FF, D, FF, WT + WT_W1 + (size_t)l * FF * D, scr, s * UNIT + r, lane); }
        else if (u < 50) { const int l = (u - 34) / 4, s = (u - 34) % 4; p0_transpose_item(a.in[I_W2] + (size_t)l * FF * D, FF, D, WT + WT_W2 + (size_t)l * D * FF, scr, s * UNIT + r, lane); }
        else if (u < 52) { const int s = u - 50;                      p0_transpose_item(a.in[I_WKV], D, 2 * D, WT + WT_WKV, scr, s * UNIT + r, lane); }
        else if (u < 54) { const int l = u - 52;                      p0_transpose_item(a.in[I_WQ] + (size_t)l * D * D, D, D, WT + WT_WQ + (size_t)l * D * D, scr, r, lane); }
        else             { const int l = u - 54;                      p0_transpose_item(a.in[I_WO] + (size_t)l * D * D, D, D, WT + WT_WO + (size_t)l * D * D, scr, r, lane); }
    }
}

template <bool KV>
__device__ __forceinline__ void norm_phase(Frame& F, const float* xin, const float* g, const float* shift, const float* scale, int modstride, bf16* Hout,
                                           const float* kvg, const float* kvmod, bf16* HKV, const float* w_f, const float* b_f, float* LOGF) {
    PHASE_IDS
    const int gw = F.vcu * NWAVES + wave, NGW = F.G * NWAVES;
    LAS float* WFT = (LAS float*)F.lds;
    if (KV) { for (int i = tid; i < NH * D; i += NWAVES * 64) { const int h = i / D, col = i % D; WFT[i] = w_f[col * NH + h]; } __syncthreads(); }
    for (int it = gw; it < M / 16; it += NGW) {
        const int row0 = it * 16, b = row0 / SEQ;
        f32x4 gs[8], sh[8];
#pragma unroll
        for (int j = 0; j < 8; ++j) { const int c = 4 * lane + 256 * j; const f32x4 gv = *(const f32x4*)(g + c), sc = *(const f32x4*)(scale + (size_t)b * modstride + c);
            gs[j] = gv * (1.f + sc); sh[j] = *(const f32x4*)(shift + (size_t)b * modstride + c);
        }
        for (int r = 0; r < 16; ++r) { const int row = row0 + r;
            const GAS f32x4* xr = (const GAS f32x4*)(xin + (size_t)row * D) + lane;
            f32x4 v[8]; float s = 0.f;
#pragma unroll
            for (int j = 0; j < 8; ++j) { v[j] = xr[64 * j]; s += (v[j].x * v[j].x + v[j].y * v[j].y) + (v[j].z * v[j].z + v[j].w * v[j].w); }
            const float rstd = 1.f / sqrtf(wave_sum(s) * (1.f / D) + EPS);
            GAS v2u* o8 = (GAS v2u*)(Hout + (size_t)row * D) + lane;
#pragma unroll
            for (int j = 0; j < 8; ++j) { const f32x4 y = (v[j] * rstd) * gs[j] + sh[j]; o8[64 * j] = (v2u){pk2(y.x, y.y), pk2(y.z, y.w)}; }
            if (KV) {
                GAS v2u* k8 = (GAS v2u*)(HKV + (size_t)row * D) + lane; float z[16];
#pragma unroll
                for (int h = 0; h < 16; ++h) z[h] = 0.f;
#pragma unroll
                for (int j = 0; j < 8; ++j) { const int c = 4 * lane + 256 * j; const f32x4 g2 = *(const f32x4*)(kvg + c), s2 = *(const f32x4*)(kvmod + (size_t)b * 2 * D + D + c), h2 = *(const f32x4*)(kvmod + (size_t)b * 2 * D + c);
                    const f32x4 y = (v[j] * rstd) * (g2 * (1.f + s2)) + h2; k8[64 * j] = (v2u){pk2(y.x, y.y), pk2(y.z, y.w)};
#pragma unroll
                    for (int h = 0; h < 16; ++h) { const f32x4 w = *(const LAS f32x4*)(WFT + h * D + 4 * lane + 256 * j); z[h] += (y.x * w.x + y.y * w.y) + (y.z * w.z + y.w * w.w); } }
                float mine = 0.f;
#pragma unroll
                for (int h = 0; h < 16; ++h) { const float t = wave_sum(z[h]); if (lane == h) mine = t; }
                if (lane < 16) { const float zz = mine + b_f[lane]; const float ls = fminf(zz, 0.f) - log1pf(__expf(-fabsf(zz)));
                    LOGF[((size_t)b * NH + lane) * SEQ + (row - b * SEQ)] = ls; }
            }
        }
    }
    if (KV) __syncthreads();
}
__device__ __forceinline__ void headnorm_rows(Frame& F, bf16* T, const float* gain) {
    PHASE_IDS
    const int gw = F.vcu * NWAVES + wave, NGW = F.G * NWAVES;
    const int d0 = (8 * lane) & 127; const f32x4 g0 = *(const f32x4*)(gain + d0), g1 = *(const f32x4*)(gain + d0 + 4);
    for (int it = gw; it < M / 16; it += NGW) {
        for (int r = 0; r < 16; ++r) { GAS v4u* p = (GAS v4u*)(T + (size_t)(it * 16 + r) * D) + lane;
            v4u w[4];
#pragma unroll
            for (int j = 0; j < 4; ++j) w[j] = p[64 * j];
#pragma unroll
            for (int j = 0; j < 4; ++j) { float x[8] = {bflo(w[j].x), bfhi(w[j].x), bflo(w[j].y), bfhi(w[j].y), bflo(w[j].z), bfhi(w[j].z), bflo(w[j].w), bfhi(w[j].w)};
                float s = 0.f;
#pragma unroll
                for (int e = 0; e < 8; ++e) s += x[e] * x[e];
                s += __shfl_xor(s, 1); s += __shfl_xor(s, 2); s += __shfl_xor(s, 4); s += __shfl_xor(s, 8);
                const float rstd = 1.f / sqrtf(s * (1.f / HD) + EPS);
                v4u o; o.x = pk2(x[0] * rstd * g0.x, x[1] * rstd * g0.y); o.y = pk2(x[2] * rstd * g0.z, x[3] * rstd * g0.w); o.z = pk2(x[4] * rstd * g1.x, x[5] * rstd * g1.y); o.w = pk2(x[6] * rstd * g1.z, x[7] * rstd * g1.w);
                p[64 * j] = o; } }
    }
}
__device__ __forceinline__ void cumsum_phase(Frame& F, const float* LOGF, float* FB) {
    PHASE_IDS
    const int gw = F.vcu * NWAVES + wave, NGW = F.G * NWAVES;
    for (int bh = gw; bh < BATCH * NH; bh += NGW) {
        const f32x4* src = (const f32x4*)(LOGF + (size_t)bh * SEQ + 64 * lane); f32x4 v[16]; float run = 0.f;
#pragma unroll
        for (int i = 0; i < 16; ++i) { v[i] = src[i]; run += v[i].x; v[i].x = run; run += v[i].y; v[i].y = run; run += v[i].z; v[i].z = run; run += v[i].w; v[i].w = run; }
        float incl = run;
#pragma unroll
        for (int o = 1; o < 64; o <<= 1) { const float t = __shfl_up(incl, o); if (lane >= o) incl += t; }
        const float off = incl - run;
        f32x4* dst = (f32x4*)(FB + (size_t)bh * SEQ + 64 * lane);
#pragma unroll
        for (int i = 0; i < 16; ++i) dst[i] = v[i] + off;
    }
}

constexpr int SG_VT = 0, SG_STG = 65536, SG_STG_ROW = 144, SG_STG_WAVE = 32 * SG_STG_ROW, SG_TAB = SG_STG + 8 * SG_STG_WAVE, SG_RED = SG_TAB + 1024;
__device__ __forceinline__ void sg_phase(Frame& F, int layer, bf16* U, const bf16* V, const f32x2* vstat, const float* ln_g, const float* ln_b, const bf16* WSM, const float* bs) {
    PHASE_IDS
    const int wid = wave, r32 = lane & 31, hi = lane >> 5, wq = wid & 3, ch = wid >> 2;
    LAS unsigned char* lds = F.lds;
    LAS f32x2* TAB = (LAS f32x2*)(lds + SG_TAB); LAS f32x2* RED = (LAS f32x2*)(lds + SG_RED);
    const int sr = tid >> 4, sc = (tid & 15) * 8, vst0 = att::v_st(sr, sc), vst1 = att::v_st(32 + sr, sc);
    const unsigned vbase = (unsigned)(uintptr_t)(lds + SG_VT) + (unsigned)att::v_rd_base(lane);
    LAS unsigned char* stg = lds + SG_STG + wid * SG_STG_WAVE;
    for (int nb = blockIdx.x; nb < M / GB; nb += F.G) {
        const int r0 = nb * GB;
        { const int row = tid & 127, part = tid >> 7; float s = 0.f, ss = 0.f;
#pragma unroll 8
          for (int q = 0; q < 24; ++q) { const f32x2 p = vstat[(size_t)(part * 24 + q) * M + r0 + row]; s += p.x; ss += p.y; }
          RED[part * 128 + row] = (f32x2){s, ss}; }
        __syncthreads();
        if (tid < 128) { const f32x2 a = RED[tid], b = RED[128 + tid], c = RED[256 + tid], d = RED[384 + tid];
            const float mean = ((a.x + b.x) + (c.x + d.x)) * (1.f / GH); const float var = ((a.y + b.y) + (c.y + d.y)) * (1.f / GH) - mean * mean;
            TAB[tid] = (f32x2){mean, 1.f / sqrtf(fmaxf(var, 0.f) + EPS)}; }
        __syncthreads();
        f32x2 st[4];
#pragma unroll
        for (int q = 0; q < 4; ++q) st[q] = TAB[(q >> 1) * 64 + (q & 1) * 32 + sr];
        const bf16* Vb = V + (size_t)r0 * GH; bf16* Ub = U + (size_t)r0 * GH;
        v4u vr[4], ur[4];
#define SG_VLOAD(c0) do { _Pragma("unroll") for (int q = 0; q < 4; ++q) vr[q] = *(const GAS v4u*)(Vb + (size_t)((q >> 1) * 64 + (q & 1) * 32 + sr) * GH + (c0) + sc); } while (0)
#define SG_VWRITE(c0, buf) do { const f32x4 g0 = *(const f32x4*)(ln_g + (c0) + sc), g1 = *(const f32x4*)(ln_g + (c0) + sc + 4), b0 = *(const f32x4*)(ln_b + (c0) + sc), b1 = *(const f32x4*)(ln_b + (c0) + sc + 4); \
        _Pragma("unroll") for (int q = 0; q < 4; ++q) { const float mu = st[q].x, rs = st[q].y; v4u o; \
            o.x = pk2((bflo(vr[q].x) - mu) * rs * g0.x + b0.x, (bfhi(vr[q].x) - mu) * rs * g0.y + b0.y); o.y = pk2((bflo(vr[q].y) - mu) * rs * g0.z + b0.z, (bfhi(vr[q].y) - mu) * rs * g0.w + b0.w); \
            o.z = pk2((bflo(vr[q].z) - mu) * rs * g1.x + b1.x, (bfhi(vr[q].z) - mu) * rs * g1.y + b1.y); o.w = pk2((bflo(vr[q].w) - mu) * rs * g1.z + b1.z, (bfhi(vr[q].w) - mu) * rs * g1.w + b1.w); \
            *(LAS v4u*)(lds + SG_VT + ((buf) * 2 + (q >> 1)) * 16384 + ((q & 1) ? vst1 : vst0)) = o; } } while (0)
        SG_VLOAD(0); SG_VWRITE(0, 0);
        RAW_BAR();
        bf16x8 wf[2][4]; f32x4 bsv[4];
        for (int t = 0; t < GH / 128; ++t) {
            const int c0 = t * 128, buf = t & 1, g = t / 6;
#pragma unroll
            for (int q = 0; q < 4; ++q) { const int p = lane + 64 * q; ur[q] = *(const GAS v4u*)(Ub + (size_t)(32 * wq + (p >> 3)) * GH + c0 + 64 * ch + 8 * (p & 7)); }
            if (t + 1 < GH / 128) SG_VLOAD(c0 + 128);
            if (t % 6 == 0) {
                const bf16* wp = WSM + ((size_t)(layer * NG + g) * GB + 32 * wq + r32) * GB + 8 * hi;
#pragma unroll
                for (int jt = 0; jt < 2; ++jt)
#pragma unroll
                    for (int ks = 0; ks < 4; ++ks) wf[jt][ks] = *(const bf16x8*)(wp + 64 * jt + 16 * ks);
                const float* bp = bs + (size_t)(layer * NG + g) * GB + 32 * wq + 4 * hi;
#pragma unroll
                for (int q = 0; q < 4; ++q) bsv[q] = *(const f32x4*)(bp + 8 * q);
            }
            f32x16 o[2] = {};
#define SG_TRRD(dst, off) asm volatile("ds_read_b64_tr_b16 %0, %1 offset:%2" : "=&v"(dst) : "v"(va), "i"(off) : "memory")
#define SG_PV(dd, jt) do { const unsigned va = vbase + (unsigned)((buf * 2 + (jt)) * 16384 + (2 * ch + (dd)) * 512); s16x4 l0, l1, l2, l3, h0, h1, h2, h3; \
            SG_TRRD(l0, 0); SG_TRRD(h0, 2048); SG_TRRD(l1, 4096); SG_TRRD(h1, 6144); SG_TRRD(l2, 8192); SG_TRRD(h2, 10240); SG_TRRD(l3, 12288); SG_TRRD(h3, 14336); \
            asm volatile("s_waitcnt lgkmcnt(0)" ::: "memory"); __builtin_amdgcn_sched_barrier(0); \
            o[dd] = __builtin_amdgcn_mfma_f32_32x32x16_bf16(wf[jt][0], (bf16x8){l0[0], l0[1], l0[2], l0[3], h0[0], h0[1], h0[2], h0[3]}, o[dd], 0, 0, 0); \
            o[dd] = __builtin_amdgcn_mfma_f32_32x32x16_bf16(wf[jt][1], (bf16x8){l1[0], l1[1], l1[2], l1[3], h1[0], h1[1], h1[2], h1[3]}, o[dd], 0, 0, 0); \
            o[dd] = __builtin_amdgcn_mfma_f32_32x32x16_bf16(wf[jt][2], (bf16x8){l2[0], l2[1], l2[2], l2[3], h2[0], h2[1], h2[2], h2[3]}, o[dd], 0, 0, 0); \
            o[dd] = __builtin_amdgcn_mfma_f32_32x32x16_bf16(wf[jt][3], (bf16x8){l3[0], l3[1], l3[2], l3[3], h3[0], h3[1], h3[2], h3[3]}, o[dd], 0, 0, 0); } while (0)
            SG_PV(0, 0); SG_PV(1, 0);
            if (wq >= 2) { SG_PV(0, 1); SG_PV(1, 1); }
#pragma unroll
            for (int dd = 0; dd < 2; ++dd)
#pragma unroll
                for (int r = 0; r < 16; ++r) { const float val = o[dd][r] + bsv[r >> 2][r & 3];
                    *(LAS unsigned short*)(stg + att::crow(r, hi) * SG_STG_ROW + (dd * 32 + r32) * 2) = (unsigned short)f2bf(val); }
            LDS_WAIT();
#pragma unroll
            for (int q = 0; q < 4; ++q) { const int p = lane + 64 * q; const v4u sv = *(const LAS v4u*)(stg + (p >> 3) * SG_STG_ROW + (p & 7) * 16); const v4u uu = ur[q]; v4u w;
                w.x = pk2(bflo(uu.x) * bflo(sv.x), bfhi(uu.x) * bfhi(sv.x)); w.y = pk2(bflo(uu.y) * bflo(sv.y), bfhi(uu.y) * bfhi(sv.y));
                w.z = pk2(bflo(uu.z) * bflo(sv.z), bfhi(uu.z) * bfhi(sv.z)); w.w = pk2(bflo(uu.w) * bflo(sv.w), bfhi(uu.w) * bfhi(sv.w));
                *(GAS v4u*)(Ub + (size_t)(32 * wq + (p >> 3)) * GH + c0 + 64 * ch + 8 * (p & 7)) = w; }
            if (t + 1 < GH / 128) SG_VWRITE(c0 + 128, buf ^ 1);
            RAW_BAR();
        }
#undef SG_VLOAD
#undef SG_VWRITE
#undef SG_TRRD
#undef SG_PV
        __syncthreads();
    }
}


__device__ __forceinline__ int att_bh(int L) { const int k = L >> 3; return (k >> 3) * 8 + (L & 7); }
__device__ __forceinline__ att::BlockRef att_ref(int L, int pass, const bf16* Q, const bf16* K, const bf16* V, bf16* O) {
    const int x = (L >> 3) & 7, bh = att_bh(L), b = bh >> 4, h = bh & 15, qb = pass ? 15 - x : x;
    const size_t base = (size_t)b * SEQ * D + (size_t)h * HD, qoff = base + (size_t)qb * 256 * D;
    att::BlockRef r; r.Q = Q + qoff; r.O = O + qoff; r.K = K + base; r.V = V + base; r.P0 = qb * 256; return r;
}
__device__ __forceinline__ void attn_phase(Frame& F, char* lds, const bf16* Q, const bf16* K, const bf16* V, bf16* O, const float* FB) {
    constexpr int TOTAL = BATCH * NH * 8;
    int L = blockIdx.x; if (L >= TOTAL) return;
    const int stride = F.G; int pass = 0;
    att::BlockRef cur = att_ref(L, 0, Q, K, V, O);
    att::Seam S;
    att::prime(cur, lds, S);
    for (;;) {
        const bool more_pass = pass == 0, more_item = L + stride < TOTAL, last = !more_pass && !more_item;
        int Ln = L, passn = pass + 1;
        if (!more_pass) { passn = 0; Ln = more_item ? L + stride : L; }
        const att::BlockRef nxt = last ? cur : att_ref(Ln, passn, Q, K, V, O);
        att::block(cur, nxt, pass == 0 ? FB + (size_t)att_bh(L) * SEQ : (const float*)nullptr, lds, S);
        if (last) break;
        cur = nxt; L = Ln; pass = passn;
    }
}

__global__ void __launch_bounds__(NWAVES * 64, 2) yoco_fwd(Args args) {
    extern __shared__ __attribute__((aligned(16))) unsigned char lds[];
    Frame F;
    F.lds = (LAS unsigned char*)lds;
    F.G = gridDim.x; { const int bx = blockIdx.x; F.vcu = (F.G % 8 == 0) ? (bx % 8) * (F.G / 8) + bx / 8 : bx; }
    F.ws = args.ws;
    unsigned char* ws = args.ws;
    volatile LAS unsigned* MISC = (volatile LAS unsigned*)(F.lds + MISC_OFF);
    for (int u = threadIdx.x; u < (LDS_BYTES - LDSCTL_OFF) / 4; u += NWAVES * 64) ((LAS unsigned*)(F.lds + LDSCTL_OFF))[u] = 0u;
    __syncthreads();
    const int lo = args.ph_lo, hi = args.ph_hi;
    XcdBarrier bar = xcd_barrier_post((unsigned*)(ws + WS_CTL) + CW_BAR + (size_t)args.li * XCD_BAR_WORDS, MISC + 8);
    int ph = 0;
#ifndef EN_MASK
#define EN_MASK 0xFFFF
#endif
#define EN(k) ((EN_MASK >> (k)) & 1)
#define RUN (ph >= lo && ph < hi)
#define SEAM() do { if (ph >= lo && ph + 1 < hi) xcd_barrier(bar); ++ph; } while (0)

    const float* x_in = args.in[I_X]; float* out = args.out;
    bf16* WT = (bf16*)(ws + WS_WT);
    bf16* H = (bf16*)(ws + WS_H); bf16* U = (bf16*)(ws + WS_U); bf16* V = (bf16*)(ws + WS_V); bf16* HID = (bf16*)(ws + WS_HID);
    bf16* Qb = (bf16*)(ws + WS_Q); bf16* Ob = (bf16*)(ws + WS_O); bf16* HKV = (bf16*)(ws + WS_HKV); bf16* Kb = (bf16*)(ws + WS_KB); bf16* Vb = (bf16*)(ws + WS_VB);
    float* LOGF = (float*)(ws + WS_LOGF); float* FB = (float*)(ws + WS_FB);
    f32x2* VSTAT = (f32x2*)(ws + WS_VSTAT);

    if (RUN && EN(0)) p0_prologue(F, args);
    SEAM();
#pragma unroll 1
    for (int l = 0; l < DEPTH; ++l) {
        const float* mod = (const float*)(ws + WS_MOD) + (size_t)l * BATCH * NMOD;
        const float* xcur = (l == 0) ? x_in : (const float*)out;
        if (RUN && EN(1)) {
            if (l == NA) norm_phase<true>(F, xcur, args.in[I_NORMG] + (size_t)(2 * l) * D, mod, mod + D, NMOD, H, args.in[I_KVNG], (const float*)(ws + WS_KVMOD), HKV, args.in[I_WF], args.in[I_BF], LOGF);
            else norm_phase<false>(F, xcur, args.in[I_NORMG] + (size_t)(2 * l) * D, mod, mod + D, NMOD, H, nullptr, nullptr, nullptr, nullptr, nullptr, nullptr);
        }
        SEAM();
        if (l < NA) {
            if (RUN && EN(2)) { pg8::Gemm g{H, WT + WT_WIN + (size_t)l * GN * D, M, GN, D}; pg8::StaticOrder S; S.init(M, GN, F.G, (int)blockIdx.x);
                pg8::EpiBf16<1, true> E{U, GH, GH, (size_t)(WS_V - WS_U) / 2, (pg8::f32x2v*)VSTAT, M};
                pg8::gemm_phase<pg8::EpiBf16<1, true>, pg8::StaticOrder, true, true>(F.lds, g, S, E); }
            SEAM();
            if (RUN && EN(3)) sg_phase(F, l, U, V, VSTAT, args.in[I_LNG] + (size_t)l * GH, args.in[I_LNB] + (size_t)l * GH, (const bf16*)(ws + WS_WSM), args.in[I_BS]);
            SEAM();
        } else {
            const int bl = l - NA;
            if (RUN && EN(4)) {
#pragma unroll 1
                for (int s = (l == NA ? 0 : 1); s < 2; ++s) {
                    pg8::Gemm g{s == 0 ? HKV : H, s == 0 ? WT + WT_WKV : WT + WT_WQ + (size_t)bl * D * D, M, s == 0 ? 2 * D : D, D};
                    pg8::StaticOrder S; S.init(M, g.N, F.G, (int)blockIdx.x);
                    pg8::EpiBf16<0, false> E{s == 0 ? Kb : Qb, D, s == 0 ? D : 0, (size_t)(WS_VB - WS_KB) / 2, nullptr, M};
                    pg8::gemm_phase<pg8::EpiBf16<0, false>, pg8::StaticOrder, true, true>(F.lds, g, S, E);
                }
            }
            SEAM();
            if (RUN && EN(5)) { headnorm_rows(F, Qb, args.in[I_QNG] + bl * HD); if (l == NA) { headnorm_rows(F, Kb, args.in[I_KNG]); cumsum_phase(F, LOGF, FB); } }
            SEAM();
            if (RUN && EN(6)) attn_phase(F, (char*)lds, Qb, Kb, Vb, Ob, FB);
            SEAM();
        }
        if (RUN && EN(7)) { pg8::Gemm g{l < NA ? U : Ob, l < NA ? WT + WT_WOUT + (size_t)l * D * GH : WT + WT_WO + (size_t)(l - NA) * D * D, M, D, l < NA ? GH : D};
            pg8::StaticOrder S; S.init(M, D, F.G, (int)blockIdx.x);
            pg8::EpiResid E{xcur, out, D, mod + 2 * D, NMOD, SEQ / 256};
            pg8::gemm_phase<pg8::EpiResid, pg8::StaticOrder, true, true>(F.lds, g, S, E); }
        SEAM();
        if (RUN && EN(8)) norm_phase<false>(F, out, args.in[I_NORMG] + (size_t)(2 * l + 1) * D, mod + 3 * D, mod + 4 * D, NMOD, H, nullptr, nullptr, nullptr, nullptr, nullptr, nullptr);
        SEAM();
        if (RUN && EN(9)) { pg8::Gemm g{H, WT + WT_W1 + (size_t)l * FF * D, M, FF, D}; pg8::StaticOrder S; S.init(M, FF, F.G, (int)blockIdx.x);
            pg8::EpiBf16<2, false> E{HID, FF, 0, 0, nullptr, M};
            pg8::gemm_phase<pg8::EpiBf16<2, false>, pg8::StaticOrder, true, true>(F.lds, g, S, E); }
        SEAM();
        if (RUN && EN(10)) { pg8::Gemm g{HID, WT + WT_W2 + (size_t)l * D * FF, M, D, FF}; pg8::StaticOrder S; S.init(M, D, F.G, (int)blockIdx.x);
            pg8::EpiResid E{out, out, D, mod + 5 * D, NMOD, SEQ / 256};
            pg8::gemm_phase<pg8::EpiResid, pg8::StaticOrder, true, true>(F.lds, g, S, E); }
        SEAM();
    }
#undef RUN
#undef SEAM
}

extern "C" void kernel_launch(void* const* d_in, const int* in_sizes, int n_in, void* d_out, int out_size, void* d_ws, size_t ws_size, hipStream_t stream) {
    static int grid = 0;
    if (grid == 0) {
        if (n_in != 23 || in_sizes[0] != M * D || out_size != M * D || ws_size < WS_END) { fprintf(stderr, "kernel_launch: shape/workspace mismatch (n_in %d in0 %d out %d ws %zu, need %zu)\n", n_in, n_in > 0 ? in_sizes[0] : -1, out_size, ws_size, (size_t)WS_END); grid = -1; return; }
        int dev = 0, cus = 0, per_cu = 0;
        if (hipGetDevice(&dev) != hipSuccess || hipDeviceGetAttribute(&cus, hipDeviceAttributeMultiprocessorCount, dev) != hipSuccess) { grid = -1; return; }
        if (hipFuncSetAttribute((const void*)yoco_fwd, hipFuncAttributeMaxDynamicSharedMemorySize, LDS_BYTES) != hipSuccess) { fprintf(stderr, "kernel_launch: hipFuncSetAttribute failed\n"); grid = -1; return; }
        if (hipOccupancyMaxActiveBlocksPerMultiprocessor(&per_cu, (const void*)yoco_fwd, NWAVES * 64, LDS_BYTES) != hipSuccess || per_cu < 1) { fprintf(stderr, "kernel_launch: occupancy query says %d\n", per_cu); }
        (void)hipGetLastError();
        grid = cus;
    }
    if (grid < 0) return;
    if (hipMemsetAsync((char*)d_ws + WS_CTL, 0, CTL_ZERO_BYTES, stream) != hipSuccess) return;
    Args a{};
    for (int i = 0; i < 23; ++i) a.in[i] = (const float*)d_in[i];
    a.out = (float*)d_out; a.ws = (unsigned char*)d_ws;
#if MK_N_LAUNCHES == 1
    a.ph_lo = 0; a.ph_hi = 1000; a.li = 0; a.pad = 0;
    hipLaunchKernelGGL(yoco_fwd, dim3(grid), dim3(NWAVES * 64), LDS_BYTES, stream, a);
#else
    for (int li = 0; li < 31; ++li) { a.ph_lo = li; a.ph_hi = li + 1; a.li = li; a.pad = 0;
        hipLaunchKernelGGL(yoco_fwd, dim3(grid), dim3(NWAVES * 64), LDS_BYTES, stream, a); }
#endif
}
```

```cpp
#include <hip/hip_runtime.h>
#include <cstdio>
#include <cstdint>

namespace pg8 {
#define PG8_LAS __attribute__((address_space(3)))
typedef unsigned short bf16_t;
typedef short bf16x8 __attribute__((ext_vector_type(8)));
typedef float f32x4 __attribute__((ext_vector_type(4)));
typedef unsigned u32x4 __attribute__((ext_vector_type(4)));
constexpr int BM = 256, BK = 64, HALF = 128, HTB = HALF * BK * 2  , STAGE_BYTES = 8 * HTB, NXCD = 8, WGM = 8;

__host__ __device__ __forceinline__ int lds_byte(int r, int c) { const int st = (r >> 4) * 2 + (c >> 5), rr = r & 15, cc = c & 31, ob = rr * 64 + cc * 2; return st * 1024 + (ob ^ (((ob >> 9) & 1) << 5)); }
__host__ __device__ __forceinline__ void stage_rc(int b, int& R, int& C) { const int st = b / 1024, sb = b % 1024, swz = sb ^ (((sb >> 9) & 1) << 5); R = (st >> 1) * 16 + swz / 64; C = (st & 1) * 32 + (swz % 64) / 2; }
__host__ __device__ __forceinline__ int perm32(int rho) { const int n = rho >> 4, i = rho & 15; return 8 * (i >> 2) + 4 * n + (i & 3); }

struct Unit { int pm, pn; };
struct Gemm { const bf16_t* A; const bf16_t* Bt; int M, N, K; int a_tiled; };

struct StaticOrder {
    int nM, nN, nwg, G, c;
    __host__ __device__ void init(int M, int N, int G_, int c_) { nM = M / BM; nN = N / BM; nwg = nM * nN; G = G_; c = c_; }
    __host__ __device__ bool next(int i, Unit& u) const {
        const long L = (long)i * G + c; if (L >= nwg) return false;
        int wgid = (int)L; { const int q = nwg / NXCD, r = nwg % NXCD, xcd = wgid % NXCD, off = wgid / NXCD; wgid = (xcd < r ? xcd * (q + 1) : r * (q + 1) + (xcd - r) * q) + off; }
        const int nig = WGM * nN, gid = wgid / nig, fm = gid * WGM, gsz = (nM - fm) < WGM ? (nM - fm) : WGM;
        u.pm = fm + ((wgid % nig) % gsz); u.pn = (wgid % nig) / gsz; return true;
    }
    __device__ __forceinline__ void a_ready(const Unit&) const {}
    __device__ __forceinline__ void done(const Unit&) const {}
};

__device__ __forceinline__ unsigned cvt_pk_bf16(float lo, float hi) { unsigned r; asm volatile("v_cvt_pk_bf16_f32 %0, %1, %2" : "=v"(r) : "v"(lo), "v"(hi)); return r; }
typedef float f32x2 __attribute__((ext_vector_type(2)));
__device__ __forceinline__ f32x2 gelu_pk(f32x2 v) {
    const f32x2 av = __builtin_elementwise_abs(v), d = av * 0.2316418882f + 1.0f;
    f32x2 t; t.x = __builtin_amdgcn_rcpf(d.x); t.y = __builtin_amdgcn_rcpf(d.y);
    f32x2 q = t * 0.5307027145f + (-0.7265760135f); q = q * t + 0.7107068705f; q = q * t + (-0.142248368f); q = q * t + 0.127414796f; q = q * t;
    const f32x2 s = (v * v) * (-0.72134752044f);
    f32x2 e; e.x = __builtin_amdgcn_exp2f(s.x); e.y = __builtin_amdgcn_exp2f(s.y);
    const f32x2 m = v * (q * e), r = v - m;
    f32x2 o; o.x = v.x < 0.f ? m.x : r.x; o.y = v.y < 0.f ? m.y : r.y; return o;
}


typedef float f32x2v __attribute__((ext_vector_type(2)));
template <int ACT, bool VSTAT> struct EpiBf16 {
    static constexpr bool PERM = true, AFTER_DRAIN = false;
    bf16_t* O; int ldc; int split_cols; size_t split_stride; f32x2v* vstat; int Mrows;
    __device__ __forceinline__ void operator()(const f32x4 (&acc)[2][2][4][2], const Unit& u, int wr, int wc, int fr, int fq) const {
        const int row0 = u.pm * BM + wr * 64 + fr; int colt = u.pn * BM; bf16_t* base = O; int t = 0;
        if (split_cols) { t = colt / split_cols; base += (size_t)t * split_stride; colt -= t * split_cols; }
        const int col0 = colt + wc * 32 + 8 * fq;
#pragma unroll
        for (int ai = 0; ai < 2; ++ai)
#pragma unroll
            for (int m = 0; m < 4; ++m) { const int row = row0 + ai * HALF + m * 16; bf16_t* rowp = base + (size_t)row * ldc + col0;
                float s = 0.f, ss = 0.f;
#pragma unroll
                for (int bj = 0; bj < 2; ++bj) { f32x4 v0 = acc[ai][bj][m][0], v1 = acc[ai][bj][m][1];
                    if (ACT == 1) { f32x2 a = gelu_pk((f32x2){v0[0], v0[1]}), b = gelu_pk((f32x2){v0[2], v0[3]}), c = gelu_pk((f32x2){v1[0], v1[1]}), d = gelu_pk((f32x2){v1[2], v1[3]});
                        v0 = (f32x4){a.x, a.y, b.x, b.y}; v1 = (f32x4){c.x, c.y, d.x, d.y}; }
                    if (ACT == 2) {
#pragma unroll
                        for (int e = 0; e < 4; ++e) { const float a = fmaxf(v0[e], 0.f), b = fmaxf(v1[e], 0.f); v0[e] = a * a; v1[e] = b * b; } }
                    if (VSTAT) { s += ((v0[0] + v0[1]) + (v0[2] + v0[3])) + ((v1[0] + v1[1]) + (v1[2] + v1[3]));
                        ss += ((v0[0] * v0[0] + v0[1] * v0[1]) + (v0[2] * v0[2] + v0[3] * v0[3])) + ((v1[0] * v1[0] + v1[1] * v1[1]) + (v1[2] * v1[2] + v1[3] * v1[3])); }
                    u32x4 w; w.x = cvt_pk_bf16(v0[0], v0[1]); w.y = cvt_pk_bf16(v0[2], v0[3]); w.z = cvt_pk_bf16(v1[0], v1[1]); w.w = cvt_pk_bf16(v1[2], v1[3]);
                    *(u32x4*)(rowp + bj * HALF) = w; }
                if (VSTAT) { if (t == 1) { s += __shfl_xor(s, 16); s += __shfl_xor(s, 32); ss += __shfl_xor(ss, 16); ss += __shfl_xor(ss, 32);
                    if (fq == 0) vstat[(size_t)((colt >> 8) * 4 + wc) * Mrows + row] = (f32x2v){s, ss}; } } }
    }
};
struct EpiResid {
    static constexpr bool PERM = false, AFTER_DRAIN = false;
    const float* base; float* out; int ldc; const float* gate; int gstride; int tiles_per_batch;
    __device__ __forceinline__ void operator()(const f32x4 (&acc)[2][2][4][2], const Unit& u, int wr, int wc, int fr, int fq) const {
        const int col0 = u.pn * BM + wc * 32 + 4 * fq; const float* g = gate + (size_t)(u.pm / tiles_per_batch) * gstride + col0;
        f32x4 gv[2][2];
#pragma unroll
        for (int bj = 0; bj < 2; ++bj)
#pragma unroll
            for (int n = 0; n < 2; ++n) gv[bj][n] = *(const f32x4*)(g + bj * HALF + n * 16);
#pragma unroll
        for (int ai = 0; ai < 2; ++ai)
#pragma unroll
            for (int m = 0; m < 4; ++m) { const size_t off = (size_t)(u.pm * BM + ai * HALF + wr * 64 + m * 16 + fr) * ldc + col0;
#pragma unroll
                for (int bj = 0; bj < 2; ++bj)
#pragma unroll
                    for (int n = 0; n < 2; ++n) { const f32x4 bs = *(const f32x4*)(base + off + bj * HALF + n * 16); const f32x4 o = bs + gv[bj][n] * acc[ai][bj][m][n];
                        *(f32x4*)(out + off + bj * HALF + n * 16) = o; }
                if (m & 1) asm volatile("" ::: "memory"); }
    }
};


struct EpiGmlpIn {
    static constexpr bool PERM = true, AFTER_DRAIN = false;
    bf16_t* U; bf16_t* V; f32x2v* vstat; int Mrows; int GHc;
    __device__ __forceinline__ void operator()(const f32x4 (&acc)[2][2][4][2], const Unit& u, int wr, int wc, int fr, int fq) const {
        const int colt_all = u.pn * BM; const int t = colt_all >= GHc ? 1 : 0; const int colt = colt_all - t * GHc; const int nch = GHc >> 7;
        const int frs = (fr & ~0xC) | ((fr & 4) << 1) | ((fr & 8) >> 1);
#pragma unroll
        for (int ai = 0; ai < 2; ++ai)
#pragma unroll
            for (int m = 0; m < 4; ++m) { const int nb = u.pm * 2 + ai, k = wr * 64 + m * 16 + fr, row = nb * 128 + k, kks = m * 16 + frs;
                float s = 0.f, ss = 0.f;
#pragma unroll
                for (int bj = 0; bj < 2; ++bj) { f32x4 v0 = acc[ai][bj][m][0], v1 = acc[ai][bj][m][1];
                    { f32x2 a = gelu_pk((f32x2){v0[0], v0[1]}), b = gelu_pk((f32x2){v0[2], v0[3]}), c = gelu_pk((f32x2){v1[0], v1[1]}), d = gelu_pk((f32x2){v1[2], v1[3]});
                      v0 = (f32x4){a.x, a.y, b.x, b.y}; v1 = (f32x4){c.x, c.y, d.x, d.y}; }
                    s += ((v0[0] + v0[1]) + (v0[2] + v0[3])) + ((v1[0] + v1[1]) + (v1[2] + v1[3]));
                    ss += ((v0[0] * v0[0] + v0[1] * v0[1]) + (v0[2] * v0[2] + v0[3] * v0[3])) + ((v1[0] * v1[0] + v1[1] * v1[1]) + (v1[2] * v1[2] + v1[3] * v1[3]));
                    u32x4 w; w.x = cvt_pk_bf16(v0[0], v0[1]); w.y = cvt_pk_bf16(v0[2], v0[3]); w.z = cvt_pk_bf16(v1[0], v1[1]); w.w = cvt_pk_bf16(v1[2], v1[3]);
                    const size_t tile = (size_t)nb * nch + (colt >> 7) + bj;
                    if (t == 0) *(u32x4*)((char*)U + tile * 32768 + (size_t)k * 256 + (wc * 32 + 8 * fq) * 2) = w;
                    else        *(u32x4*)((char*)V + (tile * 2 + wr) * 16384 + ((kks >> 3) * 4 + wc) * 512 + ((kks & 7) * 32 + 8 * fq) * 2) = w; }
                if (t == 1) { s += __shfl_xor(s, 16); s += __shfl_xor(s, 32); ss += __shfl_xor(ss, 16); ss += __shfl_xor(ss, 32);
                    if (fq == 0) vstat[(size_t)((colt >> 8) * 4 + wc) * Mrows + row] = (f32x2v){s, ss}; } }
    }
};

template <class Epi, class Sched, bool ALIGN_EPI = false, bool SP2 = false>
__device__ __forceinline__ void gemm_phase(PG8_LAS unsigned char* lds, const Gemm g, const Sched& S, const Epi& E) {
    int tid_ = threadIdx.x; asm volatile("" : "+v"(tid_));
    const int tid = tid_, wid = __builtin_amdgcn_readfirstlane(tid >> 6), lane = tid & 63, wr = wid >> 2, wc = wid & 3, fr = lane & 15, fq = lane >> 4;
    const int K = g.K, nt = K / BK, rsA = g.a_tiled ? 128 : K;
#define PG8_KOFFA(t) (g.a_tiled ? ((size_t)((t) >> 1) * 32768 + (size_t)((t) & 1) * 128) : (size_t)(t) * kstep)
    unsigned voffA[2], voffB[2];
#pragma unroll
    for (int i = 0; i < 2; ++i) { int R, C; stage_rc(tid * 16 + i * 8192, R, C); const int Rb = Epi::PERM ? ((R & ~31) + perm32(R & 31)) : R;
        voffA[i] = (unsigned)(R * rsA + C) * 2u; voffB[i] = (unsigned)(Rb * K + C) * 2u; }
    const size_t kstep = (size_t)(BK * 2);
    const size_t hstep = (size_t)HALF * K * 2;
    const size_t tstep = 2 * hstep;
    const unsigned ldsw = (unsigned)wid * 1024u;
    const int aoff = lds_byte(wr * 64 + fr, fq * 8), boff = lds_byte(wc * 32 + fr, fq * 8);
#define PG8_SA(b, h) (((b) * 2 + (h)) * HTB)
#define PG8_SB(b, h) ((4 + (b) * 2 + (h)) * HTB)
#define PG8_STAGE(bufoff, gbase, voff) do { _Pragma("unroll") for (int _i = 0; _i < 2; ++_i) \
        __builtin_amdgcn_global_load_lds((const unsigned*)((const char*)(gbase) + (voff)[_i]), (PG8_LAS unsigned*)(lds + (bufoff) + ldsw + _i * 8192), 16, 0, 0); } while (0)
#define PG8_LDA(dst, b, h) do { _Pragma("unroll") for (int m = 0; m < 4; ++m) _Pragma("unroll") for (int k = 0; k < 2; ++k) dst[m][k] = *(const PG8_LAS bf16x8*)(lds + PG8_SA(b, h) + aoff + m * 2048 + k * 1024); } while (0)
#define PG8_LDB(dst, b, h) do { _Pragma("unroll") for (int n = 0; n < 2; ++n) _Pragma("unroll") for (int k = 0; k < 2; ++k) dst[n][k] = *(const PG8_LAS bf16x8*)(lds + PG8_SB(b, h) + boff + n * 2048 + k * 1024); } while (0)
#define PG8_MMA(ai, bj, At, Bt) do { __builtin_amdgcn_s_setprio(1); _Pragma("unroll") for (int m = 0; m < 4; ++m) _Pragma("unroll") for (int n = 0; n < 2; ++n) _Pragma("unroll") for (int k = 0; k < 2; ++k) \
        acc[ai][bj][m][n] = __builtin_amdgcn_mfma_f32_16x16x32_bf16(Bt[n][k], At[m][k], acc[ai][bj][m][n], 0, 0, 0); __builtin_amdgcn_s_setprio(0); } while (0)
#define PG8_WAIT_V(n) asm volatile("s_waitcnt vmcnt(" #n ")" ::: "memory")
#define PG8_WAIT_L(n) asm volatile("s_waitcnt lgkmcnt(" #n ")" ::: "memory")
#define PG8_BAR __builtin_amdgcn_s_barrier()
#define PG8_SCHED __builtin_amdgcn_sched_barrier(0)
    Unit cur, nxt; int ui = 0;
    if (!S.next(0, cur)) return;
    f32x4 acc[2][2][4][2];
#pragma unroll
    for (int a = 0; a < 2; ++a)
#pragma unroll
        for (int b = 0; b < 2; ++b)
#pragma unroll
            for (int m = 0; m < 4; ++m)
#pragma unroll
                for (int n = 0; n < 2; ++n) acc[a][b][m][n] = (f32x4){0.f, 0.f, 0.f, 0.f};
    bf16x8 At[4][2], B0[2][2], B1[2][2];
    const char* cA = (const char*)g.A + (size_t)cur.pm * tstep; const char* cB = (const char*)g.Bt + (size_t)cur.pn * tstep;
    S.a_ready(cur);
    if constexpr (SP2) {
        PG8_STAGE(PG8_SB(0, 0), cB, voffB); PG8_STAGE(PG8_SB(0, 1), cB + hstep, voffB); PG8_STAGE(PG8_SA(0, 0), cA, voffA); PG8_STAGE(PG8_SA(0, 1), cA + hstep, voffA);
        if (wr == 1) PG8_BAR;
        PG8_WAIT_V(2); PG8_BAR;
        PG8_STAGE(PG8_SB(1, 0), cB + kstep, voffB); PG8_STAGE(PG8_SA(1, 0), cA + kstep, voffA); PG8_STAGE(PG8_SB(1, 1), cB + hstep + kstep, voffB);
        PG8_WAIT_V(6); PG8_BAR;
    } else {
        PG8_STAGE(PG8_SB(0, 0), cB, voffB); PG8_STAGE(PG8_SA(0, 0), cA, voffA); PG8_STAGE(PG8_SB(0, 1), cB + hstep, voffB); PG8_STAGE(PG8_SA(0, 1), cA + hstep, voffA);
        if (wr == 1) PG8_BAR;
        PG8_WAIT_V(4); PG8_BAR;
        PG8_STAGE(PG8_SB(1, 0), cB + kstep, voffB); PG8_STAGE(PG8_SA(1, 0), cA + kstep, voffA); PG8_STAGE(PG8_SB(1, 1), cB + hstep + kstep, voffB);
        PG8_WAIT_V(6); PG8_BAR;
    }
    for (;;) {
        const bool has_next = S.next(ui + 1, nxt);
        const char* nA = has_next ? (const char*)g.A + (size_t)nxt.pm * tstep : cA; const char* nB = has_next ? (const char*)g.Bt + (size_t)nxt.pn * tstep : cB;
        for (int t = 0; t < nt; t += 2) {
            const bool last = (t == nt - 2);
            const char* a1 = cA + PG8_KOFFA(t + 1);
            const char* a2 = last ? nA : cA + PG8_KOFFA(t + 2); const char* b2 = last ? nB : cB + (size_t)(t + 2) * kstep;
            const char* a3 = a2 + kstep; const char* b3 = b2 + kstep;
            if (last && has_next) S.a_ready(nxt);
            if constexpr (SP2) {
            PG8_LDB(B0, 0, 0); PG8_LDB(B1, 0, 1); PG8_SCHED; PG8_LDA(At, 0, 0); PG8_STAGE(PG8_SA(1, 1), a1 + hstep, voffA);
            PG8_WAIT_V(8); PG8_WAIT_L(0); PG8_BAR; PG8_MMA(0, 0, At, B0); PG8_MMA(0, 1, At, B1); PG8_BAR; PG8_SCHED;
            PG8_LDA(At, 0, 1); PG8_STAGE(PG8_SB(0, 0), b2, voffB); PG8_STAGE(PG8_SB(0, 1), b2 + hstep, voffB); PG8_STAGE(PG8_SA(0, 0), a2, voffA);
            PG8_WAIT_V(8); PG8_WAIT_L(0); PG8_BAR; PG8_MMA(1, 0, At, B0); PG8_MMA(1, 1, At, B1); PG8_BAR; PG8_SCHED;
            PG8_LDB(B0, 1, 0); PG8_LDB(B1, 1, 1); PG8_SCHED; PG8_LDA(At, 1, 0); PG8_STAGE(PG8_SA(0, 1), a2 + hstep, voffA);
            PG8_WAIT_V(8); PG8_WAIT_L(0); PG8_BAR; PG8_MMA(0, 0, At, B0); PG8_MMA(0, 1, At, B1); PG8_BAR; PG8_SCHED;
            PG8_LDA(At, 1, 1); PG8_STAGE(PG8_SB(1, 0), b3, voffB); PG8_STAGE(PG8_SB(1, 1), b3 + hstep, voffB); PG8_STAGE(PG8_SA(1, 0), a3, voffA);
            PG8_WAIT_V(8); PG8_WAIT_L(0); PG8_BAR; PG8_MMA(1, 0, At, B0); PG8_MMA(1, 1, At, B1); PG8_BAR; PG8_SCHED;
            } else {
            PG8_LDB(B0, 0, 0); PG8_SCHED; PG8_LDA(At, 0, 0); PG8_STAGE(PG8_SA(1, 1), a1 + hstep, voffA);
            PG8_WAIT_L(8); PG8_BAR; PG8_WAIT_L(0); PG8_MMA(0, 0, At, B0); PG8_BAR; PG8_SCHED;
            PG8_LDB(B1, 0, 1); PG8_STAGE(PG8_SB(0, 0), b2, voffB);
            PG8_BAR; PG8_WAIT_L(0); PG8_MMA(0, 1, At, B1); PG8_BAR;
            PG8_LDA(At, 0, 1); PG8_STAGE(PG8_SA(0, 0), a2, voffA);
            PG8_BAR; PG8_WAIT_L(0); PG8_MMA(1, 0, At, B0); PG8_BAR; PG8_SCHED;
            PG8_STAGE(PG8_SB(0, 1), b2 + hstep, voffB);
            PG8_WAIT_V(6); PG8_BAR; PG8_MMA(1, 1, At, B1); PG8_BAR;
            PG8_LDB(B0, 1, 0); PG8_SCHED; PG8_LDA(At, 1, 0); PG8_STAGE(PG8_SA(0, 1), a2 + hstep, voffA);
            PG8_WAIT_L(8); PG8_BAR; PG8_WAIT_L(0); PG8_MMA(0, 0, At, B0); PG8_BAR; PG8_SCHED;
            PG8_LDB(B1, 1, 1); PG8_STAGE(PG8_SB(1, 0), b3, voffB);
            PG8_BAR; PG8_WAIT_L(0); PG8_MMA(0, 1, At, B1); PG8_BAR;
            PG8_LDA(At, 1, 1); PG8_STAGE(PG8_SA(1, 0), a3, voffA);
            PG8_BAR; PG8_WAIT_L(0); PG8_MMA(1, 0, At, B0); PG8_BAR; PG8_SCHED;
            PG8_STAGE(PG8_SB(1, 1), b3 + hstep, voffB);
            PG8_WAIT_V(6); PG8_BAR; PG8_MMA(1, 1, At, B1); PG8_BAR;
            }
        }
        if constexpr (ALIGN_EPI) { if (wr == 0) PG8_BAR; }
        if constexpr (!Epi::AFTER_DRAIN) { E(acc, cur, wr, wc, fr, fq); S.done(cur); }
        if (!has_next) break;
#pragma unroll
        for (int a = 0; a < 2; ++a)
#pragma unroll
            for (int b = 0; b < 2; ++b)
#pragma unroll
                for (int m = 0; m < 4; ++m)
#pragma unroll
                    for (int n = 0; n < 2; ++n) acc[a][b][m][n] = (f32x4){0.f, 0.f, 0.f, 0.f};
        cur = nxt; cA = nA; cB = nB; ++ui;
        if constexpr (ALIGN_EPI) { if (wr == 1) PG8_BAR; }
    }
    PG8_WAIT_V(0);
    if constexpr (!ALIGN_EPI) { if (wr == 0) PG8_BAR; }
    PG8_BAR;
    if constexpr (Epi::AFTER_DRAIN) { E.fused(acc, cur, wr, wc, fr, fq, lds, wid, lane); S.done(cur); }
#undef PG8_SA
#undef PG8_KOFFA
#undef PG8_SB
#undef PG8_STAGE
#undef PG8_LDA
#undef PG8_LDB
#undef PG8_MMA
#undef PG8_WAIT_V
#undef PG8_WAIT_L
#undef PG8_BAR
#undef PG8_SCHED
}
}

namespace att {
typedef unsigned short bf16;
typedef short bf16x8 __attribute__((ext_vector_type(8)));
typedef short s16x4 __attribute__((ext_vector_type(4)));
typedef float f32x16 __attribute__((ext_vector_type(16)));
typedef float f32x4 __attribute__((ext_vector_type(4)));
typedef unsigned u32x4 __attribute__((ext_vector_type(4)));
typedef unsigned u32x2 __attribute__((ext_vector_type(2)));
constexpr int D = 128, PITCH = 2048, SEQ = 4096, NH = 16, NB = 8;
constexpr float THR = 8.f;
constexpr float SCALE = 0.08838834764831845f;
constexpr float INV_SCALE = 11.313708498984761f;
constexpr int NW = 8, QBLK = 32, KVBLK = 64, QB = NW * QBLK;
constexpr int SHM_V = KVBLK * D * 2, SHM_K = KVBLK * D * 2;
constexpr int LDS_WS = 2 * SHM_V + 2 * SHM_K;
constexpr int LDS_FB = LDS_WS + NW * 64 * 4;
constexpr int LDS_BYTES = LDS_FB + SEQ * 8;
constexpr int W = 1 << 30;

#define KSWZ(row, colB) ((row) * 256 + ((colB) ^ (((row) & 7) << 4)))
#define SBAR() __builtin_amdgcn_sched_barrier(0)
__device__ __forceinline__ int v_st(int k, int c) { const int kk = (k & ~0xC) | ((k & 4) << 1) | ((k & 8) >> 1); return ((kk >> 3) * 4 + (c >> 5)) * 512 + ((kk & 7) * 32 + (c & 31)) * 2; }
__device__ __forceinline__ int v_rd_base(int lane) { return ((lane & 3) << 3) | (((lane >> 2) & 3) << 6) | (((lane >> 4) & 1) << 5) | (((lane >> 5) & 1) << 8); }
constexpr int v_rd_off(int d0, int ks, int half) { return d0 * 512 + ks * 4096 + half * 2048; }
__device__ __forceinline__ int crow(int r, int hi) { return (r & 3) + 8 * (r >> 2) + 4 * hi; }
__device__ __forceinline__ unsigned cvtpk(float lo, float hi) { unsigned r; asm volatile("v_cvt_pk_bf16_f32 %0, %1, %2" : "=v"(r) : "v"(lo), "v"(hi)); return r; }
__device__ __forceinline__ bf16x8 load8(const bf16* p) { return *reinterpret_cast<const bf16x8*>(p); }
__device__ __forceinline__ void mask_tile(f32x16& p0, f32x16& p1, int dq, unsigned Wm) {
    const float NEG = -__builtin_inff();
#pragma unroll
    for (int r = 0; r < 16; ++r) {
        const int c = (r & 3) + 8 * (r >> 2);
        if ((unsigned)(dq - c) >= Wm) p0[r] = NEG;
        if ((unsigned)(dq - c - 32) >= Wm) p1[r] = NEG;
    }
}
__device__ __forceinline__ void partialSM(f32x16& p0, f32x16& p1, float& m_reg, float& mn, float& alpha) {
    float pmax = p0[0]; for (int r = 1; r < 16; ++r) pmax = fmaxf(pmax, p0[r]); for (int r = 0; r < 16; ++r) pmax = fmaxf(pmax, p1[r]);
    { auto rr = __builtin_amdgcn_permlane32_swap(__float_as_uint(pmax), __float_as_uint(pmax), false, false);
      pmax = fmaxf(__uint_as_float(rr[0]), __uint_as_float(rr[1])); }
    constexpr float C2 = 1.4426950408889634f * SCALE;
    if (__builtin_expect(__all((pmax - m_reg) * SCALE <= THR), 1)) { mn = m_reg; alpha = 1.f; }
    else { mn = fmaxf(m_reg, pmax); alpha = __builtin_amdgcn_exp2f((m_reg - mn) * C2); m_reg = mn; }
    const float mnL = -mn * C2;
    for (int r = 0; r < 16; ++r) p0[r] = fmaf(p0[r], C2, mnL); for (int r = 0; r < 16; ++r) p1[r] = fmaf(p1[r], C2, mnL);
    for (int r = 0; r < 16; ++r) p0[r] = __builtin_amdgcn_exp2f(p0[r]);
}
__device__ __forceinline__ void finishSM(f32x16& p0, f32x16& p1, float alpha, float& l_reg, bf16x8& pa0, bf16x8& pa1, bf16x8& pa2, bf16x8& pa3) {
    for (int r = 0; r < 16; ++r) p1[r] = __builtin_amdgcn_exp2f(p1[r]);
    float ps = 0; for (int r = 0; r < 16; ++r) ps += p0[r]; for (int r = 0; r < 16; ++r) ps += p1[r];
    { auto rr = __builtin_amdgcn_permlane32_swap(__float_as_uint(ps), __float_as_uint(ps), false, false);
      ps = __uint_as_float(rr[0]) + __uint_as_float(rr[1]); }
    l_reg = l_reg * alpha + ps;
#define PK4(P, B_, OUT) do { unsigned a0 = cvtpk(P[B_+0], P[B_+1]), a1 = cvtpk(P[B_+2], P[B_+3]);                          \
        unsigned b0 = cvtpk(P[B_+4], P[B_+5]), b1 = cvtpk(P[B_+6], P[B_+7]);                                             \
        auto r0 = __builtin_amdgcn_permlane32_swap(a0, b0, false, false); auto r1 = __builtin_amdgcn_permlane32_swap(a1, b1, false, false); \
        u32x4 w = {r0[0], r1[0], r0[1], r1[1]}; OUT = *reinterpret_cast<bf16x8*>(&w); } while (0)
    PK4(p0, 0, pa0); PK4(p0, 8, pa1); PK4(p1, 0, pa2); PK4(p1, 8, pa3);
#undef PK4
}
template <int KB>
__device__ __forceinline__ void qkt(f32x16& p0, f32x16& p1, const char* K_lds, int r32, int hi, const bf16x8* qr, const char* fb, bf16x8 ones) {
    p0 = f32x16{}; p1 = f32x16{};
    const char* kb[4];
#pragma unroll
    for (int dd = 0; dd < 4; ++dd) kb[dd] = K_lds + KB * SHM_K + KSWZ(r32, (dd * 16 + hi * 8) * 2);
#pragma unroll
    for (int d0 = 0; d0 < 8; ++d0) { const char* a = kb[d0 & 3] + (d0 >> 2) * 128;
        bf16x8 b0 = *reinterpret_cast<const bf16x8*>(a);
        bf16x8 b1 = *reinterpret_cast<const bf16x8*>(a + 32 * 256);
        p0 = __builtin_amdgcn_mfma_f32_32x32x16_bf16(b0, qr[d0], p0, 0, 0, 0);
        p1 = __builtin_amdgcn_mfma_f32_32x32x16_bf16(b1, qr[d0], p1, 0, 0, 0); }
    { const u32x2 t0 = *reinterpret_cast<const u32x2*>(fb), t1 = *reinterpret_cast<const u32x2*>(fb + 32 * 8);
      u32x4 w0 = {t0.x, t0.y, 0u, 0u}, w1 = {t1.x, t1.y, 0u, 0u};
      p0 = __builtin_amdgcn_mfma_f32_32x32x16_bf16(*reinterpret_cast<bf16x8*>(&w0), ones, p0, 0, 0, 0);
      p1 = __builtin_amdgcn_mfma_f32_32x32x16_bf16(*reinterpret_cast<bf16x8*>(&w1), ones, p1, 0, 0, 0); }
}
template <int VB>
__device__ __forceinline__ void pv_tile(f32x16* o, int vb0, bf16x8 pa0, bf16x8 pa1, bf16x8 pa2, bf16x8 pa3) {
#define TRRD(dst, off) asm volatile("ds_read_b64_tr_b16 %0, %1 offset:%2" : "=&v"(dst) : "v"(vb0), "i"(off) : "memory")
#define PV_D0(d0) do { s16x4 l0, l1, l2, l3, h0, h1, h2, h3; constexpr int b_ = VB * SHM_V + v_rd_off(d0, 0, 0); \
        TRRD(l0, b_); TRRD(h0, b_ + 2048); TRRD(l1, b_ + 4096); TRRD(h1, b_ + 6144); TRRD(l2, b_ + 8192); TRRD(h2, b_ + 10240); TRRD(l3, b_ + 12288); TRRD(h3, b_ + 14336); \
        asm volatile("s_waitcnt lgkmcnt(0)" ::: "memory"); SBAR();   \
        o[d0] = __builtin_amdgcn_mfma_f32_32x32x16_bf16(pa0, (bf16x8){l0[0], l0[1], l0[2], l0[3], h0[0], h0[1], h0[2], h0[3]}, o[d0], 0, 0, 0);   \
        o[d0] = __builtin_amdgcn_mfma_f32_32x32x16_bf16(pa1, (bf16x8){l1[0], l1[1], l1[2], l1[3], h1[0], h1[1], h1[2], h1[3]}, o[d0], 0, 0, 0);   \
        o[d0] = __builtin_amdgcn_mfma_f32_32x32x16_bf16(pa2, (bf16x8){l2[0], l2[1], l2[2], l2[3], h2[0], h2[1], h2[2], h2[3]}, o[d0], 0, 0, 0);   \
        o[d0] = __builtin_amdgcn_mfma_f32_32x32x16_bf16(pa3, (bf16x8){l3[0], l3[1], l3[2], l3[3], h3[0], h3[1], h3[2], h3[3]}, o[d0], 0, 0, 0); } while (0)
    PV_D0(0); PV_D0(1); PV_D0(2); PV_D0(3);
#undef PV_D0
#undef TRRD
}
struct BlockRef { const bf16* Q; const bf16* K; const bf16* V; bf16* O; int P0; };
struct Seam { bf16x8 qr[8]; bf16x8 st_v0, st_v1, st_k0, st_k1; };
#define ROW(p, k0, rr) ((p) + (size_t)((k0) + (rr)) * PITCH + sc)
#define VMW() asm volatile("s_waitcnt vmcnt(0)" ::: "memory")
#define VMWN(n) asm volatile("s_waitcnt vmcnt(%0)" :: "i"(n) : "memory")
#define SLOAD_H(Kp, Vp, k0) do { S.st_v0 = load8(ROW(Vp, k0, sr)); S.st_v1 = load8(ROW(Vp, k0, 32 + sr));              \
                         S.st_k0 = load8(ROW(Kp, k0, sr)); S.st_k1 = load8(ROW(Kp, k0, 32 + sr)); } while (0)
#define SWRITE_HK(bf) do { *(bf16x8*)(K_lds + (bf) * SHM_K + kws) = S.st_k0; *(bf16x8*)(K_lds + (bf) * SHM_K + kws + 32 * 256) = S.st_k1; } while (0)
#define SWRITE_HV(bf) do { *(bf16x8*)(V_lds + (bf) * SHM_V + vst0) = S.st_v0; *(bf16x8*)(V_lds + (bf) * SHM_V + vst1) = S.st_v1; } while (0)
#define SWRITE_H(bf) do { SWRITE_HV(bf); SWRITE_HK(bf); } while (0)
__device__ __forceinline__ void prime(const BlockRef& cur, char* lds, Seam& S) {
    int tid_ = threadIdx.x; asm volatile("" : "+v"(tid_));
    const int tid = tid_, wid = __builtin_amdgcn_readfirstlane(tid >> 6), lane = tid & 63, r32 = lane & 31, hi = lane >> 5;
    const int sr = tid >> 4, sc = (tid & 15) * 8, kws = KSWZ(sr, sc * 2); char* K_lds = lds + 2 * SHM_V;
    for (int d0 = 0; d0 < 8; ++d0) S.qr[d0] = load8(cur.Q + (size_t)(wid * QBLK + r32) * PITCH + d0 * 16 + hi * 8);
    SLOAD_H(cur.K, cur.V, 0); VMW(); SWRITE_HK(0);
    __syncthreads();
}
__device__ __forceinline__ void block(const BlockRef& cur, const BlockRef& nxt, const float* Fcum, char* lds, Seam& S) {
    int tid_ = threadIdx.x; asm volatile("" : "+v"(tid_));
    const int tid = tid_, wid = __builtin_amdgcn_readfirstlane(tid >> 6), lane = tid & 63, r32 = lane & 31, hi = lane >> 5;
    const int NT = cur.P0 / KVBLK + 4;
    const int qlo = cur.P0 + wid * QBLK, qm = qlo + r32 - 4 * hi;
    char* V_lds = lds; char* K_lds = lds + 2 * SHM_V;
    float* ws = (float*)(lds + LDS_WS) + wid * 64; float* li_l = ws, * al_l = ws + 32;
    const char* FBl = lds + LDS_FB + r32 * 8;
    if (Fcum) {
#pragma unroll
        for (int i = 0; i < SEQ / 512; ++i) { const int s = tid + 512 * i; const float x = -Fcum[s] * INV_SCALE;
            const unsigned xh = cvtpk(x, 0.f) & 0xffffu; const float r1 = x - __uint_as_float(xh << 16);
            const unsigned xm = cvtpk(r1, 0.f) & 0xffffu; const float r2 = r1 - __uint_as_float(xm << 16);
            const unsigned xl = cvtpk(r2, 0.f) & 0xffffu;
            *(u32x2*)(lds + LDS_FB + s * 8) = (u32x2){xh | (xm << 16), xl}; }
        __syncthreads();
    }
    u32x4 onesw = {hi == 0 ? 0x3F803F80u : 0u, hi == 0 ? 0x00003F80u : 0u, 0u, 0u};
    const bf16x8 ones = *reinterpret_cast<bf16x8*>(&onesw);
    float m_reg = -1e30f, l_reg = 0; f32x16 o[4] = {};
    const int sr = tid >> 4, sc = (tid & 15) * 8, vst0 = v_st(sr, sc), vst1 = v_st(32 + sr, sc), kws = KSWZ(sr, sc * 2);
    const int vb0 = (int)(uintptr_t)V_lds + v_rd_base(lane);
    const bf16* Kh = cur.K; const bf16* Vh = cur.V;
#define RESC(a) do { if (__any((a) < 1.f)) { if (hi == 0) al_l[r32] = (a); asm volatile("s_waitcnt lgkmcnt(0)" ::: "memory");              \
                     for (int d_ = 0; d_ < 4; ++d_) for (int r = 0; r < 16; ++r) o[d_][r] *= al_l[crow(r, hi)]; } } while (0)
#define KBASE(t) ((t) * KVBLK)
#define MASKT(P0_, P1_, t) do { const int kb_ = KBASE(t); if (kb_ + KVBLK - 1 > qlo) mask_tile(P0_, P1_, qm - kb_, (unsigned)W); } while (0)
    constexpr int NQL = 8;
#define SEAM_K0() do { VMWN(NQL); SWRITE_HK(0); SBAR(); } while (0)
    f32x16 pA0, pA1, pB0, pB1; float mnA, mnB, alA, alB; bf16x8 pa0, pa1, pa2, pa3;
    SWRITE_HV(0); SBAR();
    if (NT > 1) { SLOAD_H(Kh, Vh, KBASE(1)); }
    SBAR(); qkt<0>(pA0, pA1, K_lds, r32, hi, S.qr, FBl + KBASE(0) * 8, ones);
    MASKT(pA0, pA1, 0); partialSM(pA0, pA1, m_reg, mnA, alA);
    if (NT > 1) { VMW(); SWRITE_H(1); }
    __syncthreads();
#define HALF_STEP(PX0, PX1, mnX, alX, PY0, PY1, alY, t, KB, VB, SB) do {                                                      \
        SBAR(); qkt<KB>(PX0, PX1, K_lds, r32, hi, S.qr, FBl + KBASE(t) * 8, ones);                                             \
        finishSM(PY0, PY1, alY, l_reg, pa0, pa1, pa2, pa3); SBAR();                                                           \
        if ((t) + 1 < NT) { SLOAD_H(Kh, Vh, KBASE((t) + 1)); SBAR(); }                                               \
        pv_tile<VB>(o, vb0, pa0, pa1, pa2, pa3); MASKT(PX0, PX1, (t)); partialSM(PX0, PX1, m_reg, mnX, alX);                                        \
        __syncthreads();                                                                                                      \
        if ((t) + 1 < NT) { VMW(); SWRITE_H(SB); }                                                                          \
        RESC(alX); __syncthreads(); } while (0)
    for (int t = 1; t + 1 < NT; t += 2) {
        HALF_STEP(pB0, pB1, mnB, alB, pA0, pA1, alA, t, 1, 0, 0);
        HALF_STEP(pA0, pA1, mnA, alA, pB0, pB1, alB, t + 1, 0, 1, 1);
    }
    const bool even = (NT & 1) == 0;
    if (even) { SBAR(); qkt<1>(pB0, pB1, K_lds, r32, hi, S.qr, FBl + KBASE(NT - 1) * 8, ones); SBAR(); }
    SLOAD_H(nxt.K, nxt.V, 0); SBAR();
#pragma unroll
    for (int d0 = 0; d0 < 8; ++d0) S.qr[d0] = load8(nxt.Q + (size_t)(wid * QBLK + r32) * PITCH + d0 * 16 + hi * 8);
    SBAR();
    finishSM(pA0, pA1, alA, l_reg, pa0, pa1, pa2, pa3); SBAR();
    pv_tile<0>(o, vb0, pa0, pa1, pa2, pa3);
    if (even) { MASKT(pB0, pB1, NT - 1); partialSM(pB0, pB1, m_reg, mnB, alB); __syncthreads(); RESC(alB);
        finishSM(pB0, pB1, alB, l_reg, pa0, pa1, pa2, pa3); SBAR(); pv_tile<1>(o, vb0, pa0, pa1, pa2, pa3); }
    SBAR(); SEAM_K0();
    if (hi == 0) li_l[r32] = l_reg; asm volatile("s_waitcnt lgkmcnt(0)" ::: "memory");
    float rli[16];
#pragma unroll
    for (int r = 0; r < 16; ++r) rli[r] = __builtin_amdgcn_rcpf(li_l[crow(r, hi)]);
    bf16* Ow = cur.O + (size_t)(wid * QBLK) * PITCH;
#pragma unroll
    for (int r = 0; r < 16; ++r) { const int orow = crow(r, hi);
#pragma unroll
        for (int d0 = 0; d0 < 4; ++d0) { const float v = o[d0][r] * rli[r];
            const float vn = __shfl_xor(v, 1);
            if ((r32 & 1) == 0) *(unsigned*)(Ow + (size_t)orow * PITCH + d0 * 32 + r32) = cvtpk(v, vn); } }
    __syncthreads();
#undef RESC
#undef KBASE
#undef MASKT
#undef SEAM_K0
#undef HALF_STEP
}
#undef ROW
#undef VMW
#undef VMWN
#undef SLOAD_H
#undef SWRITE_HK
#undef SWRITE_HV
#undef SWRITE_H
}


constexpr int NWAVES = 8;
#ifndef MK_N_LAUNCHES
#define MK_N_LAUNCHES 1
#endif
constexpr int BATCH = 8, SEQ = 4096, D = 2048, M = BATCH * SEQ, DEPTH = 4, NA = 2;
constexpr int GH = 3 * D  , GN = 2 * GH  , NG = 8, GD = GH / NG  , GB = 128;
constexpr int NH = 16, HD = 128, FF = 4 * D, NMOD = 6 * D;
constexpr float EPS = 1e-6f;
constexpr size_t MiB = 1u << 20;
constexpr size_t WS_CTL = 0, CTL_ZERO_BYTES = 1 * MiB;
constexpr size_t WS_MOD = 1 * MiB;
constexpr size_t WS_KVMOD = WS_MOD + (size_t)DEPTH * BATCH * NMOD * 4;
constexpr size_t WS_WSM = 3 * MiB;
constexpr size_t WS_LOGF = 4 * MiB, WS_FB = 6 * MiB;
constexpr size_t WS_VSTAT = 8 * MiB;
constexpr size_t WS_WT = 40 * MiB;
constexpr size_t WT_WIN = 0, WT_WOUT = WT_WIN + (size_t)2 * GN * D, WT_W1 = WT_WOUT + (size_t)2 * D * GH, WT_W2 = WT_W1 + (size_t)4 * FF * D,
                 WT_WKV = WT_W2 + (size_t)4 * D * FF, WT_WQ = WT_WKV + (size_t)2 * D * D, WT_WO = WT_WQ + (size_t)2 * D * D, WT_END = WT_WO + (size_t)2 * D * D;
static_assert(WT_END * 2 == 448 * MiB, "weights");
constexpr size_t WS_H = 488 * MiB;
constexpr size_t WS_Z = 616 * MiB;
constexpr size_t WS_U = WS_Z, WS_V = WS_Z + 384 * MiB;
constexpr size_t WS_HID = WS_Z;
constexpr size_t WS_Q = WS_Z, WS_O = WS_Z + 128 * MiB, WS_HKV = WS_Z + 256 * MiB, WS_KB = WS_Z + 512 * MiB, WS_VB = WS_Z + 640 * MiB;
constexpr size_t WS_END = WS_Z + 768 * MiB;
constexpr int CW_BAR = 4096;
constexpr int RING_BYTES = 131072, LDS_BYTES = 163840, LDSCTL_OFF = LDS_BYTES - 512, MISC_OFF = LDSCTL_OFF + 320;

#define GAS __attribute__((address_space(1)))
#define LAS __attribute__((address_space(3)))
typedef unsigned short bf16;
typedef unsigned v4u __attribute__((ext_vector_type(4)));
typedef unsigned v2u __attribute__((ext_vector_type(2)));
typedef float f32x4 __attribute__((ext_vector_type(4)));
typedef float f32x2 __attribute__((ext_vector_type(2)));
typedef short bf16x8 __attribute__((ext_vector_type(8)));
typedef short s16x4 __attribute__((ext_vector_type(4)));
typedef float f32x16 __attribute__((ext_vector_type(16)));
typedef GAS unsigned gu32;
#define RLX_AGENT __ATOMIC_RELAXED, __HIP_MEMORY_SCOPE_AGENT
#define LDS_WAIT() asm volatile("s_waitcnt lgkmcnt(0)" ::: "memory")
#define VM_WAIT() asm volatile("s_waitcnt vmcnt(0)" ::: "memory")
#define RAW_BAR() do { asm volatile("s_waitcnt lgkmcnt(0)" ::: "memory"); __builtin_amdgcn_s_barrier(); asm volatile("" ::: "memory"); } while (0)
__device__ __forceinline__ unsigned f2bf(float f) { unsigned u = __builtin_bit_cast(unsigned, f); return (u + 0x7fffu + ((u >> 16) & 1u)) >> 16; }
__device__ __forceinline__ unsigned pk2(float lo, float hi) { unsigned r; asm volatile("v_cvt_pk_bf16_f32 %0, %1, %2" : "=v"(r) : "v"(lo), "v"(hi)); return r; }
__device__ __forceinline__ float bflo(unsigned w) { return __uint_as_float(w << 16); }
__device__ __forceinline__ float bfhi(unsigned w) { return __uint_as_float(w & 0xffff0000u); }

#define XB_TMO      128
#define XB_XCNT(j)  (256  + 64 * (j))
#define XB_XSUB(j)  (1280 + 64 * (j))
#define XB_XGEN(j)  (2304 + 64 * (j))
#define XB_TOP      3328
#define XB_TOPGEN   3392
#define XCD_BAR_WORDS 3456
#define XB_SPIN_CAP (1u << 18)
__device__ __forceinline__ unsigned xb_ld(unsigned* p)              { return __hip_atomic_load(p, __ATOMIC_RELAXED, __HIP_MEMORY_SCOPE_AGENT); }
__device__ __forceinline__ unsigned xb_add(unsigned* p, unsigned v) { return __hip_atomic_fetch_add(p, v, __ATOMIC_RELAXED, __HIP_MEMORY_SCOPE_AGENT); }
__device__ __forceinline__ unsigned xb_xcc_id() { return (unsigned)__builtin_amdgcn_s_getreg((3 << 11) | 20) & 0xFu; }
#define XB_SPIN(cond, bar) do { unsigned _sp = 0; while (cond) { __builtin_amdgcn_s_sleep(1); \
    if ((++_sp & 255u) == 0u) { if (xb_ld(&(bar)[XB_TMO])) break; if (_sp > XB_SPIN_CAP) { atomicAdd(&(bar)[XB_TMO], 1u); break; } } } } while (0)
struct XcdBarrier { unsigned* bar; unsigned x; volatile LAS unsigned* st; };
__device__ __forceinline__ XcdBarrier xcd_barrier_post(unsigned* bar, volatile LAS unsigned* st) {
    XcdBarrier b; b.bar = bar; b.x = xb_xcc_id(); b.st = st;
    if (threadIdx.x == 0) (void)xb_add(&bar[XB_XCNT(b.x)], 1u);
    return b;
}
__device__ __forceinline__ void xcd_barrier_complete(unsigned* bar, unsigned x, unsigned& nloc, unsigned& nx) {
    const unsigned G = gridDim.x * gridDim.y * gridDim.z;
    unsigned sum, cnt, mine, sp = 0u;
    for (;;) {
        sum = 0u; cnt = 0u; mine = 0u;
#pragma unroll
        for (unsigned j = 0; j < 16; ++j) { const unsigned c = xb_ld(&bar[XB_XCNT(j)]); sum += c; cnt += (c > 0u) ? 1u : 0u; mine = (j == x) ? c : mine; }
        if (sum == G) break;
        __builtin_amdgcn_s_sleep(1);
        if ((++sp & 255u) == 0u) { if (xb_ld(&bar[XB_TMO])) break; if (sp > XB_SPIN_CAP) { atomicAdd(&bar[XB_TMO], 1u); break; } }
    }
    nloc = mine > 0u ? mine : 1u; nx = cnt > 0u ? cnt : 1u;
}
__device__ __forceinline__ void xcd_barrier(const XcdBarrier& b) {
    asm volatile("s_waitcnt vmcnt(0)" ::: "memory");
    __syncthreads();
    if (threadIdx.x == 0) {
        unsigned* bar = b.bar;
        __builtin_amdgcn_s_waitcnt(0);
        unsigned nloc = b.st[0], nx = b.st[1];
        if (nloc == 0u) { xcd_barrier_complete(bar, b.x, nloc, nx); b.st[0] = nloc; b.st[1] = nx; }
        const unsigned old = xb_add(&bar[XB_XSUB(b.x)], 1u);
        const unsigned gen = old / nloc;
        if (old + 1u == (gen + 1u) * nloc) {
            __builtin_amdgcn_fence(__ATOMIC_RELEASE, "agent");
            asm volatile("s_waitcnt vmcnt(0)" ::: "memory");
            const unsigned og = xb_add(&bar[XB_TOP], 1u);
            const unsigned tg = og / nx;
            if (og + 1u == (tg + 1u) * nx) xb_add(&bar[XB_TOPGEN], 1u);
            else XB_SPIN(xb_ld(&bar[XB_TOPGEN]) == tg, bar);
            __builtin_amdgcn_fence(__ATOMIC_ACQUIRE, "agent");
            xb_add(&bar[XB_XGEN(b.x)], 1u);
            asm volatile("s_waitcnt vmcnt(0)" ::: "memory");
        } else {
            XB_SPIN(xb_ld(&bar[XB_XGEN(b.x)]) == gen, bar);
            __builtin_amdgcn_fence(__ATOMIC_ACQUIRE, "agent");
            asm volatile("s_waitcnt vmcnt(0)" ::: "memory");
        }
    }
    __syncthreads();
}

struct Frame {
    LAS unsigned char* lds;
    int vcu, G;
};
constexpr int PT_OUT = 23, PT_WS = 24;
template <class T> __device__ __forceinline__ T* ldptr(const Frame& F, int i) {
    const unsigned long long v = ((const LAS unsigned long long*)(F.lds + LDSCTL_OFF))[i];
    const unsigned lo = __builtin_amdgcn_readfirstlane((unsigned)v), hi = __builtin_amdgcn_readfirstlane((unsigned)(v >> 32));
    return (T*)(((unsigned long long)hi << 32) | lo);
}
#define INP(i) ldptr<const float>(F, (i))
#define WSP() ldptr<unsigned char>(F, PT_WS)
#define PHASE_IDS int tid_ = threadIdx.x; asm volatile("" : "+v"(tid_)); const int tid = tid_, lane = tid & 63, wave = __builtin_amdgcn_readfirstlane(tid >> 6); (void)lane; (void)wave;
__device__ __forceinline__ float wave_sum(float v) {
#pragma unroll
    for (int o = 1; o < 64; o <<= 1) v += __shfl_xor(v, o);
    return v;
}
__device__ __forceinline__ void p0_transpose_item(const float* W, int K, int N, bf16* WT, LAS float* scr, int item, int lane) {
    const int nblk = N / 32, kb = item / nblk, nb = item % nblk, k0 = 64 * kb, n0 = 32 * nb;
#pragma unroll 8
    for (int i = 0; i < 32; ++i) { const int kk = 2 * i + (lane >> 5); scr[kk * 33 + (lane & 31)] = W[(size_t)(k0 + kk) * N + n0 + (lane & 31)]; }
    LDS_WAIT(); asm volatile("" ::: "memory");
    const int c = lane & 7;
#pragma unroll
    for (int j = 0; j < 4; ++j) { const int n = (lane >> 3) + 8 * j; const LAS float* s = scr + (8 * c) * 33 + n;
        v4u o; o.x = pk2(s[0 * 33], s[1 * 33]); o.y = pk2(s[2 * 33], s[3 * 33]); o.z = pk2(s[4 * 33], s[5 * 33]); o.w = pk2(s[6 * 33], s[7 * 33]);
        *(GAS v4u*)(WT + (size_t)(n0 + n) * K + k0 + 8 * c) = o; }
    LDS_WAIT(); asm volatile("" ::: "memory");
}

struct Args { const float* in[23]; float* out; unsigned char* ws; int ph_lo, ph_hi, li, pad; };
enum { I_X = 0, I_C, I_ADAW, I_ADAB, I_NORMG, I_W1, I_W2, I_WIN, I_LNG, I_LNB, I_WS, I_BS, I_WOUT, I_KVNG, I_KVADAW, I_KVADAB, I_WKV, I_KNG, I_WF, I_BF, I_WQ, I_QNG, I_WO };

__device__ __forceinline__ void p0_prologue(Frame& F) {
    PHASE_IDS
    unsigned char* const wsp = WSP();
    bf16* WT = (bf16*)(wsp + WS_WT);
    const int NSTRIP = DEPTH * (NMOD / 256) + (2 * D) / 256;
    for (int it = blockIdx.x; it < NSTRIP; it += F.G) {
        LAS float* SC = (LAS float*)F.lds;
        LAS float* RED = (LAS float*)(F.lds + 65536);
        const float* c = INP(I_C);
        for (int i = tid; i < BATCH * D; i += NWAVES * 64) { const int b = i / D, k = i % D; const float x = c[i]; SC[k * 8 + b] = x / (1.f + __expf(-x)); }
        __syncthreads();
        const float* W; const float* bias; float* out; int N, n0;
        if (it < DEPTH * (NMOD / 256)) { const int l = it / (NMOD / 256), s = it % (NMOD / 256); W = INP(I_ADAW) + (size_t)l * D * NMOD; N = NMOD; n0 = s * 256; bias = INP(I_ADAB) + l * NMOD; out = (float*)(wsp + WS_MOD) + (size_t)l * BATCH * NMOD; }
        else { const int s = it - DEPTH * (NMOD / 256); W = INP(I_KVADAW); N = 2 * D; n0 = s * 256; bias = INP(I_KVADAB); out = (float*)(wsp + WS_KVMOD); }
        f32x4 acc[8];
#pragma unroll
        for (int b = 0; b < 8; ++b) acc[b] = (f32x4){0.f, 0.f, 0.f, 0.f};
        const float* wp = W + (size_t)(wave * 256) * N + n0 + 4 * lane;
#pragma unroll 8
        for (int k = 0; k < 256; ++k) { const f32x4 wv = *(const f32x4*)(wp + (size_t)k * N);
            const f32x4 s0 = *(const LAS f32x4*)(SC + (wave * 256 + k) * 8), s1 = *(const LAS f32x4*)(SC + (wave * 256 + k) * 8 + 4);
            acc[0] += s0.x * wv; acc[1] += s0.y * wv; acc[2] += s0.z * wv; acc[3] += s0.w * wv; acc[4] += s1.x * wv; acc[5] += s1.y * wv; acc[6] += s1.z * wv; acc[7] += s1.w * wv; }
#pragma unroll
        for (int b = 0; b < 8; ++b) *(LAS f32x4*)(RED + (wave * 8 + b) * 256 + 4 * lane) = acc[b];
        __syncthreads();
#pragma unroll
        for (int i = 0; i < 4; ++i) { const int idx = tid + 512 * i, b = idx >> 8, col = idx & 255; float s = bias[n0 + col];
#pragma unroll
            for (int w = 0; w < 8; ++w) s += RED[(w * 8 + b) * 256 + col];
            out[(size_t)b * N + n0 + col] = s; }
        __syncthreads();
    }
    { float* WSF = (float*)(wsp + WS_WSM); const float* ws_in = INP(I_WS);
      for (int i = blockIdx.x * 512 + tid; i < NA * NG * GB * GB; i += F.G * 512) { const int col = i & 127, row = (i >> 7) & 127; WSF[i] = ((col >> 6) <= (row >> 6)) ? ws_in[i] : 0.f; } }
    LAS float* scr = (LAS float*)(F.lds + wave * 16384);
    const int gw = F.vcu * NWAVES + wave, NGW = F.G * NWAVES;
    constexpr int UNIT = 2048;
    for (int it = gw; it < 56 * UNIT; it += NGW) {
        const int u = it / UNIT, r = it % UNIT;
        if (u < 12)      { const int l = u / 6, s = u % 6;            p0_transpose_item(INP(I_WIN) + (size_t)l * D * GN, D, GN, WT + WT_WIN + (size_t)l * GN * D, scr, s * UNIT + r, lane); }
        else if (u < 18) { const int l = (u - 12) / 3, s = (u - 12) % 3; p0_transpose_item(INP(I_WOUT) + (size_t)l * GH * D, GH, D, WT + WT_WOUT + (size_t)l * D * GH, scr, s * UNIT + r, lane); }
        else if (u < 34) { const int l = (u - 18) / 4, s = (u - 18) % 4; p0_transpose_item(INP(I_W1) + (size_t)l * D * FF, D, FF, WT + WT_W1 + (size_t)l * FF * D, scr, s * UNIT + r, lane); }
        else if (u < 50) { const int l = (u - 34) / 4, s = (u - 34) % 4; p0_transpose_item(INP(I_W2) + (size_t)l * FF * D, FF, D, WT + WT_W2 + (size_t)l * D * FF, scr, s * UNIT + r, lane); }
        else if (u < 52) { const int s = u - 50;                      p0_transpose_item(INP(I_WKV), D, 2 * D, WT + WT_WKV, scr, s * UNIT + r, lane); }
        else if (u < 54) { const int l = u - 52;                      p0_transpose_item(INP(I_WQ) + (size_t)l * D * D, D, D, WT + WT_WQ + (size_t)l * D * D, scr, r, lane); }
        else             { const int l = u - 54;                      p0_transpose_item(INP(I_WO) + (size_t)l * D * D, D, D, WT + WT_WO + (size_t)l * D * D, scr, r, lane); }
    }
}

template <bool KV>
__device__ __forceinline__ void norm_phase(Frame& F, const float* xin, const float* g, const float* shift, const float* scale, int modstride, bf16* Hout,
                                           const float* kvg, const float* kvmod, bf16* HKV, const float* w_f, const float* b_f, float* LOGF) {
    PHASE_IDS
    const int gw = F.vcu * NWAVES + wave, NGW = F.G * NWAVES;
    LAS float* WFT = (LAS float*)F.lds;
    if (KV) { for (int i = tid; i < NH * D; i += NWAVES * 64) { const int h = i / D, col = i % D; WFT[i] = w_f[col * NH + h]; } __syncthreads(); }
    for (int it = gw; it < M / 16; it += NGW) {
        const int row0 = it * 16, b = row0 / SEQ;
        f32x4 gs[8], sh[8];
#pragma unroll
        for (int j = 0; j < 8; ++j) { const int c = 4 * lane + 256 * j; const f32x4 gv = *(const f32x4*)(g + c), sc = *(const f32x4*)(scale + (size_t)b * modstride + c);
            gs[j] = gv * (1.f + sc); sh[j] = *(const f32x4*)(shift + (size_t)b * modstride + c);
        }
        for (int r = 0; r < 16; ++r) { const int row = row0 + r;
            const GAS f32x4* xr = (const GAS f32x4*)(xin + (size_t)row * D) + lane;
            f32x4 v[8]; float s = 0.f;
#pragma unroll
            for (int j = 0; j < 8; ++j) { v[j] = xr[64 * j]; s += (v[j].x * v[j].x + v[j].y * v[j].y) + (v[j].z * v[j].z + v[j].w * v[j].w); }
            const float rstd = 1.f / sqrtf(wave_sum(s) * (1.f / D) + EPS);
            GAS v2u* o8 = (GAS v2u*)(Hout + (size_t)row * D) + lane;
#pragma unroll
            for (int j = 0; j < 8; ++j) { const f32x4 y = (v[j] * rstd) * gs[j] + sh[j]; o8[64 * j] = (v2u){pk2(y.x, y.y), pk2(y.z, y.w)}; }
            if (KV) {
                GAS v2u* k8 = (GAS v2u*)(HKV + (size_t)row * D) + lane; float z[16];
#pragma unroll
                for (int h = 0; h < 16; ++h) z[h] = 0.f;
#pragma unroll
                for (int j = 0; j < 8; ++j) { const int c = 4 * lane + 256 * j; const f32x4 g2 = *(const f32x4*)(kvg + c), s2 = *(const f32x4*)(kvmod + (size_t)b * 2 * D + D + c), h2 = *(const f32x4*)(kvmod + (size_t)b * 2 * D + c);
                    const f32x4 y = (v[j] * rstd) * (g2 * (1.f + s2)) + h2; k8[64 * j] = (v2u){pk2(y.x, y.y), pk2(y.z, y.w)};
#pragma unroll
                    for (int h = 0; h < 16; ++h) { const f32x4 w = *(const LAS f32x4*)(WFT + h * D + 4 * lane + 256 * j); z[h] += (y.x * w.x + y.y * w.y) + (y.z * w.z + y.w * w.w); } }
                float mine = 0.f;
#pragma unroll
                for (int h = 0; h < 16; ++h) { const float t = wave_sum(z[h]); if (lane == h) mine = t; }
                if (lane < 16) { const float zz = mine + b_f[lane]; const float ls = fminf(zz, 0.f) - log1pf(__expf(-fabsf(zz)));
                    LOGF[((size_t)b * NH + lane) * SEQ + (row - b * SEQ)] = ls; }
            }
        }
    }
    if (KV) __syncthreads();
}
__device__ __forceinline__ void headnorm_rows(Frame& F, bf16* T, const float* gain) {
    PHASE_IDS
    const int gw = F.vcu * NWAVES + wave, NGW = F.G * NWAVES;
    const int d0 = (8 * lane) & 127; const f32x4 g0 = *(const f32x4*)(gain + d0), g1 = *(const f32x4*)(gain + d0 + 4);
    for (int it = gw; it < M / 16; it += NGW) {
        for (int r = 0; r < 16; ++r) { GAS v4u* p = (GAS v4u*)(T + (size_t)(it * 16 + r) * D) + lane;
            v4u w[4];
#pragma unroll
            for (int j = 0; j < 4; ++j) w[j] = p[64 * j];
#pragma unroll
            for (int j = 0; j < 4; ++j) { float x[8] = {bflo(w[j].x), bfhi(w[j].x), bflo(w[j].y), bfhi(w[j].y), bflo(w[j].z), bfhi(w[j].z), bflo(w[j].w), bfhi(w[j].w)};
                float s = 0.f;
#pragma unroll
                for (int e = 0; e < 8; ++e) s += x[e] * x[e];
                s += __shfl_xor(s, 1); s += __shfl_xor(s, 2); s += __shfl_xor(s, 4); s += __shfl_xor(s, 8);
                const float rstd = 1.f / sqrtf(s * (1.f / HD) + EPS);
                v4u o; o.x = pk2(x[0] * rstd * g0.x, x[1] * rstd * g0.y); o.y = pk2(x[2] * rstd * g0.z, x[3] * rstd * g0.w); o.z = pk2(x[4] * rstd * g1.x, x[5] * rstd * g1.y); o.w = pk2(x[6] * rstd * g1.z, x[7] * rstd * g1.w);
                p[64 * j] = o; } }
    }
}
__device__ __forceinline__ void cumsum_phase(Frame& F, const float* LOGF, float* FB) {
    PHASE_IDS
    const int gw = F.vcu * NWAVES + wave, NGW = F.G * NWAVES;
    for (int bh = gw; bh < BATCH * NH; bh += NGW) {
        const f32x4* src = (const f32x4*)(LOGF + (size_t)bh * SEQ + 64 * lane); f32x4 v[16]; float run = 0.f;
#pragma unroll
        for (int i = 0; i < 16; ++i) { v[i] = src[i]; run += v[i].x; v[i].x = run; run += v[i].y; v[i].y = run; run += v[i].z; v[i].z = run; run += v[i].w; v[i].w = run; }
        float incl = run;
#pragma unroll
        for (int o = 1; o < 64; o <<= 1) { const float t = __shfl_up(incl, o); if (lane >= o) incl += t; }
        const float off = incl - run;
        f32x4* dst = (f32x4*)(FB + (size_t)bh * SEQ + 64 * lane);
#pragma unroll
        for (int i = 0; i < 16; ++i) dst[i] = v[i] + off;
    }
}

constexpr int SG_NCH = GH / 128;
constexpr int SG_VT = 0, SG_STG = 65536, SG_STG_ROW = 144, SG_STG_WAVE = 32 * SG_STG_ROW, SG_MEAN = SG_STG + 8 * SG_STG_WAVE  , SG_RSTD = SG_MEAN + 512, SG_RED = SG_RSTD + 512, SG_MT = SG_RED + 4096  , SG_END = SG_MT + 8 * 384;
__device__ __forceinline__ void sg_phase(Frame& F, int layer, bf16* U, const bf16* V, const f32x2* vstat, const float* ln_g, const float* ln_b, const float* WSF, const float* bs) {
    PHASE_IDS
    const int wid = wave, r32 = lane & 31, hi = lane >> 5, wq = wid & 3, ch = wid >> 2;
    LAS unsigned char* lds = F.lds;
    LAS float* MEAN = (LAS float*)(lds + SG_MEAN); LAS float* RSTD = (LAS float*)(lds + SG_RSTD); LAS f32x2* RED = (LAS f32x2*)(lds + SG_RED);
    LAS float* MT = (LAS float*)(lds + SG_MT + wid * 384);
    const unsigned vbase = (unsigned)(uintptr_t)(lds + SG_VT) + (unsigned)att::v_rd_base(lane);
    LAS unsigned char* stg = lds + SG_STG + wid * SG_STG_WAVE;
    { const int nb = blockIdx.x;
        const int r0 = nb * GB;
        { const int row = tid & 127, part = tid >> 7; float s = 0.f, ss = 0.f; const f32x2* vp = vstat + (size_t)(part * 24) * M + r0 + row;
#pragma unroll 1
          for (int q0 = 0; q0 < 24; q0 += 8) { f32x2 p[8];
#pragma unroll
            for (int q = 0; q < 8; ++q) p[q] = vp[(size_t)(q0 + q) * M];
#pragma unroll
            for (int q = 0; q < 8; ++q) { s += p[q].x; ss += p[q].y; } }
          RED[part * 128 + row] = (f32x2){s, ss}; }
        __syncthreads();
        if (tid < 128) { const f32x2 a = RED[tid], b = RED[128 + tid], c = RED[256 + tid], d = RED[384 + tid];
            const float mean = ((a.x + b.x) + (c.x + d.x)) * (1.f / GH); const float var = ((a.y + b.y) + (c.y + d.y)) * (1.f / GH) - mean * mean;
            MEAN[tid] = mean; RSTD[tid] = 1.f / sqrtf(fmaxf(var, 0.f) + EPS); }
        __syncthreads();
        const unsigned char* Vt = (const unsigned char*)V + (size_t)nb * SG_NCH * 32768;
        unsigned char* Ut = (unsigned char*)U + (size_t)nb * SG_NCH * 32768 + (size_t)(32 * wq) * 256 + (size_t)(64 * ch) * 2;
        v4u vr[4], ur[2][4]; float lg[2][2], lb[2][2];
#define SG_VLOAD(t) do { _Pragma("unroll") for (int q = 0; q < 4; ++q) vr[q] = *(const GAS v4u*)(Vt + (size_t)(t) * 32768 + (size_t)(tid + 512 * q) * 16); } while (0)
#define SG_VWRITE(buf) do { _Pragma("unroll") for (int q = 0; q < 4; ++q) *(LAS v4u*)(lds + SG_VT + (buf) * 32768 + (tid + 512 * q) * 16) = vr[q]; } while (0)
#define SG_ULOAD(t, slot) do { _Pragma("unroll") for (int q = 0; q < 4; ++q) { const int p = lane + 64 * q; ur[slot][q] = *(const GAS v4u*)(Ut + (size_t)(t) * 32768 + (p >> 3) * 256 + (p & 7) * 16); } } while (0)
#define SG_GBLOAD(t, slot) do { _Pragma("unroll") for (int dd = 0; dd < 2; ++dd) { const int c = (t) * 128 + 64 * ch + 32 * dd + r32; lg[slot][dd] = ln_g[c]; lb[slot][dd] = ln_b[c]; } } while (0)
        SG_VLOAD(0); SG_ULOAD(0, 0); SG_GBLOAD(0, 0);
        SG_VWRITE(0);
        RAW_BAR();
#pragma unroll 1
        for (int g = 0; g < NG; ++g) {
            bf16x8 wf[2][4];
            { const float* wp = WSF + ((size_t)(layer * NG + g) * GB + 32 * wq + r32) * GB + 8 * hi; float msum = 0.f, ssum = 0.f;
#pragma unroll
              for (int jt = 0; jt < 2; ++jt)
#pragma unroll
                for (int ks = 0; ks < 4; ++ks) { const int j0 = 64 * jt + 16 * ks + 8 * hi; v4u w = {0u, 0u, 0u, 0u};
                    if (jt == 0 || wq >= 2) { const f32x4 w0 = *(const f32x4*)(wp + 64 * jt + 16 * ks), w1 = *(const f32x4*)(wp + 64 * jt + 16 * ks + 4);
                        const f32x4 r0v = *(const LAS f32x4*)(RSTD + j0), r1v = *(const LAS f32x4*)(RSTD + j0 + 4), m0v = *(const LAS f32x4*)(MEAN + j0), m1v = *(const LAS f32x4*)(MEAN + j0 + 4);
                        w.x = pk2(w0.x * r0v.x, w0.y * r0v.y); w.y = pk2(w0.z * r0v.z, w0.w * r0v.w); w.z = pk2(w1.x * r1v.x, w1.y * r1v.y); w.w = pk2(w1.z * r1v.z, w1.w * r1v.w);
                        msum += (bflo(w.x) * m0v.x + bfhi(w.x) * m0v.y) + (bflo(w.y) * m0v.z + bfhi(w.y) * m0v.w) + (bflo(w.z) * m1v.x + bfhi(w.z) * m1v.y) + (bflo(w.w) * m1v.z + bfhi(w.w) * m1v.w);
                        ssum += ((w0.x + w0.y) + (w0.z + w0.w)) + ((w1.x + w1.y) + (w1.z + w1.w)); }
                    wf[jt][ks] = __builtin_bit_cast(bf16x8, w); }
              msum += __shfl_xor(msum, 32); ssum += __shfl_xor(ssum, 32);
              if (hi == 0) { MT[r32] = -msum; MT[32 + r32] = ssum; MT[64 + r32] = bs[(size_t)(layer * NG + g) * GB + 32 * wq + r32]; }
              LDS_WAIT(); }
#define SG_TRRD(dst, off) asm volatile("ds_read_b64_tr_b16 %0, %1 offset:%2" : "=&v"(dst) : "v"(va), "i"(off) : "memory")
#define SG_PV(dd, jt, buf) do { const unsigned va = vbase + (unsigned)(((buf) * 2 + (jt)) * 16384 + (2 * ch + (dd)) * 512); s16x4 l0, l1, l2, l3, h0, h1, h2, h3; \
            SG_TRRD(l0, 0); SG_TRRD(h0, 2048); SG_TRRD(l1, 4096); SG_TRRD(h1, 6144); SG_TRRD(l2, 8192); SG_TRRD(h2, 10240); SG_TRRD(l3, 12288); SG_TRRD(h3, 14336); \
            asm volatile("s_waitcnt lgkmcnt(0)" ::: "memory"); __builtin_amdgcn_sched_barrier(0); \
            o[dd] = __builtin_amdgcn_mfma_f32_32x32x16_bf16(wf[jt][0], (bf16x8){l0[0], l0[1], l0[2], l0[3], h0[0], h0[1], h0[2], h0[3]}, o[dd], 0, 0, 0); \
            o[dd] = __builtin_amdgcn_mfma_f32_32x32x16_bf16(wf[jt][1], (bf16x8){l1[0], l1[1], l1[2], l1[3], h1[0], h1[1], h1[2], h1[3]}, o[dd], 0, 0, 0); \
            o[dd] = __builtin_amdgcn_mfma_f32_32x32x16_bf16(wf[jt][2], (bf16x8){l2[0], l2[1], l2[2], l2[3], h2[0], h2[1], h2[2], h2[3]}, o[dd], 0, 0, 0); \
            o[dd] = __builtin_amdgcn_mfma_f32_32x32x16_bf16(wf[jt][3], (bf16x8){l3[0], l3[1], l3[2], l3[3], h3[0], h3[1], h3[2], h3[3]}, o[dd], 0, 0, 0); } while (0)
#define SG_CHUNK(s) do { const int t = 6 * g + 2 * s2 + (s); \
            if (t + 1 < SG_NCH) { SG_VLOAD(t + 1); SG_ULOAD(t + 1, ((s) + 1) & 1); SG_GBLOAD(t + 1, ((s) + 1) & 1); } \
            asm volatile("" ::: "memory"); __builtin_amdgcn_sched_barrier(0); \
            f32x16 o[2] = {}; \
            SG_PV(0, 0, (s) & 1); SG_PV(1, 0, (s) & 1); \
            if (wq >= 2) { SG_PV(0, 1, (s) & 1); SG_PV(1, 1, (s) & 1); } \
            _Pragma("unroll") for (int dd = 0; dd < 2; ++dd) { const float gg = lg[(s) & 1][dd], bb = lb[(s) & 1][dd]; \
                _Pragma("unroll") for (int q = 0; q < 4; ++q) { const f32x4 Aq = *(const LAS f32x4*)(MT + 8 * q + 4 * hi), Bq = *(const LAS f32x4*)(MT + 32 + 8 * q + 4 * hi), Cq = *(const LAS f32x4*)(MT + 64 + 8 * q + 4 * hi); \
                  _Pragma("unroll") for (int e = 0; e < 4; ++e) { const int r = 4 * q + e; const float val = gg * (o[dd][r] + Aq[e]) + (bb * Bq[e] + Cq[e]); \
                    *(LAS unsigned short*)(stg + att::crow(r, hi) * SG_STG_ROW + (dd * 32 + r32) * 2) = (unsigned short)f2bf(val); } } } \
            LDS_WAIT(); \
            _Pragma("unroll") for (int q = 0; q < 4; ++q) { const int p = lane + 64 * q; const v4u sv = *(const LAS v4u*)(stg + (p >> 3) * SG_STG_ROW + (p & 7) * 16); const v4u uu = ur[(s) & 1][q]; v4u w; \
                w.x = pk2(bflo(uu.x) * bflo(sv.x), bfhi(uu.x) * bfhi(sv.x)); w.y = pk2(bflo(uu.y) * bflo(sv.y), bfhi(uu.y) * bfhi(sv.y)); \
                w.z = pk2(bflo(uu.z) * bflo(sv.z), bfhi(uu.z) * bfhi(sv.z)); w.w = pk2(bflo(uu.w) * bflo(sv.w), bfhi(uu.w) * bfhi(sv.w)); \
                *(GAS v4u*)(Ut + (size_t)t * 32768 + (p >> 3) * 256 + (p & 7) * 16) = w; } \
            asm volatile("" ::: "memory"); __builtin_amdgcn_sched_barrier(0); \
            if (t + 1 < SG_NCH) SG_VWRITE(((s) + 1) & 1); \
            RAW_BAR(); } while (0)
#pragma unroll 1
            for (int s2 = 0; s2 < 3; ++s2) { SG_CHUNK(0); SG_CHUNK(1); }
        }
#undef SG_VLOAD
#undef SG_VWRITE
#undef SG_ULOAD
#undef SG_GBLOAD
#undef SG_TRRD
#undef SG_PV
#undef SG_CHUNK
        __syncthreads();
    }
}


__device__ __forceinline__ int att_bh(int L) { const int k = L >> 3; return (k >> 3) * 8 + (L & 7); }
__device__ __forceinline__ att::BlockRef att_ref(int L, int pass, const bf16* Q, const bf16* K, const bf16* V, bf16* O) {
    const int x = (L >> 3) & 7, bh = att_bh(L), b = bh >> 4, h = bh & 15, qb = pass ? 15 - x : x;
    const size_t base = (size_t)b * SEQ * D + (size_t)h * HD, qoff = base + (size_t)qb * 256 * D;
    att::BlockRef r; r.Q = Q + qoff; r.O = O + qoff; r.K = K + base; r.V = V + base; r.P0 = qb * 256; return r;
}
__device__ __forceinline__ void attn_phase(Frame& F, char* lds, const bf16* Q, const bf16* K, const bf16* V, bf16* O, const float* FB) {
    constexpr int TOTAL = BATCH * NH * 8;
    int L = blockIdx.x; if (L >= TOTAL) return;
    const int stride = F.G; int pass = 0;
    att::BlockRef cur = att_ref(L, 0, Q, K, V, O);
    att::Seam S;
    att::prime(cur, lds, S);
    for (;;) {
        const bool more_pass = pass == 0, more_item = L + stride < TOTAL, last = !more_pass && !more_item;
        int Ln = L, passn = pass + 1;
        if (!more_pass) { passn = 0; Ln = more_item ? L + stride : L; }
        const att::BlockRef nxt = last ? cur : att_ref(Ln, passn, Q, K, V, O);
        att::block(cur, nxt, pass == 0 ? FB + (size_t)att_bh(L) * SEQ : (const float*)nullptr, lds, S);
        if (last) break;
        cur = nxt; L = Ln; pass = passn;
    }
}

#ifndef DUPMASK
#define DUPMASK 0
#endif
#ifndef EN_MASK
#define EN_MASK 0xFFFF
#endif
#define EN(k) ((EN_MASK >> (k)) & 1)
#define NREP(c) (((DUPMASK >> (c)) & 1) ? 2 : 1)
__global__ void __launch_bounds__(NWAVES * 64, 2) yoco_fwd(Args args) {
    extern __shared__ __attribute__((aligned(16))) unsigned char lds[];
    Frame F;
    F.lds = (LAS unsigned char*)lds;
    F.G = gridDim.x; { const int bx = blockIdx.x; F.vcu = (F.G % 8 == 0) ? (bx % 8) * (F.G / 8) + bx / 8 : bx; }
    volatile LAS unsigned* MISC = (volatile LAS unsigned*)(F.lds + MISC_OFF);
    for (int u = threadIdx.x; u < (LDS_BYTES - LDSCTL_OFF) / 4; u += NWAVES * 64) ((LAS unsigned*)(F.lds + LDSCTL_OFF))[u] = 0u;
    __syncthreads();
    if (threadIdx.x < 25) { LAS unsigned long long* PT = (LAS unsigned long long*)(F.lds + LDSCTL_OFF); const int i = threadIdx.x;
        PT[i] = i < 23 ? (unsigned long long)args.in[i] : (i == 23 ? (unsigned long long)args.out : (unsigned long long)args.ws); }
    const int lo = args.ph_lo, hi = args.ph_hi;
    XcdBarrier bar = xcd_barrier_post((unsigned*)(args.ws + WS_CTL) + CW_BAR + (size_t)args.li * XCD_BAR_WORDS, MISC + 8);
    __syncthreads();
    int ph = 0;
#define RUN(c) (ph >= lo && ph < hi && EN(c))
#define SEAM() do { if (ph >= lo && ph + 1 < hi) xcd_barrier(bar); ++ph; } while (0)
#define REPEAT(c) _Pragma("unroll 1") for (int rep = 0; rep < NREP(c); ++rep)
#define REP_BAR() do { if (rep) xcd_barrier(bar); } while (0)
#define MODP(l) ((const float*)(ws + WS_MOD) + (size_t)(l) * BATCH * NMOD)

    if (RUN(0)) { REPEAT(0) { REP_BAR(); p0_prologue(F); } }
    SEAM();
#pragma unroll 1
    for (int l = 0; l < DEPTH; ++l) {
        if (RUN(1)) { REPEAT(1) { REP_BAR(); unsigned char* ws = WSP(); const float* mod = MODP(l); const float* xcur = (l == 0) ? INP(I_X) : (const float*)ldptr<float>(F, PT_OUT);
            if (l == NA) norm_phase<true>(F, xcur, INP(I_NORMG) + (size_t)(2 * l) * D, mod, mod + D, NMOD, (bf16*)(ws + WS_H), INP(I_KVNG), (const float*)(ws + WS_KVMOD), (bf16*)(ws + WS_HKV), INP(I_WF), INP(I_BF), (float*)(ws + WS_LOGF));
            else norm_phase<false>(F, xcur, INP(I_NORMG) + (size_t)(2 * l) * D, mod, mod + D, NMOD, (bf16*)(ws + WS_H), nullptr, nullptr, nullptr, nullptr, nullptr, nullptr); } }
        SEAM();
        if (l < NA) {
            if (RUN(2)) { REPEAT(2) { REP_BAR(); unsigned char* ws = WSP();
                pg8::Gemm g{(const bf16*)(ws + WS_H), (const bf16*)(ws + WS_WT) + WT_WIN + (size_t)l * GN * D, M, GN, D, 0}; pg8::StaticOrder S; S.init(M, GN, F.G, (int)blockIdx.x);
                pg8::EpiGmlpIn E{(bf16*)(ws + WS_U), (bf16*)(ws + WS_V), (pg8::f32x2v*)(ws + WS_VSTAT), M, GH};
                pg8::gemm_phase<pg8::EpiGmlpIn, pg8::StaticOrder, true, true>(F.lds, g, S, E); } }
            SEAM();
            if (RUN(3)) { unsigned char* ws = WSP();
                sg_phase(F, l, (bf16*)(ws + WS_U), (const bf16*)(ws + WS_V), (const f32x2*)(ws + WS_VSTAT), INP(I_LNG) + (size_t)l * GH, INP(I_LNB) + (size_t)l * GH, (const float*)(ws + WS_WSM), INP(I_BS)); }
            SEAM();
        } else {
            const int bl = l - NA;
            if (RUN(4)) { unsigned char* ws = WSP();
#pragma unroll 1
                for (int s = (l == NA ? 0 : 1); s < 2; ++s) {
                    pg8::Gemm g{(const bf16*)(ws + (s == 0 ? WS_HKV : WS_H)), (const bf16*)(ws + WS_WT) + (s == 0 ? WT_WKV : WT_WQ + (size_t)bl * D * D), M, s == 0 ? 2 * D : D, D, 0};
                    pg8::StaticOrder S; S.init(M, g.N, F.G, (int)blockIdx.x);
                    pg8::EpiBf16<0, false> E{(bf16*)(ws + (s == 0 ? WS_KB : WS_Q)), D, s == 0 ? D : 0, (size_t)(WS_VB - WS_KB) / 2, nullptr, M};
                    pg8::gemm_phase<pg8::EpiBf16<0, false>, pg8::StaticOrder, true, true>(F.lds, g, S, E);
                } }
            SEAM();
            if (RUN(5)) { unsigned char* ws = WSP(); headnorm_rows(F, (bf16*)(ws + WS_Q), INP(I_QNG) + bl * HD);
                if (l == NA) { headnorm_rows(F, (bf16*)(ws + WS_KB), INP(I_KNG)); cumsum_phase(F, (const float*)(ws + WS_LOGF), (float*)(ws + WS_FB)); } }
            SEAM();
            if (RUN(6)) { REPEAT(6) { REP_BAR(); unsigned char* ws = WSP();
                attn_phase(F, (char*)lds, (const bf16*)(ws + WS_Q), (const bf16*)(ws + WS_KB), (const bf16*)(ws + WS_VB), (bf16*)(ws + WS_O), (const float*)(ws + WS_FB)); } }
            SEAM();
        }
        if (RUN(7)) { REPEAT(7) { REP_BAR(); const bool real = rep == NREP(7) - 1; unsigned char* ws = WSP(); float* out = ldptr<float>(F, PT_OUT);
            pg8::Gemm g{(const bf16*)(ws + (l < NA ? WS_U : WS_O)), (const bf16*)(ws + WS_WT) + (l < NA ? WT_WOUT + (size_t)l * D * GH : WT_WO + (size_t)(l - NA) * D * D), M, D, l < NA ? GH : D, l < NA ? 1 : 0};
            pg8::StaticOrder S; S.init(M, D, F.G, (int)blockIdx.x);
            pg8::EpiResid E{(l == 0) ? INP(I_X) : (const float*)out, out, D, real ? MODP(l) + 2 * D : (const float*)(ws + WS_CTL + 512 * 1024), real ? NMOD : 0, SEQ / 256};
            pg8::gemm_phase<pg8::EpiResid, pg8::StaticOrder, true, true>(F.lds, g, S, E); } }
        SEAM();
        if (RUN(8)) { REPEAT(8) { REP_BAR(); unsigned char* ws = WSP(); const float* mod = MODP(l);
            norm_phase<false>(F, ldptr<float>(F, PT_OUT), INP(I_NORMG) + (size_t)(2 * l + 1) * D, mod + 3 * D, mod + 4 * D, NMOD, (bf16*)(ws + WS_H), nullptr, nullptr, nullptr, nullptr, nullptr, nullptr); } }
        SEAM();
        if (RUN(9)) { REPEAT(9) { REP_BAR(); unsigned char* ws = WSP();
            pg8::Gemm g{(const bf16*)(ws + WS_H), (const bf16*)(ws + WS_WT) + WT_W1 + (size_t)l * FF * D, M, FF, D, 0}; pg8::StaticOrder S; S.init(M, FF, F.G, (int)blockIdx.x);
            pg8::EpiBf16<2, false> E{(bf16*)(ws + WS_HID), FF, 0, 0, nullptr, M};
            pg8::gemm_phase<pg8::EpiBf16<2, false>, pg8::StaticOrder, true, true>(F.lds, g, S, E); } }
        SEAM();
        if (RUN(10)) { REPEAT(10) { REP_BAR(); const bool real = rep == NREP(10) - 1; unsigned char* ws = WSP(); float* out = ldptr<float>(F, PT_OUT);
            pg8::Gemm g{(const bf16*)(ws + WS_HID), (const bf16*)(ws + WS_WT) + WT_W2 + (size_t)l * D * FF, M, D, FF, 0}; pg8::StaticOrder S; S.init(M, D, F.G, (int)blockIdx.x);
            pg8::EpiResid E{out, out, D, real ? MODP(l) + 5 * D : (const float*)(ws + WS_CTL + 512 * 1024), real ? NMOD : 0, SEQ / 256};
            pg8::gemm_phase<pg8::EpiResid, pg8::StaticOrder, true, true>(F.lds, g, S, E); } }
        SEAM();
    }
#undef RUN
#undef SEAM
}

extern "C" void kernel_launch(void* const* d_in, const int* in_sizes, int n_in, void* d_out, int out_size, void* d_ws, size_t ws_size, hipStream_t stream) {
    static int grid = 0;
    if (grid == 0) {
        if (n_in != 23 || in_sizes[0] != M * D || out_size != M * D || ws_size < WS_END) { fprintf(stderr, "kernel_launch: shape/workspace mismatch (n_in %d in0 %d out %d ws %zu, need %zu)\n", n_in, n_in > 0 ? in_sizes[0] : -1, out_size, ws_size, (size_t)WS_END); grid = -1; return; }
        int dev = 0, cus = 0, per_cu = 0;
        if (hipGetDevice(&dev) != hipSuccess || hipDeviceGetAttribute(&cus, hipDeviceAttributeMultiprocessorCount, dev) != hipSuccess) { grid = -1; return; }
        if (hipFuncSetAttribute((const void*)yoco_fwd, hipFuncAttributeMaxDynamicSharedMemorySize, LDS_BYTES) != hipSuccess) { fprintf(stderr, "kernel_launch: hipFuncSetAttribute failed\n"); grid = -1; return; }
        if (hipOccupancyMaxActiveBlocksPerMultiprocessor(&per_cu, (const void*)yoco_fwd, NWAVES * 64, LDS_BYTES) != hipSuccess || per_cu < 1) { fprintf(stderr, "kernel_launch: occupancy query says %d\n", per_cu); }
        (void)hipGetLastError();
        grid = cus;
        if (grid != M / GB) { fprintf(stderr, "kernel_launch: this kernel needs exactly %d CUs (got %d)\n", M / GB, cus); grid = -1; return; }
    }
    if (grid < 0) return;
    if (hipMemsetAsync((char*)d_ws + WS_CTL, 0, CTL_ZERO_BYTES, stream) != hipSuccess) return;
    Args a{};
    for (int i = 0; i < 23; ++i) a.in[i] = (const float*)d_in[i];
    a.out = (float*)d_out; a.ws = (unsigned char*)d_ws;
#if MK_N_LAUNCHES == 1
    a.ph_lo = 0; a.ph_hi = 1000; a.li = 0; a.pad = 0;
    hipLaunchKernelGGL(yoco_fwd, dim3(grid), dim3(NWAVES * 64), LDS_BYTES, stream, a);
#else
    for (int li = 0; li < 31; ++li) { a.ph_lo = li; a.ph_hi = li + 1; a.li = li; a.pad = 0;
        hipLaunchKernelGGL(yoco_fwd, dim3(grid), dim3(NWAVES * 64), LDS_BYTES, stream, a); }
#endif
}
```

```cpp
#include <hip/hip_runtime.h>
#include <cstdio>
#include <cstdint>

template <int XM> __device__ __forceinline__ float lane_xor(float v) {
    static_assert(XM >= 1 && XM < 32, "lane_xor: in-half xor only");
    return __uint_as_float((unsigned)__builtin_amdgcn_ds_swizzle((int)__float_as_uint(v), (XM << 10) | 0x1F));
}
__device__ __forceinline__ float lane_sum_halves(float v) {
    auto rr = __builtin_amdgcn_permlane32_swap(__float_as_uint(v), __float_as_uint(v), false, false);
    return __uint_as_float(rr[0]) + __uint_as_float(rr[1]);
}
__device__ __forceinline__ float lane_max_halves(float v) {
    auto rr = __builtin_amdgcn_permlane32_swap(__float_as_uint(v), __float_as_uint(v), false, false);
    return fmaxf(__uint_as_float(rr[0]), __uint_as_float(rr[1]));
}
#ifndef PG8_BT
#define PG8_BT 1
#endif
#ifndef WGM_SET
#define WGM_SET 4
#endif
namespace pg8 {
#define PG8_LAS __attribute__((address_space(3)))
typedef unsigned short bf16_t;
typedef short bf16x8 __attribute__((ext_vector_type(8)));
typedef float f32x4 __attribute__((ext_vector_type(4)));
typedef unsigned u32x4 __attribute__((ext_vector_type(4)));
constexpr int BM = 256, BK = 64, HALF = 128, HTB = HALF * BK * 2  , STAGE_BYTES = 8 * HTB, NXCD = 8, WGM = WGM_SET;

__host__ __device__ __forceinline__ int lds_byte(int r, int c) { const int st = (r >> 4) * 2 + (c >> 5), rr = r & 15, cc = c & 31, ob = rr * 64 + cc * 2; return st * 1024 + (ob ^ (((ob >> 9) & 1) << 5)); }
__host__ __device__ __forceinline__ void stage_rc(int b, int& R, int& C) { const int st = b / 1024, sb = b % 1024, swz = sb ^ (((sb >> 9) & 1) << 5); R = (st >> 1) * 16 + swz / 64; C = (st & 1) * 32 + (swz % 64) / 2; }
__host__ __device__ __forceinline__ int perm32(int rho) { const int n = rho >> 4, i = rho & 15; return 8 * (i >> 2) + 4 * n + (i & 3); }

struct Unit { int pm, pn; };
struct Gemm { const bf16_t* A; const bf16_t* Bt; int M, N, K; int a_tiled; };

struct StaticOrder {
    int nM, nN, nwg, G, c, wgm;
    __host__ __device__ void init(int M, int N, int G_, int c_, int wgm_ = WGM) { nM = M / BM; nN = N / BM; nwg = nM * nN; G = G_; c = c_; wgm = wgm_; }
    __host__ __device__ bool next(int i, Unit& u) const {
        const long L = (long)i * G + c; if (L >= nwg) return false;
        int wgid = (int)L; { const int q = nwg / NXCD, r = nwg % NXCD, xcd = wgid % NXCD, off = wgid / NXCD; wgid = (xcd < r ? xcd * (q + 1) : r * (q + 1) + (xcd - r) * q) + off; }
        const int nig = wgm * nN, gid = wgid / nig, fm = gid * wgm, gsz = (nM - fm) < wgm ? (nM - fm) : wgm;
        u.pm = fm + ((wgid % nig) % gsz); u.pn = (wgid % nig) / gsz; return true;
    }
    __device__ __forceinline__ void a_ready(const Unit&) const {}
    __device__ __forceinline__ void done(const Unit&) const {}
};

__device__ __forceinline__ unsigned cvt_pk_bf16(float lo, float hi) { unsigned r; asm volatile("v_cvt_pk_bf16_f32 %0, %1, %2" : "=v"(r) : "v"(lo), "v"(hi)); return r; }
typedef float f32x2 __attribute__((ext_vector_type(2)));
#ifdef GELU_AS
__device__ __forceinline__ f32x2 gelu_pk(f32x2 v) {
    const f32x2 av = __builtin_elementwise_abs(v), d = av * 0.2316418882f + 1.0f;
    f32x2 t; t.x = __builtin_amdgcn_rcpf(d.x); t.y = __builtin_amdgcn_rcpf(d.y);
    f32x2 q = t * 0.5307027145f + (-0.7265760135f); q = q * t + 0.7107068705f; q = q * t + (-0.142248368f); q = q * t + 0.127414796f; q = q * t;
    const f32x2 s = (v * v) * (-0.72134752044f);
    f32x2 e; e.x = __builtin_amdgcn_exp2f(s.x); e.y = __builtin_amdgcn_exp2f(s.y);
    const f32x2 m = v * (q * e), r = v - m;
    f32x2 o; o.x = v.x < 0.f ? m.x : r.x; o.y = v.y < 0.f ? m.y : r.y; return o;
}
#else
__device__ __forceinline__ float relu1(float x) { float r; asm("v_max_f32_e32 %0, 0, %1" : "=v"(r) : "v"(x)); return r; }
__device__ __forceinline__ float absmin1(float x, float c) { float r; asm("v_min_f32_e64 %0, |%1|, %2" : "=v"(r) : "v"(x), "s"(c)); return r; }
__device__ __forceinline__ f32x2 gelu_pk(f32x2 v) {
    f32x2 a; a.x = absmin1(v.x, 12.f); a.y = absmin1(v.y, 12.f);
    f32x2 p = a * 3.3104759495472535e-05f + (-0.0007693342049606144f); p = p * a + 0.00808112882077694f; p = p * a + (-0.053412798792123795f); p = p * a + (-0.45877042412757874f);
    p = p * a + (-1.151201844215393f); p = p * a + (-0.9999930262565613f);
    f32x2 e; e.x = __builtin_amdgcn_exp2f(p.x); e.y = __builtin_amdgcn_exp2f(p.y);
    f32x2 r; r.x = relu1(v.x); r.y = relu1(v.y);
    return r - a * e;
}
#endif


#ifdef SC1_STORES
#define PG8_BIGSTORE(ptr, val) asm volatile("global_store_dwordx4 %0, %1, off sc1" :: "v"(ptr), "v"(val) : "memory")
#elif defined(NT_STORES)
#define PG8_BIGSTORE(ptr, val) __builtin_nontemporal_store((val), (ptr))
#else
#define PG8_BIGSTORE(ptr, val) (*(ptr) = (val))
#endif

typedef float f32x2v __attribute__((ext_vector_type(2)));
template <int ACT, bool VSTAT, bool TILED = false> struct EpiBf16 {
    static constexpr bool PERM = true, AFTER_DRAIN = false;
    bf16_t* O; int ldc; int split_cols; size_t split_stride; f32x2v* vstat; int Mrows;
    __device__ __forceinline__ void operator()(const f32x4 (&acc)[2][2][4][2], const Unit& u, int wr, int wc, int fr, int fq) const {
        const int row0 = u.pm * BM + wr * 64 + fr; int colt = u.pn * BM; bf16_t* base = O; int t = 0;
        if (split_cols) { t = colt / split_cols; base += (size_t)t * split_stride; colt -= t * split_cols; }
        const int col0 = colt + wc * 32 + 8 * fq;
        bf16_t* p0; size_t s_ai, s_m, s_bj;
        if (TILED) { const int nch = ldc >> 7; p0 = base + ((size_t)((u.pm * 2) * nch + (colt >> 7)) * 128 + wr * 64 + fr) * 128 + wc * 32 + 8 * fq; s_ai = (size_t)nch * 16384; s_m = 16 * 128; s_bj = 16384; }
        else { p0 = base + (size_t)row0 * ldc + col0; s_ai = (size_t)HALF * ldc; s_m = (size_t)16 * ldc; s_bj = HALF; }
#pragma unroll
        for (int ai = 0; ai < 2; ++ai)
#pragma unroll
            for (int m = 0; m < 4; ++m) { const int row = row0 + ai * HALF + m * 16;
                float s = 0.f, ss = 0.f;
#pragma unroll
                for (int bj = 0; bj < 2; ++bj) { f32x4 v0 = acc[ai][bj][m][0], v1 = acc[ai][bj][m][1];
                    if (ACT == 1) { f32x2 a = gelu_pk((f32x2){v0[0], v0[1]}), b = gelu_pk((f32x2){v0[2], v0[3]}), c = gelu_pk((f32x2){v1[0], v1[1]}), d = gelu_pk((f32x2){v1[2], v1[3]});
                        v0 = (f32x4){a.x, a.y, b.x, b.y}; v1 = (f32x4){c.x, c.y, d.x, d.y}; }
                    if (ACT == 2) {
#pragma unroll
                        for (int e = 0; e < 4; ++e) { const float a = relu1(v0[e]), b = relu1(v1[e]); v0[e] = a * a; v1[e] = b * b; } }
                    if (VSTAT) { s += ((v0[0] + v0[1]) + (v0[2] + v0[3])) + ((v1[0] + v1[1]) + (v1[2] + v1[3]));
                        ss += ((v0[0] * v0[0] + v0[1] * v0[1]) + (v0[2] * v0[2] + v0[3] * v0[3])) + ((v1[0] * v1[0] + v1[1] * v1[1]) + (v1[2] * v1[2] + v1[3] * v1[3])); }
                    u32x4 w; w.x = cvt_pk_bf16(v0[0], v0[1]); w.y = cvt_pk_bf16(v0[2], v0[3]); w.z = cvt_pk_bf16(v1[0], v1[1]); w.w = cvt_pk_bf16(v1[2], v1[3]);
                    PG8_BIGSTORE((u32x4*)(p0 + ai * s_ai + m * s_m + bj * s_bj), w); }
                if (VSTAT) { if (t == 1) { s += lane_xor<16>(s); s = lane_sum_halves(s); ss += lane_xor<16>(ss); ss = lane_sum_halves(ss);
                    if (fq == 0) vstat[(size_t)((colt >> 8) * 4 + wc) * Mrows + row] = (f32x2v){s, ss}; } } }
    }
};
struct EpiResid {
    static constexpr bool PERM = false, AFTER_DRAIN = false;
    const float* base; float* out; int ldc; const float* gate; int gstride; int tiles_per_batch;
    __device__ __forceinline__ void operator()(const f32x4 (&acc)[2][2][4][2], const Unit& u, int wr, int wc, int fr, int fq) const {
        const int col0 = u.pn * BM + wc * 32 + 4 * fq; const float* g = gate + (size_t)(u.pm / tiles_per_batch) * gstride + col0;
        f32x4 gv[2][2];
#pragma unroll
        for (int bj = 0; bj < 2; ++bj)
#pragma unroll
            for (int n = 0; n < 2; ++n) gv[bj][n] = *(const f32x4*)(g + bj * HALF + n * 16);
#pragma unroll
        for (int ai = 0; ai < 2; ++ai)
#pragma unroll
            for (int m = 0; m < 4; ++m) { const size_t off = (size_t)(u.pm * BM + ai * HALF + wr * 64 + m * 16 + fr) * ldc + col0;
#pragma unroll
                for (int bj = 0; bj < 2; ++bj)
#pragma unroll
                    for (int n = 0; n < 2; ++n) { const f32x4 bs = *(const f32x4*)(base + off + bj * HALF + n * 16); const f32x4 o = bs + gv[bj][n] * acc[ai][bj][m][n];
                        *(f32x4*)(out + off + bj * HALF + n * 16) = o; }
                if (m & 1) asm volatile("" ::: "memory"); }
    }
};


struct EpiGmlpIn {
    static constexpr bool PERM = true, AFTER_DRAIN = false;
    bf16_t* U; bf16_t* V; f32x2v* vstat; int Mrows; int GHc; int do_gelu;
    __device__ __forceinline__ void operator()(const f32x4 (&acc)[2][2][4][2], const Unit& u, int wr, int wc, int fr, int fq) const {
        const int colt_all = u.pn * BM; const int t = colt_all >= GHc ? 1 : 0; const int colt = colt_all - t * GHc; const int nch = GHc >> 7;
        const int frs = (fr & ~0xC) | ((fr & 4) << 1) | ((fr & 8) >> 1);
        const int row0 = u.pm * BM + wr * 64 + fr;
        char* p; size_t s_ai, s_m, s_bj;
        if (t == 0) { p = (char*)U + ((size_t)(u.pm * 2) * nch + (colt >> 7)) * 32768 + (size_t)(wr * 64 + fr) * 256 + (wc * 32 + 8 * fq) * 2; s_ai = (size_t)nch * 32768; s_m = 16 * 256; s_bj = 32768; }
        else { p = (char*)V + ((size_t)((u.pm * 2) * nch + (colt >> 7)) * 2 + wr) * 16384 + ((frs >> 3) * 4 + wc) * 512 + ((frs & 7) * 32 + 8 * fq) * 2; s_ai = (size_t)nch * 32768; s_m = 4096; s_bj = 32768; }
        f32x2v* vs = vstat + (size_t)((colt >> 8) * 4 + wc) * Mrows + row0;
        if (t == 0) body<false>(acc, p, s_ai, s_m, s_bj, vs, fq); else body<true>(acc, p, s_ai, s_m, s_bj, vs, fq);
    }
    template <bool STATS>
    __device__ __forceinline__ void body(const f32x4 (&acc)[2][2][4][2], char* p, size_t s_ai, size_t s_m, size_t s_bj, f32x2v* vs, int fq) const {
#pragma unroll
        for (int ai = 0; ai < 2; ++ai)
#pragma unroll
            for (int m = 0; m < 4; ++m) {
                f32x2 s2 = {0.f, 0.f}, q2 = {0.f, 0.f};
#pragma unroll
                for (int bj = 0; bj < 2; ++bj) { const f32x4 v0 = acc[ai][bj][m][0], v1 = acc[ai][bj][m][1];
                    f32x2 a = {v0[0], v0[1]}, b = {v0[2], v0[3]}, c = {v1[0], v1[1]}, d = {v1[2], v1[3]};
                    if (STATS && do_gelu) { a = gelu_pk(a); b = gelu_pk(b); c = gelu_pk(c); d = gelu_pk(d); }
                    if (STATS) { s2 += (a + b) + (c + d); q2 = a * a + q2; q2 = b * b + q2; q2 = c * c + q2; q2 = d * d + q2; }
                    u32x4 w; w.x = cvt_pk_bf16(a.x, a.y); w.y = cvt_pk_bf16(b.x, b.y); w.z = cvt_pk_bf16(c.x, c.y); w.w = cvt_pk_bf16(d.x, d.y);
                    PG8_BIGSTORE((u32x4*)(p + ai * s_ai + m * s_m + bj * s_bj), w); }
                if (STATS) { float s = s2.x + s2.y, ss = q2.x + q2.y; s += lane_xor<16>(s); s = lane_sum_halves(s); ss += lane_xor<16>(ss); ss = lane_sum_halves(ss);
                    if (fq == 0) vs[ai * HALF + m * 16] = (f32x2v){s, ss}; } }
    }
};

struct EpiDelta {
    static constexpr bool PERM = true, AFTER_DRAIN = false;
    bf16_t* O; int ldc; const float* gate; int gstride; int tiles_per_batch;
    __device__ __forceinline__ void operator()(const f32x4 (&acc)[2][2][4][2], const Unit& u, int wr, int wc, int fr, int fq) const {
        const int row0 = u.pm * BM + wr * 64 + fr, col0 = u.pn * BM + wc * 32 + 8 * fq; const float* g = gate + (size_t)(u.pm / tiles_per_batch) * gstride + col0;
        f32x4 gv[2][2];
#pragma unroll
        for (int bj = 0; bj < 2; ++bj)
#pragma unroll
            for (int n = 0; n < 2; ++n) gv[bj][n] = *(const f32x4*)(g + bj * HALF + 4 * n);
#pragma unroll
        for (int ai = 0; ai < 2; ++ai)
#pragma unroll
            for (int m = 0; m < 4; ++m) { bf16_t* rowp = O + (size_t)(row0 + ai * HALF + m * 16) * ldc + col0;
#pragma unroll
                for (int bj = 0; bj < 2; ++bj) { const f32x4 v0 = acc[ai][bj][m][0] * gv[bj][0], v1 = acc[ai][bj][m][1] * gv[bj][1];
                    u32x4 w; w.x = cvt_pk_bf16(v0[0], v0[1]); w.y = cvt_pk_bf16(v0[2], v0[3]); w.z = cvt_pk_bf16(v1[0], v1[1]); w.w = cvt_pk_bf16(v1[2], v1[3]);
                    PG8_BIGSTORE((u32x4*)(rowp + bj * HALF), w); } }
    }
};

struct EpiHeadNorm {
    static constexpr bool PERM = true, AFTER_DRAIN = false;
    bf16_t* O; int ldc; int split_cols; size_t split_stride; int norm_parts; const float* gain; float eps; PG8_LAS float* P; float gscale;
    __device__ __forceinline__ void operator()(const f32x4 (&acc)[2][2][4][2], const Unit& u, int wr, int wc, int fr, int fq) const {
        const int row0 = u.pm * BM + wr * 64 + fr; int colt = u.pn * BM; bf16_t* base = O; int t = 0;
        if (split_cols) { t = colt / split_cols; base += (size_t)t * split_stride; colt -= t * split_cols; }
        const int col0 = colt + wc * 32 + 8 * fq;
        const bool norm = t < norm_parts;
        if (norm) {
#pragma unroll
            for (int ai = 0; ai < 2; ++ai)
#pragma unroll
                for (int m = 0; m < 4; ++m)
#pragma unroll
                    for (int bj = 0; bj < 2; ++bj) { const f32x4 v0 = acc[ai][bj][m][0], v1 = acc[ai][bj][m][1];
                        float s = ((v0[0] * v0[0] + v0[1] * v0[1]) + (v0[2] * v0[2] + v0[3] * v0[3])) + ((v1[0] * v1[0] + v1[1] * v1[1]) + (v1[2] * v1[2] + v1[3] * v1[3]));
                        s += lane_xor<16>(s); s = lane_sum_halves(s);
                        if (fq == 0) P[(ai * HALF + wr * 64 + m * 16 + fr) * 8 + bj * 4 + wc] = s; }
            asm volatile("s_waitcnt lgkmcnt(0)" ::: "memory"); __builtin_amdgcn_s_barrier(); asm volatile("" ::: "memory");
        }
        f32x4 g0 = {1.f, 1.f, 1.f, 1.f}, g1 = {1.f, 1.f, 1.f, 1.f};
        if (norm) { g0 = *(const f32x4*)(gain + wc * 32 + 8 * fq) * gscale; g1 = *(const f32x4*)(gain + wc * 32 + 8 * fq + 4) * gscale; }
#pragma unroll
        for (int ai = 0; ai < 2; ++ai)
#pragma unroll
            for (int m = 0; m < 4; ++m) { bf16_t* rowp = base + (size_t)(row0 + ai * HALF + m * 16) * ldc + col0;
#pragma unroll
                for (int bj = 0; bj < 2; ++bj) { f32x4 v0 = acc[ai][bj][m][0], v1 = acc[ai][bj][m][1];
                    if (norm) { const f32x4 p = *(const PG8_LAS f32x4*)(P + (ai * HALF + wr * 64 + m * 16 + fr) * 8 + bj * 4);
                        const float r = 1.0f / sqrtf(((p[0] + p[1]) + (p[2] + p[3])) * (1.0f / 128.0f) + eps); v0 = v0 * r * g0; v1 = v1 * r * g1; }
                    u32x4 w; w.x = cvt_pk_bf16(v0[0], v0[1]); w.y = cvt_pk_bf16(v0[2], v0[3]); w.z = cvt_pk_bf16(v1[0], v1[1]); w.w = cvt_pk_bf16(v1[2], v1[3]);
                    PG8_BIGSTORE((u32x4*)(rowp + bj * HALF), w); } }
    }
};

template <class Epi, class Sched, bool ALIGN_EPI = false, bool SP2 = false>
__device__ __forceinline__ void gemm_phase(PG8_LAS unsigned char* lds, const Gemm g, const Sched& S, const Epi& E) {
    int tid_ = threadIdx.x; asm volatile("" : "+v"(tid_));
    const int tid = tid_, wid = __builtin_amdgcn_readfirstlane(tid >> 6), lane = tid & 63, wr = wid >> 2, wc = wid & 3, fr = lane & 15, fq = lane >> 4;
    const int K = g.K, nt = K / BK, rsA = g.a_tiled ? 128 : K;
#define PG8_KOFFA(t) (g.a_tiled ? ((size_t)((t) >> 1) * 32768 + (size_t)((t) & 1) * 128) : (size_t)(t) * kstep)
#define PG8_KOFFB(t) (PG8_BT ? ((size_t)((t) >> 1) * 32768 + (size_t)((t) & 1) * 128) : (size_t)(t) * kstep)
    unsigned voffA[2], voffB[2];
#pragma unroll
    for (int i = 0; i < 2; ++i) { int R, C; stage_rc(tid * 16 + i * 8192, R, C); const int Rb = Epi::PERM ? ((R & ~31) + perm32(R & 31)) : R;
        voffA[i] = (unsigned)(R * rsA + C) * 2u; voffB[i] = (unsigned)(Rb * (PG8_BT ? 128 : K) + C) * 2u; }
    const size_t kstep = (size_t)(BK * 2);
    const size_t hstep = (size_t)HALF * K * 2;
    const size_t tstep = 2 * hstep;
    const unsigned ldsw = (unsigned)wid * 1024u;
    const int aoff = lds_byte(wr * 64 + fr, fq * 8), boff = lds_byte(wc * 32 + fr, fq * 8);
#define PG8_SA(b, h) (((b) * 2 + (h)) * HTB)
#define PG8_SB(b, h) ((4 + (b) * 2 + (h)) * HTB)
#define PG8_STAGE(bufoff, gbase, voff) do { _Pragma("unroll") for (int _i = 0; _i < 2; ++_i) \
        __builtin_amdgcn_global_load_lds((const unsigned*)((const char*)(gbase) + (voff)[_i]), (PG8_LAS unsigned*)(lds + (bufoff) + ldsw + _i * 8192), 16, 0, 0); } while (0)
#define PG8_LDA(dst, b, h) do { _Pragma("unroll") for (int m = 0; m < 4; ++m) _Pragma("unroll") for (int k = 0; k < 2; ++k) dst[m][k] = *(const PG8_LAS bf16x8*)(lds + PG8_SA(b, h) + aoff + m * 2048 + k * 1024); } while (0)
#define PG8_LDB(dst, b, h) do { _Pragma("unroll") for (int n = 0; n < 2; ++n) _Pragma("unroll") for (int k = 0; k < 2; ++k) dst[n][k] = *(const PG8_LAS bf16x8*)(lds + PG8_SB(b, h) + boff + n * 2048 + k * 1024); } while (0)
#define PG8_MMA(ai, bj, At, Bt) do { __builtin_amdgcn_s_setprio(1); _Pragma("unroll") for (int m = 0; m < 4; ++m) _Pragma("unroll") for (int n = 0; n < 2; ++n) _Pragma("unroll") for (int k = 0; k < 2; ++k) \
        acc[ai][bj][m][n] = __builtin_amdgcn_mfma_f32_16x16x32_bf16(Bt[n][k], At[m][k], acc[ai][bj][m][n], 0, 0, 0); __builtin_amdgcn_s_setprio(0); } while (0)
#define PG8_WAIT_V(n) asm volatile("s_waitcnt vmcnt(" #n ")" ::: "memory")
#define PG8_WAIT_L(n) asm volatile("s_waitcnt lgkmcnt(" #n ")" ::: "memory")
#define PG8_BAR __builtin_amdgcn_s_barrier()
#define PG8_SCHED __builtin_amdgcn_sched_barrier(0)
    Unit cur, nxt; int ui = 0;
    if (!S.next(0, cur)) return;
#ifdef STAGGER_TICKS
    { const unsigned grp = (blockIdx.x >> 3) & 3u; if (grp) { const unsigned long long t0 = __builtin_amdgcn_s_memrealtime(); while (__builtin_amdgcn_s_memrealtime() - t0 < (unsigned long long)(grp * STAGGER_TICKS)) __builtin_amdgcn_s_sleep(2); } }
#endif
    f32x4 acc[2][2][4][2];
#pragma unroll
    for (int a = 0; a < 2; ++a)
#pragma unroll
        for (int b = 0; b < 2; ++b)
#pragma unroll
            for (int m = 0; m < 4; ++m)
#pragma unroll
                for (int n = 0; n < 2; ++n) acc[a][b][m][n] = (f32x4){0.f, 0.f, 0.f, 0.f};
    bf16x8 At[4][2], B0[2][2], B1[2][2];
    const char* cA = (const char*)g.A + (size_t)cur.pm * tstep; const char* cB = (const char*)g.Bt + (size_t)cur.pn * tstep;
    S.a_ready(cur);
    if constexpr (SP2) {
        PG8_STAGE(PG8_SB(0, 0), cB, voffB); PG8_STAGE(PG8_SB(0, 1), cB + hstep, voffB); PG8_STAGE(PG8_SA(0, 0), cA, voffA); PG8_STAGE(PG8_SA(0, 1), cA + hstep, voffA);
        if (wr == 1) PG8_BAR;
        PG8_WAIT_V(2); PG8_BAR;
        PG8_STAGE(PG8_SB(1, 0), cB + kstep, voffB); PG8_STAGE(PG8_SA(1, 0), cA + kstep, voffA); PG8_STAGE(PG8_SB(1, 1), cB + hstep + kstep, voffB);
        PG8_WAIT_V(6); PG8_BAR;
    } else {
        PG8_STAGE(PG8_SB(0, 0), cB, voffB); PG8_STAGE(PG8_SA(0, 0), cA, voffA); PG8_STAGE(PG8_SB(0, 1), cB + hstep, voffB); PG8_STAGE(PG8_SA(0, 1), cA + hstep, voffA);
        if (wr == 1) PG8_BAR;
        PG8_WAIT_V(4); PG8_BAR;
        PG8_STAGE(PG8_SB(1, 0), cB + kstep, voffB); PG8_STAGE(PG8_SA(1, 0), cA + kstep, voffA); PG8_STAGE(PG8_SB(1, 1), cB + hstep + kstep, voffB);
        PG8_WAIT_V(6); PG8_BAR;
    }
    for (;;) {
        const bool has_next = S.next(ui + 1, nxt);
        const char* nA = has_next ? (const char*)g.A + (size_t)nxt.pm * tstep : cA; const char* nB = has_next ? (const char*)g.Bt + (size_t)nxt.pn * tstep : cB;
        for (int t = 0; t < nt; t += 2) {
            const bool last = (t == nt - 2);
            const char* a1 = cA + PG8_KOFFA(t + 1);
            const char* a2 = last ? nA : cA + PG8_KOFFA(t + 2); const char* b2 = last ? nB : cB + PG8_KOFFB(t + 2);
            const char* a3 = a2 + kstep; const char* b3 = b2 + kstep;
            if (last && has_next) S.a_ready(nxt);
            if constexpr (SP2) {
            PG8_LDB(B0, 0, 0); PG8_LDB(B1, 0, 1); PG8_SCHED; PG8_LDA(At, 0, 0); PG8_STAGE(PG8_SA(1, 1), a1 + hstep, voffA);
            PG8_WAIT_V(8); PG8_WAIT_L(0); PG8_BAR; PG8_MMA(0, 0, At, B0); PG8_MMA(0, 1, At, B1); PG8_BAR; PG8_SCHED;
            PG8_LDA(At, 0, 1); PG8_STAGE(PG8_SB(0, 0), b2, voffB); PG8_STAGE(PG8_SB(0, 1), b2 + hstep, voffB); PG8_STAGE(PG8_SA(0, 0), a2, voffA);
            PG8_WAIT_V(8); PG8_WAIT_L(0); PG8_BAR; PG8_MMA(1, 0, At, B0); PG8_MMA(1, 1, At, B1); PG8_BAR; PG8_SCHED;
            PG8_LDB(B0, 1, 0); PG8_LDB(B1, 1, 1); PG8_SCHED; PG8_LDA(At, 1, 0); PG8_STAGE(PG8_SA(0, 1), a2 + hstep, voffA);
            PG8_WAIT_V(8); PG8_WAIT_L(0); PG8_BAR; PG8_MMA(0, 0, At, B0); PG8_MMA(0, 1, At, B1); PG8_BAR; PG8_SCHED;
            PG8_LDA(At, 1, 1); PG8_STAGE(PG8_SB(1, 0), b3, voffB); PG8_STAGE(PG8_SB(1, 1), b3 + hstep, voffB); PG8_STAGE(PG8_SA(1, 0), a3, voffA);
            PG8_WAIT_V(8); PG8_WAIT_L(0); PG8_BAR; PG8_MMA(1, 0, At, B0); PG8_MMA(1, 1, At, B1); PG8_BAR; PG8_SCHED;
            } else {
            PG8_LDB(B0, 0, 0); PG8_SCHED; PG8_LDA(At, 0, 0); PG8_STAGE(PG8_SA(1, 1), a1 + hstep, voffA);
            PG8_WAIT_L(8); PG8_BAR; PG8_WAIT_L(0); PG8_MMA(0, 0, At, B0); PG8_BAR; PG8_SCHED;
            PG8_LDB(B1, 0, 1); PG8_STAGE(PG8_SB(0, 0), b2, voffB);
            PG8_BAR; PG8_WAIT_L(0); PG8_MMA(0, 1, At, B1); PG8_BAR;
            PG8_LDA(At, 0, 1); PG8_STAGE(PG8_SA(0, 0), a2, voffA);
            PG8_BAR; PG8_WAIT_L(0); PG8_MMA(1, 0, At, B0); PG8_BAR; PG8_SCHED;
            PG8_STAGE(PG8_SB(0, 1), b2 + hstep, voffB);
            PG8_WAIT_V(6); PG8_BAR; PG8_MMA(1, 1, At, B1); PG8_BAR;
            PG8_LDB(B0, 1, 0); PG8_SCHED; PG8_LDA(At, 1, 0); PG8_STAGE(PG8_SA(0, 1), a2 + hstep, voffA);
            PG8_WAIT_L(8); PG8_BAR; PG8_WAIT_L(0); PG8_MMA(0, 0, At, B0); PG8_BAR; PG8_SCHED;
            PG8_LDB(B1, 1, 1); PG8_STAGE(PG8_SB(1, 0), b3, voffB);
            PG8_BAR; PG8_WAIT_L(0); PG8_MMA(0, 1, At, B1); PG8_BAR;
            PG8_LDA(At, 1, 1); PG8_STAGE(PG8_SA(1, 0), a3, voffA);
            PG8_BAR; PG8_WAIT_L(0); PG8_MMA(1, 0, At, B0); PG8_BAR; PG8_SCHED;
            PG8_STAGE(PG8_SB(1, 1), b3 + hstep, voffB);
            PG8_WAIT_V(6); PG8_BAR; PG8_MMA(1, 1, At, B1); PG8_BAR;
            }
        }
        if constexpr (ALIGN_EPI) { if (wr == 0) PG8_BAR; }
        if constexpr (!Epi::AFTER_DRAIN) { E(acc, cur, wr, wc, fr, fq); S.done(cur); }
        if (!has_next) break;
#pragma unroll
        for (int a = 0; a < 2; ++a)
#pragma unroll
            for (int b = 0; b < 2; ++b)
#pragma unroll
                for (int m = 0; m < 4; ++m)
#pragma unroll
                    for (int n = 0; n < 2; ++n) acc[a][b][m][n] = (f32x4){0.f, 0.f, 0.f, 0.f};
        cur = nxt; cA = nA; cB = nB; ++ui;
        if constexpr (ALIGN_EPI) { if (wr == 1) PG8_BAR; }
    }
    PG8_WAIT_V(0);
    if constexpr (!ALIGN_EPI) { if (wr == 0) PG8_BAR; }
    PG8_BAR;
    if constexpr (Epi::AFTER_DRAIN) { E.fused(acc, cur, wr, wc, fr, fq, lds, wid, lane); S.done(cur); }
#undef PG8_SA
#undef PG8_KOFFA
#undef PG8_KOFFB
#undef PG8_SB
#undef PG8_STAGE
#undef PG8_LDA
#undef PG8_LDB
#undef PG8_MMA
#undef PG8_WAIT_V
#undef PG8_WAIT_L
#undef PG8_BAR
#undef PG8_SCHED
}
}

namespace att {
typedef unsigned short bf16;
typedef short bf16x8 __attribute__((ext_vector_type(8)));
typedef short s16x4 __attribute__((ext_vector_type(4)));
typedef float f32x16 __attribute__((ext_vector_type(16)));
typedef float f32x4 __attribute__((ext_vector_type(4)));
typedef unsigned u32x4 __attribute__((ext_vector_type(4)));
typedef unsigned u32x2 __attribute__((ext_vector_type(2)));
constexpr int D = 128, PITCH = 2048, SEQ = 4096, NH = 16, NB = 8;
#ifndef ATT_THR
#define ATT_THR 8.f
#endif
constexpr float THR = ATT_THR;
constexpr float SCALE = 0.08838834764831845f;
constexpr float INV_SCALE = 11.313708498984761f;
constexpr float LOG2E = 1.4426950408889634f;
constexpr int NW = 8, QBLK = 32, KVBLK = 64, QB = NW * QBLK;
constexpr int SHM_V = KVBLK * D * 2, SHM_K = KVBLK * D * 2;
constexpr int NVB = 3;
constexpr int LDS_WS = NVB * SHM_V + 2 * SHM_K;
constexpr int LDS_FB = LDS_WS + NW * 64 * 4;
constexpr int LDS_BYTES = LDS_FB + SEQ * 8;
constexpr int W = 1 << 30;

#define KSWZ(row, colB) ((row) * 256 + ((colB) ^ (((row) & 15) << 4)))
#define SBAR() __builtin_amdgcn_sched_barrier(0)
__device__ __forceinline__ int v_st(int k, int c) { const int kk = (k & ~0xC) | ((k & 4) << 1) | ((k & 8) >> 1); return ((kk >> 3) * 4 + (c >> 5)) * 512 + ((kk & 7) * 32 + (c & 31)) * 2; }
__device__ __forceinline__ int v_rd_base(int lane) { return ((lane & 3) << 3) | (((lane >> 2) & 3) << 6) | (((lane >> 4) & 1) << 5) | (((lane >> 5) & 1) << 8); }
constexpr int v_rd_off(int d0, int ks, int half) { return d0 * 512 + ks * 4096 + half * 2048; }
__device__ __forceinline__ int crow(int r, int hi) { return (r & 3) + 8 * (r >> 2) + 4 * hi; }
__device__ __forceinline__ unsigned cvtpk(float lo, float hi) { unsigned r; asm volatile("v_cvt_pk_bf16_f32 %0, %1, %2" : "=v"(r) : "v"(lo), "v"(hi)); return r; }
__device__ __forceinline__ bf16x8 load8(const bf16* p) { return *reinterpret_cast<const bf16x8*>(p); }
__device__ __forceinline__ void mask_tile(f32x16& p0, f32x16& p1, int dq, unsigned Wm) {
    const float NEG = -__builtin_inff();
#pragma unroll
    for (int r = 0; r < 16; ++r) {
        const int c = (r & 3) + 8 * (r >> 2);
        if ((unsigned)(dq - c) >= Wm) p0[r] = NEG;
        if ((unsigned)(dq - c - 32) >= Wm) p1[r] = NEG;
    }
}
__device__ __forceinline__ void split3(float x, unsigned& w0, unsigned& w1) {
    const unsigned xh = cvtpk(x, 0.f) & 0xffffu; const float r1 = x - __uint_as_float(xh << 16);
    const unsigned xm = cvtpk(r1, 0.f) & 0xffffu; const float r2 = r1 - __uint_as_float(xm << 16);
    w0 = xh | (xm << 16); w1 = cvtpk(r2, 0.f) & 0xffffu;
}
__device__ __forceinline__ bf16x8 make_negB(float m_ref, int hi) {
    unsigned n0, n1; split3(-m_ref, n0, n1);
    u32x4 w = {0x3F803F80u, 0x00003F80u | (n0 << 16), (n0 >> 16) | (n1 << 16), 0u};
    if (hi) w = (u32x4){0u, 0u, 0u, 0u};
    return *reinterpret_cast<bf16x8*>(&w);
}
__device__ __forceinline__ void trackmax(const f32x16& p0, const f32x16& p1, bool track, float& mrun) {
    if (track) { float pmax = p0[0]; for (int r = 1; r < 16; ++r) pmax = fmaxf(pmax, p0[r]); for (int r = 0; r < 16; ++r) pmax = fmaxf(pmax, p1[r]);
        auto rr = __builtin_amdgcn_permlane32_swap(__float_as_uint(pmax), __float_as_uint(pmax), false, false);
        mrun = fmaxf(mrun, fmaxf(__uint_as_float(rr[0]), __uint_as_float(rr[1]))); }
}
__device__ __forceinline__ void partialSM(f32x16& p0) {
    for (int r = 0; r < 16; ++r) p0[r] = __builtin_amdgcn_exp2f(p0[r]);
}
__device__ __forceinline__ void finishSM(f32x16& p0, f32x16& p1, float& l_reg, bf16x8& pa0, bf16x8& pa1, bf16x8& pa2, bf16x8& pa3) {
    for (int r = 0; r < 16; ++r) p1[r] = __builtin_amdgcn_exp2f(p1[r]);
    float ps = 0; for (int r = 0; r < 16; ++r) ps += p0[r]; for (int r = 0; r < 16; ++r) ps += p1[r];
    { auto rr = __builtin_amdgcn_permlane32_swap(__float_as_uint(ps), __float_as_uint(ps), false, false);
      ps = __uint_as_float(rr[0]) + __uint_as_float(rr[1]); }
    l_reg += ps;
#define PK4(P, B_, OUT) do { unsigned a0 = cvtpk(P[B_+0], P[B_+1]), a1 = cvtpk(P[B_+2], P[B_+3]);                          \
        unsigned b0 = cvtpk(P[B_+4], P[B_+5]), b1 = cvtpk(P[B_+6], P[B_+7]);                                             \
        auto r0 = __builtin_amdgcn_permlane32_swap(a0, b0, false, false); auto r1 = __builtin_amdgcn_permlane32_swap(a1, b1, false, false); \
        u32x4 w = {r0[0], r1[0], r0[1], r1[1]}; OUT = *reinterpret_cast<bf16x8*>(&w); } while (0)
    PK4(p0, 0, pa0); PK4(p0, 8, pa1); PK4(p1, 0, pa2); PK4(p1, 8, pa3);
#undef PK4
}
#define KRD(dst, a, off) asm volatile("ds_read_b128 %0, %1 offset:%2" : "=&v"(dst) : "v"(a), "i"(off) : "memory")
#define KWAIT(f0, f1, n) asm volatile("s_waitcnt lgkmcnt(%2)" : "+v"(f0), "+v"(f1) : "i"(n) : "memory")
#ifdef ATT_QKT_ORIG
#define qkt qkt_c
#endif
template <int KB>
__device__ __forceinline__ void qkt_c(f32x16& p0, f32x16& p1, const int (&ka)[8], const bf16x8* qr, const char* fb, bf16x8 ones) {
    p0 = f32x16{}; p1 = f32x16{};
#pragma unroll
    for (int d0 = 0; d0 < 8; ++d0) { const __attribute__((address_space(3))) char* a = (const __attribute__((address_space(3))) char*)(uintptr_t)(unsigned)ka[d0] + KB * SHM_K;
        bf16x8 b0 = *reinterpret_cast<const __attribute__((address_space(3))) bf16x8*>(a);
        bf16x8 b1 = *reinterpret_cast<const __attribute__((address_space(3))) bf16x8*>(a + 32 * 256);
        p0 = __builtin_amdgcn_mfma_f32_32x32x16_bf16(b0, qr[d0], p0, 0, 0, 0);
        p1 = __builtin_amdgcn_mfma_f32_32x32x16_bf16(b1, qr[d0], p1, 0, 0, 0); }
    { const u32x2 t0 = *reinterpret_cast<const u32x2*>(fb), t1 = *reinterpret_cast<const u32x2*>(fb + 32 * 8);
      u32x4 w0 = {t0.x, t0.y, 0x3F803F80u, 0u}, w1 = {t1.x, t1.y, 0x3F803F80u, 0u};
      p0 = __builtin_amdgcn_mfma_f32_32x32x16_bf16(*reinterpret_cast<bf16x8*>(&w0), ones, p0, 0, 0, 0);
      p1 = __builtin_amdgcn_mfma_f32_32x32x16_bf16(*reinterpret_cast<bf16x8*>(&w1), ones, p1, 0, 0, 0); }
}
#ifndef ATT_QKT_ORIG
template <int KB>
__device__ __forceinline__ void qkt(f32x16& p0, f32x16& p1, const int (&ka)[8], const bf16x8* qr, const char* fb, bf16x8 ones) {
    p0 = f32x16{}; p1 = f32x16{};
    bf16x8 fa0, fa1, fb0, fb1, fc0, fc1;
#define KOFF(d0) (KB * SHM_K + ((d0) >> 2) * 128)
#define KLD(x0, x1, d0) do { KRD(x0, ka[d0], KB * SHM_K); KRD(x1, ka[d0], KB * SHM_K + 32 * 256); } while (0)
#ifdef ATT_QKT_SBAR
#define KMM(x0, x1, d0, n) do { asm volatile("s_waitcnt lgkmcnt(%0)" :: "i"(n) : "memory"); SBAR(); p0 = __builtin_amdgcn_mfma_f32_32x32x16_bf16(x0, qr[d0], p0, 0, 0, 0); p1 = __builtin_amdgcn_mfma_f32_32x32x16_bf16(x1, qr[d0], p1, 0, 0, 0); SBAR(); } while (0)
#else
#define KMM(x0, x1, d0, n) do { KWAIT(x0, x1, n); p0 = __builtin_amdgcn_mfma_f32_32x32x16_bf16(x0, qr[d0], p0, 0, 0, 0); p1 = __builtin_amdgcn_mfma_f32_32x32x16_bf16(x1, qr[d0], p1, 0, 0, 0); } while (0)
#endif
    KLD(fa0, fa1, 0); KLD(fb0, fb1, 1); KLD(fc0, fc1, 2);
    KMM(fa0, fa1, 0, 4); KLD(fa0, fa1, 3);
    KMM(fb0, fb1, 1, 4); KLD(fb0, fb1, 4);
    KMM(fc0, fc1, 2, 4); KLD(fc0, fc1, 5);
    KMM(fa0, fa1, 3, 4); KLD(fa0, fa1, 6);
    KMM(fb0, fb1, 4, 4); KLD(fb0, fb1, 7);
    KMM(fc0, fc1, 5, 4);
    KMM(fa0, fa1, 6, 2);
    KMM(fb0, fb1, 7, 0);
#undef KMM
#undef KLD
#undef KOFF
    { const u32x2 t0 = *reinterpret_cast<const u32x2*>(fb), t1 = *reinterpret_cast<const u32x2*>(fb + 32 * 8);
      u32x4 w0 = {t0.x, t0.y, 0x3F803F80u, 0u}, w1 = {t1.x, t1.y, 0x3F803F80u, 0u};
      p0 = __builtin_amdgcn_mfma_f32_32x32x16_bf16(*reinterpret_cast<bf16x8*>(&w0), ones, p0, 0, 0, 0);
      p1 = __builtin_amdgcn_mfma_f32_32x32x16_bf16(*reinterpret_cast<bf16x8*>(&w1), ones, p1, 0, 0, 0); }
}
#endif
template <int KB>
__device__ __forceinline__ void qkt_sm(f32x16& p0, f32x16& p1, const int (&ka)[8], const bf16x8* qr, const char* fb, bf16x8 ones,
                                       f32x16& y0, f32x16& y1, float& l_reg, bf16x8& pa0, bf16x8& pa1, bf16x8& pa2, bf16x8& pa3) {
    p0 = f32x16{}; p1 = f32x16{};
    bf16x8 fa0, fa1, fb0, fb1, fc0, fc1; float ps;
#define KOFF(d0) (KB * SHM_K + ((d0) >> 2) * 128)
#define KLD(x0, x1, d0) do { KRD(x0, ka[d0], KB * SHM_K); KRD(x1, ka[d0], KB * SHM_K + 32 * 256); } while (0)
#define KMM(x0, x1, d0, n) asm volatile("s_waitcnt lgkmcnt(%0)" :: "i"(n) : "memory"); SBAR(); p0 = __builtin_amdgcn_mfma_f32_32x32x16_bf16(x0, qr[d0], p0, 0, 0, 0); p1 = __builtin_amdgcn_mfma_f32_32x32x16_bf16(x1, qr[d0], p1, 0, 0, 0);
#define PK4(P, B_, OUT) do { unsigned a0 = cvtpk(P[B_+0], P[B_+1]), a1 = cvtpk(P[B_+2], P[B_+3]);                          \
        unsigned b0 = cvtpk(P[B_+4], P[B_+5]), b1 = cvtpk(P[B_+6], P[B_+7]);                                             \
        auto r0 = __builtin_amdgcn_permlane32_swap(a0, b0, false, false); auto r1 = __builtin_amdgcn_permlane32_swap(a1, b1, false, false); \
        u32x4 w = {r0[0], r1[0], r0[1], r1[1]}; OUT = *reinterpret_cast<bf16x8*>(&w); } while (0)
#define EX4(B_) do { y1[B_] = __builtin_amdgcn_exp2f(y1[B_]); y1[B_+1] = __builtin_amdgcn_exp2f(y1[B_+1]); y1[B_+2] = __builtin_amdgcn_exp2f(y1[B_+2]); y1[B_+3] = __builtin_amdgcn_exp2f(y1[B_+3]); \
        ps += (y1[B_] + y1[B_+1]) + (y1[B_+2] + y1[B_+3]); } while (0)
    KLD(fa0, fa1, 0); KLD(fb0, fb1, 1); KLD(fc0, fc1, 2);
    KMM(fa0, fa1, 0, 4) ps = (((y0[0] + y0[1]) + (y0[2] + y0[3])) + ((y0[4] + y0[5]) + (y0[6] + y0[7]))) + (((y0[8] + y0[9]) + (y0[10] + y0[11])) + ((y0[12] + y0[13]) + (y0[14] + y0[15]))); SBAR(); KLD(fa0, fa1, 3);
    KMM(fb0, fb1, 1, 4) PK4(y0, 0, pa0); PK4(y0, 8, pa1); SBAR(); KLD(fb0, fb1, 4);
    KMM(fc0, fc1, 2, 4) EX4(0); SBAR(); KLD(fc0, fc1, 5);
    KMM(fa0, fa1, 3, 4) EX4(4); SBAR(); KLD(fa0, fa1, 6);
    KMM(fb0, fb1, 4, 4) EX4(8); SBAR(); KLD(fb0, fb1, 7);
    KMM(fc0, fc1, 5, 4) EX4(12); SBAR();
    KMM(fa0, fa1, 6, 2) PK4(y1, 0, pa2); SBAR();
    KMM(fb0, fb1, 7, 0) PK4(y1, 8, pa3);
    { auto rr = __builtin_amdgcn_permlane32_swap(__float_as_uint(ps), __float_as_uint(ps), false, false); ps = __uint_as_float(rr[0]) + __uint_as_float(rr[1]); }
    l_reg += ps; SBAR();
#undef EX4
#undef PK4
#undef KMM
#undef KLD
#undef KOFF
    { const u32x2 t0 = *reinterpret_cast<const u32x2*>(fb), t1 = *reinterpret_cast<const u32x2*>(fb + 32 * 8);
      u32x4 w0 = {t0.x, t0.y, 0x3F803F80u, 0u}, w1 = {t1.x, t1.y, 0x3F803F80u, 0u};
      p0 = __builtin_amdgcn_mfma_f32_32x32x16_bf16(*reinterpret_cast<bf16x8*>(&w0), ones, p0, 0, 0, 0);
      p1 = __builtin_amdgcn_mfma_f32_32x32x16_bf16(*reinterpret_cast<bf16x8*>(&w1), ones, p1, 0, 0, 0); }
}
template <bool EX = true>
__device__ __forceinline__ void pv_tile(f32x16* o, int vb0  , bf16x8 pa0, bf16x8 pa1, bf16x8 pa2, bf16x8 pa3, f32x16& px) {
#define TRRD(dst, off) asm volatile("ds_read_b64_tr_b16 %0, %1 offset:%2" : "=&v"(dst) : "v"(vb0), "i"(off) : "memory")
#define VLD(x0, x1, x2, x3, hg) do { constexpr int b_ = v_rd_off((hg) >> 1, 2 * ((hg) & 1), 0); TRRD(x0, b_); TRRD(x1, b_ + 2048); TRRD(x2, b_ + 4096); TRRD(x3, b_ + 6144); } while (0)
#define VMM(x0, x1, x2, x3, hg, pq0, pq1, n) do { asm volatile("s_waitcnt lgkmcnt(%0)" :: "i"(n) : "memory"); SBAR();                                   \
        o[(hg) >> 1] = __builtin_amdgcn_mfma_f32_32x32x16_bf16(pq0, (bf16x8){x0[0], x0[1], x0[2], x0[3], x1[0], x1[1], x1[2], x1[3]}, o[(hg) >> 1], 0, 0, 0);                        \
        if (EX) px[2 * (hg)] = __builtin_amdgcn_exp2f(px[2 * (hg)]);                                                                                                                \
        o[(hg) >> 1] = __builtin_amdgcn_mfma_f32_32x32x16_bf16(pq1, (bf16x8){x2[0], x2[1], x2[2], x2[3], x3[0], x3[1], x3[2], x3[3]}, o[(hg) >> 1], 0, 0, 0);                        \
        if (EX) { px[2 * (hg) + 1] = __builtin_amdgcn_exp2f(px[2 * (hg) + 1]); asm volatile("" : "+v"(px[2 * (hg)]), "+v"(px[2 * (hg) + 1])); }     \
        SBAR(); } while (0)
    s16x4 a0, a1, a2, a3, b0, b1, b2, b3;
    VLD(a0, a1, a2, a3, 0); VLD(b0, b1, b2, b3, 1);
    VMM(a0, a1, a2, a3, 0, pa0, pa1, 4); VLD(a0, a1, a2, a3, 2);
    VMM(b0, b1, b2, b3, 1, pa2, pa3, 4); VLD(b0, b1, b2, b3, 3);
    VMM(a0, a1, a2, a3, 2, pa0, pa1, 4); VLD(a0, a1, a2, a3, 4);
    VMM(b0, b1, b2, b3, 3, pa2, pa3, 4); VLD(b0, b1, b2, b3, 5);
    VMM(a0, a1, a2, a3, 4, pa0, pa1, 4); VLD(a0, a1, a2, a3, 6);
    VMM(b0, b1, b2, b3, 5, pa2, pa3, 4); VLD(b0, b1, b2, b3, 7);
    VMM(a0, a1, a2, a3, 6, pa0, pa1, 4);
    VMM(b0, b1, b2, b3, 7, pa2, pa3, 0);
#undef VMM
#undef VLD
#undef TRRD
}
struct BlockRef { const bf16* Q; const bf16* K; const bf16* V; bf16* O; int P0; const float* F; };
struct Seam { bf16x8 qr[8]; bf16x8 st_v0, st_v1, st_k0, st_k1; };
#define ROW(p, k0, rr) ((p) + (size_t)((k0) + (rr)) * PITCH + sc)
#define VMW() asm volatile("s_waitcnt vmcnt(0)" ::: "memory")
#define VMWN(n) asm volatile("s_waitcnt vmcnt(%0)" :: "i"(n) : "memory")
#define SLOAD_H(Kp, Vp, k0) do { S.st_v0 = load8(ROW(Vp, k0, sr)); S.st_v1 = load8(ROW(Vp, k0, 32 + sr));              \
                         S.st_k0 = load8(ROW(Kp, k0, sr)); S.st_k1 = load8(ROW(Kp, k0, 32 + sr)); } while (0)
#define SWRITE_HK(bf) do { *(bf16x8*)(K_lds + (bf) * SHM_K + kws) = S.st_k0; *(bf16x8*)(K_lds + (bf) * SHM_K + kws + 32 * 256) = S.st_k1; } while (0)
#define SWRITE_HV(off) do { *(bf16x8*)(V_lds + (off) + vst0) = S.st_v0; *(bf16x8*)(V_lds + (off) + vst1) = S.st_v1; } while (0)
__device__ __forceinline__ void prime(const BlockRef& cur, char* lds, Seam& S) {
    int tid_ = threadIdx.x; asm volatile("" : "+v"(tid_));
    const int tid = tid_, wid = __builtin_amdgcn_readfirstlane(tid >> 6), lane = tid & 63, r32 = lane & 31, hi = lane >> 5;
    const int sr = tid >> 4, sc = (tid & 15) * 8, kws = KSWZ(sr, sc * 2); char* K_lds = lds + NVB * SHM_V;
    for (int d0 = 0; d0 < 8; ++d0) S.qr[d0] = load8(cur.Q + (size_t)(wid * QBLK + r32) * PITCH + d0 * 16 + hi * 8);
    SLOAD_H(cur.K, cur.V, cur.P0 + QB - KVBLK); VMW(); SWRITE_HK(0);
    __syncthreads();
}
__device__ __forceinline__ void block(const BlockRef& cur, const BlockRef& nxt, char* lds, Seam& S, float thr2) {
    int tid_ = threadIdx.x; asm volatile("" : "+v"(tid_));
    const int tid = tid_, wid = __builtin_amdgcn_readfirstlane(tid >> 6), lane = tid & 63, r32 = lane & 31, hi = lane >> 5;
    const int NTB = cur.P0 / KVBLK + 4; int NT = NTB;
    const int qlo = cur.P0 + wid * QBLK, qm = qlo + r32 - 4 * hi;
    char* V_lds = lds; char* K_lds = lds + NVB * SHM_V;
    float* ws = (float*)(lds + LDS_WS) + wid * 64; float* li_l = ws, * al_l = ws + 32;
    const char* FBl = lds + LDS_FB + r32 * 8;
    const float f_row = cur.F[cur.P0 + wid * QBLK + r32];
    {
        const float* Fcum = cur.F; const int s_end = cur.P0 + QB;
        for (int s = tid * 4; s < s_end; s += 2048) {
            const f32x4 f4 = *(const f32x4*)(Fcum + s); unsigned w0, w1, w2, w3, w4, w5, w6, w7;
            split3(-f4.x * LOG2E, w0, w1); split3(-f4.y * LOG2E, w2, w3); split3(-f4.z * LOG2E, w4, w5); split3(-f4.w * LOG2E, w6, w7);
            *(u32x4*)(lds + LDS_FB + s * 8) = (u32x4){w0, w1 | 0x3F800000u, w2, w3 | 0x3F800000u}; *(u32x4*)(lds + LDS_FB + s * 8 + 16) = (u32x4){w4, w5 | 0x3F800000u, w6, w7 | 0x3F800000u}; }
        __syncthreads();
    }
    float m_reg = -f_row * LOG2E, l_reg = 0; f32x16 o[4] = {};
    bf16x8 ones = make_negB(m_reg, hi);
    const int sr = tid >> 4, sc = (tid & 15) * 8, vst0 = v_st(sr, sc), vst1 = v_st(32 + sr, sc), kws = KSWZ(sr, sc * 2);
    const int vb0 = (int)(uintptr_t)V_lds + v_rd_base(lane);
    int ka[8];
#pragma unroll
    for (int dd = 0; dd < 8; ++dd) ka[dd] = (int)(uintptr_t)K_lds + KSWZ(r32, (dd * 16 + hi * 8) * 2);
    const bf16* Kh = cur.K; const bf16* Vh = cur.V;
#define KBASE(t) ((NTB - 1 - (t)) * KVBLK)
#define MASKT(P0_, P1_, t) do { const int kb_ = KBASE(t); if (kb_ + KVBLK - 1 > qlo) mask_tile(P0_, P1_, qm - kb_, (unsigned)W); } while (0)
    constexpr int NQL = 8;
#define SEAM_K0() do { VMWN(NQL); SWRITE_HK(0); SBAR(); } while (0)
    f32x16 pA0, pA1, pB0, pB1; bf16x8 pa0, pa1, pa2, pa3; float mrun = -3.0e38f;
    SWRITE_HV(0); SBAR();
    if (NT > 1) { SLOAD_H(Kh, Vh, KBASE(1)); }
    SBAR(); qkt<0>(pA0, pA1, ka, S.qr, FBl + KBASE(0) * 8, ones);
    MASKT(pA0, pA1, 0); trackmax(pA0, pA1, true, mrun); partialSM(pA0);
    if (NT > 1) { VMW(); SWRITE_HK(1); SWRITE_HV(SHM_V); }
    __syncthreads();
    int vr = 0, vw = 2 * SHM_V;
#define VNEXT(x) ((x) == (NVB - 1) * SHM_V ? 0 : (x) + SHM_V)
#define HALF_STEP(PX0, PX1, PY0, PY1, t, KB) do {                                                      \
        SBAR(); qkt_sm<KB>(PX0, PX1, ka, S.qr, FBl + KBASE(t) * 8, ones, PY0, PY1, l_reg, pa0, pa1, pa2, pa3); SBAR();                                             \
        if ((t) + 1 < NT) { SLOAD_H(Kh, Vh, KBASE((t) + 1)); SBAR(); }                                               \
        MASKT(PX0, PX1, (t)); trackmax(PX0, PX1, (t) <= 4, mrun); SBAR(); pv_tile<true>(o, vb0 + vr, pa0, pa1, pa2, pa3, PX0);                                        \
        if ((t) + 1 < NT) { VMW(); SWRITE_HK((KB) ^ 1); SWRITE_HV(vw); }     \
        vr = VNEXT(vr); vw = VNEXT(vw);                                                                                        \
        __syncthreads(); } while (0)
    for (int t = 1; t + 1 < NT; t += 2) {
        HALF_STEP(pB0, pB1, pA0, pA1, t, 1);
        HALF_STEP(pA0, pA1, pB0, pB1, t + 1, 0);
#ifndef ATT_NO_EARLY_EXIT
        if (t == 3 && NT > 6) {
            float c = mrun + m_reg;
            c = fminf(c, lane_xor<1>(c)); c = fminf(c, lane_xor<2>(c)); c = fminf(c, lane_xor<4>(c)); c = fminf(c, lane_xor<8>(c)); c = fminf(c, lane_xor<16>(c));
            if (lane == 0) al_l[0] = c;
            __syncthreads();
            float cb = ((const float*)(lds + LDS_WS))[(lane & 7) * 64 + 32];
            cb = fminf(cb, lane_xor<1>(cb)); cb = fminf(cb, lane_xor<2>(cb)); cb = fminf(cb, lane_xor<4>(cb));
            const float lim = cb - thr2;
            const int ti = 5 + 2 * lane, kbi = (NTB - 1 - ti) * KVBLK; bool ok = false;
            if (kbi >= KVBLK) { const u32x2 w = *(const u32x2*)(lds + LDS_FB + (kbi - 1) * 8);
                const float bk = (__uint_as_float(w.x << 16) + __uint_as_float(w.x & 0xffff0000u)) + __uint_as_float(w.y << 16); ok = bk <= lim; }
            const unsigned long long mk = __ballot(ok);
            if (mk) NT = __builtin_amdgcn_readfirstlane(4 + 2 * (int)__ffsll((long long)mk));
        }
#endif
    }
    constexpr bool even = true;
    if (even) { SBAR(); qkt_c<1>(pB0, pB1, ka, S.qr, FBl + KBASE(NT - 1) * 8, ones); SBAR(); }
    SLOAD_H(nxt.K, nxt.V, nxt.P0 + QB - KVBLK); SBAR();
#pragma unroll
    for (int d0 = 0; d0 < 8; ++d0) S.qr[d0] = load8(nxt.Q + (size_t)(wid * QBLK + r32) * PITCH + d0 * 16 + hi * 8);
    SBAR();
    finishSM(pA0, pA1, l_reg, pa0, pa1, pa2, pa3); SBAR();
    MASKT(pB0, pB1, NT - 1); SBAR();
    pv_tile<true>(o, vb0 + vr, pa0, pa1, pa2, pa3, pB0); vr = VNEXT(vr);
    if (even) { __syncthreads();
        finishSM(pB0, pB1, l_reg, pa0, pa1, pa2, pa3); SBAR(); pv_tile<false>(o, vb0 + vr, pa0, pa1, pa2, pa3, pB0); }
    SBAR(); SEAM_K0();
    if (hi == 0) li_l[r32] = l_reg; asm volatile("s_waitcnt lgkmcnt(0)" ::: "memory");
    float rli[16];
#pragma unroll
    for (int r = 0; r < 16; ++r) rli[r] = __builtin_amdgcn_rcpf(li_l[crow(r, hi)]);
    bf16* Ow = cur.O + (size_t)(wid * QBLK) * PITCH;
#pragma unroll
    for (int r = 0; r < 16; ++r) { const int orow = crow(r, hi);
#pragma unroll
        for (int d0 = 0; d0 < 4; ++d0) { const float v = o[d0][r] * rli[r];
            const float vn = __uint_as_float(__builtin_amdgcn_update_dpp(0u, __float_as_uint(v), 0xB1  , 0xF, 0xF, true));
            if ((r32 & 1) == 0) *(unsigned*)(Ow + (size_t)orow * PITCH + d0 * 32 + r32) = cvtpk(v, vn); } }
    __syncthreads();
#undef KBASE
#undef MASKT
#undef SEAM_K0
#undef HALF_STEP
}
#undef ROW
#undef VMW
#undef VMWN
#undef SLOAD_H
#undef SWRITE_HK
#undef SWRITE_HV
#undef SWRITE_H
}


constexpr int NWAVES = 8;
#ifndef MK_N_LAUNCHES
#define MK_N_LAUNCHES 1
#endif
constexpr int BATCH = 8, SEQ = 4096, D = 2048, M = BATCH * SEQ, DEPTH = 4, NA = 2;
constexpr int GH = 3 * D  , GN = 2 * GH  , NG = 8, GD = GH / NG  , GB = 128;
constexpr int NH = 16, HD = 128, FF = 4 * D, NMOD = 6 * D;
constexpr float EPS = 1e-6f;
constexpr size_t MiB = 1u << 20;
constexpr size_t WS_CTL = 0, CTL_ZERO_BYTES = 1 * MiB;
constexpr size_t WS_MOD = 1 * MiB;
constexpr size_t WS_KVMOD = WS_MOD + (size_t)DEPTH * BATCH * NMOD * 4;
constexpr size_t WS_WSM = 3 * MiB;
constexpr size_t WS_LOGF = 4 * MiB, WS_FB = 6 * MiB;
constexpr size_t WS_VSTAT = 8 * MiB;
constexpr size_t WS_JLO = 32 * MiB;
constexpr size_t WS_WT = 40 * MiB;
constexpr size_t WT_WIN = 0, WT_WOUT = WT_WIN + (size_t)2 * GN * D, WT_W1 = WT_WOUT + (size_t)2 * D * GH, WT_W2 = WT_W1 + (size_t)4 * FF * D,
                 WT_WKV = WT_W2 + (size_t)4 * D * FF, WT_WQ = WT_WKV + (size_t)2 * D * D, WT_WO = WT_WQ + (size_t)2 * D * D, WT_END = WT_WO + (size_t)2 * D * D;
static_assert(WT_END * 2 == 448 * MiB, "weights");
constexpr size_t WS_H = 488 * MiB;
constexpr size_t WS_Z = 616 * MiB;
constexpr size_t WS_U = WS_Z, WS_V = WS_Z + 384 * MiB;
constexpr size_t WS_HID = WS_Z;
constexpr size_t WS_Q = WS_Z, WS_O = WS_Z + 128 * MiB, WS_HKV = WS_Z + 256 * MiB, WS_KB = WS_Z + 512 * MiB, WS_VB = WS_Z + 640 * MiB;
constexpr size_t WS_DELTA = WS_Z + 768 * MiB;
constexpr size_t WS_END = WS_Z + 896 * MiB;
constexpr int CW_BAR = 4096;
constexpr int CW_QUEUE = 65536;
static_assert(CW_BAR + 9 * 3456 <= CW_QUEUE && (CW_QUEUE + 4 * 512) * 4 <= 512 * 1024, "control words: barrier regions, queue heads and the zero page (at 512 KiB) must not overlap");
constexpr int RING_BYTES = 131072, LDS_BYTES = 163840, LDSCTL_OFF = LDS_BYTES - 512, MISC_OFF = LDSCTL_OFF + 320;

#define GAS __attribute__((address_space(1)))
#define LAS __attribute__((address_space(3)))
typedef unsigned short bf16;
typedef unsigned v4u __attribute__((ext_vector_type(4)));
typedef unsigned v2u __attribute__((ext_vector_type(2)));
typedef float f32x4 __attribute__((ext_vector_type(4)));
typedef float f32x2 __attribute__((ext_vector_type(2)));
typedef short bf16x8 __attribute__((ext_vector_type(8)));
typedef short s16x4 __attribute__((ext_vector_type(4)));
typedef float f32x16 __attribute__((ext_vector_type(16)));
typedef GAS unsigned gu32;
#define RLX_AGENT __ATOMIC_RELAXED, __HIP_MEMORY_SCOPE_AGENT
#define LDS_WAIT() asm volatile("s_waitcnt lgkmcnt(0)" ::: "memory")
#define VM_WAIT() asm volatile("s_waitcnt vmcnt(0)" ::: "memory")
#define RAW_BAR() do { asm volatile("s_waitcnt lgkmcnt(0)" ::: "memory"); __builtin_amdgcn_s_barrier(); asm volatile("" ::: "memory"); } while (0)
__device__ __forceinline__ unsigned f2bf(float f) { unsigned u = __builtin_bit_cast(unsigned, f); return (u + 0x7fffu + ((u >> 16) & 1u)) >> 16; }
__device__ __forceinline__ unsigned pk2(float lo, float hi) { unsigned r; asm volatile("v_cvt_pk_bf16_f32 %0, %1, %2" : "=v"(r) : "v"(lo), "v"(hi)); return r; }
__device__ __forceinline__ float bflo(unsigned w) { return __uint_as_float(w << 16); }
__device__ __forceinline__ float bfhi(unsigned w) { return __uint_as_float(w & 0xffff0000u); }

#define XB_TMO      128
#define XB_XCNT(j)  (256  + 64 * (j))
#define XB_XSUB(j)  (1280 + 64 * (j))
#define XB_XGEN(j)  (2304 + 64 * (j))
#define XB_TOP      3328
#define XB_TOPGEN   3392
#define XCD_BAR_WORDS 3456
#define XB_SPIN_CAP (1u << 18)
__device__ __forceinline__ unsigned xb_ld(unsigned* p)              { return __hip_atomic_load(p, __ATOMIC_RELAXED, __HIP_MEMORY_SCOPE_AGENT); }
__device__ __forceinline__ unsigned xb_add(unsigned* p, unsigned v) { return __hip_atomic_fetch_add(p, v, __ATOMIC_RELAXED, __HIP_MEMORY_SCOPE_AGENT); }
__device__ __forceinline__ unsigned xb_xcc_id() { return (unsigned)__builtin_amdgcn_s_getreg((3 << 11) | 20) & 0xFu; }
#define XB_SPIN(cond, bar) do { unsigned _sp = 0; while (cond) { __builtin_amdgcn_s_sleep(1); \
    if ((++_sp & 255u) == 0u) { if (xb_ld(&(bar)[XB_TMO])) break; if (_sp > XB_SPIN_CAP) { atomicAdd(&(bar)[XB_TMO], 1u); break; } } } } while (0)
struct XcdBarrier { unsigned* bar; unsigned x; volatile LAS unsigned* st; unsigned gsize; };
__device__ __forceinline__ XcdBarrier xcd_barrier_post(unsigned* bar, volatile LAS unsigned* st, unsigned gsize) {
    XcdBarrier b; b.bar = bar; b.x = xb_xcc_id(); b.st = st; b.gsize = gsize;
    if (threadIdx.x == 0) (void)xb_add(&bar[XB_XCNT(b.x)], 1u);
    return b;
}
__device__ __forceinline__ void xcd_barrier_complete(unsigned* bar, unsigned x, unsigned G, unsigned& nloc, unsigned& nx) {
    unsigned sum, cnt, mine, sp = 0u;
    for (;;) {
        sum = 0u; cnt = 0u; mine = 0u;
#pragma unroll
        for (unsigned j = 0; j < 16; ++j) { const unsigned c = xb_ld(&bar[XB_XCNT(j)]); sum += c; cnt += (c > 0u) ? 1u : 0u; }
        mine = xb_ld(&bar[XB_XCNT(x)]);
        if (sum == G) break;
        __builtin_amdgcn_s_sleep(1);
        if ((++sp & 255u) == 0u) { if (xb_ld(&bar[XB_TMO])) break; if (sp > XB_SPIN_CAP) { atomicAdd(&bar[XB_TMO], 1u); break; } }
    }
    nloc = mine > 0u ? mine : 1u; nx = cnt > 0u ? cnt : 1u;
}
__device__ __forceinline__ void xcd_barrier(const XcdBarrier& b) {
    asm volatile("s_waitcnt vmcnt(0)" ::: "memory");
    __syncthreads();
    if (threadIdx.x == 0) {
        unsigned* bar = b.bar;
        __builtin_amdgcn_s_waitcnt(0);
        unsigned nloc = b.st[0], nx = b.st[1];
        if (nloc == 0u) { xcd_barrier_complete(bar, b.x, b.gsize, nloc, nx); b.st[0] = nloc; b.st[1] = nx; }
        const unsigned old = xb_add(&bar[XB_XSUB(b.x)], 1u);
        const unsigned gen = old / nloc;
        if (old + 1u == (gen + 1u) * nloc) {
            __builtin_amdgcn_fence(__ATOMIC_RELEASE, "agent");
            asm volatile("s_waitcnt vmcnt(0)" ::: "memory");
            const unsigned og = xb_add(&bar[XB_TOP], 1u);
            const unsigned tg = og / nx;
            if (og + 1u == (tg + 1u) * nx) xb_add(&bar[XB_TOPGEN], 1u);
            else XB_SPIN(xb_ld(&bar[XB_TOPGEN]) == tg, bar);
            __builtin_amdgcn_fence(__ATOMIC_ACQUIRE, "agent");
            xb_add(&bar[XB_XGEN(b.x)], 1u);
            asm volatile("s_waitcnt vmcnt(0)" ::: "memory");
        } else {
            XB_SPIN(xb_ld(&bar[XB_XGEN(b.x)]) == gen, bar);
            __builtin_amdgcn_fence(__ATOMIC_ACQUIRE, "agent");
            asm volatile("s_waitcnt vmcnt(0)" ::: "memory");
        }
    }
    __syncthreads();
}

struct Frame {
    LAS unsigned char* lds;
    int vcu, G;
};
constexpr int PT_OUT = 23, PT_WS = 24;
template <class T> __device__ __forceinline__ T* ldptr(const Frame& F, int i) {
    const unsigned long long v = ((const LAS unsigned long long*)(F.lds + LDSCTL_OFF))[i];
    const unsigned lo = __builtin_amdgcn_readfirstlane((unsigned)v), hi = __builtin_amdgcn_readfirstlane((unsigned)(v >> 32));
    return (T*)(GAS T*)(((unsigned long long)hi << 32) | lo);
}
#define INP(i) ldptr<const float>(F, (i))
#define WSP() ldptr<unsigned char>(F, PT_WS)
#define PHASE_IDS int tid_ = threadIdx.x; asm volatile("" : "+v"(tid_)); const int tid = tid_, lane = tid & 63, wave = __builtin_amdgcn_readfirstlane(tid >> 6); (void)lane; (void)wave;
__device__ __forceinline__ float wave_sum(float v) {
    v += lane_xor<1>(v); v += lane_xor<2>(v); v += lane_xor<4>(v); v += lane_xor<8>(v); v += lane_xor<16>(v);
    return lane_sum_halves(v);
}
__device__ __forceinline__ void p0_transpose_item(const GAS float* W, int K, int N, bf16* WT, LAS float* scr, int item, int lane) {
    const int nblk = N / 32, kb = item / nblk, nb = item % nblk, k0 = 64 * kb, n0 = 32 * nb;
#pragma unroll 8
    for (int i = 0; i < 32; ++i) { const int kk = 2 * i + (lane >> 5); scr[kk * 33 + (lane & 31)] = W[(size_t)(k0 + kk) * N + n0 + (lane & 31)]; }
    LDS_WAIT(); asm volatile("" ::: "memory");
    const int c = lane & 7;
#pragma unroll
    for (int j = 0; j < 4; ++j) { const int n = (lane >> 3) + 8 * j; const LAS float* s = scr + (8 * c) * 33 + n;
        v4u o; o.x = pk2(s[0 * 33], s[1 * 33]); o.y = pk2(s[2 * 33], s[3 * 33]); o.z = pk2(s[4 * 33], s[5 * 33]); o.w = pk2(s[6 * 33], s[7 * 33]);
        if (PG8_BT) *(GAS v4u*)(WT + ((size_t)((n0 + n) >> 7) * (K >> 7) + ((k0 + 8 * c) >> 7)) * 16384 + (size_t)((n0 + n) & 127) * 128 + ((k0 + 8 * c) & 127)) = o;
        else *(GAS v4u*)(WT + (size_t)(n0 + n) * K + k0 + 8 * c) = o; }
    LDS_WAIT(); asm volatile("" ::: "memory");
}

struct Args { const float* in[23]; float* out; unsigned char* ws; int ph_lo, ph_hi, li, pad; unsigned nbytes[24]; };
enum { I_X = 0, I_C, I_ADAW, I_ADAB, I_NORMG, I_W1, I_W2, I_WIN, I_LNG, I_LNB, I_WS, I_BS, I_WOUT, I_KVNG, I_KVADAW, I_KVADAB, I_WKV, I_KNG, I_WF, I_BF, I_WQ, I_QNG, I_WO };

__device__ __forceinline__ void p0_prologue(Frame& F, int parts = 3) {
    PHASE_IDS
    unsigned char* const wsp = WSP();
    bf16* WT = (bf16*)(wsp + WS_WT);
    const int NSTRIP = DEPTH * (NMOD / 256) + (2 * D) / 256;
    if (parts & 1) for (int it = blockIdx.x; it < NSTRIP; it += F.G) {
        LAS float* SC = (LAS float*)F.lds;
        LAS float* RED = (LAS float*)(F.lds + 65536);
        const float* c = INP(I_C);
        for (int i = tid; i < BATCH * D; i += NWAVES * 64) { const int b = i / D, k = i % D; const float x = c[i]; SC[k * 8 + b] = x / (1.f + __expf(-x)); }
        __syncthreads();
        const float* W; const float* bias; float* out; int N, n0;
        if (it < DEPTH * (NMOD / 256)) { const int l = it / (NMOD / 256), s = it % (NMOD / 256); W = INP(I_ADAW) + (size_t)l * D * NMOD; N = NMOD; n0 = s * 256; bias = INP(I_ADAB) + l * NMOD; out = (float*)(wsp + WS_MOD) + (size_t)l * BATCH * NMOD; }
        else { const int s = it - DEPTH * (NMOD / 256); W = INP(I_KVADAW); N = 2 * D; n0 = s * 256; bias = INP(I_KVADAB); out = (float*)(wsp + WS_KVMOD); }
        f32x4 acc[8];
#pragma unroll
        for (int b = 0; b < 8; ++b) acc[b] = (f32x4){0.f, 0.f, 0.f, 0.f};
        const float* wp = W + (size_t)(wave * 256) * N + n0 + 4 * lane;
#pragma unroll 8
        for (int k = 0; k < 256; ++k) { const f32x4 wv = *(const f32x4*)(wp + (size_t)k * N);
            const f32x4 s0 = *(const LAS f32x4*)(SC + (wave * 256 + k) * 8), s1 = *(const LAS f32x4*)(SC + (wave * 256 + k) * 8 + 4);
            acc[0] += s0.x * wv; acc[1] += s0.y * wv; acc[2] += s0.z * wv; acc[3] += s0.w * wv; acc[4] += s1.x * wv; acc[5] += s1.y * wv; acc[6] += s1.z * wv; acc[7] += s1.w * wv; }
#pragma unroll
        for (int b = 0; b < 8; ++b) *(LAS f32x4*)(RED + (wave * 8 + b) * 256 + 4 * lane) = acc[b];
        __syncthreads();
#pragma unroll
        for (int i = 0; i < 4; ++i) { const int idx = tid + 512 * i, b = idx >> 8, col = idx & 255; float s = bias[n0 + col];
#pragma unroll
            for (int w = 0; w < 8; ++w) s += RED[(w * 8 + b) * 256 + col];
            out[(size_t)b * N + n0 + col] = s; }
        __syncthreads();
    }
    if (!(parts & 2)) return;
    { float* WSF = (float*)(wsp + WS_WSM); const float* ws_in = INP(I_WS);
      for (int i = blockIdx.x * 512 + tid; i < NA * NG * GB * GB; i += F.G * 512) { const int col = i & 127, row = (i >> 7) & 127; WSF[i] = ((col >> 6) <= (row >> 6)) ? ws_in[i] : 0.f; } }
    LAS float* scr = (LAS float*)(F.lds + wave * 16384);
    const int gw = F.vcu * NWAVES + wave, NGW = F.G * NWAVES;
    constexpr int UNIT = 2048;
    const int NGV = NSTRIP < F.G ? NSTRIP : F.G, nfree = (F.G - NGV) * NWAVES, R1 = (nfree > 0 && F.G == 256) ? 53 : 1 << 30;
    const int fidx = ((int)blockIdx.x - NGV) * NWAVES + wave;
    for (int i = 0;; ++i) {
        int it;
        if (i < R1) { it = gw + NGW * i; if (it >= 56 * UNIT) break; }
        else { if (fidx < 0) break; it = R1 * NGW + fidx + nfree * (i - R1); if (it >= 56 * UNIT) break; }
        const int u = it / UNIT, r = it % UNIT;
        if (u < 12)      { const int l = u / 6, s = u % 6;            p0_transpose_item((const GAS float*)INP(I_WIN) + (size_t)l * D * GN, D, GN, WT + WT_WIN + (size_t)l * GN * D, scr, s * UNIT + r, lane); }
        else if (u < 18) { const int l = (u - 12) / 3, s = (u - 12) % 3; p0_transpose_item((const GAS float*)INP(I_WOUT) + (size_t)l * GH * D, GH, D, WT + WT_WOUT + (size_t)l * D * GH, scr, s * UNIT + r, lane); }
        else if (u < 34) { const int l = (u - 18) / 4, s = (u - 18) % 4; p0_transpose_item((const GAS float*)INP(I_W1) + (size_t)l * D * FF, D, FF, WT + WT_W1 + (size_t)l * FF * D, scr, s * UNIT + r, lane); }
        else if (u < 50) { const int l = (u - 34) / 4, s = (u - 34) % 4; p0_transpose_item((const GAS float*)INP(I_W2) + (size_t)l * FF * D, FF, D, WT + WT_W2 + (size_t)l * D * FF, scr, s * UNIT + r, lane); }
        else if (u < 52) { const int s = u - 50;                      p0_transpose_item((const GAS float*)INP(I_WKV), D, 2 * D, WT + WT_WKV, scr, s * UNIT + r, lane); }
        else if (u < 54) { const int l = u - 52;                      p0_transpose_item((const GAS float*)INP(I_WQ) + (size_t)l * D * D, D, D, WT + WT_WQ + (size_t)l * D * D, scr, r, lane); }
        else             { const int l = u - 54;                      p0_transpose_item((const GAS float*)INP(I_WO) + (size_t)l * D * D, D, D, WT + WT_WO + (size_t)l * D * D, scr, r, lane); }
    }
}

constexpr int XP = 2 * D;
template <bool KV, bool XBI>
__device__ __forceinline__ void norm_phase(Frame& F, const float* xin, const bf16* delta, const bf16* delta2, bf16* xout, const float* g, const float* shift, const float* scale, int modstride, bf16* Hout,
                                           const float* kvg, const float* kvmod, bf16* HKV, const float* w_f, const float* b_f, float* LOGF) {
    PHASE_IDS
    const int gw = F.vcu * NWAVES + wave, NGW = F.G * NWAVES;
    LAS float* WFT = (LAS float*)F.lds;
    if (KV) { for (int i = tid; i < NH * D; i += NWAVES * 64) { const int h = i / D, col = i % D; WFT[i] = w_f[col * NH + h]; } __syncthreads(); }
    for (int it = gw; it < M / 16; it += NGW) {
        const int row0 = it * 16, b = row0 / SEQ;
        f32x4 gs[8], sh[8];
        if (!KV) {
#pragma unroll
        for (int j = 0; j < 8; ++j) { const int c = 4 * lane + 256 * j; const f32x4 gv = *(const f32x4*)(g + c), sc = *(const f32x4*)(scale + (size_t)b * modstride + c);
            gs[j] = gv * (1.f + sc); sh[j] = *(const f32x4*)(shift + (size_t)b * modstride + c);
        } }
#ifdef NT_THIN
#define NP_LD(p) __builtin_nontemporal_load(p)
#else
#define NP_LD(p) (*(p))
#endif
        f32x4 vn[8]; v2u xn[8], dn[8], dn2[8];
#define NP_LOAD(row_) do { if (XBI) { const GAS v2u* xr_ = (const GAS v2u*)((const bf16*)xin + (size_t)(row_) * XP) + lane; _Pragma("unroll") for (int j = 0; j < 8; ++j) xn[j] = NP_LD(xr_ + 64 * j); } \
            else { const GAS f32x4* xr_ = (const GAS f32x4*)(xin + (size_t)(row_) * D) + lane; _Pragma("unroll") for (int j = 0; j < 8; ++j) vn[j] = NP_LD(xr_ + 64 * j); } \
            if (delta) { const GAS v2u* dr_ = (const GAS v2u*)(delta + (size_t)(row_) * D) + lane; _Pragma("unroll") for (int j = 0; j < 8; ++j) dn[j] = NP_LD(dr_ + 64 * j); } \
            if (delta2) { const GAS v2u* dr_ = (const GAS v2u*)(delta2 + (size_t)(row_) * D) + lane; _Pragma("unroll") for (int j = 0; j < 8; ++j) dn2[j] = NP_LD(dr_ + 64 * j); } } while (0)
        NP_LOAD(row0);
#pragma unroll 2
        for (int r = 0; r < 16; ++r) { const int row = row0 + r;
            f32x4 v[8]; float s = 0.f;
#pragma unroll
            for (int j = 0; j < 8; ++j) { v[j] = XBI ? (f32x4){bflo(xn[j].x), bfhi(xn[j].x), bflo(xn[j].y), bfhi(xn[j].y)} : vn[j];
                if (delta) v[j] += (f32x4){bflo(dn[j].x), bfhi(dn[j].x), bflo(dn[j].y), bfhi(dn[j].y)};
                if (delta2) v[j] += (f32x4){bflo(dn2[j].x), bfhi(dn2[j].x), bflo(dn2[j].y), bfhi(dn2[j].y)}; }
            if (r + 1 < 16) NP_LOAD(row + 1);
            __builtin_amdgcn_sched_barrier(0);
            if (xout) { GAS v2u* xo = (GAS v2u*)(xout + (size_t)row * XP) + lane;
#pragma unroll
                for (int j = 0; j < 8; ++j) xo[64 * j] = (v2u){pk2(v[j].x, v[j].y), pk2(v[j].z, v[j].w)}; }
#pragma unroll
            for (int j = 0; j < 8; ++j) s += (v[j].x * v[j].x + v[j].y * v[j].y) + (v[j].z * v[j].z + v[j].w * v[j].w);
            const float rstd = 1.f / sqrtf(wave_sum(s) * (1.f / D) + EPS);
            GAS v2u* o8 = (GAS v2u*)(Hout + (size_t)row * D) + lane;
#pragma unroll
            for (int j = 0; j < 8; ++j) { f32x4 gsj, shj;
                if (KV) { const int c = 4 * lane + 256 * j; gsj = *(const f32x4*)(g + c) * (1.f + *(const f32x4*)(scale + (size_t)b * modstride + c)); shj = *(const f32x4*)(shift + (size_t)b * modstride + c); }
                else { gsj = gs[j]; shj = sh[j]; }
                const f32x4 y = (v[j] * rstd) * gsj + shj; o8[64 * j] = (v2u){pk2(y.x, y.y), pk2(y.z, y.w)}; }
            if (KV) {
                GAS v2u* k8 = (GAS v2u*)(HKV + (size_t)row * D) + lane; f32x4 y[8];
#pragma unroll
                for (int j = 0; j < 8; ++j) { const int c = 4 * lane + 256 * j; const f32x4 g2 = *(const f32x4*)(kvg + c), s2 = *(const f32x4*)(kvmod + (size_t)b * 2 * D + D + c), h2 = *(const f32x4*)(kvmod + (size_t)b * 2 * D + c);
                    y[j] = (v[j] * rstd) * (g2 * (1.f + s2)) + h2; k8[64 * j] = (v2u){pk2(y[j].x, y[j].y), pk2(y[j].z, y[j].w)}; }
                float mine = 0.f;
#pragma unroll 1
                for (int h = 0; h < 16; ++h) { float z = 0.f;
#pragma unroll
                    for (int j = 0; j < 8; ++j) { const f32x4 w = *(const LAS f32x4*)(WFT + h * D + 4 * lane + 256 * j); z += (y[j].x * w.x + y[j].y * w.y) + (y[j].z * w.z + y[j].w * w.w); }
                    const float t = wave_sum(z); if (lane == h) mine = t; }
                if (lane < 16) { const float zz = mine + b_f[lane]; const float ls = fminf(zz, 0.f) - log1pf(__expf(-fabsf(zz)));
                    LOGF[((size_t)b * NH + lane) * SEQ + (row - b * SEQ)] = ls; }
            }
        }
    }
#undef NP_LOAD
#undef NP_LD
    if (KV) __syncthreads();
}
__device__ __forceinline__ void resid_final(Frame& F, const bf16* xb, float* xo_, const bf16* delta) {
    PHASE_IDS
    const int gw = F.vcu * NWAVES + wave, NGW = F.G * NWAVES;
    for (int rr = 0; rr < M / NGW; ++rr) { const int row = gw * (M / NGW) + rr;
        const GAS v2u* xr = (const GAS v2u*)(xb + (size_t)row * XP) + lane; GAS f32x4* xw = (GAS f32x4*)(xo_ + (size_t)row * D) + lane; const GAS v2u* dr = (const GAS v2u*)(delta + (size_t)row * D) + lane;
        v2u v[8], d[8];
#pragma unroll
        for (int j = 0; j < 8; ++j) { v[j] = xr[64 * j]; d[j] = dr[64 * j]; }
        asm volatile("s_waitcnt vmcnt(0)" ::: "memory");
#pragma unroll
        for (int j = 0; j < 8; ++j) xw[64 * j] = (f32x4){bflo(v[j].x), bfhi(v[j].x), bflo(v[j].y), bfhi(v[j].y)} + (f32x4){bflo(d[j].x), bfhi(d[j].x), bflo(d[j].y), bfhi(d[j].y)}; }
}
__device__ __forceinline__ void headnorm_rows(Frame& F, bf16* T, bf16* Tout, const float* gain) {
    PHASE_IDS
    const int gw = F.vcu * NWAVES + wave, NGW = F.G * NWAVES;
    const int d0 = (8 * lane) & 127; const f32x4 g0 = *(const f32x4*)(gain + d0), g1 = *(const f32x4*)(gain + d0 + 4);
    for (int it = gw; it < M / 16; it += NGW) {
        for (int r = 0; r < 16; ++r) { GAS v4u* p = (GAS v4u*)(T + (size_t)(it * 16 + r) * D) + lane; GAS v4u* po = (GAS v4u*)(Tout + (size_t)(it * 16 + r) * D) + lane;
            v4u w[4];
#pragma unroll
            for (int j = 0; j < 4; ++j) w[j] = p[64 * j];
#pragma unroll
            for (int j = 0; j < 4; ++j) { float x[8] = {bflo(w[j].x), bfhi(w[j].x), bflo(w[j].y), bfhi(w[j].y), bflo(w[j].z), bfhi(w[j].z), bflo(w[j].w), bfhi(w[j].w)};
                float s = 0.f;
#pragma unroll
                for (int e = 0; e < 8; ++e) s += x[e] * x[e];
                s += lane_xor<1>(s); s += lane_xor<2>(s); s += lane_xor<4>(s); s += lane_xor<8>(s);
                const float rstd = 1.f / sqrtf(s * (1.f / HD) + EPS);
                v4u o; o.x = pk2(x[0] * rstd * g0.x, x[1] * rstd * g0.y); o.y = pk2(x[2] * rstd * g0.z, x[3] * rstd * g0.w); o.z = pk2(x[4] * rstd * g1.x, x[5] * rstd * g1.y); o.w = pk2(x[6] * rstd * g1.z, x[7] * rstd * g1.w);
                po[64 * j] = o; } }
    }
}
__device__ __forceinline__ void cumsum_phase(Frame& F, const float* LOGF, float* FB, const float* qgain  , const float* kgain  , int* JLO) {
    PHASE_IDS
    const int grp = blockIdx.x & 7, lw = (int)(blockIdx.x >> 3) * NWAVES + wave;
    for (int bh = grp * NH + lw; lw < NH && bh < (grp + 1) * NH; bh += BATCH * NH) {
        const f32x4* src = (const f32x4*)(LOGF + (size_t)bh * SEQ + 64 * lane); f32x4 v[16]; float run = 0.f;
#pragma unroll
        for (int i = 0; i < 16; ++i) { v[i] = src[i]; run += v[i].x; v[i].x = run; run += v[i].y; v[i].y = run; run += v[i].z; v[i].z = run; run += v[i].w; v[i].w = run; }
        float incl = run;
#define CS_DPP(x, ctrl, rmask, bc) __uint_as_float((unsigned)__builtin_amdgcn_update_dpp(0, (int)__float_as_uint(x), ctrl, rmask, 0xF, bc))
        incl += CS_DPP(incl, 0x111, 0xF, true); incl += CS_DPP(incl, 0x112, 0xF, true); incl += CS_DPP(incl, 0x114, 0xF, true); incl += CS_DPP(incl, 0x118, 0xF, true);
        incl += CS_DPP(incl, 0x142, 0xA, false); incl += CS_DPP(incl, 0x143, 0xC, false);
#undef CS_DPP
        const float off = incl - run;
        f32x4* dst = (f32x4*)(FB + (size_t)bh * SEQ + 64 * lane);
#pragma unroll
        for (int i = 0; i < 16; ++i) dst[i] = v[i] + off;
        float gq = fmaxf(fmaxf(fabsf(qgain[lane]), fabsf(qgain[64 + lane])), fmaxf(fabsf(qgain[128 + lane]), fabsf(qgain[192 + lane]))), gk = fmaxf(fabsf(kgain[lane]), fabsf(kgain[64 + lane]));
        { gq = fmaxf(gq, lane_xor<1>(gq)); gq = fmaxf(gq, lane_xor<2>(gq)); gq = fmaxf(gq, lane_xor<4>(gq)); gq = fmaxf(gq, lane_xor<8>(gq)); gq = fmaxf(gq, lane_xor<16>(gq)); gq = lane_max_halves(gq);
          gk = fmaxf(gk, lane_xor<1>(gk)); gk = fmaxf(gk, lane_xor<2>(gk)); gk = fmaxf(gk, lane_xor<4>(gk)); gk = fmaxf(gk, lane_xor<8>(gk)); gk = fmaxf(gk, lane_xor<16>(gk)); gk = lane_max_halves(gk); }
        const float BL = (float)HD * gq * gk * 1.02f * 0.08838834764831845f, thr = 2.f * BL + 25.f;
        const float fend = v[15].w + off, ffirst = v[0].x + off; int myj = 0;
#pragma unroll
        for (int qb = 0; qb < SEQ / 256; ++qb) { const float fp0 = __uint_as_float((unsigned)__builtin_amdgcn_readlane((int)__float_as_uint(ffirst), 4 * qb)); const bool skip = (lane < 4 * qb) && (fend - fp0 >= thr);
            const int cnt = __popcll(__ballot(skip)); if (lane == qb) myj = cnt; }
#ifdef NO_STATIC_SKIP
        myj = 0;
#endif
        if (lane < SEQ / 256) JLO[bh * (SEQ / 256) + lane] = myj;
        if (lane == 0) ((float*)JLO)[BATCH * NH * (SEQ / 256) + grp] = BL * 1.4426950408889634f + 36.2f;
    }
}

constexpr int SG_NCH = GH / 128;
constexpr int SG_VT = 0, SG_STG = 65536, SG_STG_ROW = 144, SG_STG_WAVE = 32 * SG_STG_ROW, SG_MEAN = SG_STG + 8 * SG_STG_WAVE  , SG_RSTD = SG_MEAN + 512, SG_RED = SG_RSTD + 512, SG_MT = SG_RED + 4096  , SG_END = SG_MT + 8 * 384;
__device__ __forceinline__ void sg_phase(Frame& F, int layer, bf16* U, const bf16* V, const f32x2* vstat, const float* ln_g, const float* ln_b, const float* WSF, const float* bs, bool do_store) {
    PHASE_IDS
    const int wid = wave, r32 = lane & 31, hi = lane >> 5, wq = wid & 3, ch = wid >> 2;
    LAS unsigned char* lds = F.lds;
    LAS float* MEAN = (LAS float*)(lds + SG_MEAN); LAS float* RSTD = (LAS float*)(lds + SG_RSTD); LAS f32x2* RED = (LAS f32x2*)(lds + SG_RED);
    LAS float* MT = (LAS float*)(lds + SG_MT + wid * 384);
    const unsigned vbase = (unsigned)(uintptr_t)(lds + SG_VT) + (unsigned)att::v_rd_base(lane);
    LAS unsigned char* stg = lds + SG_STG + wid * SG_STG_WAVE;
    { const int nb = F.vcu;
        const int r0 = nb * GB;
        { const int row = tid & 127, part = tid >> 7; float s = 0.f, ss = 0.f; const f32x2* vp = vstat + (size_t)(part * 24) * M + r0 + row;
#pragma unroll 1
          for (int q0 = 0; q0 < 24; q0 += 8) { f32x2 p[8];
#pragma unroll
            for (int q = 0; q < 8; ++q) p[q] = vp[(size_t)(q0 + q) * M];
#pragma unroll
            for (int q = 0; q < 8; ++q) { s += p[q].x; ss += p[q].y; } }
          RED[part * 128 + row] = (f32x2){s, ss}; }
        __syncthreads();
        if (tid < 128) { const f32x2 a = RED[tid], b = RED[128 + tid], c = RED[256 + tid], d = RED[384 + tid];
            const float mean = ((a.x + b.x) + (c.x + d.x)) * (1.f / GH); const float var = ((a.y + b.y) + (c.y + d.y)) * (1.f / GH) - mean * mean;
            MEAN[tid] = mean; RSTD[tid] = 1.f / sqrtf(fmaxf(var, 0.f) + EPS); }
        __syncthreads();
        const unsigned char* Vt = (const unsigned char*)V + (size_t)nb * SG_NCH * 32768;
        unsigned char* Ut = (unsigned char*)U + (size_t)nb * SG_NCH * 32768 + (size_t)(32 * wq) * 256 + (size_t)(64 * ch) * 2;
        v4u vr[4], ur[2][4]; float lg[2][2], lb[2][2];
#define SG_VLOAD(t) do { _Pragma("unroll") for (int q = 0; q < 4; ++q) vr[q] = *(const GAS v4u*)(Vt + (size_t)(t) * 32768 + (size_t)(tid + 512 * q) * 16); } while (0)
#define SG_VWRITE(buf) do { _Pragma("unroll") for (int q = 0; q < 4; ++q) *(LAS v4u*)(lds + SG_VT + (buf) * 32768 + (tid + 512 * q) * 16) = vr[q]; } while (0)
#define SG_ULOAD(t, slot) do { _Pragma("unroll") for (int q = 0; q < 4; ++q) { const int p = lane + 64 * q; ur[slot][q] = *(const GAS v4u*)(Ut + (size_t)(t) * 32768 + (p >> 3) * 256 + (p & 7) * 16); } } while (0)
#define SG_GBLOAD(t, slot) do { _Pragma("unroll") for (int dd = 0; dd < 2; ++dd) { const int c = (t) * 128 + 64 * ch + 32 * dd + r32; lg[slot][dd] = ln_g[c]; lb[slot][dd] = ln_b[c]; } } while (0)
        SG_VLOAD(0); SG_ULOAD(0, 0); SG_GBLOAD(0, 0);
        SG_VWRITE(0);
        RAW_BAR();
#pragma unroll 1
        for (int g = 0; g < NG; ++g) {
            bf16x8 wf[2][4];
            { const float* wp = WSF + ((size_t)(layer * NG + g) * GB + 32 * wq + r32) * GB + 8 * hi; float msum = 0.f, ssum = 0.f;
#pragma unroll
              for (int jt = 0; jt < 2; ++jt)
#pragma unroll
                for (int ks = 0; ks < 4; ++ks) { const int j0 = 64 * jt + 16 * ks + 8 * hi; v4u w = {0u, 0u, 0u, 0u};
                    if (jt == 0 || wq >= 2) { const f32x4 w0 = *(const f32x4*)(wp + 64 * jt + 16 * ks), w1 = *(const f32x4*)(wp + 64 * jt + 16 * ks + 4);
                        const f32x4 r0v = *(const LAS f32x4*)(RSTD + j0), r1v = *(const LAS f32x4*)(RSTD + j0 + 4), m0v = *(const LAS f32x4*)(MEAN + j0), m1v = *(const LAS f32x4*)(MEAN + j0 + 4);
                        w.x = pk2(w0.x * r0v.x, w0.y * r0v.y); w.y = pk2(w0.z * r0v.z, w0.w * r0v.w); w.z = pk2(w1.x * r1v.x, w1.y * r1v.y); w.w = pk2(w1.z * r1v.z, w1.w * r1v.w);
                        msum += (bflo(w.x) * m0v.x + bfhi(w.x) * m0v.y) + (bflo(w.y) * m0v.z + bfhi(w.y) * m0v.w) + (bflo(w.z) * m1v.x + bfhi(w.z) * m1v.y) + (bflo(w.w) * m1v.z + bfhi(w.w) * m1v.w);
                        ssum += ((w0.x + w0.y) + (w0.z + w0.w)) + ((w1.x + w1.y) + (w1.z + w1.w)); }
                    wf[jt][ks] = __builtin_bit_cast(bf16x8, w); }
              msum = lane_sum_halves(msum); ssum = lane_sum_halves(ssum);
              if (hi == 0) { MT[r32] = -msum; MT[32 + r32] = ssum; MT[64 + r32] = bs[(size_t)(layer * NG + g) * GB + 32 * wq + r32]; }
              LDS_WAIT(); }
#define SG_TRRD(dst, off) asm volatile("ds_read_b64_tr_b16 %0, %1 offset:%2" : "=&v"(dst) : "v"(va), "i"(off) : "memory")
#define SG_PV(dd, jt, buf) do { const unsigned va = vbase + (unsigned)(((buf) * 2 + (jt)) * 16384 + (2 * ch + (dd)) * 512); s16x4 l0, l1, l2, l3, h0, h1, h2, h3; \
            SG_TRRD(l0, 0); SG_TRRD(h0, 2048); SG_TRRD(l1, 4096); SG_TRRD(h1, 6144); SG_TRRD(l2, 8192); SG_TRRD(h2, 10240); SG_TRRD(l3, 12288); SG_TRRD(h3, 14336); \
            asm volatile("s_waitcnt lgkmcnt(0)" ::: "memory"); __builtin_amdgcn_sched_barrier(0); \
            o[dd] = __builtin_amdgcn_mfma_f32_32x32x16_bf16(wf[jt][0], (bf16x8){l0[0], l0[1], l0[2], l0[3], h0[0], h0[1], h0[2], h0[3]}, o[dd], 0, 0, 0); \
            o[dd] = __builtin_amdgcn_mfma_f32_32x32x16_bf16(wf[jt][1], (bf16x8){l1[0], l1[1], l1[2], l1[3], h1[0], h1[1], h1[2], h1[3]}, o[dd], 0, 0, 0); \
            o[dd] = __builtin_amdgcn_mfma_f32_32x32x16_bf16(wf[jt][2], (bf16x8){l2[0], l2[1], l2[2], l2[3], h2[0], h2[1], h2[2], h2[3]}, o[dd], 0, 0, 0); \
            o[dd] = __builtin_amdgcn_mfma_f32_32x32x16_bf16(wf[jt][3], (bf16x8){l3[0], l3[1], l3[2], l3[3], h3[0], h3[1], h3[2], h3[3]}, o[dd], 0, 0, 0); } while (0)
#define SG_CHUNK(s) do { const int t = 6 * g + 2 * s2 + (s); \
            if (t + 1 < SG_NCH) { SG_VLOAD(t + 1); SG_ULOAD(t + 1, ((s) + 1) & 1); SG_GBLOAD(t + 1, ((s) + 1) & 1); } \
            asm volatile("" ::: "memory"); __builtin_amdgcn_sched_barrier(0); \
            f32x16 o[2] = {}; \
            SG_PV(0, 0, (s) & 1); SG_PV(1, 0, (s) & 1); \
            if (wq >= 2) { SG_PV(0, 1, (s) & 1); SG_PV(1, 1, (s) & 1); } \
            _Pragma("unroll") for (int dd = 0; dd < 2; ++dd) { const float gg = lg[(s) & 1][dd], bb = lb[(s) & 1][dd]; \
                _Pragma("unroll") for (int q = 0; q < 4; ++q) { const f32x4 Aq = *(const LAS f32x4*)(MT + 8 * q + 4 * hi), Bq = *(const LAS f32x4*)(MT + 32 + 8 * q + 4 * hi), Cq = *(const LAS f32x4*)(MT + 64 + 8 * q + 4 * hi); \
                  _Pragma("unroll") for (int e = 0; e < 4; ++e) { const int r = 4 * q + e; const float val = gg * (o[dd][r] + Aq[e]) + (bb * Bq[e] + Cq[e]); \
                    *(LAS unsigned short*)(stg + att::crow(r, hi) * SG_STG_ROW + (dd * 32 + r32) * 2) = (unsigned short)pk2(val, val); } } } \
            LDS_WAIT(); \
            _Pragma("unroll") for (int q = 0; q < 4; ++q) { const int p = lane + 64 * q; const v4u sv = *(const LAS v4u*)(stg + (p >> 3) * SG_STG_ROW + (p & 7) * 16); const v4u uu = ur[(s) & 1][q]; v4u w; \
                const pg8::f32x2 gx = pg8::gelu_pk((pg8::f32x2){bflo(uu.x), bfhi(uu.x)}), gy = pg8::gelu_pk((pg8::f32x2){bflo(uu.y), bfhi(uu.y)}), gz = pg8::gelu_pk((pg8::f32x2){bflo(uu.z), bfhi(uu.z)}), gw = pg8::gelu_pk((pg8::f32x2){bflo(uu.w), bfhi(uu.w)});     \
                w.x = pk2(gx.x * bflo(sv.x), gx.y * bfhi(sv.x)); w.y = pk2(gy.x * bflo(sv.y), gy.y * bfhi(sv.y)); \
                w.z = pk2(gz.x * bflo(sv.z), gz.y * bfhi(sv.z)); w.w = pk2(gw.x * bflo(sv.w), gw.y * bfhi(sv.w)); \
                if (do_store) *(GAS v4u*)(Ut + (size_t)t * 32768 + (p >> 3) * 256 + (p & 7) * 16) = w; } \
            asm volatile("" ::: "memory"); __builtin_amdgcn_sched_barrier(0); \
            if (t + 1 < SG_NCH) SG_VWRITE(((s) + 1) & 1); \
            RAW_BAR(); } while (0)
#pragma unroll 1
            for (int s2 = 0; s2 < 3; ++s2) { SG_CHUNK(0); SG_CHUNK(1); }
        }
#undef SG_VLOAD
#undef SG_VWRITE
#undef SG_ULOAD
#undef SG_GBLOAD
#undef SG_TRRD
#undef SG_PV
#undef SG_CHUNK
        __syncthreads();
    }
}


#ifdef SG_V1
constexpr int SG1_VT = 0, SG1_STG = 65536, SG1_STG_ROW = 144, SG1_STG_WAVE = 32 * SG1_STG_ROW, SG1_TAB = SG1_STG + 8 * SG1_STG_WAVE, SG1_RED = SG1_TAB + 1024;
__device__ __forceinline__ void sg_phase_v1(Frame& F, int layer, bf16* U, const bf16* V, const f32x2* vstat, const float* ln_g, const float* ln_b, const float* WSF, const float* bs) {
    PHASE_IDS
    const int wid = wave, r32 = lane & 31, hi = lane >> 5, wq = wid & 3, ch = wid >> 2;
    LAS unsigned char* lds = F.lds;
    LAS f32x2* TAB = (LAS f32x2*)(lds + SG1_TAB); LAS f32x2* RED = (LAS f32x2*)(lds + SG1_RED);
    const int sr = tid >> 4, sc = (tid & 15) * 8, vst0 = att::v_st(sr, sc), vst1 = att::v_st(32 + sr, sc);
    const unsigned vbase = (unsigned)(uintptr_t)(lds + SG1_VT) + (unsigned)att::v_rd_base(lane);
    LAS unsigned char* stg = lds + SG1_STG + wid * SG1_STG_WAVE;
    for (int nb = blockIdx.x; nb < M / GB; nb += F.G) {
        const int r0 = nb * GB;
        { const int row = tid & 127, part = tid >> 7; float s = 0.f, ss = 0.f;
#pragma unroll 8
          for (int q = 0; q < 24; ++q) { const f32x2 p = vstat[(size_t)(part * 24 + q) * M + r0 + row]; s += p.x; ss += p.y; }
          RED[part * 128 + row] = (f32x2){s, ss}; }
        __syncthreads();
        if (tid < 128) { const f32x2 a = RED[tid], b = RED[128 + tid], c = RED[256 + tid], d = RED[384 + tid];
            const float mean = ((a.x + b.x) + (c.x + d.x)) * (1.f / GH); const float var = ((a.y + b.y) + (c.y + d.y)) * (1.f / GH) - mean * mean;
            TAB[tid] = (f32x2){mean, 1.f / sqrtf(fmaxf(var, 0.f) + EPS)}; }
        __syncthreads();
        f32x2 st[4];
#pragma unroll
        for (int q = 0; q < 4; ++q) st[q] = TAB[(q >> 1) * 64 + (q & 1) * 32 + sr];
        const bf16* Vb = V + (size_t)r0 * GH; bf16* Ub = U + (size_t)r0 * GH;
        v4u vr[4], ur[4];
#define SG1_VLOAD(c0) do { _Pragma("unroll") for (int q = 0; q < 4; ++q) vr[q] = *(const GAS v4u*)(Vb + (size_t)((q >> 1) * 64 + (q & 1) * 32 + sr) * GH + (c0) + sc); } while (0)
#define SG1_VWRITE(c0, buf) do { const f32x4 g0 = *(const f32x4*)(ln_g + (c0) + sc), g1 = *(const f32x4*)(ln_g + (c0) + sc + 4), b0 = *(const f32x4*)(ln_b + (c0) + sc), b1 = *(const f32x4*)(ln_b + (c0) + sc + 4); \
        _Pragma("unroll") for (int q = 0; q < 4; ++q) { const float mu = st[q].x, rs = st[q].y; v4u o; \
            o.x = pk2((bflo(vr[q].x) - mu) * rs * g0.x + b0.x, (bfhi(vr[q].x) - mu) * rs * g0.y + b0.y); o.y = pk2((bflo(vr[q].y) - mu) * rs * g0.z + b0.z, (bfhi(vr[q].y) - mu) * rs * g0.w + b0.w); \
            o.z = pk2((bflo(vr[q].z) - mu) * rs * g1.x + b1.x, (bfhi(vr[q].z) - mu) * rs * g1.y + b1.y); o.w = pk2((bflo(vr[q].w) - mu) * rs * g1.z + b1.z, (bfhi(vr[q].w) - mu) * rs * g1.w + b1.w); \
            *(LAS v4u*)(lds + SG1_VT + ((buf) * 2 + (q >> 1)) * 16384 + ((q & 1) ? vst1 : vst0)) = o; } } while (0)
        SG1_VLOAD(0); SG1_VWRITE(0, 0);
        RAW_BAR();
        bf16x8 wf[2][4]; f32x4 bsv[4];
        for (int t = 0; t < GH / 128; ++t) {
            const int c0 = t * 128, buf = t & 1, g = t / 6;
#pragma unroll
            for (int q = 0; q < 4; ++q) { const int p = lane + 64 * q; ur[q] = *(const GAS v4u*)(Ub + (size_t)(32 * wq + (p >> 3)) * GH + c0 + 64 * ch + 8 * (p & 7)); }
            if (t + 1 < GH / 128) SG1_VLOAD(c0 + 128);
            if (t % 6 == 0) {
                const float* wp = WSF + ((size_t)(layer * NG + g) * GB + 32 * wq + r32) * GB + 8 * hi;
#pragma unroll
                for (int jt = 0; jt < 2; ++jt)
#pragma unroll
                    for (int ks = 0; ks < 4; ++ks) { const f32x4 w0 = *(const f32x4*)(wp + 64 * jt + 16 * ks), w1 = *(const f32x4*)(wp + 64 * jt + 16 * ks + 4); v4u w = {pk2(w0.x, w0.y), pk2(w0.z, w0.w), pk2(w1.x, w1.y), pk2(w1.z, w1.w)}; wf[jt][ks] = __builtin_bit_cast(bf16x8, w); }
                const float* bp = bs + (size_t)(layer * NG + g) * GB + 32 * wq + 4 * hi;
#pragma unroll
                for (int q = 0; q < 4; ++q) bsv[q] = *(const f32x4*)(bp + 8 * q);
            }
            f32x16 o[2] = {};
#define SG1_TRRD(dst, off) asm volatile("ds_read_b64_tr_b16 %0, %1 offset:%2" : "=&v"(dst) : "v"(va), "i"(off) : "memory")
#define SG1_PV(dd, jt) do { const unsigned va = vbase + (unsigned)((buf * 2 + (jt)) * 16384 + (2 * ch + (dd)) * 512); s16x4 l0, l1, l2, l3, h0, h1, h2, h3; \
            SG1_TRRD(l0, 0); SG1_TRRD(h0, 2048); SG1_TRRD(l1, 4096); SG1_TRRD(h1, 6144); SG1_TRRD(l2, 8192); SG1_TRRD(h2, 10240); SG1_TRRD(l3, 12288); SG1_TRRD(h3, 14336); \
            asm volatile("s_waitcnt lgkmcnt(0)" ::: "memory"); __builtin_amdgcn_sched_barrier(0); \
            o[dd] = __builtin_amdgcn_mfma_f32_32x32x16_bf16(wf[jt][0], (bf16x8){l0[0], l0[1], l0[2], l0[3], h0[0], h0[1], h0[2], h0[3]}, o[dd], 0, 0, 0); \
            o[dd] = __builtin_amdgcn_mfma_f32_32x32x16_bf16(wf[jt][1], (bf16x8){l1[0], l1[1], l1[2], l1[3], h1[0], h1[1], h1[2], h1[3]}, o[dd], 0, 0, 0); \
            o[dd] = __builtin_amdgcn_mfma_f32_32x32x16_bf16(wf[jt][2], (bf16x8){l2[0], l2[1], l2[2], l2[3], h2[0], h2[1], h2[2], h2[3]}, o[dd], 0, 0, 0); \
            o[dd] = __builtin_amdgcn_mfma_f32_32x32x16_bf16(wf[jt][3], (bf16x8){l3[0], l3[1], l3[2], l3[3], h3[0], h3[1], h3[2], h3[3]}, o[dd], 0, 0, 0); } while (0)
            SG1_PV(0, 0); SG1_PV(1, 0);
            if (wq >= 2) { SG1_PV(0, 1); SG1_PV(1, 1); }
#pragma unroll
            for (int dd = 0; dd < 2; ++dd)
#pragma unroll
                for (int r = 0; r < 16; ++r) { const float val = o[dd][r] + bsv[r >> 2][r & 3];
                    *(LAS unsigned short*)(stg + att::crow(r, hi) * SG1_STG_ROW + (dd * 32 + r32) * 2) = (unsigned short)f2bf(val); }
            LDS_WAIT();
#pragma unroll
            for (int q = 0; q < 4; ++q) { const int p = lane + 64 * q; const v4u sv = *(const LAS v4u*)(stg + (p >> 3) * SG1_STG_ROW + (p & 7) * 16); const v4u uu = ur[q]; v4u w;
                w.x = pk2(bflo(uu.x) * bflo(sv.x), bfhi(uu.x) * bfhi(sv.x)); w.y = pk2(bflo(uu.y) * bflo(sv.y), bfhi(uu.y) * bfhi(sv.y));
                w.z = pk2(bflo(uu.z) * bflo(sv.z), bfhi(uu.z) * bfhi(sv.z)); w.w = pk2(bflo(uu.w) * bflo(sv.w), bfhi(uu.w) * bfhi(sv.w));
                *(GAS v4u*)(Ub + (size_t)(32 * wq + (p >> 3)) * GH + c0 + 64 * ch + 8 * (p & 7)) = w; }
            if (t + 1 < GH / 128) SG1_VWRITE(c0 + 128, buf ^ 1);
            RAW_BAR();
        }
#undef SG1_VLOAD
#undef SG1_VWRITE
#undef SG1_TRRD
#undef SG1_PV
        __syncthreads();
    }
}


#endif

__device__ __forceinline__ att::BlockRef att_ref(unsigned k, int cls, const bf16* Q, const bf16* K, const bf16* V, bf16* O, const float* FB, const int* JLO) {
#ifndef ATT_QUADS
    const int h = k & 15, qb = 15 - (int)(k >> 4), b = cls, bh = b * NH + h;
#else
    const int r = k & 63, h = r >> 2, qb = 15 - 4 * (int)(k >> 6) - (r & 3), b = (cls - h) & 7, bh = b * NH + h;
#endif
    const size_t base = (size_t)b * SEQ * D + (size_t)h * HD, qoff = base + (size_t)qb * 256 * D;
    const int s0 = (JLO[bh * (SEQ / 256) + qb] >> 1) * 128;
    att::BlockRef rf; rf.Q = Q + qoff; rf.O = O + qoff; rf.K = K + base + (size_t)s0 * D; rf.V = V + base + (size_t)s0 * D; rf.P0 = qb * 256 - s0; rf.F = FB + (size_t)bh * SEQ + s0; return rf;
}
__device__ __forceinline__ void attn_phase(Frame& F, char* lds, const bf16* Q, const bf16* K, const bf16* V, bf16* O, const float* FB, const int* JLO, unsigned* qword) {
    constexpr unsigned NTK = 256;
    const int cls = blockIdx.x & 7; unsigned* qw = qword + 64 * cls;
    volatile LAS unsigned* TK = (volatile LAS unsigned*)(F.lds + att::LDS_BYTES);
    if (threadIdx.x == 0) { const unsigned t0 = __hip_atomic_fetch_add(qw, 1u, __ATOMIC_RELAXED, __HIP_MEMORY_SCOPE_AGENT), t1 = __hip_atomic_fetch_add(qw, 1u, __ATOMIC_RELAXED, __HIP_MEMORY_SCOPE_AGENT); TK[0] = t0; TK[1] = t1; }
    __syncthreads();
    unsigned cur_t = __builtin_amdgcn_readfirstlane(TK[0]), nxt_t = __builtin_amdgcn_readfirstlane(TK[1]);
    __syncthreads();
    if (cur_t >= NTK) return;
    att::BlockRef cur = att_ref(cur_t, cls, Q, K, V, O, FB, JLO);
    const float thr2 = ((const float*)JLO)[BATCH * NH * (SEQ / 256) + cls];
    att::Seam S;
    att::prime(cur, lds, S);
    for (;;) {
        const bool has_next = nxt_t < NTK;
        const att::BlockRef nxt = has_next ? att_ref(nxt_t, cls, Q, K, V, O, FB, JLO) : cur;
        att::block(cur, nxt, lds, S, thr2);
        if (threadIdx.x == 0 && has_next) TK[0] = __hip_atomic_fetch_add(qw, 1u, __ATOMIC_RELAXED, __HIP_MEMORY_SCOPE_AGENT);
        __syncthreads();
        if (!has_next) break;
        cur = nxt; cur_t = nxt_t; nxt_t = __builtin_amdgcn_readfirstlane(TK[0]);
        __syncthreads();
    }
}

#define ZBV(off_mib, per_batch_mib) (WS_Z + (size_t)(blockIdx.x & 7) * (size_t)(96 - (per_batch_mib)) * MiB + (size_t)(off_mib) * MiB)
#define ZB_U ZBV(0, 48)
#define ZB_V ZBV(48, 48)
#define ZB_HID ZBV(0, 64)
#define ZB_Q ZBV(0, 16)
#define ZB_O ZBV(16, 16)
#define ZB_HKV ZBV(32, 16)
#define ZB_KB ZBV(64, 16)
#define ZB_VB ZBV(80, 16)
#define ZB_D1A ZBV(64, 16)

#ifndef DUPMASK
#define DUPMASK 0
#endif
#ifndef EN_MASK
#define EN_MASK 0xFFFF
#endif
#define EN(k) ((EN_MASK >> (k)) & 1)
#ifndef GELU_PROBE
#define GELU_PROBE 0
#endif
#ifndef HID_TILED
#define HID_TILED true
#endif
#ifndef PG8_ALIGN_SET
#define PG8_ALIGN_SET true
#endif
#ifndef PG8_SP2_SET
#define PG8_SP2_SET true
#endif
#ifndef WGM_G1
#define WGM_G1 4
#endif
#ifndef WGM_QKV
#define WGM_QKV 4
#endif
#ifndef WGM_M1
#define WGM_M1 4
#endif
#ifndef WGM_RES
#define WGM_RES 4
#endif
#define NREP(c) (((DUPMASK >> (c)) & 1) ? 2 : 1)
__global__ void __launch_bounds__(NWAVES * 64, 2) yoco_fwd(Args args) {
    extern __shared__ __attribute__((aligned(16))) unsigned char lds[];
    Frame F;
    F.lds = (LAS unsigned char*)lds;
    F.G = gridDim.x; { const int bx = blockIdx.x; F.vcu = (F.G % 8 == 0) ? (bx % 8) * (F.G / 8) + bx / 8 : bx; }
    volatile LAS unsigned* MISC = (volatile LAS unsigned*)(F.lds + MISC_OFF);
    for (int u = threadIdx.x; u < (LDS_BYTES - LDSCTL_OFF) / 4; u += NWAVES * 64) ((LAS unsigned*)(F.lds + LDSCTL_OFF))[u] = 0u;
    __syncthreads();
    if (threadIdx.x < 25) { LAS unsigned long long* PT = (LAS unsigned long long*)(F.lds + LDSCTL_OFF); const int i = threadIdx.x;
        PT[i] = i < 23 ? (unsigned long long)args.in[i] : (i == 23 ? (unsigned long long)args.out : (unsigned long long)args.ws); }
    const int lo = args.ph_lo, hi = args.ph_hi;
    XcdBarrier gbar = xcd_barrier_post((unsigned*)(args.ws + WS_CTL) + CW_BAR, MISC + 8, gridDim.x);
    XcdBarrier bar = xcd_barrier_post((unsigned*)(args.ws + WS_CTL) + CW_BAR + (size_t)(1 + (blockIdx.x & 7)) * XCD_BAR_WORDS, MISC + 10, gridDim.x >> 3);
    __syncthreads();
    int ph = 0; int l_cur = 0;
#define RUN(c) (ph >= lo && ph < hi && EN(c))
#define SEAM() do { if (ph >= lo && ph + 1 < hi) xcd_barrier(bar); ++ph; } while (0)
#ifndef DUP_LMASK
#define DUP_LMASK 0xF
#endif
#define REPEAT(c) const int nrep_ = (NREP(c) == 2 && c != 0 && !((DUP_LMASK >> l_cur) & 1)) ? 1 : NREP(c); _Pragma("unroll 1") for (int rep = 0; rep < nrep_; ++rep)
#define REP_BAR() do { if (rep) xcd_barrier(bar); } while (0)
#define MODP(l) ((const float*)(ws + WS_MOD) + (size_t)(l) * BATCH * NMOD)

#ifdef TLB_WARM
    {
      const int rank = blockIdx.x >> 3, nrank = (int)gridDim.x >> 3; unsigned acc_ = 0;
      for (int bi = 0; bi < 25; ++bi) { const char* base = (const char*)ldptr<char>(F, bi); const size_t bytes = bi < 23 ? (size_t)args.nbytes[bi] : (bi == 23 ? (size_t)M * D * 4 : (size_t)WS_END);
          for (size_t off = ((size_t)rank * 512 + threadIdx.x) * (size_t)TLB_WARM; off < bytes; off += (size_t)nrank * 512 * (size_t)TLB_WARM) acc_ += *(const volatile unsigned*)(base + off); }
      if (acc_ == 0x12345678u) ((volatile unsigned*)(args.ws + WS_CTL))[64] = acc_; }
    __syncthreads();
#endif
#ifdef WARM_READ_MB
    {
      const float* xw = ldptr<const float>(F, I_X); f32x4 acc_ = {0.f, 0.f, 0.f, 0.f}; const size_t nv = (size_t)WARM_READ_MB * 65536;
      for (size_t i = (size_t)blockIdx.x * 512 + threadIdx.x; i < nv; i += (size_t)gridDim.x * 512) acc_ += ((const f32x4*)xw)[i];
      if (acc_.x + acc_.y + acc_.z + acc_.w == 1.2345e30f) ((volatile float*)(args.ws + WS_CTL))[65] = acc_.x; }
    __syncthreads();
#endif
#ifdef MFMA_PROBE_ITERS
    {
      typedef short pb8 __attribute__((ext_vector_type(8))); typedef float pf4 __attribute__((ext_vector_type(4)));
      const unsigned lid = threadIdx.x * 2654435761u; unsigned pw[4] = {lid | 0x3f803f80u, (lid >> 3) | 0x3f003f00u, (lid << 5) ^ 0x40004000u, (lid >> 7) | 0x3e803e80u};
      pb8 pa = __builtin_bit_cast(pb8, *(v4u*)pw), pbb = pa; pf4 c0 = {0,0,0,0}, c1 = c0, c2 = c0, c3 = c0;
      for (int it = 0; it < MFMA_PROBE_ITERS; ++it) {
#pragma unroll
        for (int q = 0; q < 16; ++q) { c0 = __builtin_amdgcn_mfma_f32_16x16x32_bf16(pa, pbb, c0, 0, 0, 0); c1 = __builtin_amdgcn_mfma_f32_16x16x32_bf16(pbb, pa, c1, 0, 0, 0);
            c2 = __builtin_amdgcn_mfma_f32_16x16x32_bf16(pa, pa, c2, 0, 0, 0); c3 = __builtin_amdgcn_mfma_f32_16x16x32_bf16(pbb, pbb, c3, 0, 0, 0); }
        c0 *= 0.5f; c1 *= 0.5f; c2 *= 0.5f; c3 *= 0.5f; }
      if (c0[0] + c1[1] + c2[2] + c3[3] == 1.2345e30f) ((volatile float*)(args.ws + WS_CTL))[66] = c0[0]; }
    __syncthreads();
#endif
#ifdef START_DELAY_US
    { const unsigned long long t0 = __builtin_amdgcn_s_memrealtime(); while (__builtin_amdgcn_s_memrealtime() - t0 < (unsigned long long)START_DELAY_US * 100ull) __builtin_amdgcn_s_sleep(32); }
#endif
#if defined(FIX_P0_US) || defined(FIX_A_US)
    const unsigned long long t_start = __builtin_amdgcn_s_memrealtime();
#endif
#ifdef P0_SPLIT
    p0_prologue(F, 1); xcd_barrier(gbar);
#ifdef FIX_A_US
    while (__builtin_amdgcn_s_memrealtime() - t_start < (unsigned long long)FIX_A_US * 100ull) __builtin_amdgcn_s_sleep(32);
#endif
    p0_prologue(F, 2);
#else
    if (RUN(0)) { REPEAT(0) { if (rep) xcd_barrier(gbar); p0_prologue(F); } }
#endif
    if (ph >= lo && ph + 1 < hi) xcd_barrier(gbar);
    ++ph;
#ifndef GROUP_STAGGER_MODE
#define GROUP_STAGGER_MODE 0
#endif
#ifdef GROUP_STAGGER_TICKS
    { const unsigned long long t0 = __builtin_amdgcn_s_memrealtime(), w = (unsigned long long)(GROUP_STAGGER_MODE == 1 ? (blockIdx.x & 1) : (blockIdx.x & 7)) * GROUP_STAGGER_TICKS; while (__builtin_amdgcn_s_memrealtime() - t0 < w) __builtin_amdgcn_s_sleep(8); }
#endif
#ifdef FIX_P0_US
    while (__builtin_amdgcn_s_memrealtime() - t_start < (unsigned long long)FIX_P0_US * 100ull) __builtin_amdgcn_s_sleep(32);
#endif
#ifdef EXTRA_BARS
    for (int eb = 0; eb < EXTRA_BARS; ++eb) xcd_barrier(gbar);
#endif
#pragma unroll 1
    for (int l = 0; l < DEPTH; ++l) { l_cur = l;
#define D1P(ll) ((const bf16*)(ws + ((ll) < NA ? ZB_D1A : WS_DELTA)))
        if (RUN(1)) { unsigned char* ws = WSP(); const float* mod = MODP(l); bf16* xb = (bf16*)ldptr<float>(F, PT_OUT) + D;
              const bf16* d1 = (l == 0 || l - 1 >= NA) ? (const bf16*)nullptr : D1P(l - 1); const bf16* d2 = (l == 0) ? (const bf16*)nullptr : (const bf16*)(ws + WS_DELTA);
            if (l == NA) norm_phase<true, true>(F, (const float*)xb, d1, d2, xb, INP(I_NORMG) + (size_t)(2 * l) * D, mod, mod + D, NMOD, (bf16*)(ws + WS_H), INP(I_KVNG), (const float*)(ws + WS_KVMOD), (bf16*)(ws + ZB_HKV), INP(I_WF), INP(I_BF), (float*)(ws + WS_LOGF));
            else if (l <= 1) norm_phase<false, false>(F, INP(I_X), d1, d2, (l == 0) ? (bf16*)nullptr : xb, INP(I_NORMG) + (size_t)(2 * l) * D, mod, mod + D, NMOD, (bf16*)(ws + WS_H), nullptr, nullptr, nullptr, nullptr, nullptr, nullptr);
            else norm_phase<false, true>(F, (const float*)xb, d1, d2, xb, INP(I_NORMG) + (size_t)(2 * l) * D, mod, mod + D, NMOD, (bf16*)(ws + WS_H), nullptr, nullptr, nullptr, nullptr, nullptr, nullptr); }
        SEAM();
        if (l < NA) {
            if (RUN(2)) { REPEAT(2) { REP_BAR(); unsigned char* ws = WSP();
                pg8::Gemm g{(const bf16*)(ws + WS_H), (const bf16*)(ws + WS_WT) + WT_WIN + (size_t)l * GN * D, M, GN, D, 0}; pg8::StaticOrder S; S.init(M, GN, F.G, (int)blockIdx.x, WGM_G1);
#ifdef SG_V1
                pg8::EpiBf16<1, true> E{(bf16*)(ws + ZB_U), GH, GH, (size_t)(ZB_V - ZB_U) / 2, (pg8::f32x2v*)(ws + WS_VSTAT), M};
                pg8::gemm_phase<pg8::EpiBf16<1, true>, pg8::StaticOrder, PG8_ALIGN_SET, PG8_SP2_SET>(F.lds, g, S, E); } }
#else
                pg8::EpiGmlpIn E{(bf16*)(ws + ZB_U), (bf16*)(ws + ZB_V), (pg8::f32x2v*)(ws + WS_VSTAT), M, GH, (GELU_PROBE && rep < nrep_ - 1) ? 0 : 1};
                pg8::gemm_phase<pg8::EpiGmlpIn, pg8::StaticOrder, PG8_ALIGN_SET, PG8_SP2_SET>(F.lds, g, S, E); } }
#endif
            SEAM();
            if (RUN(3)) { REPEAT(3) { REP_BAR(); unsigned char* ws = WSP();
#ifdef SG_V1
                sg_phase_v1(F, l, (bf16*)(ws + ZB_U), (const bf16*)(ws + ZB_V), (const f32x2*)(ws + WS_VSTAT), INP(I_LNG) + (size_t)l * GH, INP(I_LNB) + (size_t)l * GH, (const float*)(ws + WS_WSM), INP(I_BS)); } }
#else
                sg_phase(F, l, (bf16*)(ws + ZB_U), (const bf16*)(ws + ZB_V), (const f32x2*)(ws + WS_VSTAT), INP(I_LNG) + (size_t)l * GH, INP(I_LNB) + (size_t)l * GH, (const float*)(ws + WS_WSM), INP(I_BS), rep == nrep_ - 1); } }
#endif
            SEAM();
        } else {
            const int bl = l - NA;
            if (RUN(4)) { REPEAT(4) { REP_BAR(); unsigned char* ws = WSP();
                if (l == NA) cumsum_phase(F, (const float*)(ws + WS_LOGF), (float*)(ws + WS_FB), INP(I_QNG), INP(I_KNG), (int*)(ws + WS_JLO));
#pragma unroll 1
                for (int s = (l == NA ? 0 : 1); s < 2; ++s) {
                    pg8::Gemm g{(const bf16*)(ws + (s == 0 ? ZB_HKV : WS_H)), (const bf16*)(ws + WS_WT) + (s == 0 ? WT_WKV : WT_WQ + (size_t)bl * D * D), M, s == 0 ? 2 * D : D, D, 0};
                    pg8::StaticOrder S; S.init(M, g.N, F.G, (int)blockIdx.x, WGM_QKV);
                    pg8::EpiHeadNorm E{(bf16*)(ws + (s == 0 ? ZB_KB : ZB_Q)), D, s == 0 ? D : 0, (size_t)(ZB_VB - ZB_KB) / 2, 1, s == 0 ? INP(I_KNG) : INP(I_QNG) + bl * HD, EPS, (LAS float*)(F.lds + RING_BYTES), s == 0 ? 1.0f : att::SCALE * att::LOG2E};
                    pg8::gemm_phase<pg8::EpiHeadNorm, pg8::StaticOrder, true, PG8_SP2_SET>(F.lds, g, S, E);
                } } }
            SEAM();
            if (RUN(6)) { REPEAT(6) { REP_BAR(); unsigned char* ws = WSP();
                attn_phase(F, (char*)lds, (const bf16*)(ws + ZB_Q), (const bf16*)(ws + ZB_KB), (const bf16*)(ws + ZB_VB), (bf16*)(ws + ZB_O), (const float*)(ws + WS_FB), (const int*)(ws + WS_JLO),
                           (unsigned*)(ws + WS_CTL) + CW_QUEUE + 512 * (2 * bl + rep)); } }
            SEAM();
        }
        if (RUN(7)) { REPEAT(7) { REP_BAR(); unsigned char* ws = WSP();
            pg8::StaticOrder S; S.init(M, D, F.G, (int)blockIdx.x, WGM_RES);
            pg8::EpiDelta E{(bf16*)D1P(l), D, MODP(l) + 2 * D, NMOD, SEQ / 256};
            if (l < NA) { pg8::Gemm g{(const bf16*)(ws + ZB_U), (const bf16*)(ws + WS_WT) + WT_WOUT + (size_t)l * D * GH, M, D, GH, 1};
                pg8::gemm_phase<pg8::EpiDelta, pg8::StaticOrder, PG8_ALIGN_SET, PG8_SP2_SET>(F.lds, g, S, E); }
            else { pg8::Gemm g{(const bf16*)(ws + ZB_O), (const bf16*)(ws + WS_WT) + WT_WO + (size_t)(l - NA) * D * D, M, D, D, 0};
                pg8::gemm_phase<pg8::EpiDelta, pg8::StaticOrder, PG8_ALIGN_SET, PG8_SP2_SET>(F.lds, g, S, E); } } }
        SEAM();
        if (RUN(8)) { unsigned char* ws = WSP(); const float* mod = MODP(l); bf16* xb = (bf16*)ldptr<float>(F, PT_OUT) + D;
            if (l == 0) norm_phase<false, false>(F, INP(I_X), D1P(l), nullptr, nullptr, INP(I_NORMG) + (size_t)(2 * l + 1) * D, mod + 3 * D, mod + 4 * D, NMOD, (bf16*)(ws + WS_H), nullptr, nullptr, nullptr, nullptr, nullptr, nullptr);
            else norm_phase<false, true>(F, (const float*)xb, D1P(l), nullptr, l < NA ? (bf16*)nullptr : xb, INP(I_NORMG) + (size_t)(2 * l + 1) * D, mod + 3 * D, mod + 4 * D, NMOD, (bf16*)(ws + WS_H), nullptr, nullptr, nullptr, nullptr, nullptr, nullptr); }
        SEAM();
#ifdef CLOCK_PROBE
        const unsigned long long cp_c0 = __builtin_amdgcn_s_memtime(), cp_r0 = __builtin_amdgcn_s_memrealtime();
#endif
        if (RUN(9)) { REPEAT(9) { REP_BAR(); unsigned char* ws = WSP();
            pg8::Gemm g{(const bf16*)(ws + WS_H), (const bf16*)(ws + WS_WT) + WT_W1 + (size_t)l * FF * D, M, FF, D, 0}; pg8::StaticOrder S; S.init(M, FF, F.G, (int)blockIdx.x, WGM_M1);
            pg8::EpiBf16<2, false, HID_TILED> E{(bf16*)(ws + ZB_HID), FF, 0, 0, nullptr, M};
            pg8::gemm_phase<pg8::EpiBf16<2, false, HID_TILED>, pg8::StaticOrder, PG8_ALIGN_SET, PG8_SP2_SET>(F.lds, g, S, E); } }
#ifdef CLOCK_PROBE
        if (l == CLOCK_PROBE && blockIdx.x == 0) {
            const unsigned long long dc = __builtin_amdgcn_s_memtime() - cp_c0, dr = __builtin_amdgcn_s_memrealtime() - cp_r0;
            const unsigned long long mhz = dc * 100ull / dr; const unsigned long long wait_ticks = (mhz > 1000ull ? mhz - 1000ull : 0ull) * 100ull;
            const unsigned long long t0 = __builtin_amdgcn_s_memrealtime(); while (__builtin_amdgcn_s_memrealtime() - t0 < wait_ticks) __builtin_amdgcn_s_sleep(32); }
#endif
        SEAM();
        if (RUN(10)) { REPEAT(10) { REP_BAR(); unsigned char* ws = WSP();
            pg8::Gemm g{(const bf16*)(ws + ZB_HID), (const bf16*)(ws + WS_WT) + WT_W2 + (size_t)l * D * FF, M, D, FF, HID_TILED ? 1 : 0}; pg8::StaticOrder S; S.init(M, D, F.G, (int)blockIdx.x, WGM_RES);
            pg8::EpiDelta E{(bf16*)(ws + WS_DELTA), D, MODP(l) + 5 * D, NMOD, SEQ / 256};
            pg8::gemm_phase<pg8::EpiDelta, pg8::StaticOrder, PG8_ALIGN_SET, PG8_SP2_SET>(F.lds, g, S, E); } }
        SEAM();
    }
    if (RUN(11)) { l_cur = 0; REPEAT(11) { REP_BAR(); unsigned char* ws = WSP(); float* out = ldptr<float>(F, PT_OUT); resid_final(F, (const bf16*)out + D, rep == nrep_ - 1 ? out : (float*)(ws + WS_Z), (const bf16*)(ws + WS_DELTA)); } }
#undef RUN
#undef SEAM
}

extern "C" void kernel_launch(void* const* d_in, const int* in_sizes, int n_in, void* d_out, int out_size, void* d_ws, size_t ws_size, hipStream_t stream) {
    static int grid = 0;
    if (grid == 0) {
        if (n_in != 23 || in_sizes[0] != M * D || out_size != M * D || ws_size < WS_END) { fprintf(stderr, "kernel_launch: shape/workspace mismatch (n_in %d in0 %d out %d ws %zu, need %zu)\n", n_in, n_in > 0 ? in_sizes[0] : -1, out_size, ws_size, (size_t)WS_END); grid = -1; return; }
        int dev = 0, cus = 0, per_cu = 0;
        if (hipGetDevice(&dev) != hipSuccess || hipDeviceGetAttribute(&cus, hipDeviceAttributeMultiprocessorCount, dev) != hipSuccess) { grid = -1; return; }
        if (hipFuncSetAttribute((const void*)yoco_fwd, hipFuncAttributeMaxDynamicSharedMemorySize, LDS_BYTES) != hipSuccess) { fprintf(stderr, "kernel_launch: hipFuncSetAttribute failed\n"); grid = -1; return; }
        if (hipOccupancyMaxActiveBlocksPerMultiprocessor(&per_cu, (const void*)yoco_fwd, NWAVES * 64, LDS_BYTES) != hipSuccess || per_cu < 1) { fprintf(stderr, "kernel_launch: occupancy query says %d\n", per_cu); }
        (void)hipGetLastError();
        grid = cus;
        if (grid != M / GB) { fprintf(stderr, "kernel_launch: this kernel needs exactly %d CUs (got %d)\n", M / GB, cus); grid = -1; return; }
    }
    if (grid < 0) return;
    if (hipMemsetAsync((char*)d_ws + WS_CTL, 0, CTL_ZERO_BYTES, stream) != hipSuccess) return;
    Args a{};
    for (int i = 0; i < 23; ++i) { a.in[i] = (const float*)d_in[i]; a.nbytes[i] = (unsigned)in_sizes[i] * 4u; }
    a.out = (float*)d_out; a.ws = (unsigned char*)d_ws;
#if MK_N_LAUNCHES == 1
    a.ph_lo = 0; a.ph_hi = 1000; a.li = 0; a.pad = 0;
    hipLaunchKernelGGL(yoco_fwd, dim3(grid), dim3(NWAVES * 64), LDS_BYTES, stream, a);
#else
    for (int li = 0; li < 64; ++li) { a.ph_lo = li; a.ph_hi = li + 1; a.li = li; a.pad = 0;
        hipLaunchKernelGGL(yoco_fwd, dim3(grid), dim3(NWAVES * 64), LDS_BYTES, stream, a); }
#endif
}
```

```cpp
#include <hip/hip_runtime.h>
#include <cstdio>
#include <cstdint>

template <int XM> __device__ __forceinline__ float lane_xor(float v) {
    static_assert(XM >= 1 && XM < 32, "lane_xor: in-half xor only");
    return __uint_as_float((unsigned)__builtin_amdgcn_ds_swizzle((int)__float_as_uint(v), (XM << 10) | 0x1F));
}
__device__ __forceinline__ float lane_sum_halves(float v) {
    auto rr = __builtin_amdgcn_permlane32_swap(__float_as_uint(v), __float_as_uint(v), false, false);
    return __uint_as_float(rr[0]) + __uint_as_float(rr[1]);
}
__device__ __forceinline__ float lane_max_halves(float v) {
    auto rr = __builtin_amdgcn_permlane32_swap(__float_as_uint(v), __float_as_uint(v), false, false);
    return fmaxf(__uint_as_float(rr[0]), __uint_as_float(rr[1]));
}
#ifndef PG8_BT
#define PG8_BT 1
#endif
#ifndef WGM_SET
#define WGM_SET 4
#endif
namespace pg8 {
#define PG8_LAS __attribute__((address_space(3)))
typedef unsigned short bf16_t;
typedef short bf16x8 __attribute__((ext_vector_type(8)));
typedef float f32x4 __attribute__((ext_vector_type(4)));
typedef unsigned u32x4 __attribute__((ext_vector_type(4)));
constexpr int BM = 256, BK = 64, HALF = 128, HTB = HALF * BK * 2  , STAGE_BYTES = 8 * HTB, NXCD = 8, WGM = WGM_SET;

__host__ __device__ __forceinline__ int lds_byte(int r, int c) { const int st = (r >> 4) * 2 + (c >> 5), rr = r & 15, cc = c & 31, ob = rr * 64 + cc * 2; return st * 1024 + (ob ^ (((ob >> 9) & 1) << 5)); }
__host__ __device__ __forceinline__ void stage_rc(int b, int& R, int& C) { const int st = b / 1024, sb = b % 1024, swz = sb ^ (((sb >> 9) & 1) << 5); R = (st >> 1) * 16 + swz / 64; C = (st & 1) * 32 + (swz % 64) / 2; }
__host__ __device__ __forceinline__ int perm32(int rho) { const int n = rho >> 4, i = rho & 15; return 8 * (i >> 2) + 4 * n + (i & 3); }

struct Unit { int pm, pn; };
struct Gemm { const bf16_t* A; const bf16_t* Bt; int M, N, K; int a_tiled; };

struct StaticOrder {
    int nM, nN, nwg, G, c, wgm;
    __host__ __device__ void init(int M, int N, int G_, int c_, int wgm_ = WGM) { nM = M / BM; nN = N / BM; nwg = nM * nN; G = G_; c = c_; wgm = wgm_; }
    __host__ __device__ bool next(int i, Unit& u) const {
        const long L = (long)i * G + c; if (L >= nwg) return false;
        int wgid = (int)L; { const int q = nwg / NXCD, r = nwg % NXCD, xcd = wgid % NXCD, off = wgid / NXCD; wgid = (xcd < r ? xcd * (q + 1) : r * (q + 1) + (xcd - r) * q) + off; }
        const int nig = wgm * nN, gid = wgid / nig, fm = gid * wgm, gsz = (nM - fm) < wgm ? (nM - fm) : wgm;
        u.pm = fm + ((wgid % nig) % gsz); u.pn = (wgid % nig) / gsz; return true;
    }
    __device__ __forceinline__ void a_ready(const Unit&) const {}
    __device__ __forceinline__ void done(const Unit&) const {}
};

__device__ __forceinline__ unsigned cvt_pk_bf16(float lo, float hi) { unsigned r; asm volatile("v_cvt_pk_bf16_f32 %0, %1, %2" : "=v"(r) : "v"(lo), "v"(hi)); return r; }
typedef float f32x2 __attribute__((ext_vector_type(2)));
#ifdef GELU_AS
__device__ __forceinline__ f32x2 gelu_pk(f32x2 v) {
    const f32x2 av = __builtin_elementwise_abs(v), d = av * 0.2316418882f + 1.0f;
    f32x2 t; t.x = __builtin_amdgcn_rcpf(d.x); t.y = __builtin_amdgcn_rcpf(d.y);
    f32x2 q = t * 0.5307027145f + (-0.7265760135f); q = q * t + 0.7107068705f; q = q * t + (-0.142248368f); q = q * t + 0.127414796f; q = q * t;
    const f32x2 s = (v * v) * (-0.72134752044f);
    f32x2 e; e.x = __builtin_amdgcn_exp2f(s.x); e.y = __builtin_amdgcn_exp2f(s.y);
    const f32x2 m = v * (q * e), r = v - m;
    f32x2 o; o.x = v.x < 0.f ? m.x : r.x; o.y = v.y < 0.f ? m.y : r.y; return o;
}
#else
__device__ __forceinline__ float relu1(float x) { float r; asm("v_max_f32_e32 %0, 0, %1" : "=v"(r) : "v"(x)); return r; }
__device__ __forceinline__ float absmin1(float x, float c) { float r; asm("v_min_f32_e64 %0, |%1|, %2" : "=v"(r) : "v"(x), "s"(c)); return r; }
__device__ __forceinline__ f32x2 gelu_pk(f32x2 v) {
    f32x2 a; a.x = absmin1(v.x, 12.f); a.y = absmin1(v.y, 12.f);
    f32x2 p = a * (-0.00047331248060800135f) + 0.0070845820009708405f; p = p * a + (-0.051827456802129745f); p = p * a + (-0.45999234914779663f);
    p = p * a + (-1.1507879495620728f); p = p * a + (-1.0000375509262085f);
    f32x2 e; e.x = __builtin_amdgcn_exp2f(p.x); e.y = __builtin_amdgcn_exp2f(p.y);
    f32x2 r; r.x = relu1(v.x); r.y = relu1(v.y);
    return r - a * e;
}
#endif


#ifdef SC1_STORES
#define PG8_BIGSTORE(ptr, val) asm volatile("global_store_dwordx4 %0, %1, off sc1" :: "v"(ptr), "v"(val) : "memory")
#elif defined(NT_STORES)
#define PG8_BIGSTORE(ptr, val) __builtin_nontemporal_store((val), (ptr))
#else
#define PG8_BIGSTORE(ptr, val) (*(ptr) = (val))
#endif

typedef float f32x2v __attribute__((ext_vector_type(2)));
template <int ACT, bool VSTAT, bool TILED = false> struct EpiBf16 {
    static constexpr bool PERM = true, AFTER_DRAIN = false;
    bf16_t* O; int ldc; int split_cols; size_t split_stride; f32x2v* vstat; int Mrows;
    __device__ __forceinline__ void operator()(const f32x4 (&acc)[2][2][4][2], const Unit& u, int wr, int wc, int fr, int fq) const {
        const int row0 = u.pm * BM + wr * 64 + fr; int colt = u.pn * BM; bf16_t* base = O; int t = 0;
        if (split_cols) { t = colt / split_cols; base += (size_t)t * split_stride; colt -= t * split_cols; }
        const int col0 = colt + wc * 32 + 8 * fq;
        bf16_t* p0; size_t s_ai, s_m, s_bj;
        if (TILED) { const int nch = ldc >> 7; p0 = base + ((size_t)((u.pm * 2) * nch + (colt >> 7)) * 128 + wr * 64 + fr) * 128 + wc * 32 + 8 * fq; s_ai = (size_t)nch * 16384; s_m = 16 * 128; s_bj = 16384; }
        else { p0 = base + (size_t)row0 * ldc + col0; s_ai = (size_t)HALF * ldc; s_m = (size_t)16 * ldc; s_bj = HALF; }
#pragma unroll
        for (int ai = 0; ai < 2; ++ai)
#pragma unroll
            for (int m = 0; m < 4; ++m) { const int row = row0 + ai * HALF + m * 16;
                float s = 0.f, ss = 0.f;
#pragma unroll
                for (int bj = 0; bj < 2; ++bj) { f32x4 v0 = acc[ai][bj][m][0], v1 = acc[ai][bj][m][1];
                    if (ACT == 1) { f32x2 a = gelu_pk((f32x2){v0[0], v0[1]}), b = gelu_pk((f32x2){v0[2], v0[3]}), c = gelu_pk((f32x2){v1[0], v1[1]}), d = gelu_pk((f32x2){v1[2], v1[3]});
                        v0 = (f32x4){a.x, a.y, b.x, b.y}; v1 = (f32x4){c.x, c.y, d.x, d.y}; }
                    if (ACT == 2) {
#pragma unroll
                        for (int e = 0; e < 4; ++e) { const float a = relu1(v0[e]), b = relu1(v1[e]); v0[e] = a * a; v1[e] = b * b; } }
                    if (VSTAT) { s += ((v0[0] + v0[1]) + (v0[2] + v0[3])) + ((v1[0] + v1[1]) + (v1[2] + v1[3]));
                        ss += ((v0[0] * v0[0] + v0[1] * v0[1]) + (v0[2] * v0[2] + v0[3] * v0[3])) + ((v1[0] * v1[0] + v1[1] * v1[1]) + (v1[2] * v1[2] + v1[3] * v1[3])); }
                    u32x4 w; w.x = cvt_pk_bf16(v0[0], v0[1]); w.y = cvt_pk_bf16(v0[2], v0[3]); w.z = cvt_pk_bf16(v1[0], v1[1]); w.w = cvt_pk_bf16(v1[2], v1[3]);
                    PG8_BIGSTORE((u32x4*)(p0 + ai * s_ai + m * s_m + bj * s_bj), w); }
                if (VSTAT) { if (t == 1) { s += lane_xor<16>(s); s = lane_sum_halves(s); ss += lane_xor<16>(ss); ss = lane_sum_halves(ss);
                    if (fq == 0) vstat[(size_t)((colt >> 8) * 4 + wc) * Mrows + row] = (f32x2v){s, ss}; } } }
    }
};
struct EpiResid {
    static constexpr bool PERM = false, AFTER_DRAIN = false;
    const float* base; float* out; int ldc; const float* gate; int gstride; int tiles_per_batch;
    __device__ __forceinline__ void operator()(const f32x4 (&acc)[2][2][4][2], const Unit& u, int wr, int wc, int fr, int fq) const {
        const int col0 = u.pn * BM + wc * 32 + 4 * fq; const float* g = gate + (size_t)(u.pm / tiles_per_batch) * gstride + col0;
        f32x4 gv[2][2];
#pragma unroll
        for (int bj = 0; bj < 2; ++bj)
#pragma unroll
            for (int n = 0; n < 2; ++n) gv[bj][n] = *(const f32x4*)(g + bj * HALF + n * 16);
#pragma unroll
        for (int ai = 0; ai < 2; ++ai)
#pragma unroll
            for (int m = 0; m < 4; ++m) { const size_t off = (size_t)(u.pm * BM + ai * HALF + wr * 64 + m * 16 + fr) * ldc + col0;
#pragma unroll
                for (int bj = 0; bj < 2; ++bj)
#pragma unroll
                    for (int n = 0; n < 2; ++n) { const f32x4 bs = *(const f32x4*)(base + off + bj * HALF + n * 16); const f32x4 o = bs + gv[bj][n] * acc[ai][bj][m][n];
                        *(f32x4*)(out + off + bj * HALF + n * 16) = o; }
                if (m & 1) asm volatile("" ::: "memory"); }
    }
};


struct EpiGmlpIn {
    static constexpr bool PERM = true, AFTER_DRAIN = false;
    bf16_t* U; bf16_t* V; f32x2v* vstat; int Mrows; int GHc; int do_gelu;
    __device__ __forceinline__ void operator()(const f32x4 (&acc)[2][2][4][2], const Unit& u, int wr, int wc, int fr, int fq) const {
        const int colt_all = u.pn * BM; const int t = colt_all >= GHc ? 1 : 0; const int colt = colt_all - t * GHc; const int nch = GHc >> 7;
        const int frs = (fr & ~0xC) | ((fr & 4) << 1) | ((fr & 8) >> 1);
        const int row0 = u.pm * BM + wr * 64 + fr;
        char* p; size_t s_ai, s_m, s_bj;
        if (t == 0) { p = (char*)U + ((size_t)(u.pm * 2) * nch + (colt >> 7)) * 32768 + (size_t)(wr * 64 + fr) * 256 + (wc * 32 + 8 * fq) * 2; s_ai = (size_t)nch * 32768; s_m = 16 * 256; s_bj = 32768; }
        else { p = (char*)V + ((size_t)((u.pm * 2) * nch + (colt >> 7)) * 2 + wr) * 16384 + ((frs >> 3) * 4 + wc) * 512 + ((frs & 7) * 32 + 8 * fq) * 2; s_ai = (size_t)nch * 32768; s_m = 4096; s_bj = 32768; }
        f32x2v* vs = vstat + (size_t)((colt >> 8) * 4 + wc) * Mrows + row0;
        if (t == 0) body<false>(acc, p, s_ai, s_m, s_bj, vs, fq); else body<true>(acc, p, s_ai, s_m, s_bj, vs, fq);
    }
    template <bool STATS>
    __device__ __forceinline__ void body(const f32x4 (&acc)[2][2][4][2], char* p, size_t s_ai, size_t s_m, size_t s_bj, f32x2v* vs, int fq) const {
#pragma unroll
        for (int ai = 0; ai < 2; ++ai)
#pragma unroll
            for (int m = 0; m < 4; ++m) {
                f32x2 s2 = {0.f, 0.f}, q2 = {0.f, 0.f};
#pragma unroll
                for (int bj = 0; bj < 2; ++bj) { const f32x4 v0 = acc[ai][bj][m][0], v1 = acc[ai][bj][m][1];
                    f32x2 a = {v0[0], v0[1]}, b = {v0[2], v0[3]}, c = {v1[0], v1[1]}, d = {v1[2], v1[3]};
                    if (STATS && do_gelu) { a = gelu_pk(a); b = gelu_pk(b); c = gelu_pk(c); d = gelu_pk(d); }
                    if (STATS) { s2 += (a + b) + (c + d); q2 = a * a + q2; q2 = b * b + q2; q2 = c * c + q2; q2 = d * d + q2; }
                    u32x4 w; w.x = cvt_pk_bf16(a.x, a.y); w.y = cvt_pk_bf16(b.x, b.y); w.z = cvt_pk_bf16(c.x, c.y); w.w = cvt_pk_bf16(d.x, d.y);
                    PG8_BIGSTORE((u32x4*)(p + ai * s_ai + m * s_m + bj * s_bj), w); }
                if (STATS) { float s = s2.x + s2.y, ss = q2.x + q2.y; s += lane_xor<16>(s); s = lane_sum_halves(s); ss += lane_xor<16>(ss); ss = lane_sum_halves(ss);
                    if (fq == 0) vs[ai * HALF + m * 16] = (f32x2v){s, ss}; } }
    }
};

struct EpiDelta {
    static constexpr bool PERM = true, AFTER_DRAIN = false;
    bf16_t* O; int ldc; const float* gate; int gstride; int tiles_per_batch;
    __device__ __forceinline__ void operator()(const f32x4 (&acc)[2][2][4][2], const Unit& u, int wr, int wc, int fr, int fq) const {
        const int row0 = u.pm * BM + wr * 64 + fr, col0 = u.pn * BM + wc * 32 + 8 * fq; const float* g = gate + (size_t)(u.pm / tiles_per_batch) * gstride + col0;
        f32x4 gv[2][2];
#pragma unroll
        for (int bj = 0; bj < 2; ++bj)
#pragma unroll
            for (int n = 0; n < 2; ++n) gv[bj][n] = *(const f32x4*)(g + bj * HALF + 4 * n);
#pragma unroll
        for (int ai = 0; ai < 2; ++ai)
#pragma unroll
            for (int m = 0; m < 4; ++m) { bf16_t* rowp = O + (size_t)(row0 + ai * HALF + m * 16) * ldc + col0;
#pragma unroll
                for (int bj = 0; bj < 2; ++bj) { const f32x4 v0 = acc[ai][bj][m][0] * gv[bj][0], v1 = acc[ai][bj][m][1] * gv[bj][1];
                    u32x4 w; w.x = cvt_pk_bf16(v0[0], v0[1]); w.y = cvt_pk_bf16(v0[2], v0[3]); w.z = cvt_pk_bf16(v1[0], v1[1]); w.w = cvt_pk_bf16(v1[2], v1[3]);
                    PG8_BIGSTORE((u32x4*)(rowp + bj * HALF), w); } }
    }
};

struct EpiHeadNorm {
    static constexpr bool PERM = true, AFTER_DRAIN = false;
    bf16_t* O; int ldc; int split_cols; size_t split_stride; int norm_parts; const float* gain; float eps; PG8_LAS float* P; float gscale;
    __device__ __forceinline__ void operator()(const f32x4 (&acc)[2][2][4][2], const Unit& u, int wr, int wc, int fr, int fq) const {
        const int row0 = u.pm * BM + wr * 64 + fr; int colt = u.pn * BM; bf16_t* base = O; int t = 0;
        if (split_cols) { t = colt / split_cols; base += (size_t)t * split_stride; colt -= t * split_cols; }
        const int col0 = colt + wc * 32 + 8 * fq;
        const bool norm = t < norm_parts;
        if (norm) {
#pragma unroll
            for (int ai = 0; ai < 2; ++ai)
#pragma unroll
                for (int m = 0; m < 4; ++m)
#pragma unroll
                    for (int bj = 0; bj < 2; ++bj) { const f32x4 v0 = acc[ai][bj][m][0], v1 = acc[ai][bj][m][1];
                        float s = ((v0[0] * v0[0] + v0[1] * v0[1]) + (v0[2] * v0[2] + v0[3] * v0[3])) + ((v1[0] * v1[0] + v1[1] * v1[1]) + (v1[2] * v1[2] + v1[3] * v1[3]));
                        s += lane_xor<16>(s); s = lane_sum_halves(s);
                        if (fq == 0) P[(ai * HALF + wr * 64 + m * 16 + fr) * 8 + bj * 4 + wc] = s; }
            asm volatile("s_waitcnt lgkmcnt(0)" ::: "memory"); __builtin_amdgcn_s_barrier(); asm volatile("" ::: "memory");
        }
        f32x4 g0 = {1.f, 1.f, 1.f, 1.f}, g1 = {1.f, 1.f, 1.f, 1.f};
        if (norm) { g0 = *(const f32x4*)(gain + wc * 32 + 8 * fq) * gscale; g1 = *(const f32x4*)(gain + wc * 32 + 8 * fq + 4) * gscale; }
#pragma unroll
        for (int ai = 0; ai < 2; ++ai)
#pragma unroll
            for (int m = 0; m < 4; ++m) { bf16_t* rowp = base + (size_t)(row0 + ai * HALF + m * 16) * ldc + col0;
#pragma unroll
                for (int bj = 0; bj < 2; ++bj) { f32x4 v0 = acc[ai][bj][m][0], v1 = acc[ai][bj][m][1];
                    if (norm) { const f32x4 p = *(const PG8_LAS f32x4*)(P + (ai * HALF + wr * 64 + m * 16 + fr) * 8 + bj * 4);
                        const float r = 1.0f / sqrtf(((p[0] + p[1]) + (p[2] + p[3])) * (1.0f / 128.0f) + eps); v0 = v0 * r * g0; v1 = v1 * r * g1; }
                    u32x4 w; w.x = cvt_pk_bf16(v0[0], v0[1]); w.y = cvt_pk_bf16(v0[2], v0[3]); w.z = cvt_pk_bf16(v1[0], v1[1]); w.w = cvt_pk_bf16(v1[2], v1[3]);
                    PG8_BIGSTORE((u32x4*)(rowp + bj * HALF), w); } }
    }
};

template <class Epi, class Sched, bool ALIGN_EPI = false, bool SP2 = false>
__device__ __forceinline__ void gemm_phase(PG8_LAS unsigned char* lds, const Gemm g, const Sched& S, const Epi& E) {
    int tid_ = threadIdx.x; asm volatile("" : "+v"(tid_));
    const int tid = tid_, wid = __builtin_amdgcn_readfirstlane(tid >> 6), lane = tid & 63, wr = wid >> 2, wc = wid & 3, fr = lane & 15, fq = lane >> 4;
    const int K = g.K, nt = K / BK, rsA = g.a_tiled ? 128 : K;
#define PG8_KOFFA(t) (g.a_tiled ? ((size_t)((t) >> 1) * 32768 + (size_t)((t) & 1) * 128) : (size_t)(t) * kstep)
#define PG8_KOFFB(t) (PG8_BT ? ((size_t)((t) >> 1) * 32768 + (size_t)((t) & 1) * 128) : (size_t)(t) * kstep)
    unsigned voffA[2], voffB[2];
#pragma unroll
    for (int i = 0; i < 2; ++i) { int R, C; stage_rc(tid * 16 + i * 8192, R, C); const int Rb = Epi::PERM ? ((R & ~31) + perm32(R & 31)) : R;
        voffA[i] = (unsigned)(R * rsA + C) * 2u; voffB[i] = (unsigned)(Rb * (PG8_BT ? 128 : K) + C) * 2u; }
    const size_t kstep = (size_t)(BK * 2);
    const size_t hstep = (size_t)HALF * K * 2;
    const size_t tstep = 2 * hstep;
    const unsigned ldsw = (unsigned)wid * 1024u;
    const int aoff = lds_byte(wr * 64 + fr, fq * 8), boff = lds_byte(wc * 32 + fr, fq * 8);
#define PG8_SA(b, h) (((b) * 2 + (h)) * HTB)
#define PG8_SB(b, h) ((4 + (b) * 2 + (h)) * HTB)
#define PG8_STAGE(bufoff, gbase, voff) do { _Pragma("unroll") for (int _i = 0; _i < 2; ++_i) \
        __builtin_amdgcn_global_load_lds((const unsigned*)((const char*)(gbase) + (voff)[_i]), (PG8_LAS unsigned*)(lds + (bufoff) + ldsw + _i * 8192), 16, 0, 0); } while (0)
#define PG8_LDA(dst, b, h) do { _Pragma("unroll") for (int m = 0; m < 4; ++m) _Pragma("unroll") for (int k = 0; k < 2; ++k) dst[m][k] = *(const PG8_LAS bf16x8*)(lds + PG8_SA(b, h) + aoff + m * 2048 + k * 1024); } while (0)
#define PG8_LDB(dst, b, h) do { _Pragma("unroll") for (int n = 0; n < 2; ++n) _Pragma("unroll") for (int k = 0; k < 2; ++k) dst[n][k] = *(const PG8_LAS bf16x8*)(lds + PG8_SB(b, h) + boff + n * 2048 + k * 1024); } while (0)
#define PG8_MMA(ai, bj, At, Bt) do { __builtin_amdgcn_s_setprio(1); _Pragma("unroll") for (int m = 0; m < 4; ++m) _Pragma("unroll") for (int n = 0; n < 2; ++n) _Pragma("unroll") for (int k = 0; k < 2; ++k) \
        acc[ai][bj][m][n] = __builtin_amdgcn_mfma_f32_16x16x32_bf16(Bt[n][k], At[m][k], acc[ai][bj][m][n], 0, 0, 0); __builtin_amdgcn_s_setprio(0); } while (0)
#define PG8_WAIT_V(n) asm volatile("s_waitcnt vmcnt(" #n ")" ::: "memory")
#define PG8_WAIT_L(n) asm volatile("s_waitcnt lgkmcnt(" #n ")" ::: "memory")
#define PG8_BAR __builtin_amdgcn_s_barrier()
#define PG8_SCHED __builtin_amdgcn_sched_barrier(0)
    Unit cur, nxt; int ui = 0;
    if (!S.next(0, cur)) return;
#ifdef STAGGER_TICKS
    { const unsigned grp = (blockIdx.x >> 3) & 3u; if (grp) { const unsigned long long t0 = __builtin_amdgcn_s_memrealtime(); while (__builtin_amdgcn_s_memrealtime() - t0 < (unsigned long long)(grp * STAGGER_TICKS)) __builtin_amdgcn_s_sleep(2); } }
#endif
    f32x4 acc[2][2][4][2];
#pragma unroll
    for (int a = 0; a < 2; ++a)
#pragma unroll
        for (int b = 0; b < 2; ++b)
#pragma unroll
            for (int m = 0; m < 4; ++m)
#pragma unroll
                for (int n = 0; n < 2; ++n) acc[a][b][m][n] = (f32x4){0.f, 0.f, 0.f, 0.f};
    bf16x8 At[4][2], B0[2][2], B1[2][2];
    const char* cA = (const char*)g.A + (size_t)cur.pm * tstep; const char* cB = (const char*)g.Bt + (size_t)cur.pn * tstep;
    S.a_ready(cur);
    if constexpr (SP2) {
        PG8_STAGE(PG8_SB(0, 0), cB, voffB); PG8_STAGE(PG8_SB(0, 1), cB + hstep, voffB); PG8_STAGE(PG8_SA(0, 0), cA, voffA); PG8_STAGE(PG8_SA(0, 1), cA + hstep, voffA);
        if (wr == 1) PG8_BAR;
        PG8_WAIT_V(2); PG8_BAR;
        PG8_STAGE(PG8_SB(1, 0), cB + kstep, voffB); PG8_STAGE(PG8_SA(1, 0), cA + kstep, voffA); PG8_STAGE(PG8_SB(1, 1), cB + hstep + kstep, voffB);
        PG8_WAIT_V(6); PG8_BAR;
    } else {
        PG8_STAGE(PG8_SB(0, 0), cB, voffB); PG8_STAGE(PG8_SA(0, 0), cA, voffA); PG8_STAGE(PG8_SB(0, 1), cB + hstep, voffB); PG8_STAGE(PG8_SA(0, 1), cA + hstep, voffA);
        if (wr == 1) PG8_BAR;
        PG8_WAIT_V(4); PG8_BAR;
        PG8_STAGE(PG8_SB(1, 0), cB + kstep, voffB); PG8_STAGE(PG8_SA(1, 0), cA + kstep, voffA); PG8_STAGE(PG8_SB(1, 1), cB + hstep + kstep, voffB);
        PG8_WAIT_V(6); PG8_BAR;
    }
    for (;;) {
        const bool has_next = S.next(ui + 1, nxt);
        const char* nA = has_next ? (const char*)g.A + (size_t)nxt.pm * tstep : cA; const char* nB = has_next ? (const char*)g.Bt + (size_t)nxt.pn * tstep : cB;
        for (int t = 0; t < nt; t += 2) {
            const bool last = (t == nt - 2);
            const char* a1 = cA + PG8_KOFFA(t + 1);
            const char* a2 = last ? nA : cA + PG8_KOFFA(t + 2); const char* b2 = last ? nB : cB + PG8_KOFFB(t + 2);
            const char* a3 = a2 + kstep; const char* b3 = b2 + kstep;
            if (last && has_next) S.a_ready(nxt);
            if constexpr (SP2) {
            PG8_LDB(B0, 0, 0); PG8_LDB(B1, 0, 1); PG8_SCHED; PG8_LDA(At, 0, 0); PG8_STAGE(PG8_SA(1, 1), a1 + hstep, voffA);
            PG8_WAIT_V(8); PG8_WAIT_L(0); PG8_BAR; PG8_MMA(0, 0, At, B0); PG8_MMA(0, 1, At, B1); PG8_BAR; PG8_SCHED;
            PG8_LDA(At, 0, 1); PG8_STAGE(PG8_SB(0, 0), b2, voffB); PG8_STAGE(PG8_SB(0, 1), b2 + hstep, voffB); PG8_STAGE(PG8_SA(0, 0), a2, voffA);
            PG8_WAIT_V(8); PG8_WAIT_L(0); PG8_BAR; PG8_MMA(1, 0, At, B0); PG8_MMA(1, 1, At, B1); PG8_BAR; PG8_SCHED;
            PG8_LDB(B0, 1, 0); PG8_LDB(B1, 1, 1); PG8_SCHED; PG8_LDA(At, 1, 0); PG8_STAGE(PG8_SA(0, 1), a2 + hstep, voffA);
            PG8_WAIT_V(8); PG8_WAIT_L(0); PG8_BAR; PG8_MMA(0, 0, At, B0); PG8_MMA(0, 1, At, B1); PG8_BAR; PG8_SCHED;
            PG8_LDA(At, 1, 1); PG8_STAGE(PG8_SB(1, 0), b3, voffB); PG8_STAGE(PG8_SB(1, 1), b3 + hstep, voffB); PG8_STAGE(PG8_SA(1, 0), a3, voffA);
            PG8_WAIT_V(8); PG8_WAIT_L(0); PG8_BAR; PG8_MMA(1, 0, At, B0); PG8_MMA(1, 1, At, B1); PG8_BAR; PG8_SCHED;
            } else {
            PG8_LDB(B0, 0, 0); PG8_SCHED; PG8_LDA(At, 0, 0); PG8_STAGE(PG8_SA(1, 1), a1 + hstep, voffA);
            PG8_WAIT_L(8); PG8_BAR; PG8_WAIT_L(0); PG8_MMA(0, 0, At, B0); PG8_BAR; PG8_SCHED;
            PG8_LDB(B1, 0, 1); PG8_STAGE(PG8_SB(0, 0), b2, voffB);
            PG8_BAR; PG8_WAIT_L(0); PG8_MMA(0, 1, At, B1); PG8_BAR;
            PG8_LDA(At, 0, 1); PG8_STAGE(PG8_SA(0, 0), a2, voffA);
            PG8_BAR; PG8_WAIT_L(0); PG8_MMA(1, 0, At, B0); PG8_BAR; PG8_SCHED;
            PG8_STAGE(PG8_SB(0, 1), b2 + hstep, voffB);
            PG8_WAIT_V(6); PG8_BAR; PG8_MMA(1, 1, At, B1); PG8_BAR;
            PG8_LDB(B0, 1, 0); PG8_SCHED; PG8_LDA(At, 1, 0); PG8_STAGE(PG8_SA(0, 1), a2 + hstep, voffA);
            PG8_WAIT_L(8); PG8_BAR; PG8_WAIT_L(0); PG8_MMA(0, 0, At, B0); PG8_BAR; PG8_SCHED;
            PG8_LDB(B1, 1, 1); PG8_STAGE(PG8_SB(1, 0), b3, voffB);
            PG8_BAR; PG8_WAIT_L(0); PG8_MMA(0, 1, At, B1); PG8_BAR;
            PG8_LDA(At, 1, 1); PG8_STAGE(PG8_SA(1, 0), a3, voffA);
            PG8_BAR; PG8_WAIT_L(0); PG8_MMA(1, 0, At, B0); PG8_BAR; PG8_SCHED;
            PG8_STAGE(PG8_SB(1, 1), b3 + hstep, voffB);
            PG8_WAIT_V(6); PG8_BAR; PG8_MMA(1, 1, At, B1); PG8_BAR;
            }
        }
        if constexpr (ALIGN_EPI) { if (wr == 0) PG8_BAR; }
        if constexpr (!Epi::AFTER_DRAIN) { E(acc, cur, wr, wc, fr, fq); S.done(cur); }
        if (!has_next) break;
#pragma unroll
        for (int a = 0; a < 2; ++a)
#pragma unroll
            for (int b = 0; b < 2; ++b)
#pragma unroll
                for (int m = 0; m < 4; ++m)
#pragma unroll
                    for (int n = 0; n < 2; ++n) acc[a][b][m][n] = (f32x4){0.f, 0.f, 0.f, 0.f};
        cur = nxt; cA = nA; cB = nB; ++ui;
        if constexpr (ALIGN_EPI) { if (wr == 1) PG8_BAR; }
    }
    PG8_WAIT_V(0);
    if constexpr (!ALIGN_EPI) { if (wr == 0) PG8_BAR; }
    PG8_BAR;
    if constexpr (Epi::AFTER_DRAIN) { E.fused(acc, cur, wr, wc, fr, fq, lds, wid, lane); S.done(cur); }
#undef PG8_SA
#undef PG8_KOFFA
#undef PG8_KOFFB
#undef PG8_SB
#undef PG8_STAGE
#undef PG8_LDA
#undef PG8_LDB
#undef PG8_MMA
#undef PG8_WAIT_V
#undef PG8_WAIT_L
#undef PG8_BAR
#undef PG8_SCHED
}
}

namespace att {
typedef unsigned short bf16;
typedef short bf16x8 __attribute__((ext_vector_type(8)));
typedef short s16x4 __attribute__((ext_vector_type(4)));
typedef float f32x16 __attribute__((ext_vector_type(16)));
typedef float f32x4 __attribute__((ext_vector_type(4)));
typedef unsigned u32x4 __attribute__((ext_vector_type(4)));
typedef unsigned u32x2 __attribute__((ext_vector_type(2)));
constexpr int D = 128, PITCH = 2048, SEQ = 4096, NH = 16, NB = 8;
#ifndef ATT_THR
#define ATT_THR 8.f
#endif
constexpr float THR = ATT_THR;
constexpr float SCALE = 0.08838834764831845f;
constexpr float INV_SCALE = 11.313708498984761f;
constexpr float LOG2E = 1.4426950408889634f;
constexpr int NW = 8, QBLK = 32, KVBLK = 64, QB = NW * QBLK;
constexpr int SHM_V = KVBLK * D * 2, SHM_K = KVBLK * D * 2;
constexpr int NVB = 3;
constexpr int LDS_WS = NVB * SHM_V + 2 * SHM_K;
constexpr int LDS_FB = LDS_WS + NW * 64 * 4;
constexpr int LDS_BYTES = LDS_FB + SEQ * 8;
constexpr int W = 1 << 30;

#define KSWZ(row, colB) ((row) * 256 + ((colB) ^ (((row) & 7) << 4)))
#define SBAR() __builtin_amdgcn_sched_barrier(0)
__device__ __forceinline__ int v_st(int k, int c) { const int kk = (k & ~0xC) | ((k & 4) << 1) | ((k & 8) >> 1); return ((kk >> 3) * 4 + (c >> 5)) * 512 + ((kk & 7) * 32 + (c & 31)) * 2; }
__device__ __forceinline__ int v_rd_base(int lane) { return ((lane & 3) << 3) | (((lane >> 2) & 3) << 6) | (((lane >> 4) & 1) << 5) | (((lane >> 5) & 1) << 8); }
constexpr int v_rd_off(int d0, int ks, int half) { return d0 * 512 + ks * 4096 + half * 2048; }
__device__ __forceinline__ int crow(int r, int hi) { return (r & 3) + 8 * (r >> 2) + 4 * hi; }
__device__ __forceinline__ unsigned cvtpk(float lo, float hi) { unsigned r; asm volatile("v_cvt_pk_bf16_f32 %0, %1, %2" : "=v"(r) : "v"(lo), "v"(hi)); return r; }
__device__ __forceinline__ bf16x8 load8(const bf16* p) { return *reinterpret_cast<const bf16x8*>(p); }
__device__ __forceinline__ void mask_tile(f32x16& p0, f32x16& p1, int dq, unsigned Wm) {
    const float NEG = -__builtin_inff();
#pragma unroll
    for (int r = 0; r < 16; ++r) {
        const int c = (r & 3) + 8 * (r >> 2);
        if ((unsigned)(dq - c) >= Wm) p0[r] = NEG;
        if ((unsigned)(dq - c - 32) >= Wm) p1[r] = NEG;
    }
}
__device__ __forceinline__ void split3(float x, unsigned& w0, unsigned& w1) {
    const unsigned xh = cvtpk(x, 0.f) & 0xffffu; const float r1 = x - __uint_as_float(xh << 16);
    const unsigned xm = cvtpk(r1, 0.f) & 0xffffu; const float r2 = r1 - __uint_as_float(xm << 16);
    w0 = xh | (xm << 16); w1 = cvtpk(r2, 0.f) & 0xffffu;
}
__device__ __forceinline__ bf16x8 make_negB(float m_ref, int hi) {
    unsigned n0, n1; split3(-m_ref, n0, n1);
    u32x4 w = {0x3F803F80u, 0x00003F80u | (n0 << 16), (n0 >> 16) | (n1 << 16), 0u};
    if (hi) w = (u32x4){0u, 0u, 0u, 0u};
    return *reinterpret_cast<bf16x8*>(&w);
}
__device__ __forceinline__ void trackmax(const f32x16& p0, const f32x16& p1, bool track, float& mrun) {
    if (track) { float pmax = p0[0]; for (int r = 1; r < 16; ++r) pmax = fmaxf(pmax, p0[r]); for (int r = 0; r < 16; ++r) pmax = fmaxf(pmax, p1[r]);
        auto rr = __builtin_amdgcn_permlane32_swap(__float_as_uint(pmax), __float_as_uint(pmax), false, false);
        mrun = fmaxf(mrun, fmaxf(__uint_as_float(rr[0]), __uint_as_float(rr[1]))); }
}
__device__ __forceinline__ void partialSM(f32x16& p0) {
    for (int r = 0; r < 16; ++r) p0[r] = __builtin_amdgcn_exp2f(p0[r]);
}
__device__ __forceinline__ void finishSM(f32x16& p0, f32x16& p1, float& l_reg, bf16x8& pa0, bf16x8& pa1, bf16x8& pa2, bf16x8& pa3) {
    for (int r = 0; r < 16; ++r) p1[r] = __builtin_amdgcn_exp2f(p1[r]);
    float ps = 0; for (int r = 0; r < 16; ++r) ps += p0[r]; for (int r = 0; r < 16; ++r) ps += p1[r];
    { auto rr = __builtin_amdgcn_permlane32_swap(__float_as_uint(ps), __float_as_uint(ps), false, false);
      ps = __uint_as_float(rr[0]) + __uint_as_float(rr[1]); }
    l_reg += ps;
#define PK4(P, B_, OUT) do { unsigned a0 = cvtpk(P[B_+0], P[B_+1]), a1 = cvtpk(P[B_+2], P[B_+3]);                          \
        unsigned b0 = cvtpk(P[B_+4], P[B_+5]), b1 = cvtpk(P[B_+6], P[B_+7]);                                             \
        auto r0 = __builtin_amdgcn_permlane32_swap(a0, b0, false, false); auto r1 = __builtin_amdgcn_permlane32_swap(a1, b1, false, false); \
        u32x4 w = {r0[0], r1[0], r0[1], r1[1]}; OUT = *reinterpret_cast<bf16x8*>(&w); } while (0)
    PK4(p0, 0, pa0); PK4(p0, 8, pa1); PK4(p1, 0, pa2); PK4(p1, 8, pa3);
#undef PK4
}
#define KRD(dst, a, off) asm volatile("ds_read_b128 %0, %1 offset:%2" : "=&v"(dst) : "v"(a), "i"(off) : "memory")
#define KWAIT(f0, f1, n) asm volatile("s_waitcnt lgkmcnt(%2)" : "+v"(f0), "+v"(f1) : "i"(n) : "memory")
#ifdef ATT_QKT_ORIG
#define qkt qkt_c
#endif
template <int KB>
__device__ __forceinline__ void qkt_c(f32x16& p0, f32x16& p1, const int (&ka)[4], const bf16x8* qr, const char* fb, bf16x8 ones) {
    p0 = f32x16{}; p1 = f32x16{};
#pragma unroll
    for (int d0 = 0; d0 < 8; ++d0) { const __attribute__((address_space(3))) char* a = (const __attribute__((address_space(3))) char*)(uintptr_t)(unsigned)ka[d0 & 3] + KB * SHM_K + (d0 >> 2) * 128;
        bf16x8 b0 = *reinterpret_cast<const __attribute__((address_space(3))) bf16x8*>(a);
        bf16x8 b1 = *reinterpret_cast<const __attribute__((address_space(3))) bf16x8*>(a + 32 * 256);
        p0 = __builtin_amdgcn_mfma_f32_32x32x16_bf16(b0, qr[d0], p0, 0, 0, 0);
        p1 = __builtin_amdgcn_mfma_f32_32x32x16_bf16(b1, qr[d0], p1, 0, 0, 0); }
    { const u32x2 t0 = *reinterpret_cast<const u32x2*>(fb), t1 = *reinterpret_cast<const u32x2*>(fb + 32 * 8);
      u32x4 w0 = {t0.x, t0.y, 0x3F803F80u, 0u}, w1 = {t1.x, t1.y, 0x3F803F80u, 0u};
      p0 = __builtin_amdgcn_mfma_f32_32x32x16_bf16(*reinterpret_cast<bf16x8*>(&w0), ones, p0, 0, 0, 0);
      p1 = __builtin_amdgcn_mfma_f32_32x32x16_bf16(*reinterpret_cast<bf16x8*>(&w1), ones, p1, 0, 0, 0); }
}
#ifndef ATT_QKT_ORIG
template <int KB>
__device__ __forceinline__ void qkt(f32x16& p0, f32x16& p1, const int (&ka)[4], const bf16x8* qr, const char* fb, bf16x8 ones) {
    p0 = f32x16{}; p1 = f32x16{};
    bf16x8 fa0, fa1, fb0, fb1, fc0, fc1;
#define KOFF(d0) (KB * SHM_K + ((d0) >> 2) * 128)
#define KLD(x0, x1, d0) do { KRD(x0, ka[(d0) & 3], KOFF(d0)); KRD(x1, ka[(d0) & 3], KOFF(d0) + 32 * 256); } while (0)
#ifdef ATT_QKT_SBAR
#define KMM(x0, x1, d0, n) do { asm volatile("s_waitcnt lgkmcnt(%0)" :: "i"(n) : "memory"); SBAR(); p0 = __builtin_amdgcn_mfma_f32_32x32x16_bf16(x0, qr[d0], p0, 0, 0, 0); p1 = __builtin_amdgcn_mfma_f32_32x32x16_bf16(x1, qr[d0], p1, 0, 0, 0); SBAR(); } while (0)
#else
#define KMM(x0, x1, d0, n) do { KWAIT(x0, x1, n); p0 = __builtin_amdgcn_mfma_f32_32x32x16_bf16(x0, qr[d0], p0, 0, 0, 0); p1 = __builtin_amdgcn_mfma_f32_32x32x16_bf16(x1, qr[d0], p1, 0, 0, 0); } while (0)
#endif
    KLD(fa0, fa1, 0); KLD(fb0, fb1, 1); KLD(fc0, fc1, 2);
    KMM(fa0, fa1, 0, 4); KLD(fa0, fa1, 3);
    KMM(fb0, fb1, 1, 4); KLD(fb0, fb1, 4);
    KMM(fc0, fc1, 2, 4); KLD(fc0, fc1, 5);
    KMM(fa0, fa1, 3, 4); KLD(fa0, fa1, 6);
    KMM(fb0, fb1, 4, 4); KLD(fb0, fb1, 7);
    KMM(fc0, fc1, 5, 4);
    KMM(fa0, fa1, 6, 2);
    KMM(fb0, fb1, 7, 0);
#undef KMM
#undef KLD
#undef KOFF
    { const u32x2 t0 = *reinterpret_cast<const u32x2*>(fb), t1 = *reinterpret_cast<const u32x2*>(fb + 32 * 8);
      u32x4 w0 = {t0.x, t0.y, 0x3F803F80u, 0u}, w1 = {t1.x, t1.y, 0x3F803F80u, 0u};
      p0 = __builtin_amdgcn_mfma_f32_32x32x16_bf16(*reinterpret_cast<bf16x8*>(&w0), ones, p0, 0, 0, 0);
      p1 = __builtin_amdgcn_mfma_f32_32x32x16_bf16(*reinterpret_cast<bf16x8*>(&w1), ones, p1, 0, 0, 0); }
}
#endif
template <int KB>
__device__ __forceinline__ void qkt_sm(f32x16& p0, f32x16& p1, const int (&ka)[4], const bf16x8* qr, const char* fb, bf16x8 ones,
                                       f32x16& y0, f32x16& y1, float& l_reg, bf16x8& pa0, bf16x8& pa1, bf16x8& pa2, bf16x8& pa3) {
    p0 = f32x16{}; p1 = f32x16{};
    bf16x8 fa0, fa1, fb0, fb1, fc0, fc1; float ps;
#define KOFF(d0) (KB * SHM_K + ((d0) >> 2) * 128)
#define KLD(x0, x1, d0) do { KRD(x0, ka[(d0) & 3], KOFF(d0)); KRD(x1, ka[(d0) & 3], KOFF(d0) + 32 * 256); } while (0)
#define KMM(x0, x1, d0, n) asm volatile("s_waitcnt lgkmcnt(%0)" :: "i"(n) : "memory"); SBAR(); p0 = __builtin_amdgcn_mfma_f32_32x32x16_bf16(x0, qr[d0], p0, 0, 0, 0); p1 = __builtin_amdgcn_mfma_f32_32x32x16_bf16(x1, qr[d0], p1, 0, 0, 0);
#define PK4(P, B_, OUT) do { unsigned a0 = cvtpk(P[B_+0], P[B_+1]), a1 = cvtpk(P[B_+2], P[B_+3]);                          \
        unsigned b0 = cvtpk(P[B_+4], P[B_+5]), b1 = cvtpk(P[B_+6], P[B_+7]);                                             \
        auto r0 = __builtin_amdgcn_permlane32_swap(a0, b0, false, false); auto r1 = __builtin_amdgcn_permlane32_swap(a1, b1, false, false); \
        u32x4 w = {r0[0], r1[0], r0[1], r1[1]}; OUT = *reinterpret_cast<bf16x8*>(&w); } while (0)
#define EX4(B_) do { y1[B_] = __builtin_amdgcn_exp2f(y1[B_]); y1[B_+1] = __builtin_amdgcn_exp2f(y1[B_+1]); y1[B_+2] = __builtin_amdgcn_exp2f(y1[B_+2]); y1[B_+3] = __builtin_amdgcn_exp2f(y1[B_+3]); \
        ps += (y1[B_] + y1[B_+1]) + (y1[B_+2] + y1[B_+3]); } while (0)
    KLD(fa0, fa1, 0); KLD(fb0, fb1, 1); KLD(fc0, fc1, 2);
    KMM(fa0, fa1, 0, 4) ps = (((y0[0] + y0[1]) + (y0[2] + y0[3])) + ((y0[4] + y0[5]) + (y0[6] + y0[7]))) + (((y0[8] + y0[9]) + (y0[10] + y0[11])) + ((y0[12] + y0[13]) + (y0[14] + y0[15]))); SBAR(); KLD(fa0, fa1, 3);
    KMM(fb0, fb1, 1, 4) PK4(y0, 0, pa0); PK4(y0, 8, pa1); SBAR(); KLD(fb0, fb1, 4);
    KMM(fc0, fc1, 2, 4) EX4(0); SBAR(); KLD(fc0, fc1, 5);
    KMM(fa0, fa1, 3, 4) EX4(4); SBAR(); KLD(fa0, fa1, 6);
    KMM(fb0, fb1, 4, 4) EX4(8); SBAR(); KLD(fb0, fb1, 7);
    KMM(fc0, fc1, 5, 4) EX4(12); SBAR();
    KMM(fa0, fa1, 6, 2) PK4(y1, 0, pa2); SBAR();
    KMM(fb0, fb1, 7, 0) PK4(y1, 8, pa3);
    { auto rr = __builtin_amdgcn_permlane32_swap(__float_as_uint(ps), __float_as_uint(ps), false, false); ps = __uint_as_float(rr[0]) + __uint_as_float(rr[1]); }
    l_reg += ps; SBAR();
#undef EX4
#undef PK4
#undef KMM
#undef KLD
#undef KOFF
    { const u32x2 t0 = *reinterpret_cast<const u32x2*>(fb), t1 = *reinterpret_cast<const u32x2*>(fb + 32 * 8);
      u32x4 w0 = {t0.x, t0.y, 0x3F803F80u, 0u}, w1 = {t1.x, t1.y, 0x3F803F80u, 0u};
      p0 = __builtin_amdgcn_mfma_f32_32x32x16_bf16(*reinterpret_cast<bf16x8*>(&w0), ones, p0, 0, 0, 0);
      p1 = __builtin_amdgcn_mfma_f32_32x32x16_bf16(*reinterpret_cast<bf16x8*>(&w1), ones, p1, 0, 0, 0); }
}
template <bool EX = true>
__device__ __forceinline__ void pv_tile(f32x16* o, int vb0  , bf16x8 pa0, bf16x8 pa1, bf16x8 pa2, bf16x8 pa3, f32x16& px) {
#define TRRD(dst, off) asm volatile("ds_read_b64_tr_b16 %0, %1 offset:%2" : "=&v"(dst) : "v"(vb0), "i"(off) : "memory")
#define VLD(x0, x1, x2, x3, hg) do { constexpr int b_ = v_rd_off((hg) >> 1, 2 * ((hg) & 1), 0); TRRD(x0, b_); TRRD(x1, b_ + 2048); TRRD(x2, b_ + 4096); TRRD(x3, b_ + 6144); } while (0)
#define VMM(x0, x1, x2, x3, hg, pq0, pq1, n) do { asm volatile("s_waitcnt lgkmcnt(%0)" :: "i"(n) : "memory"); SBAR();                                   \
        o[(hg) >> 1] = __builtin_amdgcn_mfma_f32_32x32x16_bf16(pq0, (bf16x8){x0[0], x0[1], x0[2], x0[3], x1[0], x1[1], x1[2], x1[3]}, o[(hg) >> 1], 0, 0, 0);                        \
        if (EX) px[2 * (hg)] = __builtin_amdgcn_exp2f(px[2 * (hg)]);                                                                                                                \
        o[(hg) >> 1] = __builtin_amdgcn_mfma_f32_32x32x16_bf16(pq1, (bf16x8){x2[0], x2[1], x2[2], x2[3], x3[0], x3[1], x3[2], x3[3]}, o[(hg) >> 1], 0, 0, 0);                        \
        if (EX) { px[2 * (hg) + 1] = __builtin_amdgcn_exp2f(px[2 * (hg) + 1]); asm volatile("" : "+v"(px[2 * (hg)]), "+v"(px[2 * (hg) + 1])); }     \
        SBAR(); } while (0)
    s16x4 a0, a1, a2, a3, b0, b1, b2, b3;
    VLD(a0, a1, a2, a3, 0); VLD(b0, b1, b2, b3, 1);
    VMM(a0, a1, a2, a3, 0, pa0, pa1, 4); VLD(a0, a1, a2, a3, 2);
    VMM(b0, b1, b2, b3, 1, pa2, pa3, 4); VLD(b0, b1, b2, b3, 3);
    VMM(a0, a1, a2, a3, 2, pa0, pa1, 4); VLD(a0, a1, a2, a3, 4);
    VMM(b0, b1, b2, b3, 3, pa2, pa3, 4); VLD(b0, b1, b2, b3, 5);
    VMM(a0, a1, a2, a3, 4, pa0, pa1, 4); VLD(a0, a1, a2, a3, 6);
    VMM(b0, b1, b2, b3, 5, pa2, pa3, 4); VLD(b0, b1, b2, b3, 7);
    VMM(a0, a1, a2, a3, 6, pa0, pa1, 4);
    VMM(b0, b1, b2, b3, 7, pa2, pa3, 0);
#undef VMM
#undef VLD
#undef TRRD
}
struct BlockRef { const bf16* Q; const bf16* K; const bf16* V; bf16* O; int P0; const float* F; };
struct Seam { bf16x8 qr[8]; bf16x8 st_v0, st_v1, st_k0, st_k1; };
#define ROW(p, k0, rr) ((p) + (size_t)((k0) + (rr)) * PITCH + sc)
#define VMW() asm volatile("s_waitcnt vmcnt(0)" ::: "memory")
#define VMWN(n) asm volatile("s_waitcnt vmcnt(%0)" :: "i"(n) : "memory")
#define SLOAD_H(Kp, Vp, k0) do { S.st_v0 = load8(ROW(Vp, k0, sr)); S.st_v1 = load8(ROW(Vp, k0, 32 + sr));              \
                         S.st_k0 = load8(ROW(Kp, k0, sr)); S.st_k1 = load8(ROW(Kp, k0, 32 + sr)); } while (0)
#define SWRITE_HK(bf) do { *(bf16x8*)(K_lds + (bf) * SHM_K + kws) = S.st_k0; *(bf16x8*)(K_lds + (bf) * SHM_K + kws + 32 * 256) = S.st_k1; } while (0)
#define SWRITE_HV(off) do { *(bf16x8*)(V_lds + (off) + vst0) = S.st_v0; *(bf16x8*)(V_lds + (off) + vst1) = S.st_v1; } while (0)
__device__ __forceinline__ void prime(const BlockRef& cur, char* lds, Seam& S) {
    int tid_ = threadIdx.x; asm volatile("" : "+v"(tid_));
    const int tid = tid_, wid = __builtin_amdgcn_readfirstlane(tid >> 6), lane = tid & 63, r32 = lane & 31, hi = lane >> 5;
    const int sr = tid >> 4, sc = (tid & 15) * 8, kws = KSWZ(sr, sc * 2); char* K_lds = lds + NVB * SHM_V;
    for (int d0 = 0; d0 < 8; ++d0) S.qr[d0] = load8(cur.Q + (size_t)(wid * QBLK + r32) * PITCH + d0 * 16 + hi * 8);
    SLOAD_H(cur.K, cur.V, cur.P0 + QB - KVBLK); VMW(); SWRITE_HK(0);
    __syncthreads();
}
__device__ __forceinline__ void block(const BlockRef& cur, const BlockRef& nxt, char* lds, Seam& S, float thr2) {
    int tid_ = threadIdx.x; asm volatile("" : "+v"(tid_));
    const int tid = tid_, wid = __builtin_amdgcn_readfirstlane(tid >> 6), lane = tid & 63, r32 = lane & 31, hi = lane >> 5;
    const int NTB = cur.P0 / KVBLK + 4; int NT = NTB;
    const int qlo = cur.P0 + wid * QBLK, qm = qlo + r32 - 4 * hi;
    char* V_lds = lds; char* K_lds = lds + NVB * SHM_V;
    float* ws = (float*)(lds + LDS_WS) + wid * 64; float* li_l = ws, * al_l = ws + 32;
    const char* FBl = lds + LDS_FB + r32 * 8;
    const float f_row = cur.F[cur.P0 + wid * QBLK + r32];
    {
        const float* Fcum = cur.F; const int s_end = cur.P0 + QB;
        for (int s = tid * 4; s < s_end; s += 2048) {
            const f32x4 f4 = *(const f32x4*)(Fcum + s); unsigned w0, w1, w2, w3, w4, w5, w6, w7;
            split3(-f4.x * LOG2E, w0, w1); split3(-f4.y * LOG2E, w2, w3); split3(-f4.z * LOG2E, w4, w5); split3(-f4.w * LOG2E, w6, w7);
            *(u32x4*)(lds + LDS_FB + s * 8) = (u32x4){w0, w1 | 0x3F800000u, w2, w3 | 0x3F800000u}; *(u32x4*)(lds + LDS_FB + s * 8 + 16) = (u32x4){w4, w5 | 0x3F800000u, w6, w7 | 0x3F800000u}; }
        __syncthreads();
    }
    float m_reg = -f_row * LOG2E, l_reg = 0; f32x16 o[4] = {};
    bf16x8 ones = make_negB(m_reg, hi);
    const int sr = tid >> 4, sc = (tid & 15) * 8, vst0 = v_st(sr, sc), vst1 = v_st(32 + sr, sc), kws = KSWZ(sr, sc * 2);
    const int vb0 = (int)(uintptr_t)V_lds + v_rd_base(lane);
    int ka[4];
#pragma unroll
    for (int dd = 0; dd < 4; ++dd) ka[dd] = (int)(uintptr_t)K_lds + KSWZ(r32, (dd * 16 + hi * 8) * 2);
    const bf16* Kh = cur.K; const bf16* Vh = cur.V;
#define KBASE(t) ((NTB - 1 - (t)) * KVBLK)
#define MASKT(P0_, P1_, t) do { const int kb_ = KBASE(t); if (kb_ + KVBLK - 1 > qlo) mask_tile(P0_, P1_, qm - kb_, (unsigned)W); } while (0)
    constexpr int NQL = 8;
#define SEAM_K0() do { VMWN(NQL); SWRITE_HK(0); SBAR(); } while (0)
    f32x16 pA0, pA1, pB0, pB1; bf16x8 pa0, pa1, pa2, pa3; float mrun = -3.0e38f;
    SWRITE_HV(0); SBAR();
    if (NT > 1) { SLOAD_H(Kh, Vh, KBASE(1)); }
    SBAR(); qkt<0>(pA0, pA1, ka, S.qr, FBl + KBASE(0) * 8, ones);
    MASKT(pA0, pA1, 0); trackmax(pA0, pA1, true, mrun); partialSM(pA0);
    if (NT > 1) { VMW(); SWRITE_HK(1); SWRITE_HV(SHM_V); }
    __syncthreads();
    int vr = 0, vw = 2 * SHM_V;
#define VNEXT(x) ((x) == (NVB - 1) * SHM_V ? 0 : (x) + SHM_V)
#define HALF_STEP(PX0, PX1, PY0, PY1, t, KB) do {                                                      \
        SBAR(); qkt_sm<KB>(PX0, PX1, ka, S.qr, FBl + KBASE(t) * 8, ones, PY0, PY1, l_reg, pa0, pa1, pa2, pa3); SBAR();                                             \
        if ((t) + 1 < NT) { SLOAD_H(Kh, Vh, KBASE((t) + 1)); SBAR(); }                                               \
        MASKT(PX0, PX1, (t)); trackmax(PX0, PX1, (t) <= 4, mrun); SBAR(); pv_tile<true>(o, vb0 + vr, pa0, pa1, pa2, pa3, PX0);                                        \
        if ((t) + 1 < NT) { VMW(); SWRITE_HK((KB) ^ 1); SWRITE_HV(vw); }     \
        vr = VNEXT(vr); vw = VNEXT(vw);                                                                                        \
        __syncthreads(); } while (0)
    for (int t = 1; t + 1 < NT; t += 2) {
        HALF_STEP(pB0, pB1, pA0, pA1, t, 1);
        HALF_STEP(pA0, pA1, pB0, pB1, t + 1, 0);
#ifndef ATT_NO_EARLY_EXIT
        if (t == 3 && NT > 6) {
            float c = mrun + m_reg;
            c = fminf(c, lane_xor<1>(c)); c = fminf(c, lane_xor<2>(c)); c = fminf(c, lane_xor<4>(c)); c = fminf(c, lane_xor<8>(c)); c = fminf(c, lane_xor<16>(c));
            if (lane == 0) al_l[0] = c;
            __syncthreads();
            float cb = ((const float*)(lds + LDS_WS))[(lane & 7) * 64 + 32];
            cb = fminf(cb, lane_xor<1>(cb)); cb = fminf(cb, lane_xor<2>(cb)); cb = fminf(cb, lane_xor<4>(cb));
            const float lim = cb - thr2;
            const int ti = 5 + 2 * lane, kbi = (NTB - 1 - ti) * KVBLK; bool ok = false;
            if (kbi >= KVBLK) { const u32x2 w = *(const u32x2*)(lds + LDS_FB + (kbi - 1) * 8);
                const float bk = (__uint_as_float(w.x << 16) + __uint_as_float(w.x & 0xffff0000u)) + __uint_as_float(w.y << 16); ok = bk <= lim; }
            const unsigned long long mk = __ballot(ok);
            if (mk) NT = __builtin_amdgcn_readfirstlane(4 + 2 * (int)__ffsll((long long)mk));
        }
#endif
    }
    constexpr bool even = true;
    if (even) { SBAR(); qkt_c<1>(pB0, pB1, ka, S.qr, FBl + KBASE(NT - 1) * 8, ones); SBAR(); }
    SLOAD_H(nxt.K, nxt.V, nxt.P0 + QB - KVBLK); SBAR();
#pragma unroll
    for (int d0 = 0; d0 < 8; ++d0) S.qr[d0] = load8(nxt.Q + (size_t)(wid * QBLK + r32) * PITCH + d0 * 16 + hi * 8);
    SBAR();
    finishSM(pA0, pA1, l_reg, pa0, pa1, pa2, pa3); SBAR();
    MASKT(pB0, pB1, NT - 1); SBAR();
    pv_tile<true>(o, vb0 + vr, pa0, pa1, pa2, pa3, pB0); vr = VNEXT(vr);
    if (even) { __syncthreads();
        finishSM(pB0, pB1, l_reg, pa0, pa1, pa2, pa3); SBAR(); pv_tile<false>(o, vb0 + vr, pa0, pa1, pa2, pa3, pB0); }
    SBAR(); SEAM_K0();
    if (hi == 0) li_l[r32] = l_reg; asm volatile("s_waitcnt lgkmcnt(0)" ::: "memory");
    float rli[16];
#pragma unroll
    for (int r = 0; r < 16; ++r) rli[r] = __builtin_amdgcn_rcpf(li_l[crow(r, hi)]);
    bf16* Ow = cur.O + (size_t)(wid * QBLK) * PITCH;
#pragma unroll
    for (int r = 0; r < 16; ++r) { const int orow = crow(r, hi);
#pragma unroll
        for (int d0 = 0; d0 < 4; ++d0) { const float v = o[d0][r] * rli[r];
            const float vn = __uint_as_float(__builtin_amdgcn_update_dpp(0u, __float_as_uint(v), 0xB1  , 0xF, 0xF, true));
            if ((r32 & 1) == 0) *(unsigned*)(Ow + (size_t)orow * PITCH + d0 * 32 + r32) = cvtpk(v, vn); } }
    __syncthreads();
#undef KBASE
#undef MASKT
#undef SEAM_K0
#undef HALF_STEP
}
#undef ROW
#undef VMW
#undef VMWN
#undef SLOAD_H
#undef SWRITE_HK
#undef SWRITE_HV
#undef SWRITE_H
}


constexpr int NWAVES = 8;
#ifndef MK_N_LAUNCHES
#define MK_N_LAUNCHES 1
#endif
constexpr int BATCH = 8, SEQ = 4096, D = 2048, M = BATCH * SEQ, DEPTH = 4, NA = 2;
constexpr int GH = 3 * D  , GN = 2 * GH  , NG = 8, GD = GH / NG  , GB = 128;
constexpr int NH = 16, HD = 128, FF = 4 * D, NMOD = 6 * D;
constexpr float EPS = 1e-6f;
constexpr size_t MiB = 1u << 20;
constexpr size_t WS_CTL = 0, CTL_ZERO_BYTES = 1 * MiB;
constexpr size_t WS_MOD = 1 * MiB;
constexpr size_t WS_KVMOD = WS_MOD + (size_t)DEPTH * BATCH * NMOD * 4;
constexpr size_t WS_WSM = 3 * MiB;
constexpr size_t WS_LOGF = 4 * MiB, WS_FB = 6 * MiB;
constexpr size_t WS_VSTAT = 8 * MiB;
constexpr size_t WS_JLO = 32 * MiB;
constexpr size_t WS_WT = 40 * MiB;
constexpr size_t WT_WIN = 0, WT_WOUT = WT_WIN + (size_t)2 * GN * D, WT_W1 = WT_WOUT + (size_t)2 * D * GH, WT_W2 = WT_W1 + (size_t)4 * FF * D,
                 WT_WKV = WT_W2 + (size_t)4 * D * FF, WT_WQ = WT_WKV + (size_t)2 * D * D, WT_WO = WT_WQ + (size_t)2 * D * D, WT_END = WT_WO + (size_t)2 * D * D;
static_assert(WT_END * 2 == 448 * MiB, "weights");
constexpr size_t WS_H = 488 * MiB;
constexpr size_t WS_Z = 616 * MiB;
constexpr size_t WS_U = WS_Z, WS_V = WS_Z + 384 * MiB;
constexpr size_t WS_HID = WS_Z;
constexpr size_t WS_Q = WS_Z, WS_O = WS_Z + 128 * MiB, WS_HKV = WS_Z + 256 * MiB, WS_KB = WS_Z + 512 * MiB, WS_VB = WS_Z + 640 * MiB;
constexpr size_t WS_DELTA = WS_Z + 768 * MiB;
constexpr size_t WS_END = WS_Z + 896 * MiB;
constexpr int CW_BAR = 4096;
constexpr int CW_QUEUE = 65536;
static_assert(CW_BAR + 9 * 3456 <= CW_QUEUE && (CW_QUEUE + 4 * 512) * 4 <= 512 * 1024, "control words: barrier regions, queue heads and the zero page (at 512 KiB) must not overlap");
constexpr int RING_BYTES = 131072, LDS_BYTES = 163840, LDSCTL_OFF = LDS_BYTES - 512, MISC_OFF = LDSCTL_OFF + 320;

#define GAS __attribute__((address_space(1)))
#define LAS __attribute__((address_space(3)))
typedef unsigned short bf16;
typedef unsigned v4u __attribute__((ext_vector_type(4)));
typedef unsigned v2u __attribute__((ext_vector_type(2)));
typedef float f32x4 __attribute__((ext_vector_type(4)));
typedef float f32x2 __attribute__((ext_vector_type(2)));
typedef short bf16x8 __attribute__((ext_vector_type(8)));
typedef short s16x4 __attribute__((ext_vector_type(4)));
typedef float f32x16 __attribute__((ext_vector_type(16)));
typedef GAS unsigned gu32;
#define RLX_AGENT __ATOMIC_RELAXED, __HIP_MEMORY_SCOPE_AGENT
#define LDS_WAIT() asm volatile("s_waitcnt lgkmcnt(0)" ::: "memory")
#define VM_WAIT() asm volatile("s_waitcnt vmcnt(0)" ::: "memory")
#define RAW_BAR() do { asm volatile("s_waitcnt lgkmcnt(0)" ::: "memory"); __builtin_amdgcn_s_barrier(); asm volatile("" ::: "memory"); } while (0)
__device__ __forceinline__ unsigned f2bf(float f) { unsigned u = __builtin_bit_cast(unsigned, f); return (u + 0x7fffu + ((u >> 16) & 1u)) >> 16; }
__device__ __forceinline__ unsigned pk2(float lo, float hi) { unsigned r; asm volatile("v_cvt_pk_bf16_f32 %0, %1, %2" : "=v"(r) : "v"(lo), "v"(hi)); return r; }
__device__ __forceinline__ float bflo(unsigned w) { return __uint_as_float(w << 16); }
__device__ __forceinline__ float bfhi(unsigned w) { return __uint_as_float(w & 0xffff0000u); }

#define XB_TMO      128
#define XB_XCNT(j)  (256  + 64 * (j))
#define XB_XSUB(j)  (1280 + 64 * (j))
#define XB_XGEN(j)  (2304 + 64 * (j))
#define XB_TOP      3328
#define XB_TOPGEN   3392
#define XCD_BAR_WORDS 3456
#define XB_SPIN_CAP (1u << 18)
__device__ __forceinline__ unsigned xb_ld(unsigned* p)              { return __hip_atomic_load(p, __ATOMIC_RELAXED, __HIP_MEMORY_SCOPE_AGENT); }
__device__ __forceinline__ unsigned xb_add(unsigned* p, unsigned v) { return __hip_atomic_fetch_add(p, v, __ATOMIC_RELAXED, __HIP_MEMORY_SCOPE_AGENT); }
__device__ __forceinline__ unsigned xb_xcc_id() { return (unsigned)__builtin_amdgcn_s_getreg((3 << 11) | 20) & 0xFu; }
#define XB_SPIN(cond, bar) do { unsigned _sp = 0; while (cond) { __builtin_amdgcn_s_sleep(1); \
    if ((++_sp & 255u) == 0u) { if (xb_ld(&(bar)[XB_TMO])) break; if (_sp > XB_SPIN_CAP) { atomicAdd(&(bar)[XB_TMO], 1u); break; } } } } while (0)
struct XcdBarrier { unsigned* bar; unsigned x; volatile LAS unsigned* st; unsigned gsize; };
__device__ __forceinline__ XcdBarrier xcd_barrier_post(unsigned* bar, volatile LAS unsigned* st, unsigned gsize) {
    XcdBarrier b; b.bar = bar; b.x = xb_xcc_id(); b.st = st; b.gsize = gsize;
    if (threadIdx.x == 0) (void)xb_add(&bar[XB_XCNT(b.x)], 1u);
    return b;
}
__device__ __forceinline__ void xcd_barrier_complete(unsigned* bar, unsigned x, unsigned G, unsigned& nloc, unsigned& nx) {
    unsigned sum, cnt, mine, sp = 0u;
    for (;;) {
        sum = 0u; cnt = 0u; mine = 0u;
#pragma unroll
        for (unsigned j = 0; j < 16; ++j) { const unsigned c = xb_ld(&bar[XB_XCNT(j)]); sum += c; cnt += (c > 0u) ? 1u : 0u; }
        mine = xb_ld(&bar[XB_XCNT(x)]);
        if (sum == G) break;
        __builtin_amdgcn_s_sleep(1);
        if ((++sp & 255u) == 0u) { if (xb_ld(&bar[XB_TMO])) break; if (sp > XB_SPIN_CAP) { atomicAdd(&bar[XB_TMO], 1u); break; } }
    }
    nloc = mine > 0u ? mine : 1u; nx = cnt > 0u ? cnt : 1u;
}
__device__ __forceinline__ void xcd_barrier(const XcdBarrier& b) {
    asm volatile("s_waitcnt vmcnt(0)" ::: "memory");
    __syncthreads();
    if (threadIdx.x == 0) {
        unsigned* bar = b.bar;
        __builtin_amdgcn_s_waitcnt(0);
        unsigned nloc = b.st[0], nx = b.st[1];
        if (nloc == 0u) { xcd_barrier_complete(bar, b.x, b.gsize, nloc, nx); b.st[0] = nloc; b.st[1] = nx; }
        const unsigned old = xb_add(&bar[XB_XSUB(b.x)], 1u);
        const unsigned gen = old / nloc;
        if (old + 1u == (gen + 1u) * nloc) {
            __builtin_amdgcn_fence(__ATOMIC_RELEASE, "agent");
            asm volatile("s_waitcnt vmcnt(0)" ::: "memory");
            const unsigned og = xb_add(&bar[XB_TOP], 1u);
            const unsigned tg = og / nx;
            if (og + 1u == (tg + 1u) * nx) xb_add(&bar[XB_TOPGEN], 1u);
            else XB_SPIN(xb_ld(&bar[XB_TOPGEN]) == tg, bar);
            __builtin_amdgcn_fence(__ATOMIC_ACQUIRE, "agent");
            xb_add(&bar[XB_XGEN(b.x)], 1u);
            asm volatile("s_waitcnt vmcnt(0)" ::: "memory");
        } else {
            XB_SPIN(xb_ld(&bar[XB_XGEN(b.x)]) == gen, bar);
            __builtin_amdgcn_fence(__ATOMIC_ACQUIRE, "agent");
            asm volatile("s_waitcnt vmcnt(0)" ::: "memory");
        }
    }
    __syncthreads();
}

struct Frame {
    LAS unsigned char* lds;
    int vcu, G;
};
constexpr int PT_OUT = 23, PT_WS = 24;
template <class T> __device__ __forceinline__ T* ldptr(const Frame& F, int i) {
    const unsigned long long v = ((const LAS unsigned long long*)(F.lds + LDSCTL_OFF))[i];
    const unsigned lo = __builtin_amdgcn_readfirstlane((unsigned)v), hi = __builtin_amdgcn_readfirstlane((unsigned)(v >> 32));
    return (T*)(GAS T*)(((unsigned long long)hi << 32) | lo);
}
#define INP(i) ldptr<const float>(F, (i))
#define WSP() ldptr<unsigned char>(F, PT_WS)
#define PHASE_IDS int tid_ = threadIdx.x; asm volatile("" : "+v"(tid_)); const int tid = tid_, lane = tid & 63, wave = __builtin_amdgcn_readfirstlane(tid >> 6); (void)lane; (void)wave;
__device__ __forceinline__ float wave_sum(float v) {
    v += lane_xor<1>(v); v += lane_xor<2>(v); v += lane_xor<4>(v); v += lane_xor<8>(v); v += lane_xor<16>(v);
    return lane_sum_halves(v);
}
__device__ __forceinline__ void p0_transpose_item(const GAS float* W, int K, int N, bf16* WT, LAS float* scr, int item, int lane) {
    const int nblk = N / 32, kb = item / nblk, nb = item % nblk, k0 = 64 * kb, n0 = 32 * nb;
#pragma unroll 8
    for (int i = 0; i < 32; ++i) { const int kk = 2 * i + (lane >> 5); scr[kk * 33 + (lane & 31)] = W[(size_t)(k0 + kk) * N + n0 + (lane & 31)]; }
    LDS_WAIT(); asm volatile("" ::: "memory");
    const int c = lane & 7;
#pragma unroll
    for (int j = 0; j < 4; ++j) { const int n = (lane >> 3) + 8 * j; const LAS float* s = scr + (8 * c) * 33 + n;
        v4u o; o.x = pk2(s[0 * 33], s[1 * 33]); o.y = pk2(s[2 * 33], s[3 * 33]); o.z = pk2(s[4 * 33], s[5 * 33]); o.w = pk2(s[6 * 33], s[7 * 33]);
        if (PG8_BT) *(GAS v4u*)(WT + ((size_t)((n0 + n) >> 7) * (K >> 7) + ((k0 + 8 * c) >> 7)) * 16384 + (size_t)((n0 + n) & 127) * 128 + ((k0 + 8 * c) & 127)) = o;
        else *(GAS v4u*)(WT + (size_t)(n0 + n) * K + k0 + 8 * c) = o; }
    LDS_WAIT(); asm volatile("" ::: "memory");
}

struct Args { const float* in[23]; float* out; unsigned char* ws; int ph_lo, ph_hi, li, pad; unsigned nbytes[24]; };
enum { I_X = 0, I_C, I_ADAW, I_ADAB, I_NORMG, I_W1, I_W2, I_WIN, I_LNG, I_LNB, I_WS, I_BS, I_WOUT, I_KVNG, I_KVADAW, I_KVADAB, I_WKV, I_KNG, I_WF, I_BF, I_WQ, I_QNG, I_WO };

__device__ __forceinline__ void p0_prologue(Frame& F, int parts = 3) {
    PHASE_IDS
    unsigned char* const wsp = WSP();
    bf16* WT = (bf16*)(wsp + WS_WT);
    const int NSTRIP = DEPTH * (NMOD / 256) + (2 * D) / 256;
    if (parts & 1) for (int it = blockIdx.x; it < NSTRIP; it += F.G) {
        LAS float* SC = (LAS float*)F.lds;
        LAS float* RED = (LAS float*)(F.lds + 65536);
        const float* c = INP(I_C);
        for (int i = tid; i < BATCH * D; i += NWAVES * 64) { const int b = i / D, k = i % D; const float x = c[i]; SC[k * 8 + b] = x / (1.f + __expf(-x)); }
        __syncthreads();
        const float* W; const float* bias; float* out; int N, n0;
        if (it < DEPTH * (NMOD / 256)) { const int l = it / (NMOD / 256), s = it % (NMOD / 256); W = INP(I_ADAW) + (size_t)l * D * NMOD; N = NMOD; n0 = s * 256; bias = INP(I_ADAB) + l * NMOD; out = (float*)(wsp + WS_MOD) + (size_t)l * BATCH * NMOD; }
        else { const int s = it - DEPTH * (NMOD / 256); W = INP(I_KVADAW); N = 2 * D; n0 = s * 256; bias = INP(I_KVADAB); out = (float*)(wsp + WS_KVMOD); }
        f32x4 acc[8];
#pragma unroll
        for (int b = 0; b < 8; ++b) acc[b] = (f32x4){0.f, 0.f, 0.f, 0.f};
        const float* wp = W + (size_t)(wave * 256) * N + n0 + 4 * lane;
#pragma unroll 8
        for (int k = 0; k < 256; ++k) { const f32x4 wv = *(const f32x4*)(wp + (size_t)k * N);
            const f32x4 s0 = *(const LAS f32x4*)(SC + (wave * 256 + k) * 8), s1 = *(const LAS f32x4*)(SC + (wave * 256 + k) * 8 + 4);
            acc[0] += s0.x * wv; acc[1] += s0.y * wv; acc[2] += s0.z * wv; acc[3] += s0.w * wv; acc[4] += s1.x * wv; acc[5] += s1.y * wv; acc[6] += s1.z * wv; acc[7] += s1.w * wv; }
#pragma unroll
        for (int b = 0; b < 8; ++b) *(LAS f32x4*)(RED + (wave * 8 + b) * 256 + 4 * lane) = acc[b];
        __syncthreads();
#pragma unroll
        for (int i = 0; i < 4; ++i) { const int idx = tid + 512 * i, b = idx >> 8, col = idx & 255; float s = bias[n0 + col];
#pragma unroll
            for (int w = 0; w < 8; ++w) s += RED[(w * 8 + b) * 256 + col];
            out[(size_t)b * N + n0 + col] = s; }
        __syncthreads();
    }
    if (!(parts & 2)) return;
    { float* WSF = (float*)(wsp + WS_WSM); const float* ws_in = INP(I_WS);
      for (int i = blockIdx.x * 512 + tid; i < NA * NG * GB * GB; i += F.G * 512) { const int col = i & 127, row = (i >> 7) & 127; WSF[i] = ((col >> 6) <= (row >> 6)) ? ws_in[i] : 0.f; } }
    LAS float* scr = (LAS float*)(F.lds + wave * 16384);
    const int gw = F.vcu * NWAVES + wave, NGW = F.G * NWAVES;
    constexpr int UNIT = 2048;
    const int NGV = NSTRIP < F.G ? NSTRIP : F.G, nfree = (F.G - NGV) * NWAVES, R1 = (nfree > 0 && F.G == 256) ? 53 : 1 << 30;
    const int fidx = ((int)blockIdx.x - NGV) * NWAVES + wave;
    for (int i = 0;; ++i) {
        int it;
        if (i < R1) { it = gw + NGW * i; if (it >= 56 * UNIT) break; }
        else { if (fidx < 0) break; it = R1 * NGW + fidx + nfree * (i - R1); if (it >= 56 * UNIT) break; }
        const int u = it / UNIT, r = it % UNIT;
        if (u < 12)      { const int l = u / 6, s = u % 6;            p0_transpose_item((const GAS float*)INP(I_WIN) + (size_t)l * D * GN, D, GN, WT + WT_WIN + (size_t)l * GN * D, scr, s * UNIT + r, lane); }
        else if (u < 18) { const int l = (u - 12) / 3, s = (u - 12) % 3; p0_transpose_item((const GAS float*)INP(I_WOUT) + (size_t)l * GH * D, GH, D, WT + WT_WOUT + (size_t)l * D * GH, scr, s * UNIT + r, lane); }
        else if (u < 34) { const int l = (u - 18) / 4, s = (u - 18) % 4; p0_transpose_item((const GAS float*)INP(I_W1) + (size_t)l * D * FF, D, FF, WT + WT_W1 + (size_t)l * FF * D, scr, s * UNIT + r, lane); }
        else if (u < 50) { const int l = (u - 34) / 4, s = (u - 34) % 4; p0_transpose_item((const GAS float*)INP(I_W2) + (size_t)l * FF * D, FF, D, WT + WT_W2 + (size_t)l * D * FF, scr, s * UNIT + r, lane); }
        else if (u < 52) { const int s = u - 50;                      p0_transpose_item((const GAS float*)INP(I_WKV), D, 2 * D, WT + WT_WKV, scr, s * UNIT + r, lane); }
        else if (u < 54) { const int l = u - 52;                      p0_transpose_item((const GAS float*)INP(I_WQ) + (size_t)l * D * D, D, D, WT + WT_WQ + (size_t)l * D * D, scr, r, lane); }
        else             { const int l = u - 54;                      p0_transpose_item((const GAS float*)INP(I_WO) + (size_t)l * D * D, D, D, WT + WT_WO + (size_t)l * D * D, scr, r, lane); }
    }
}

constexpr int XP = 2 * D;
template <bool KV, bool XBI>
__device__ __forceinline__ void norm_phase(Frame& F, const float* xin, const bf16* delta, const bf16* delta2, bf16* xout, const float* g, const float* shift, const float* scale, int modstride, bf16* Hout,
                                           const float* kvg, const float* kvmod, bf16* HKV, const float* w_f, const float* b_f, float* LOGF) {
    PHASE_IDS
    const int gw = F.vcu * NWAVES + wave, NGW = F.G * NWAVES;
    LAS float* WFT = (LAS float*)F.lds;
    if (KV) { for (int i = tid; i < NH * D; i += NWAVES * 64) { const int h = i / D, col = i % D; WFT[i] = w_f[col * NH + h]; } __syncthreads(); }
    for (int it = gw; it < M / 16; it += NGW) {
        const int row0 = it * 16, b = row0 / SEQ;
        f32x4 gs[8], sh[8];
        if (!KV) {
#pragma unroll
        for (int j = 0; j < 8; ++j) { const int c = 4 * lane + 256 * j; const f32x4 gv = *(const f32x4*)(g + c), sc = *(const f32x4*)(scale + (size_t)b * modstride + c);
            gs[j] = gv * (1.f + sc); sh[j] = *(const f32x4*)(shift + (size_t)b * modstride + c);
        } }
#ifdef NT_THIN
#define NP_LD(p) __builtin_nontemporal_load(p)
#else
#define NP_LD(p) (*(p))
#endif
        f32x4 vn[8]; v2u xn[8], dn[8], dn2[8];
#define NP_LOAD(row_) do { if (XBI) { const GAS v2u* xr_ = (const GAS v2u*)((const bf16*)xin + (size_t)(row_) * XP) + lane; _Pragma("unroll") for (int j = 0; j < 8; ++j) xn[j] = NP_LD(xr_ + 64 * j); } \
            else { const GAS f32x4* xr_ = (const GAS f32x4*)(xin + (size_t)(row_) * D) + lane; _Pragma("unroll") for (int j = 0; j < 8; ++j) vn[j] = NP_LD(xr_ + 64 * j); } \
            if (delta) { const GAS v2u* dr_ = (const GAS v2u*)(delta + (size_t)(row_) * D) + lane; _Pragma("unroll") for (int j = 0; j < 8; ++j) dn[j] = NP_LD(dr_ + 64 * j); } \
            if (delta2) { const GAS v2u* dr_ = (const GAS v2u*)(delta2 + (size_t)(row_) * D) + lane; _Pragma("unroll") for (int j = 0; j < 8; ++j) dn2[j] = NP_LD(dr_ + 64 * j); } } while (0)
        NP_LOAD(row0);
#pragma unroll 2
        for (int r = 0; r < 16; ++r) { const int row = row0 + r;
            f32x4 v[8]; float s = 0.f;
#pragma unroll
            for (int j = 0; j < 8; ++j) { v[j] = XBI ? (f32x4){bflo(xn[j].x), bfhi(xn[j].x), bflo(xn[j].y), bfhi(xn[j].y)} : vn[j];
                if (delta) v[j] += (f32x4){bflo(dn[j].x), bfhi(dn[j].x), bflo(dn[j].y), bfhi(dn[j].y)};
                if (delta2) v[j] += (f32x4){bflo(dn2[j].x), bfhi(dn2[j].x), bflo(dn2[j].y), bfhi(dn2[j].y)}; }
            if (r + 1 < 16) NP_LOAD(row + 1);
            __builtin_amdgcn_sched_barrier(0);
            if (xout) { GAS v2u* xo = (GAS v2u*)(xout + (size_t)row * XP) + lane;
#pragma unroll
                for (int j = 0; j < 8; ++j) xo[64 * j] = (v2u){pk2(v[j].x, v[j].y), pk2(v[j].z, v[j].w)}; }
#pragma unroll
            for (int j = 0; j < 8; ++j) s += (v[j].x * v[j].x + v[j].y * v[j].y) + (v[j].z * v[j].z + v[j].w * v[j].w);
            const float rstd = 1.f / sqrtf(wave_sum(s) * (1.f / D) + EPS);
            GAS v2u* o8 = (GAS v2u*)(Hout + (size_t)row * D) + lane;
#pragma unroll
            for (int j = 0; j < 8; ++j) { f32x4 gsj, shj;
                if (KV) { const int c = 4 * lane + 256 * j; gsj = *(const f32x4*)(g + c) * (1.f + *(const f32x4*)(scale + (size_t)b * modstride + c)); shj = *(const f32x4*)(shift + (size_t)b * modstride + c); }
                else { gsj = gs[j]; shj = sh[j]; }
                const f32x4 y = (v[j] * rstd) * gsj + shj; o8[64 * j] = (v2u){pk2(y.x, y.y), pk2(y.z, y.w)}; }
            if (KV) {
                GAS v2u* k8 = (GAS v2u*)(HKV + (size_t)row * D) + lane; f32x4 y[8];
#pragma unroll
                for (int j = 0; j < 8; ++j) { const int c = 4 * lane + 256 * j; const f32x4 g2 = *(const f32x4*)(kvg + c), s2 = *(const f32x4*)(kvmod + (size_t)b * 2 * D + D + c), h2 = *(const f32x4*)(kvmod + (size_t)b * 2 * D + c);
                    y[j] = (v[j] * rstd) * (g2 * (1.f + s2)) + h2; k8[64 * j] = (v2u){pk2(y[j].x, y[j].y), pk2(y[j].z, y[j].w)}; }
                float mine = 0.f;
#pragma unroll 1
                for (int h = 0; h < 16; ++h) { float z = 0.f;
#pragma unroll
                    for (int j = 0; j < 8; ++j) { const f32x4 w = *(const LAS f32x4*)(WFT + h * D + 4 * lane + 256 * j); z += (y[j].x * w.x + y[j].y * w.y) + (y[j].z * w.z + y[j].w * w.w); }
                    const float t = wave_sum(z); if (lane == h) mine = t; }
                if (lane < 16) { const float zz = mine + b_f[lane]; const float ls = fminf(zz, 0.f) - log1pf(__expf(-fabsf(zz)));
                    LOGF[((size_t)b * NH + lane) * SEQ + (row - b * SEQ)] = ls; }
            }
        }
    }
#undef NP_LOAD
#undef NP_LD
    if (KV) __syncthreads();
}
__device__ __forceinline__ void resid_final(Frame& F, const bf16* xb, float* xo_, const bf16* delta) {
    PHASE_IDS
    const int gw = F.vcu * NWAVES + wave, NGW = F.G * NWAVES;
    for (int rr = 0; rr < M / NGW; ++rr) { const int row = gw * (M / NGW) + rr;
        const GAS v2u* xr = (const GAS v2u*)(xb + (size_t)row * XP) + lane; GAS f32x4* xw = (GAS f32x4*)(xo_ + (size_t)row * D) + lane; const GAS v2u* dr = (const GAS v2u*)(delta + (size_t)row * D) + lane;
        v2u v[8], d[8];
#pragma unroll
        for (int j = 0; j < 8; ++j) { v[j] = xr[64 * j]; d[j] = dr[64 * j]; }
        asm volatile("s_waitcnt vmcnt(0)" ::: "memory");
#pragma unroll
        for (int j = 0; j < 8; ++j) xw[64 * j] = (f32x4){bflo(v[j].x), bfhi(v[j].x), bflo(v[j].y), bfhi(v[j].y)} + (f32x4){bflo(d[j].x), bfhi(d[j].x), bflo(d[j].y), bfhi(d[j].y)}; }
}
__device__ __forceinline__ void headnorm_rows(Frame& F, bf16* T, bf16* Tout, const float* gain) {
    PHASE_IDS
    const int gw = F.vcu * NWAVES + wave, NGW = F.G * NWAVES;
    const int d0 = (8 * lane) & 127; const f32x4 g0 = *(const f32x4*)(gain + d0), g1 = *(const f32x4*)(gain + d0 + 4);
    for (int it = gw; it < M / 16; it += NGW) {
        for (int r = 0; r < 16; ++r) { GAS v4u* p = (GAS v4u*)(T + (size_t)(it * 16 + r) * D) + lane; GAS v4u* po = (GAS v4u*)(Tout + (size_t)(it * 16 + r) * D) + lane;
            v4u w[4];
#pragma unroll
            for (int j = 0; j < 4; ++j) w[j] = p[64 * j];
#pragma unroll
            for (int j = 0; j < 4; ++j) { float x[8] = {bflo(w[j].x), bfhi(w[j].x), bflo(w[j].y), bfhi(w[j].y), bflo(w[j].z), bfhi(w[j].z), bflo(w[j].w), bfhi(w[j].w)};
                float s = 0.f;
#pragma unroll
                for (int e = 0; e < 8; ++e) s += x[e] * x[e];
                s += lane_xor<1>(s); s += lane_xor<2>(s); s += lane_xor<4>(s); s += lane_xor<8>(s);
                const float rstd = 1.f / sqrtf(s * (1.f / HD) + EPS);
                v4u o; o.x = pk2(x[0] * rstd * g0.x, x[1] * rstd * g0.y); o.y = pk2(x[2] * rstd * g0.z, x[3] * rstd * g0.w); o.z = pk2(x[4] * rstd * g1.x, x[5] * rstd * g1.y); o.w = pk2(x[6] * rstd * g1.z, x[7] * rstd * g1.w);
                po[64 * j] = o; } }
    }
}
__device__ __forceinline__ void cumsum_phase(Frame& F, const float* LOGF, float* FB, const float* qgain  , const float* kgain  , int* JLO) {
    PHASE_IDS
    const int grp = blockIdx.x & 7, lw = (int)(blockIdx.x >> 3) * NWAVES + wave;
    for (int bh = grp * NH + lw; lw < NH && bh < (grp + 1) * NH; bh += BATCH * NH) {
        const f32x4* src = (const f32x4*)(LOGF + (size_t)bh * SEQ + 64 * lane); f32x4 v[16]; float run = 0.f;
#pragma unroll
        for (int i = 0; i < 16; ++i) { v[i] = src[i]; run += v[i].x; v[i].x = run; run += v[i].y; v[i].y = run; run += v[i].z; v[i].z = run; run += v[i].w; v[i].w = run; }
        float incl = run;
#define CS_DPP(x, ctrl, rmask, bc) __uint_as_float((unsigned)__builtin_amdgcn_update_dpp(0, (int)__float_as_uint(x), ctrl, rmask, 0xF, bc))
        incl += CS_DPP(incl, 0x111, 0xF, true); incl += CS_DPP(incl, 0x112, 0xF, true); incl += CS_DPP(incl, 0x114, 0xF, true); incl += CS_DPP(incl, 0x118, 0xF, true);
        incl += CS_DPP(incl, 0x142, 0xA, false); incl += CS_DPP(incl, 0x143, 0xC, false);
#undef CS_DPP
        const float off = incl - run;
        f32x4* dst = (f32x4*)(FB + (size_t)bh * SEQ + 64 * lane);
#pragma unroll
        for (int i = 0; i < 16; ++i) dst[i] = v[i] + off;
        float gq = fmaxf(fmaxf(fabsf(qgain[lane]), fabsf(qgain[64 + lane])), fmaxf(fabsf(qgain[128 + lane]), fabsf(qgain[192 + lane]))), gk = fmaxf(fabsf(kgain[lane]), fabsf(kgain[64 + lane]));
        { gq = fmaxf(gq, lane_xor<1>(gq)); gq = fmaxf(gq, lane_xor<2>(gq)); gq = fmaxf(gq, lane_xor<4>(gq)); gq = fmaxf(gq, lane_xor<8>(gq)); gq = fmaxf(gq, lane_xor<16>(gq)); gq = lane_max_halves(gq);
          gk = fmaxf(gk, lane_xor<1>(gk)); gk = fmaxf(gk, lane_xor<2>(gk)); gk = fmaxf(gk, lane_xor<4>(gk)); gk = fmaxf(gk, lane_xor<8>(gk)); gk = fmaxf(gk, lane_xor<16>(gk)); gk = lane_max_halves(gk); }
        const float BL = (float)HD * gq * gk * 1.02f * 0.08838834764831845f, thr = 2.f * BL + 25.f;
        const float fend = v[15].w + off, ffirst = v[0].x + off; int myj = 0;
#pragma unroll
        for (int qb = 0; qb < SEQ / 256; ++qb) { const float fp0 = __uint_as_float((unsigned)__builtin_amdgcn_readlane((int)__float_as_uint(ffirst), 4 * qb)); const bool skip = (lane < 4 * qb) && (fend - fp0 >= thr);
            const int cnt = __popcll(__ballot(skip)); if (lane == qb) myj = cnt; }
#ifdef NO_STATIC_SKIP
        myj = 0;
#endif
        if (lane < SEQ / 256) JLO[bh * (SEQ / 256) + lane] = myj;
        if (lane == 0) ((float*)JLO)[BATCH * NH * (SEQ / 256) + grp] = BL * 1.4426950408889634f + 36.2f;
    }
}

constexpr int SG_NCH = GH / 128;
constexpr int SG_VT = 0, SG_STG = 65536, SG_STG_ROW = 144, SG_STG_WAVE = 32 * SG_STG_ROW, SG_MEAN = SG_STG + 8 * SG_STG_WAVE  , SG_RSTD = SG_MEAN + 512, SG_RED = SG_RSTD + 512, SG_MT = SG_RED + 4096  , SG_END = SG_MT + 8 * 384;
__device__ __forceinline__ void sg_phase(Frame& F, int layer, bf16* U, const bf16* V, const f32x2* vstat, const float* ln_g, const float* ln_b, const float* WSF, const float* bs, bool do_store) {
    PHASE_IDS
    const int wid = wave, r32 = lane & 31, hi = lane >> 5, wq = wid & 3, ch = wid >> 2;
    LAS unsigned char* lds = F.lds;
    LAS float* MEAN = (LAS float*)(lds + SG_MEAN); LAS float* RSTD = (LAS float*)(lds + SG_RSTD); LAS f32x2* RED = (LAS f32x2*)(lds + SG_RED);
    LAS float* MT = (LAS float*)(lds + SG_MT + wid * 384);
    const unsigned vbase = (unsigned)(uintptr_t)(lds + SG_VT) + (unsigned)att::v_rd_base(lane);
    LAS unsigned char* stg = lds + SG_STG + wid * SG_STG_WAVE;
    { const int nb = F.vcu;
        const int r0 = nb * GB;
        { const int row = tid & 127, part = tid >> 7; float s = 0.f, ss = 0.f; const f32x2* vp = vstat + (size_t)(part * 24) * M + r0 + row;
#pragma unroll 1
          for (int q0 = 0; q0 < 24; q0 += 8) { f32x2 p[8];
#pragma unroll
            for (int q = 0; q < 8; ++q) p[q] = vp[(size_t)(q0 + q) * M];
#pragma unroll
            for (int q = 0; q < 8; ++q) { s += p[q].x; ss += p[q].y; } }
          RED[part * 128 + row] = (f32x2){s, ss}; }
        __syncthreads();
        if (tid < 128) { const f32x2 a = RED[tid], b = RED[128 + tid], c = RED[256 + tid], d = RED[384 + tid];
            const float mean = ((a.x + b.x) + (c.x + d.x)) * (1.f / GH); const float var = ((a.y + b.y) + (c.y + d.y)) * (1.f / GH) - mean * mean;
            MEAN[tid] = mean; RSTD[tid] = 1.f / sqrtf(fmaxf(var, 0.f) + EPS); }
        __syncthreads();
        const unsigned char* Vt = (const unsigned char*)V + (size_t)nb * SG_NCH * 32768;
        unsigned char* Ut = (unsigned char*)U + (size_t)nb * SG_NCH * 32768 + (size_t)(32 * wq) * 256 + (size_t)(64 * ch) * 2;
        v4u vr[4], ur[2][4]; float lg[2][2], lb[2][2];
#define SG_VLOAD(t) do { _Pragma("unroll") for (int q = 0; q < 4; ++q) vr[q] = *(const GAS v4u*)(Vt + (size_t)(t) * 32768 + (size_t)(tid + 512 * q) * 16); } while (0)
#define SG_VWRITE(buf) do { _Pragma("unroll") for (int q = 0; q < 4; ++q) *(LAS v4u*)(lds + SG_VT + (buf) * 32768 + (tid + 512 * q) * 16) = vr[q]; } while (0)
#define SG_ULOAD(t, slot) do { _Pragma("unroll") for (int q = 0; q < 4; ++q) { const int p = lane + 64 * q; ur[slot][q] = *(const GAS v4u*)(Ut + (size_t)(t) * 32768 + (p >> 3) * 256 + (p & 7) * 16); } } while (0)
#define SG_GBLOAD(t, slot) do { _Pragma("unroll") for (int dd = 0; dd < 2; ++dd) { const int c = (t) * 128 + 64 * ch + 32 * dd + r32; lg[slot][dd] = ln_g[c]; lb[slot][dd] = ln_b[c]; } } while (0)
        SG_VLOAD(0); SG_ULOAD(0, 0); SG_GBLOAD(0, 0);
        SG_VWRITE(0);
        RAW_BAR();
#pragma unroll 1
        for (int g = 0; g < NG; ++g) {
            bf16x8 wf[2][4];
            { const float* wp = WSF + ((size_t)(layer * NG + g) * GB + 32 * wq + r32) * GB + 8 * hi; float msum = 0.f, ssum = 0.f;
#pragma unroll
              for (int jt = 0; jt < 2; ++jt)
#pragma unroll
                for (int ks = 0; ks < 4; ++ks) { const int j0 = 64 * jt + 16 * ks + 8 * hi; v4u w = {0u, 0u, 0u, 0u};
                    if (jt == 0 || wq >= 2) { const f32x4 w0 = *(const f32x4*)(wp + 64 * jt + 16 * ks), w1 = *(const f32x4*)(wp + 64 * jt + 16 * ks + 4);
                        const f32x4 r0v = *(const LAS f32x4*)(RSTD + j0), r1v = *(const LAS f32x4*)(RSTD + j0 + 4), m0v = *(const LAS f32x4*)(MEAN + j0), m1v = *(const LAS f32x4*)(MEAN + j0 + 4);
                        w.x = pk2(w0.x * r0v.x, w0.y * r0v.y); w.y = pk2(w0.z * r0v.z, w0.w * r0v.w); w.z = pk2(w1.x * r1v.x, w1.y * r1v.y); w.w = pk2(w1.z * r1v.z, w1.w * r1v.w);
                        msum += (bflo(w.x) * m0v.x + bfhi(w.x) * m0v.y) + (bflo(w.y) * m0v.z + bfhi(w.y) * m0v.w) + (bflo(w.z) * m1v.x + bfhi(w.z) * m1v.y) + (bflo(w.w) * m1v.z + bfhi(w.w) * m1v.w);
                        ssum += ((w0.x + w0.y) + (w0.z + w0.w)) + ((w1.x + w1.y) + (w1.z + w1.w)); }
                    wf[jt][ks] = __builtin_bit_cast(bf16x8, w); }
              msum = lane_sum_halves(msum); ssum = lane_sum_halves(ssum);
              if (hi == 0) { MT[r32] = -msum; MT[32 + r32] = ssum; MT[64 + r32] = bs[(size_t)(layer * NG + g) * GB + 32 * wq + r32]; }
              LDS_WAIT(); }
#define SG_TRRD(dst, off) asm volatile("ds_read_b64_tr_b16 %0, %1 offset:%2" : "=&v"(dst) : "v"(va), "i"(off) : "memory")
#define SG_PV(dd, jt, buf) do { const unsigned va = vbase + (unsigned)(((buf) * 2 + (jt)) * 16384 + (2 * ch + (dd)) * 512); s16x4 l0, l1, l2, l3, h0, h1, h2, h3; \
            SG_TRRD(l0, 0); SG_TRRD(h0, 2048); SG_TRRD(l1, 4096); SG_TRRD(h1, 6144); SG_TRRD(l2, 8192); SG_TRRD(h2, 10240); SG_TRRD(l3, 12288); SG_TRRD(h3, 14336); \
            asm volatile("s_waitcnt lgkmcnt(0)" ::: "memory"); __builtin_amdgcn_sched_barrier(0); \
            o[dd] = __builtin_amdgcn_mfma_f32_32x32x16_bf16(wf[jt][0], (bf16x8){l0[0], l0[1], l0[2], l0[3], h0[0], h0[1], h0[2], h0[3]}, o[dd], 0, 0, 0); \
            o[dd] = __builtin_amdgcn_mfma_f32_32x32x16_bf16(wf[jt][1], (bf16x8){l1[0], l1[1], l1[2], l1[3], h1[0], h1[1], h1[2], h1[3]}, o[dd], 0, 0, 0); \
            o[dd] = __builtin_amdgcn_mfma_f32_32x32x16_bf16(wf[jt][2], (bf16x8){l2[0], l2[1], l2[2], l2[3], h2[0], h2[1], h2[2], h2[3]}, o[dd], 0, 0, 0); \
            o[dd] = __builtin_amdgcn_mfma_f32_32x32x16_bf16(wf[jt][3], (bf16x8){l3[0], l3[1], l3[2], l3[3], h3[0], h3[1], h3[2], h3[3]}, o[dd], 0, 0, 0); } while (0)
#define SG_CHUNK(s) do { const int t = 6 * g + 2 * s2 + (s); \
            if (t + 1 < SG_NCH) { SG_VLOAD(t + 1); SG_ULOAD(t + 1, ((s) + 1) & 1); SG_GBLOAD(t + 1, ((s) + 1) & 1); } \
            asm volatile("" ::: "memory"); __builtin_amdgcn_sched_barrier(0); \
            f32x16 o[2] = {}; \
            SG_PV(0, 0, (s) & 1); SG_PV(1, 0, (s) & 1); \
            if (wq >= 2) { SG_PV(0, 1, (s) & 1); SG_PV(1, 1, (s) & 1); } \
            _Pragma("unroll") for (int dd = 0; dd < 2; ++dd) { const float gg = lg[(s) & 1][dd], bb = lb[(s) & 1][dd]; \
                _Pragma("unroll") for (int q = 0; q < 4; ++q) { const f32x4 Aq = *(const LAS f32x4*)(MT + 8 * q + 4 * hi), Bq = *(const LAS f32x4*)(MT + 32 + 8 * q + 4 * hi), Cq = *(const LAS f32x4*)(MT + 64 + 8 * q + 4 * hi); \
                  _Pragma("unroll") for (int e = 0; e < 4; ++e) { const int r = 4 * q + e; const float val = gg * (o[dd][r] + Aq[e]) + (bb * Bq[e] + Cq[e]); \
                    *(LAS unsigned short*)(stg + att::crow(r, hi) * SG_STG_ROW + (dd * 32 + r32) * 2) = (unsigned short)pk2(val, val); } } } \
            LDS_WAIT(); \
            _Pragma("unroll") for (int q = 0; q < 4; ++q) { const int p = lane + 64 * q; const v4u sv = *(const LAS v4u*)(stg + (p >> 3) * SG_STG_ROW + (p & 7) * 16); const v4u uu = ur[(s) & 1][q]; v4u w; \
                const pg8::f32x2 gx = pg8::gelu_pk((pg8::f32x2){bflo(uu.x), bfhi(uu.x)}), gy = pg8::gelu_pk((pg8::f32x2){bflo(uu.y), bfhi(uu.y)}), gz = pg8::gelu_pk((pg8::f32x2){bflo(uu.z), bfhi(uu.z)}), gw = pg8::gelu_pk((pg8::f32x2){bflo(uu.w), bfhi(uu.w)});     \
                w.x = pk2(gx.x * bflo(sv.x), gx.y * bfhi(sv.x)); w.y = pk2(gy.x * bflo(sv.y), gy.y * bfhi(sv.y)); \
                w.z = pk2(gz.x * bflo(sv.z), gz.y * bfhi(sv.z)); w.w = pk2(gw.x * bflo(sv.w), gw.y * bfhi(sv.w)); \
                if (do_store) *(GAS v4u*)(Ut + (size_t)t * 32768 + (p >> 3) * 256 + (p & 7) * 16) = w; } \
            asm volatile("" ::: "memory"); __builtin_amdgcn_sched_barrier(0); \
            if (t + 1 < SG_NCH) SG_VWRITE(((s) + 1) & 1); \
            RAW_BAR(); } while (0)
#pragma unroll 1
            for (int s2 = 0; s2 < 3; ++s2) { SG_CHUNK(0); SG_CHUNK(1); }
        }
#undef SG_VLOAD
#undef SG_VWRITE
#undef SG_ULOAD
#undef SG_GBLOAD
#undef SG_TRRD
#undef SG_PV
#undef SG_CHUNK
        __syncthreads();
    }
}


#ifdef SG_V1
constexpr int SG1_VT = 0, SG1_STG = 65536, SG1_STG_ROW = 144, SG1_STG_WAVE = 32 * SG1_STG_ROW, SG1_TAB = SG1_STG + 8 * SG1_STG_WAVE, SG1_RED = SG1_TAB + 1024;
__device__ __forceinline__ void sg_phase_v1(Frame& F, int layer, bf16* U, const bf16* V, const f32x2* vstat, const float* ln_g, const float* ln_b, const float* WSF, const float* bs) {
    PHASE_IDS
    const int wid = wave, r32 = lane & 31, hi = lane >> 5, wq = wid & 3, ch = wid >> 2;
    LAS unsigned char* lds = F.lds;
    LAS f32x2* TAB = (LAS f32x2*)(lds + SG1_TAB); LAS f32x2* RED = (LAS f32x2*)(lds + SG1_RED);
    const int sr = tid >> 4, sc = (tid & 15) * 8, vst0 = att::v_st(sr, sc), vst1 = att::v_st(32 + sr, sc);
    const unsigned vbase = (unsigned)(uintptr_t)(lds + SG1_VT) + (unsigned)att::v_rd_base(lane);
    LAS unsigned char* stg = lds + SG1_STG + wid * SG1_STG_WAVE;
    for (int nb = blockIdx.x; nb < M / GB; nb += F.G) {
        const int r0 = nb * GB;
        { const int row = tid & 127, part = tid >> 7; float s = 0.f, ss = 0.f;
#pragma unroll 8
          for (int q = 0; q < 24; ++q) { const f32x2 p = vstat[(size_t)(part * 24 + q) * M + r0 + row]; s += p.x; ss += p.y; }
          RED[part * 128 + row] = (f32x2){s, ss}; }
        __syncthreads();
        if (tid < 128) { const f32x2 a = RED[tid], b = RED[128 + tid], c = RED[256 + tid], d = RED[384 + tid];
            const float mean = ((a.x + b.x) + (c.x + d.x)) * (1.f / GH); const float var = ((a.y + b.y) + (c.y + d.y)) * (1.f / GH) - mean * mean;
            TAB[tid] = (f32x2){mean, 1.f / sqrtf(fmaxf(var, 0.f) + EPS)}; }
        __syncthreads();
        f32x2 st[4];
#pragma unroll
        for (int q = 0; q < 4; ++q) st[q] = TAB[(q >> 1) * 64 + (q & 1) * 32 + sr];
        const bf16* Vb = V + (size_t)r0 * GH; bf16* Ub = U + (size_t)r0 * GH;
        v4u vr[4], ur[4];
#define SG1_VLOAD(c0) do { _Pragma("unroll") for (int q = 0; q < 4; ++q) vr[q] = *(const GAS v4u*)(Vb + (size_t)((q >> 1) * 64 + (q & 1) * 32 + sr) * GH + (c0) + sc); } while (0)
#define SG1_VWRITE(c0, buf) do { const f32x4 g0 = *(const f32x4*)(ln_g + (c0) + sc), g1 = *(const f32x4*)(ln_g + (c0) + sc + 4), b0 = *(const f32x4*)(ln_b + (c0) + sc), b1 = *(const f32x4*)(ln_b + (c0) + sc + 4); \
        _Pragma("unroll") for (int q = 0; q < 4; ++q) { const float mu = st[q].x, rs = st[q].y; v4u o; \
            o.x = pk2((bflo(vr[q].x) - mu) * rs * g0.x + b0.x, (bfhi(vr[q].x) - mu) * rs * g0.y + b0.y); o.y = pk2((bflo(vr[q].y) - mu) * rs * g0.z + b0.z, (bfhi(vr[q].y) - mu) * rs * g0.w + b0.w); \
            o.z = pk2((bflo(vr[q].z) - mu) * rs * g1.x + b1.x, (bfhi(vr[q].z) - mu) * rs * g1.y + b1.y); o.w = pk2((bflo(vr[q].w) - mu) * rs * g1.z + b1.z, (bfhi(vr[q].w) - mu) * rs * g1.w + b1.w); \
            *(LAS v4u*)(lds + SG1_VT + ((buf) * 2 + (q >> 1)) * 16384 + ((q & 1) ? vst1 : vst0)) = o; } } while (0)
        SG1_VLOAD(0); SG1_VWRITE(0, 0);
        RAW_BAR();
        bf16x8 wf[2][4]; f32x4 bsv[4];
        for (int t = 0; t < GH / 128; ++t) {
            const int c0 = t * 128, buf = t & 1, g = t / 6;
#pragma unroll
            for (int q = 0; q < 4; ++q) { const int p = lane + 64 * q; ur[q] = *(const GAS v4u*)(Ub + (size_t)(32 * wq + (p >> 3)) * GH + c0 + 64 * ch + 8 * (p & 7)); }
            if (t + 1 < GH / 128) SG1_VLOAD(c0 + 128);
            if (t % 6 == 0) {
                const float* wp = WSF + ((size_t)(layer * NG + g) * GB + 32 * wq + r32) * GB + 8 * hi;
#pragma unroll
                for (int jt = 0; jt < 2; ++jt)
#pragma unroll
                    for (int ks = 0; ks < 4; ++ks) { const f32x4 w0 = *(const f32x4*)(wp + 64 * jt + 16 * ks), w1 = *(const f32x4*)(wp + 64 * jt + 16 * ks + 4); v4u w = {pk2(w0.x, w0.y), pk2(w0.z, w0.w), pk2(w1.x, w1.y), pk2(w1.z, w1.w)}; wf[jt][ks] = __builtin_bit_cast(bf16x8, w); }
                const float* bp = bs + (size_t)(layer * NG + g) * GB + 32 * wq + 4 * hi;
#pragma unroll
                for (int q = 0; q < 4; ++q) bsv[q] = *(const f32x4*)(bp + 8 * q);
            }
            f32x16 o[2] = {};
#define SG1_TRRD(dst, off) asm volatile("ds_read_b64_tr_b16 %0, %1 offset:%2" : "=&v"(dst) : "v"(va), "i"(off) : "memory")
#define SG1_PV(dd, jt) do { const unsigned va = vbase + (unsigned)((buf * 2 + (jt)) * 16384 + (2 * ch + (dd)) * 512); s16x4 l0, l1, l2, l3, h0, h1, h2, h3; \
            SG1_TRRD(l0, 0); SG1_TRRD(h0, 2048); SG1_TRRD(l1, 4096); SG1_TRRD(h1, 6144); SG1_TRRD(l2, 8192); SG1_TRRD(h2, 10240); SG1_TRRD(l3, 12288); SG1_TRRD(h3, 14336); \
            asm volatile("s_waitcnt lgkmcnt(0)" ::: "memory"); __builtin_amdgcn_sched_barrier(0); \
            o[dd] = __builtin_amdgcn_mfma_f32_32x32x16_bf16(wf[jt][0], (bf16x8){l0[0], l0[1], l0[2], l0[3], h0[0], h0[1], h0[2], h0[3]}, o[dd], 0, 0, 0); \
            o[dd] = __builtin_amdgcn_mfma_f32_32x32x16_bf16(wf[jt][1], (bf16x8){l1[0], l1[1], l1[2], l1[3], h1[0], h1[1], h1[2], h1[3]}, o[dd], 0, 0, 0); \
            o[dd] = __builtin_amdgcn_mfma_f32_32x32x16_bf16(wf[jt][2], (bf16x8){l2[0], l2[1], l2[2], l2[3], h2[0], h2[1], h2[2], h2[3]}, o[dd], 0, 0, 0); \
            o[dd] = __builtin_amdgcn_mfma_f32_32x32x16_bf16(wf[jt][3], (bf16x8){l3[0], l3[1], l3[2], l3[3], h3[0], h3[1], h3[2], h3[3]}, o[dd], 0, 0, 0); } while (0)
            SG1_PV(0, 0); SG1_PV(1, 0);
            if (wq >= 2) { SG1_PV(0, 1); SG1_PV(1, 1); }
#pragma unroll
            for (int dd = 0; dd < 2; ++dd)
#pragma unroll
                for (int r = 0; r < 16; ++r) { const float val = o[dd][r] + bsv[r >> 2][r & 3];
                    *(LAS unsigned short*)(stg + att::crow(r, hi) * SG1_STG_ROW + (dd * 32 + r32) * 2) = (unsigned short)f2bf(val); }
            LDS_WAIT();
#pragma unroll
            for (int q = 0; q < 4; ++q) { const int p = lane + 64 * q; const v4u sv = *(const LAS v4u*)(stg + (p >> 3) * SG1_STG_ROW + (p & 7) * 16); const v4u uu = ur[q]; v4u w;
                w.x = pk2(bflo(uu.x) * bflo(sv.x), bfhi(uu.x) * bfhi(sv.x)); w.y = pk2(bflo(uu.y) * bflo(sv.y), bfhi(uu.y) * bfhi(sv.y));
                w.z = pk2(bflo(uu.z) * bflo(sv.z), bfhi(uu.z) * bfhi(sv.z)); w.w = pk2(bflo(uu.w) * bflo(sv.w), bfhi(uu.w) * bfhi(sv.w));
                *(GAS v4u*)(Ub + (size_t)(32 * wq + (p >> 3)) * GH + c0 + 64 * ch + 8 * (p & 7)) = w; }
            if (t + 1 < GH / 128) SG1_VWRITE(c0 + 128, buf ^ 1);
            RAW_BAR();
        }
#undef SG1_VLOAD
#undef SG1_VWRITE
#undef SG1_TRRD
#undef SG1_PV
        __syncthreads();
    }
}


#endif

__device__ __forceinline__ att::BlockRef att_ref(unsigned k, int cls, const bf16* Q, const bf16* K, const bf16* V, bf16* O, const float* FB, const int* JLO) {
#ifndef ATT_QUADS
    const int h = k & 15, qb = 15 - (int)(k >> 4), b = cls, bh = b * NH + h;
#else
    const int r = k & 63, h = r >> 2, qb = 15 - 4 * (int)(k >> 6) - (r & 3), b = (cls - h) & 7, bh = b * NH + h;
#endif
    const size_t base = (size_t)b * SEQ * D + (size_t)h * HD, qoff = base + (size_t)qb * 256 * D;
    const int s0 = (JLO[bh * (SEQ / 256) + qb] >> 1) * 128;
    att::BlockRef rf; rf.Q = Q + qoff; rf.O = O + qoff; rf.K = K + base + (size_t)s0 * D; rf.V = V + base + (size_t)s0 * D; rf.P0 = qb * 256 - s0; rf.F = FB + (size_t)bh * SEQ + s0; return rf;
}
__device__ __forceinline__ void attn_phase(Frame& F, char* lds, const bf16* Q, const bf16* K, const bf16* V, bf16* O, const float* FB, const int* JLO, unsigned* qword) {
    constexpr unsigned NTK = 256;
    const int cls = blockIdx.x & 7; unsigned* qw = qword + 64 * cls;
    volatile LAS unsigned* TK = (volatile LAS unsigned*)(F.lds + att::LDS_BYTES);
    if (threadIdx.x == 0) { const unsigned t0 = __hip_atomic_fetch_add(qw, 1u, __ATOMIC_RELAXED, __HIP_MEMORY_SCOPE_AGENT), t1 = __hip_atomic_fetch_add(qw, 1u, __ATOMIC_RELAXED, __HIP_MEMORY_SCOPE_AGENT); TK[0] = t0; TK[1] = t1; }
    __syncthreads();
    unsigned cur_t = __builtin_amdgcn_readfirstlane(TK[0]), nxt_t = __builtin_amdgcn_readfirstlane(TK[1]);
    __syncthreads();
    if (cur_t >= NTK) return;
    att::BlockRef cur = att_ref(cur_t, cls, Q, K, V, O, FB, JLO);
    const float thr2 = ((const float*)JLO)[BATCH * NH * (SEQ / 256) + cls];
    att::Seam S;
    att::prime(cur, lds, S);
    for (;;) {
        const bool has_next = nxt_t < NTK;
        const att::BlockRef nxt = has_next ? att_ref(nxt_t, cls, Q, K, V, O, FB, JLO) : cur;
        att::block(cur, nxt, lds, S, thr2);
        if (threadIdx.x == 0 && has_next) TK[0] = __hip_atomic_fetch_add(qw, 1u, __ATOMIC_RELAXED, __HIP_MEMORY_SCOPE_AGENT);
        __syncthreads();
        if (!has_next) break;
        cur = nxt; cur_t = nxt_t; nxt_t = __builtin_amdgcn_readfirstlane(TK[0]);
        __syncthreads();
    }
}

#define ZBV(off_mib, per_batch_mib) (WS_Z + (size_t)(blockIdx.x & 7) * (size_t)(96 - (per_batch_mib)) * MiB + (size_t)(off_mib) * MiB)
#define ZB_U ZBV(0, 48)
#define ZB_V ZBV(48, 48)
#define ZB_HID ZBV(0, 64)
#define ZB_Q ZBV(0, 16)
#define ZB_O ZBV(16, 16)
#define ZB_HKV ZBV(32, 16)
#define ZB_KB ZBV(64, 16)
#define ZB_VB ZBV(80, 16)
#define ZB_D1A ZBV(64, 16)

#ifndef DUPMASK
#define DUPMASK 0
#endif
#ifndef EN_MASK
#define EN_MASK 0xFFFF
#endif
#define EN(k) ((EN_MASK >> (k)) & 1)
#ifndef GELU_PROBE
#define GELU_PROBE 0
#endif
#ifndef HID_TILED
#define HID_TILED true
#endif
#ifndef PG8_ALIGN_SET
#define PG8_ALIGN_SET true
#endif
#ifndef PG8_SP2_SET
#define PG8_SP2_SET true
#endif
#ifndef WGM_G1
#define WGM_G1 4
#endif
#ifndef WGM_QKV
#define WGM_QKV 4
#endif
#ifndef WGM_M1
#define WGM_M1 4
#endif
#ifndef WGM_RES
#define WGM_RES 4
#endif
#define NREP(c) (((DUPMASK >> (c)) & 1) ? 2 : 1)
__global__ void __launch_bounds__(NWAVES * 64, 2) yoco_fwd(Args args) {
    extern __shared__ __attribute__((aligned(16))) unsigned char lds[];
    Frame F;
    F.lds = (LAS unsigned char*)lds;
    F.G = gridDim.x; { const int bx = blockIdx.x; F.vcu = (F.G % 8 == 0) ? (bx % 8) * (F.G / 8) + bx / 8 : bx; }
    volatile LAS unsigned* MISC = (volatile LAS unsigned*)(F.lds + MISC_OFF);
    for (int u = threadIdx.x; u < (LDS_BYTES - LDSCTL_OFF) / 4; u += NWAVES * 64) ((LAS unsigned*)(F.lds + LDSCTL_OFF))[u] = 0u;
    __syncthreads();
    if (threadIdx.x < 25) { LAS unsigned long long* PT = (LAS unsigned long long*)(F.lds + LDSCTL_OFF); const int i = threadIdx.x;
        PT[i] = i < 23 ? (unsigned long long)args.in[i] : (i == 23 ? (unsigned long long)args.out : (unsigned long long)args.ws); }
    const int lo = args.ph_lo, hi = args.ph_hi;
    XcdBarrier gbar = xcd_barrier_post((unsigned*)(args.ws + WS_CTL) + CW_BAR, MISC + 8, gridDim.x);
    XcdBarrier bar = xcd_barrier_post((unsigned*)(args.ws + WS_CTL) + CW_BAR + (size_t)(1 + (blockIdx.x & 7)) * XCD_BAR_WORDS, MISC + 10, gridDim.x >> 3);
    __syncthreads();
    int ph = 0; int l_cur = 0;
#define RUN(c) (ph >= lo && ph < hi && EN(c))
#define SEAM() do { if (ph >= lo && ph + 1 < hi) xcd_barrier(bar); ++ph; } while (0)
#ifndef DUP_LMASK
#define DUP_LMASK 0xF
#endif
#define REPEAT(c) const int nrep_ = (NREP(c) == 2 && c != 0 && !((DUP_LMASK >> l_cur) & 1)) ? 1 : NREP(c); _Pragma("unroll 1") for (int rep = 0; rep < nrep_; ++rep)
#define REP_BAR() do { if (rep) xcd_barrier(bar); } while (0)
#define MODP(l) ((const float*)(ws + WS_MOD) + (size_t)(l) * BATCH * NMOD)

#ifdef TLB_WARM
    {
      const int rank = blockIdx.x >> 3, nrank = (int)gridDim.x >> 3; unsigned acc_ = 0;
      for (int bi = 0; bi < 25; ++bi) { const char* base = (const char*)ldptr<char>(F, bi); const size_t bytes = bi < 23 ? (size_t)args.nbytes[bi] : (bi == 23 ? (size_t)M * D * 4 : (size_t)WS_END);
          for (size_t off = ((size_t)rank * 512 + threadIdx.x) * (size_t)TLB_WARM; off < bytes; off += (size_t)nrank * 512 * (size_t)TLB_WARM) acc_ += *(const volatile unsigned*)(base + off); }
      if (acc_ == 0x12345678u) ((volatile unsigned*)(args.ws + WS_CTL))[64] = acc_; }
    __syncthreads();
#endif
#ifdef WARM_READ_MB
    {
      const float* xw = ldptr<const float>(F, I_X); f32x4 acc_ = {0.f, 0.f, 0.f, 0.f}; const size_t nv = (size_t)WARM_READ_MB * 65536;
      for (size_t i = (size_t)blockIdx.x * 512 + threadIdx.x; i < nv; i += (size_t)gridDim.x * 512) acc_ += ((const f32x4*)xw)[i];
      if (acc_.x + acc_.y + acc_.z + acc_.w == 1.2345e30f) ((volatile float*)(args.ws + WS_CTL))[65] = acc_.x; }
    __syncthreads();
#endif
#ifdef MFMA_PROBE_ITERS
    {
      typedef short pb8 __attribute__((ext_vector_type(8))); typedef float pf4 __attribute__((ext_vector_type(4)));
      const unsigned lid = threadIdx.x * 2654435761u; unsigned pw[4] = {lid | 0x3f803f80u, (lid >> 3) | 0x3f003f00u, (lid << 5) ^ 0x40004000u, (lid >> 7) | 0x3e803e80u};
      pb8 pa = __builtin_bit_cast(pb8, *(v4u*)pw), pbb = pa; pf4 c0 = {0,0,0,0}, c1 = c0, c2 = c0, c3 = c0;
      for (int it = 0; it < MFMA_PROBE_ITERS; ++it) {
#pragma unroll
        for (int q = 0; q < 16; ++q) { c0 = __builtin_amdgcn_mfma_f32_16x16x32_bf16(pa, pbb, c0, 0, 0, 0); c1 = __builtin_amdgcn_mfma_f32_16x16x32_bf16(pbb, pa, c1, 0, 0, 0);
            c2 = __builtin_amdgcn_mfma_f32_16x16x32_bf16(pa, pa, c2, 0, 0, 0); c3 = __builtin_amdgcn_mfma_f32_16x16x32_bf16(pbb, pbb, c3, 0, 0, 0); }
        c0 *= 0.5f; c1 *= 0.5f; c2 *= 0.5f; c3 *= 0.5f; }
      if (c0[0] + c1[1] + c2[2] + c3[3] == 1.2345e30f) ((volatile float*)(args.ws + WS_CTL))[66] = c0[0]; }
    __syncthreads();
#endif
#ifdef START_DELAY_US
    { const unsigned long long t0 = __builtin_amdgcn_s_memrealtime(); while (__builtin_amdgcn_s_memrealtime() - t0 < (unsigned long long)START_DELAY_US * 100ull) __builtin_amdgcn_s_sleep(32); }
#endif
#if defined(FIX_P0_US) || defined(FIX_A_US)
    const unsigned long long t_start = __builtin_amdgcn_s_memrealtime();
#endif
#ifdef P0_SPLIT
    p0_prologue(F, 1); xcd_barrier(gbar);
#ifdef FIX_A_US
    while (__builtin_amdgcn_s_memrealtime() - t_start < (unsigned long long)FIX_A_US * 100ull) __builtin_amdgcn_s_sleep(32);
#endif
    p0_prologue(F, 2);
#else
    if (RUN(0)) { REPEAT(0) { if (rep) xcd_barrier(gbar); p0_prologue(F); } }
#endif
    if (ph >= lo && ph + 1 < hi) xcd_barrier(gbar);
    ++ph;
#ifndef GROUP_STAGGER_MODE
#define GROUP_STAGGER_MODE 0
#endif
#ifdef GROUP_STAGGER_TICKS
    { const unsigned long long t0 = __builtin_amdgcn_s_memrealtime(), w = (unsigned long long)(GROUP_STAGGER_MODE == 1 ? (blockIdx.x & 1) : (blockIdx.x & 7)) * GROUP_STAGGER_TICKS; while (__builtin_amdgcn_s_memrealtime() - t0 < w) __builtin_amdgcn_s_sleep(8); }
#endif
#ifdef FIX_P0_US
    while (__builtin_amdgcn_s_memrealtime() - t_start < (unsigned long long)FIX_P0_US * 100ull) __builtin_amdgcn_s_sleep(32);
#endif
#ifdef EXTRA_BARS
    for (int eb = 0; eb < EXTRA_BARS; ++eb) xcd_barrier(gbar);
#endif
#pragma unroll 1
    for (int l = 0; l < DEPTH; ++l) { l_cur = l;
#define D1P(ll) ((const bf16*)(ws + ((ll) < NA ? ZB_D1A : WS_DELTA)))
        if (RUN(1)) { unsigned char* ws = WSP(); const float* mod = MODP(l); bf16* xb = (bf16*)ldptr<float>(F, PT_OUT) + D;
              const bf16* d1 = (l == 0 || l - 1 >= NA) ? (const bf16*)nullptr : D1P(l - 1); const bf16* d2 = (l == 0) ? (const bf16*)nullptr : (const bf16*)(ws + WS_DELTA);
            if (l == NA) norm_phase<true, true>(F, (const float*)xb, d1, d2, xb, INP(I_NORMG) + (size_t)(2 * l) * D, mod, mod + D, NMOD, (bf16*)(ws + WS_H), INP(I_KVNG), (const float*)(ws + WS_KVMOD), (bf16*)(ws + ZB_HKV), INP(I_WF), INP(I_BF), (float*)(ws + WS_LOGF));
            else if (l <= 1) norm_phase<false, false>(F, INP(I_X), d1, d2, (l == 0) ? (bf16*)nullptr : xb, INP(I_NORMG) + (size_t)(2 * l) * D, mod, mod + D, NMOD, (bf16*)(ws + WS_H), nullptr, nullptr, nullptr, nullptr, nullptr, nullptr);
            else norm_phase<false, true>(F, (const float*)xb, d1, d2, xb, INP(I_NORMG) + (size_t)(2 * l) * D, mod, mod + D, NMOD, (bf16*)(ws + WS_H), nullptr, nullptr, nullptr, nullptr, nullptr, nullptr); }
        SEAM();
        if (l < NA) {
            if (RUN(2)) { REPEAT(2) { REP_BAR(); unsigned char* ws = WSP();
                pg8::Gemm g{(const bf16*)(ws + WS_H), (const bf16*)(ws + WS_WT) + WT_WIN + (size_t)l * GN * D, M, GN, D, 0}; pg8::StaticOrder S; S.init(M, GN, F.G, (int)blockIdx.x, WGM_G1);
#ifdef SG_V1
                pg8::EpiBf16<1, true> E{(bf16*)(ws + ZB_U), GH, GH, (size_t)(ZB_V - ZB_U) / 2, (pg8::f32x2v*)(ws + WS_VSTAT), M};
                pg8::gemm_phase<pg8::EpiBf16<1, true>, pg8::StaticOrder, PG8_ALIGN_SET, PG8_SP2_SET>(F.lds, g, S, E); } }
#else
                pg8::EpiGmlpIn E{(bf16*)(ws + ZB_U), (bf16*)(ws + ZB_V), (pg8::f32x2v*)(ws + WS_VSTAT), M, GH, (GELU_PROBE && rep < nrep_ - 1) ? 0 : 1};
                pg8::gemm_phase<pg8::EpiGmlpIn, pg8::StaticOrder, PG8_ALIGN_SET, PG8_SP2_SET>(F.lds, g, S, E); } }
#endif
            SEAM();
            if (RUN(3)) { REPEAT(3) { REP_BAR(); unsigned char* ws = WSP();
#ifdef SG_V1
                sg_phase_v1(F, l, (bf16*)(ws + ZB_U), (const bf16*)(ws + ZB_V), (const f32x2*)(ws + WS_VSTAT), INP(I_LNG) + (size_t)l * GH, INP(I_LNB) + (size_t)l * GH, (const float*)(ws + WS_WSM), INP(I_BS)); } }
#else
                sg_phase(F, l, (bf16*)(ws + ZB_U), (const bf16*)(ws + ZB_V), (const f32x2*)(ws + WS_VSTAT), INP(I_LNG) + (size_t)l * GH, INP(I_LNB) + (size_t)l * GH, (const float*)(ws + WS_WSM), INP(I_BS), rep == nrep_ - 1); } }
#endif
            SEAM();
        } else {
            const int bl = l - NA;
            if (RUN(4)) { REPEAT(4) { REP_BAR(); unsigned char* ws = WSP();
                if (l == NA) cumsum_phase(F, (const float*)(ws + WS_LOGF), (float*)(ws + WS_FB), INP(I_QNG), INP(I_KNG), (int*)(ws + WS_JLO));
#pragma unroll 1
                for (int s = (l == NA ? 0 : 1); s < 2; ++s) {
                    pg8::Gemm g{(const bf16*)(ws + (s == 0 ? ZB_HKV : WS_H)), (const bf16*)(ws + WS_WT) + (s == 0 ? WT_WKV : WT_WQ + (size_t)bl * D * D), M, s == 0 ? 2 * D : D, D, 0};
                    pg8::StaticOrder S; S.init(M, g.N, F.G, (int)blockIdx.x, WGM_QKV);
                    pg8::EpiHeadNorm E{(bf16*)(ws + (s == 0 ? ZB_KB : ZB_Q)), D, s == 0 ? D : 0, (size_t)(ZB_VB - ZB_KB) / 2, 1, s == 0 ? INP(I_KNG) : INP(I_QNG) + bl * HD, EPS, (LAS float*)(F.lds + RING_BYTES), s == 0 ? 1.0f : att::SCALE * att::LOG2E};
                    pg8::gemm_phase<pg8::EpiHeadNorm, pg8::StaticOrder, true, PG8_SP2_SET>(F.lds, g, S, E);
                } } }
            SEAM();
            if (RUN(6)) { REPEAT(6) { REP_BAR(); unsigned char* ws = WSP();
                attn_phase(F, (char*)lds, (const bf16*)(ws + ZB_Q), (const bf16*)(ws + ZB_KB), (const bf16*)(ws + ZB_VB), (bf16*)(ws + ZB_O), (const float*)(ws + WS_FB), (const int*)(ws + WS_JLO),
                           (unsigned*)(ws + WS_CTL) + CW_QUEUE + 512 * (2 * bl + rep)); } }
            SEAM();
        }
        if (RUN(7)) { REPEAT(7) { REP_BAR(); unsigned char* ws = WSP();
            pg8::StaticOrder S; S.init(M, D, F.G, (int)blockIdx.x, WGM_RES);
            pg8::EpiDelta E{(bf16*)D1P(l), D, MODP(l) + 2 * D, NMOD, SEQ / 256};
            if (l < NA) { pg8::Gemm g{(const bf16*)(ws + ZB_U), (const bf16*)(ws + WS_WT) + WT_WOUT + (size_t)l * D * GH, M, D, GH, 1};
                pg8::gemm_phase<pg8::EpiDelta, pg8::StaticOrder, PG8_ALIGN_SET, PG8_SP2_SET>(F.lds, g, S, E); }
            else { pg8::Gemm g{(const bf16*)(ws + ZB_O), (const bf16*)(ws + WS_WT) + WT_WO + (size_t)(l - NA) * D * D, M, D, D, 0};
                pg8::gemm_phase<pg8::EpiDelta, pg8::StaticOrder, PG8_ALIGN_SET, PG8_SP2_SET>(F.lds, g, S, E); } } }
        SEAM();
        if (RUN(8)) { unsigned char* ws = WSP(); const float* mod = MODP(l); bf16* xb = (bf16*)ldptr<float>(F, PT_OUT) + D;
            if (l == 0) norm_phase<false, false>(F, INP(I_X), D1P(l), nullptr, nullptr, INP(I_NORMG) + (size_t)(2 * l + 1) * D, mod + 3 * D, mod + 4 * D, NMOD, (bf16*)(ws + WS_H), nullptr, nullptr, nullptr, nullptr, nullptr, nullptr);
            else norm_phase<false, true>(F, (const float*)xb, D1P(l), nullptr, l < NA ? (bf16*)nullptr : xb, INP(I_NORMG) + (size_t)(2 * l + 1) * D, mod + 3 * D, mod + 4 * D, NMOD, (bf16*)(ws + WS_H), nullptr, nullptr, nullptr, nullptr, nullptr, nullptr); }
        SEAM();
#ifdef CLOCK_PROBE
        const unsigned long long cp_c0 = __builtin_amdgcn_s_memtime(), cp_r0 = __builtin_amdgcn_s_memrealtime();
#endif
        if (RUN(9)) { REPEAT(9) { REP_BAR(); unsigned char* ws = WSP();
            pg8::Gemm g{(const bf16*)(ws + WS_H), (const bf16*)(ws + WS_WT) + WT_W1 + (size_t)l * FF * D, M, FF, D, 0}; pg8::StaticOrder S; S.init(M, FF, F.G, (int)blockIdx.x, WGM_M1);
            pg8::EpiBf16<2, false, HID_TILED> E{(bf16*)(ws + ZB_HID), FF, 0, 0, nullptr, M};
            pg8::gemm_phase<pg8::EpiBf16<2, false, HID_TILED>, pg8::StaticOrder, PG8_ALIGN_SET, PG8_SP2_SET>(F.lds, g, S, E); } }
#ifdef CLOCK_PROBE
        if (l == CLOCK_PROBE && blockIdx.x == 0) {
            const unsigned long long dc = __builtin_amdgcn_s_memtime() - cp_c0, dr = __builtin_amdgcn_s_memrealtime() - cp_r0;
            const unsigned long long mhz = dc * 100ull / dr; const unsigned long long wait_ticks = (mhz > 1000ull ? mhz - 1000ull : 0ull) * 100ull;
            const unsigned long long t0 = __builtin_amdgcn_s_memrealtime(); while (__builtin_amdgcn_s_memrealtime() - t0 < wait_ticks) __builtin_amdgcn_s_sleep(32); }
#endif
        SEAM();
        if (RUN(10)) { REPEAT(10) { REP_BAR(); unsigned char* ws = WSP();
            pg8::Gemm g{(const bf16*)(ws + ZB_HID), (const bf16*)(ws + WS_WT) + WT_W2 + (size_t)l * D * FF, M, D, FF, HID_TILED ? 1 : 0}; pg8::StaticOrder S; S.init(M, D, F.G, (int)blockIdx.x, WGM_RES);
            pg8::EpiDelta E{(bf16*)(ws + WS_DELTA), D, MODP(l) + 5 * D, NMOD, SEQ / 256};
            pg8::gemm_phase<pg8::EpiDelta, pg8::StaticOrder, PG8_ALIGN_SET, PG8_SP2_SET>(F.lds, g, S, E); } }
        SEAM();
    }
    if (RUN(11)) { l_cur = 0; REPEAT(11) { REP_BAR(); unsigned char* ws = WSP(); float* out = ldptr<float>(F, PT_OUT); resid_final(F, (const bf16*)out + D, rep == nrep_ - 1 ? out : (float*)(ws + WS_Z), (const bf16*)(ws + WS_DELTA)); } }
#undef RUN
#undef SEAM
}

extern "C" void kernel_launch(void* const* d_in, const int* in_sizes, int n_in, void* d_out, int out_size, void* d_ws, size_t ws_size, hipStream_t stream) {
    static int grid = 0;
    if (grid == 0) {
        if (n_in != 23 || in_sizes[0] != M * D || out_size != M * D || ws_size < WS_END) { fprintf(stderr, "kernel_launch: shape/workspace mismatch (n_in %d in0 %d out %d ws %zu, need %zu)\n", n_in, n_in > 0 ? in_sizes[0] : -1, out_size, ws_size, (size_t)WS_END); grid = -1; return; }
        int dev = 0, cus = 0, per_cu = 0;
        if (hipGetDevice(&dev) != hipSuccess || hipDeviceGetAttribute(&cus, hipDeviceAttributeMultiprocessorCount, dev) != hipSuccess) { grid = -1; return; }
        if (hipFuncSetAttribute((const void*)yoco_fwd, hipFuncAttributeMaxDynamicSharedMemorySize, LDS_BYTES) != hipSuccess) { fprintf(stderr, "kernel_launch: hipFuncSetAttribute failed\n"); grid = -1; return; }
        if (hipOccupancyMaxActiveBlocksPerMultiprocessor(&per_cu, (const void*)yoco_fwd, NWAVES * 64, LDS_BYTES) != hipSuccess || per_cu < 1) { fprintf(stderr, "kernel_launch: occupancy query says %d\n", per_cu); }
        (void)hipGetLastError();
        grid = cus;
        if (grid != M / GB) { fprintf(stderr, "kernel_launch: this kernel needs exactly %d CUs (got %d)\n", M / GB, cus); grid = -1; return; }
    }
    if (grid < 0) return;
    if (hipMemsetAsync((char*)d_ws + WS_CTL, 0, CTL_ZERO_BYTES, stream) != hipSuccess) return;
    Args a{};
    for (int i = 0; i < 23; ++i) { a.in[i] = (const float*)d_in[i]; a.nbytes[i] = (unsigned)in_sizes[i] * 4u; }
    a.out = (float*)d_out; a.ws = (unsigned char*)d_ws;
#if MK_N_LAUNCHES == 1
    a.ph_lo = 0; a.ph_hi = 1000; a.li = 0; a.pad = 0;
    hipLaunchKernelGGL(yoco_fwd, dim3(grid), dim3(NWAVES * 64), LDS_BYTES, stream, a);
#else
    for (int li = 0; li < 64; ++li) { a.ph_lo = li; a.ph_hi = li + 1; a.li = li; a.pad = 0;
        hipLaunchKernelGGL(yoco_fwd, dim3(grid), dim3(NWAVES * 64), LDS_BYTES, stream, a); }
#endif
}
```

```cpp
#include <hip/hip_runtime.h>
#include <cstdio>
#include <cstdint>

template <int XM> __device__ __forceinline__ float lane_xor(float v) {
    static_assert(XM >= 1 && XM < 32, "lane_xor: in-half xor only");
    return __uint_as_float((unsigned)__builtin_amdgcn_ds_swizzle((int)__float_as_uint(v), (XM << 10) | 0x1F));
}
__device__ __forceinline__ float lane_sum_halves(float v) {
    auto rr = __builtin_amdgcn_permlane32_swap(__float_as_uint(v), __float_as_uint(v), false, false);
    return __uint_as_float(rr[0]) + __uint_as_float(rr[1]);
}
__device__ __forceinline__ float lane_max_halves(float v) {
    auto rr = __builtin_amdgcn_permlane32_swap(__float_as_uint(v), __float_as_uint(v), false, false);
    return fmaxf(__uint_as_float(rr[0]), __uint_as_float(rr[1]));
}
#ifndef PG8_BT
#define PG8_BT 1
#endif
#ifndef WGM_SET
#define WGM_SET 4
#endif
namespace pg8 {
#define PG8_LAS __attribute__((address_space(3)))
typedef unsigned short bf16_t;
typedef short bf16x8 __attribute__((ext_vector_type(8)));
typedef float f32x4 __attribute__((ext_vector_type(4)));
typedef unsigned u32x4 __attribute__((ext_vector_type(4)));
constexpr int BM = 256, BK = 64, HALF = 128, HTB = HALF * BK * 2  , STAGE_BYTES = 8 * HTB, NXCD = 8, WGM = WGM_SET;

__host__ __device__ __forceinline__ int lds_byte(int r, int c) { const int st = (r >> 4) * 2 + (c >> 5), rr = r & 15, cc = c & 31, ob = rr * 64 + cc * 2; return st * 1024 + (ob ^ (((ob >> 9) & 1) << 5)); }
__host__ __device__ __forceinline__ void stage_rc(int b, int& R, int& C) { const int st = b / 1024, sb = b % 1024, swz = sb ^ (((sb >> 9) & 1) << 5); R = (st >> 1) * 16 + swz / 64; C = (st & 1) * 32 + (swz % 64) / 2; }
__host__ __device__ __forceinline__ int perm32(int rho) { const int n = rho >> 4, i = rho & 15; return 8 * (i >> 2) + 4 * n + (i & 3); }

struct Unit { int pm, pn; };
struct Gemm { const bf16_t* A; const bf16_t* Bt; int M, N, K; int a_tiled; };

struct StaticOrder {
    int nM, nN, nwg, G, c, wgm;
    __host__ __device__ void init(int M, int N, int G_, int c_, int wgm_ = WGM) { nM = M / BM; nN = N / BM; nwg = nM * nN; G = G_; c = c_; wgm = wgm_; }
    __host__ __device__ bool next(int i, Unit& u) const {
        const long L = (long)i * G + c; if (L >= nwg) return false;
        int wgid = (int)L; { const int q = nwg / NXCD, r = nwg % NXCD, xcd = wgid % NXCD, off = wgid / NXCD; wgid = (xcd < r ? xcd * (q + 1) : r * (q + 1) + (xcd - r) * q) + off; }
        const int nig = wgm * nN, gid = wgid / nig, fm = gid * wgm, gsz = (nM - fm) < wgm ? (nM - fm) : wgm;
        u.pm = fm + ((wgid % nig) % gsz); u.pn = (wgid % nig) / gsz; return true;
    }
    __device__ __forceinline__ void a_ready(const Unit&) const {}
    __device__ __forceinline__ void done(const Unit&) const {}
};

__device__ __forceinline__ unsigned cvt_pk_bf16(float lo, float hi) { unsigned r; asm volatile("v_cvt_pk_bf16_f32 %0, %1, %2" : "=v"(r) : "v"(lo), "v"(hi)); return r; }
typedef float f32x2 __attribute__((ext_vector_type(2)));
#ifdef GELU_AS
__device__ __forceinline__ f32x2 gelu_pk(f32x2 v) {
    const f32x2 av = __builtin_elementwise_abs(v), d = av * 0.2316418882f + 1.0f;
    f32x2 t; t.x = __builtin_amdgcn_rcpf(d.x); t.y = __builtin_amdgcn_rcpf(d.y);
    f32x2 q = t * 0.5307027145f + (-0.7265760135f); q = q * t + 0.7107068705f; q = q * t + (-0.142248368f); q = q * t + 0.127414796f; q = q * t;
    const f32x2 s = (v * v) * (-0.72134752044f);
    f32x2 e; e.x = __builtin_amdgcn_exp2f(s.x); e.y = __builtin_amdgcn_exp2f(s.y);
    const f32x2 m = v * (q * e), r = v - m;
    f32x2 o; o.x = v.x < 0.f ? m.x : r.x; o.y = v.y < 0.f ? m.y : r.y; return o;
}
#else
__device__ __forceinline__ float relu1(float x) { float r; asm("v_max_f32_e32 %0, 0, %1" : "=v"(r) : "v"(x)); return r; }
__device__ __forceinline__ float absmin1(float x, float c) { float r; asm("v_min_f32_e64 %0, |%1|, %2" : "=v"(r) : "v"(x), "s"(c)); return r; }
__device__ __forceinline__ f32x2 gelu_pk(f32x2 v) {
    f32x2 a; a.x = absmin1(v.x, 12.f); a.y = absmin1(v.y, 12.f);
    f32x2 p = a * 3.3104759495472535e-05f + (-0.0007693342049606144f); p = p * a + 0.00808112882077694f; p = p * a + (-0.053412798792123795f); p = p * a + (-0.45877042412757874f);
    p = p * a + (-1.151201844215393f); p = p * a + (-0.9999930262565613f);
    f32x2 e; e.x = __builtin_amdgcn_exp2f(p.x); e.y = __builtin_amdgcn_exp2f(p.y);
    f32x2 r; r.x = relu1(v.x); r.y = relu1(v.y);
    return r - a * e;
}
#endif


#ifdef SC1_STORES
#define PG8_BIGSTORE(ptr, val) asm volatile("global_store_dwordx4 %0, %1, off sc1" :: "v"(ptr), "v"(val) : "memory")
#elif defined(NT_STORES)
#define PG8_BIGSTORE(ptr, val) __builtin_nontemporal_store((val), (ptr))
#else
#define PG8_BIGSTORE(ptr, val) (*(ptr) = (val))
#endif

typedef float f32x2v __attribute__((ext_vector_type(2)));
template <int ACT, bool VSTAT, bool TILED = false> struct EpiBf16 {
    static constexpr bool PERM = true, AFTER_DRAIN = false;
    bf16_t* O; int ldc; int split_cols; size_t split_stride; f32x2v* vstat; int Mrows;
    __device__ __forceinline__ void operator()(const f32x4 (&acc)[2][2][4][2], const Unit& u, int wr, int wc, int fr, int fq) const {
        const int row0 = u.pm * BM + wr * 64 + fr; int colt = u.pn * BM; bf16_t* base = O; int t = 0;
        if (split_cols) { t = colt / split_cols; base += (size_t)t * split_stride; colt -= t * split_cols; }
        const int col0 = colt + wc * 32 + 8 * fq;
        bf16_t* p0; size_t s_ai, s_m, s_bj;
        if (TILED) { const int nch = ldc >> 7; p0 = base + ((size_t)((u.pm * 2) * nch + (colt >> 7)) * 128 + wr * 64 + fr) * 128 + wc * 32 + 8 * fq; s_ai = (size_t)nch * 16384; s_m = 16 * 128; s_bj = 16384; }
        else { p0 = base + (size_t)row0 * ldc + col0; s_ai = (size_t)HALF * ldc; s_m = (size_t)16 * ldc; s_bj = HALF; }
#pragma unroll
        for (int ai = 0; ai < 2; ++ai)
#pragma unroll
            for (int m = 0; m < 4; ++m) { const int row = row0 + ai * HALF + m * 16;
                float s = 0.f, ss = 0.f;
#pragma unroll
                for (int bj = 0; bj < 2; ++bj) { f32x4 v0 = acc[ai][bj][m][0], v1 = acc[ai][bj][m][1];
                    if (ACT == 1) { f32x2 a = gelu_pk((f32x2){v0[0], v0[1]}), b = gelu_pk((f32x2){v0[2], v0[3]}), c = gelu_pk((f32x2){v1[0], v1[1]}), d = gelu_pk((f32x2){v1[2], v1[3]});
                        v0 = (f32x4){a.x, a.y, b.x, b.y}; v1 = (f32x4){c.x, c.y, d.x, d.y}; }
                    if (ACT == 2) {
#pragma unroll
                        for (int e = 0; e < 4; ++e) { const float a = relu1(v0[e]), b = relu1(v1[e]); v0[e] = a * a; v1[e] = b * b; } }
                    if (VSTAT) { s += ((v0[0] + v0[1]) + (v0[2] + v0[3])) + ((v1[0] + v1[1]) + (v1[2] + v1[3]));
                        ss += ((v0[0] * v0[0] + v0[1] * v0[1]) + (v0[2] * v0[2] + v0[3] * v0[3])) + ((v1[0] * v1[0] + v1[1] * v1[1]) + (v1[2] * v1[2] + v1[3] * v1[3])); }
                    u32x4 w; w.x = cvt_pk_bf16(v0[0], v0[1]); w.y = cvt_pk_bf16(v0[2], v0[3]); w.z = cvt_pk_bf16(v1[0], v1[1]); w.w = cvt_pk_bf16(v1[2], v1[3]);
                    PG8_BIGSTORE((u32x4*)(p0 + ai * s_ai + m * s_m + bj * s_bj), w); }
                if (VSTAT) { if (t == 1) { s += lane_xor<16>(s); s = lane_sum_halves(s); ss += lane_xor<16>(ss); ss = lane_sum_halves(ss);
                    if (fq == 0) vstat[(size_t)((colt >> 8) * 4 + wc) * Mrows + row] = (f32x2v){s, ss}; } } }
    }
};
struct EpiResid {
    static constexpr bool PERM = false, AFTER_DRAIN = false;
    const float* base; float* out; int ldc; const float* gate; int gstride; int tiles_per_batch;
    __device__ __forceinline__ void operator()(const f32x4 (&acc)[2][2][4][2], const Unit& u, int wr, int wc, int fr, int fq) const {
        const int col0 = u.pn * BM + wc * 32 + 4 * fq; const float* g = gate + (size_t)(u.pm / tiles_per_batch) * gstride + col0;
        f32x4 gv[2][2];
#pragma unroll
        for (int bj = 0; bj < 2; ++bj)
#pragma unroll
            for (int n = 0; n < 2; ++n) gv[bj][n] = *(const f32x4*)(g + bj * HALF + n * 16);
#pragma unroll
        for (int ai = 0; ai < 2; ++ai)
#pragma unroll
            for (int m = 0; m < 4; ++m) { const size_t off = (size_t)(u.pm * BM + ai * HALF + wr * 64 + m * 16 + fr) * ldc + col0;
#pragma unroll
                for (int bj = 0; bj < 2; ++bj)
#pragma unroll
                    for (int n = 0; n < 2; ++n) { const f32x4 bs = *(const f32x4*)(base + off + bj * HALF + n * 16); const f32x4 o = bs + gv[bj][n] * acc[ai][bj][m][n];
                        *(f32x4*)(out + off + bj * HALF + n * 16) = o; }
                if (m & 1) asm volatile("" ::: "memory"); }
    }
};


struct EpiGmlpIn {
    static constexpr bool PERM = true, AFTER_DRAIN = false;
    bf16_t* U; bf16_t* V; f32x2v* vstat; int Mrows; int GHc; int do_gelu;
    __device__ __forceinline__ void operator()(const f32x4 (&acc)[2][2][4][2], const Unit& u, int wr, int wc, int fr, int fq) const {
        const int colt_all = u.pn * BM; const int t = colt_all >= GHc ? 1 : 0; const int colt = colt_all - t * GHc; const int nch = GHc >> 7;
        const int frs = (fr & ~0xC) | ((fr & 4) << 1) | ((fr & 8) >> 1);
        const int row0 = u.pm * BM + wr * 64 + fr;
        char* p; size_t s_ai, s_m, s_bj;
        if (t == 0) { p = (char*)U + ((size_t)(u.pm * 2) * nch + (colt >> 7)) * 32768 + (size_t)(wr * 64 + fr) * 256 + (wc * 32 + 8 * fq) * 2; s_ai = (size_t)nch * 32768; s_m = 16 * 256; s_bj = 32768; }
        else { p = (char*)V + ((size_t)((u.pm * 2) * nch + (colt >> 7)) * 2 + wr) * 16384 + ((frs >> 3) * 4 + wc) * 512 + ((frs & 7) * 32 + 8 * fq) * 2; s_ai = (size_t)nch * 32768; s_m = 4096; s_bj = 32768; }
        f32x2v* vs = vstat + (size_t)((colt >> 8) * 4 + wc) * Mrows + row0;
        if (t == 0) body<false>(acc, p, s_ai, s_m, s_bj, vs, fq); else body<true>(acc, p, s_ai, s_m, s_bj, vs, fq);
    }
    template <bool STATS>
    __device__ __forceinline__ void body(const f32x4 (&acc)[2][2][4][2], char* p, size_t s_ai, size_t s_m, size_t s_bj, f32x2v* vs, int fq) const {
#pragma unroll
        for (int ai = 0; ai < 2; ++ai)
#pragma unroll
            for (int m = 0; m < 4; ++m) {
                f32x2 s2 = {0.f, 0.f}, q2 = {0.f, 0.f};
#pragma unroll
                for (int bj = 0; bj < 2; ++bj) { const f32x4 v0 = acc[ai][bj][m][0], v1 = acc[ai][bj][m][1];
                    f32x2 a = {v0[0], v0[1]}, b = {v0[2], v0[3]}, c = {v1[0], v1[1]}, d = {v1[2], v1[3]};
                    if (STATS && do_gelu) { a = gelu_pk(a); b = gelu_pk(b); c = gelu_pk(c); d = gelu_pk(d); }
                    if (STATS) { s2 += (a + b) + (c + d); q2 = a * a + q2; q2 = b * b + q2; q2 = c * c + q2; q2 = d * d + q2; }
                    u32x4 w; w.x = cvt_pk_bf16(a.x, a.y); w.y = cvt_pk_bf16(b.x, b.y); w.z = cvt_pk_bf16(c.x, c.y); w.w = cvt_pk_bf16(d.x, d.y);
                    PG8_BIGSTORE((u32x4*)(p + ai * s_ai + m * s_m + bj * s_bj), w); }
                if (STATS) { float s = s2.x + s2.y, ss = q2.x + q2.y; s += lane_xor<16>(s); s = lane_sum_halves(s); ss += lane_xor<16>(ss); ss = lane_sum_halves(ss);
                    if (fq == 0) vs[ai * HALF + m * 16] = (f32x2v){s, ss}; } }
    }
};

struct EpiDelta {
    static constexpr bool PERM = true, AFTER_DRAIN = false;
    bf16_t* O; int ldc; const float* gate; int gstride; int tiles_per_batch;
    __device__ __forceinline__ void operator()(const f32x4 (&acc)[2][2][4][2], const Unit& u, int wr, int wc, int fr, int fq) const {
        const int row0 = u.pm * BM + wr * 64 + fr, col0 = u.pn * BM + wc * 32 + 8 * fq; const float* g = gate + (size_t)(u.pm / tiles_per_batch) * gstride + col0;
        f32x4 gv[2][2];
#pragma unroll
        for (int bj = 0; bj < 2; ++bj)
#pragma unroll
            for (int n = 0; n < 2; ++n) gv[bj][n] = *(const f32x4*)(g + bj * HALF + 4 * n);
#pragma unroll
        for (int ai = 0; ai < 2; ++ai)
#pragma unroll
            for (int m = 0; m < 4; ++m) { bf16_t* rowp = O + (size_t)(row0 + ai * HALF + m * 16) * ldc + col0;
#pragma unroll
                for (int bj = 0; bj < 2; ++bj) { const f32x4 v0 = acc[ai][bj][m][0] * gv[bj][0], v1 = acc[ai][bj][m][1] * gv[bj][1];
                    u32x4 w; w.x = cvt_pk_bf16(v0[0], v0[1]); w.y = cvt_pk_bf16(v0[2], v0[3]); w.z = cvt_pk_bf16(v1[0], v1[1]); w.w = cvt_pk_bf16(v1[2], v1[3]);
                    PG8_BIGSTORE((u32x4*)(rowp + bj * HALF), w); } }
    }
};

struct EpiHeadNorm {
    static constexpr bool PERM = true, AFTER_DRAIN = false;
    bf16_t* O; int ldc; int split_cols; size_t split_stride; int norm_parts; const float* gain; float eps; PG8_LAS float* P; float gscale;
    __device__ __forceinline__ void operator()(const f32x4 (&acc)[2][2][4][2], const Unit& u, int wr, int wc, int fr, int fq) const {
        const int row0 = u.pm * BM + wr * 64 + fr; int colt = u.pn * BM; bf16_t* base = O; int t = 0;
        if (split_cols) { t = colt / split_cols; base += (size_t)t * split_stride; colt -= t * split_cols; }
        const int col0 = colt + wc * 32 + 8 * fq;
        const bool norm = t < norm_parts;
        if (norm) {
#pragma unroll
            for (int ai = 0; ai < 2; ++ai)
#pragma unroll
                for (int m = 0; m < 4; ++m)
#pragma unroll
                    for (int bj = 0; bj < 2; ++bj) { const f32x4 v0 = acc[ai][bj][m][0], v1 = acc[ai][bj][m][1];
                        float s = ((v0[0] * v0[0] + v0[1] * v0[1]) + (v0[2] * v0[2] + v0[3] * v0[3])) + ((v1[0] * v1[0] + v1[1] * v1[1]) + (v1[2] * v1[2] + v1[3] * v1[3]));
                        s += lane_xor<16>(s); s = lane_sum_halves(s);
                        if (fq == 0) P[(ai * HALF + wr * 64 + m * 16 + fr) * 8 + bj * 4 + wc] = s; }
            asm volatile("s_waitcnt lgkmcnt(0)" ::: "memory"); __builtin_amdgcn_s_barrier(); asm volatile("" ::: "memory");
        }
        f32x4 g0 = {1.f, 1.f, 1.f, 1.f}, g1 = {1.f, 1.f, 1.f, 1.f};
        if (norm) { g0 = *(const f32x4*)(gain + wc * 32 + 8 * fq) * gscale; g1 = *(const f32x4*)(gain + wc * 32 + 8 * fq + 4) * gscale; }
#pragma unroll
        for (int ai = 0; ai < 2; ++ai)
#pragma unroll
            for (int m = 0; m < 4; ++m) { bf16_t* rowp = base + (size_t)(row0 + ai * HALF + m * 16) * ldc + col0;
#pragma unroll
                for (int bj = 0; bj < 2; ++bj) { f32x4 v0 = acc[ai][bj][m][0], v1 = acc[ai][bj][m][1];
                    if (norm) { const f32x4 p = *(const PG8_LAS f32x4*)(P + (ai * HALF + wr * 64 + m * 16 + fr) * 8 + bj * 4);
                        const float r = 1.0f / sqrtf(((p[0] + p[1]) + (p[2] + p[3])) * (1.0f / 128.0f) + eps); v0 = v0 * r * g0; v1 = v1 * r * g1; }
                    u32x4 w; w.x = cvt_pk_bf16(v0[0], v0[1]); w.y = cvt_pk_bf16(v0[2], v0[3]); w.z = cvt_pk_bf16(v1[0], v1[1]); w.w = cvt_pk_bf16(v1[2], v1[3]);
                    PG8_BIGSTORE((u32x4*)(rowp + bj * HALF), w); } }
    }
};

template <class Epi, class Sched, bool ALIGN_EPI = false, bool SP2 = false>
__device__ __forceinline__ void gemm_phase(PG8_LAS unsigned char* lds, const Gemm g, const Sched& S, const Epi& E) {
    int tid_ = threadIdx.x; asm volatile("" : "+v"(tid_));
    const int tid = tid_, wid = __builtin_amdgcn_readfirstlane(tid >> 6), lane = tid & 63, wr = wid >> 2, wc = wid & 3, fr = lane & 15, fq = lane >> 4;
    const int K = g.K, nt = K / BK, rsA = g.a_tiled ? 128 : K;
#define PG8_KOFFA(t) (g.a_tiled ? ((size_t)((t) >> 1) * 32768 + (size_t)((t) & 1) * 128) : (size_t)(t) * kstep)
#define PG8_KOFFB(t) (PG8_BT ? ((size_t)((t) >> 1) * 32768 + (size_t)((t) & 1) * 128) : (size_t)(t) * kstep)
    unsigned voffA[2], voffB[2];
#pragma unroll
    for (int i = 0; i < 2; ++i) { int R, C; stage_rc(tid * 16 + i * 8192, R, C); const int Rb = Epi::PERM ? ((R & ~31) + perm32(R & 31)) : R;
        voffA[i] = (unsigned)(R * rsA + C) * 2u; voffB[i] = (unsigned)(Rb * (PG8_BT ? 128 : K) + C) * 2u; }
    const size_t kstep = (size_t)(BK * 2);
    const size_t hstep = (size_t)HALF * K * 2;
    const size_t tstep = 2 * hstep;
    const unsigned ldsw = (unsigned)wid * 1024u;
    const int aoff = lds_byte(wr * 64 + fr, fq * 8), boff = lds_byte(wc * 32 + fr, fq * 8);
#define PG8_SA(b, h) (((b) * 2 + (h)) * HTB)
#define PG8_SB(b, h) ((4 + (b) * 2 + (h)) * HTB)
#define PG8_STAGE(bufoff, gbase, voff) do { _Pragma("unroll") for (int _i = 0; _i < 2; ++_i) \
        __builtin_amdgcn_global_load_lds((const unsigned*)((const char*)(gbase) + (voff)[_i]), (PG8_LAS unsigned*)(lds + (bufoff) + ldsw + _i * 8192), 16, 0, 0); } while (0)
#define PG8_LDA(dst, b, h) do { _Pragma("unroll") for (int m = 0; m < 4; ++m) _Pragma("unroll") for (int k = 0; k < 2; ++k) dst[m][k] = *(const PG8_LAS bf16x8*)(lds + PG8_SA(b, h) + aoff + m * 2048 + k * 1024); } while (0)
#define PG8_LDB(dst, b, h) do { _Pragma("unroll") for (int n = 0; n < 2; ++n) _Pragma("unroll") for (int k = 0; k < 2; ++k) dst[n][k] = *(const PG8_LAS bf16x8*)(lds + PG8_SB(b, h) + boff + n * 2048 + k * 1024); } while (0)
#define PG8_MMA(ai, bj, At, Bt) do { __builtin_amdgcn_s_setprio(1); _Pragma("unroll") for (int m = 0; m < 4; ++m) _Pragma("unroll") for (int n = 0; n < 2; ++n) _Pragma("unroll") for (int k = 0; k < 2; ++k) \
        acc[ai][bj][m][n] = __builtin_amdgcn_mfma_f32_16x16x32_bf16(Bt[n][k], At[m][k], acc[ai][bj][m][n], 0, 0, 0); __builtin_amdgcn_s_setprio(0); } while (0)
#define PG8_WAIT_V(n) asm volatile("s_waitcnt vmcnt(" #n ")" ::: "memory")
#define PG8_WAIT_L(n) asm volatile("s_waitcnt lgkmcnt(" #n ")" ::: "memory")
#define PG8_BAR __builtin_amdgcn_s_barrier()
#define PG8_SCHED __builtin_amdgcn_sched_barrier(0)
    Unit cur, nxt; int ui = 0;
    if (!S.next(0, cur)) return;
#ifdef STAGGER_TICKS
    { const unsigned grp = (blockIdx.x >> 3) & 3u; if (grp) { const unsigned long long t0 = __builtin_amdgcn_s_memrealtime(); while (__builtin_amdgcn_s_memrealtime() - t0 < (unsigned long long)(grp * STAGGER_TICKS)) __builtin_amdgcn_s_sleep(2); } }
#endif
    f32x4 acc[2][2][4][2];
#pragma unroll
    for (int a = 0; a < 2; ++a)
#pragma unroll
        for (int b = 0; b < 2; ++b)
#pragma unroll
            for (int m = 0; m < 4; ++m)
#pragma unroll
                for (int n = 0; n < 2; ++n) acc[a][b][m][n] = (f32x4){0.f, 0.f, 0.f, 0.f};
    bf16x8 At[4][2], B0[2][2], B1[2][2];
    const char* cA = (const char*)g.A + (size_t)cur.pm * tstep; const char* cB = (const char*)g.Bt + (size_t)cur.pn * tstep;
    S.a_ready(cur);
    if constexpr (SP2) {
        PG8_STAGE(PG8_SB(0, 0), cB, voffB); PG8_STAGE(PG8_SB(0, 1), cB + hstep, voffB); PG8_STAGE(PG8_SA(0, 0), cA, voffA); PG8_STAGE(PG8_SA(0, 1), cA + hstep, voffA);
        if (wr == 1) PG8_BAR;
        PG8_WAIT_V(2); PG8_BAR;
        PG8_STAGE(PG8_SB(1, 0), cB + kstep, voffB); PG8_STAGE(PG8_SA(1, 0), cA + kstep, voffA); PG8_STAGE(PG8_SB(1, 1), cB + hstep + kstep, voffB);
        PG8_WAIT_V(6); PG8_BAR;
    } else {
        PG8_STAGE(PG8_SB(0, 0), cB, voffB); PG8_STAGE(PG8_SA(0, 0), cA, voffA); PG8_STAGE(PG8_SB(0, 1), cB + hstep, voffB); PG8_STAGE(PG8_SA(0, 1), cA + hstep, voffA);
        if (wr == 1) PG8_BAR;
        PG8_WAIT_V(4); PG8_BAR;
        PG8_STAGE(PG8_SB(1, 0), cB + kstep, voffB); PG8_STAGE(PG8_SA(1, 0), cA + kstep, voffA); PG8_STAGE(PG8_SB(1, 1), cB + hstep + kstep, voffB);
        PG8_WAIT_V(6); PG8_BAR;
    }
    for (;;) {
        const bool has_next = S.next(ui + 1, nxt);
        const char* nA = has_next ? (const char*)g.A + (size_t)nxt.pm * tstep : cA; const char* nB = has_next ? (const char*)g.Bt + (size_t)nxt.pn * tstep : cB;
        for (int t = 0; t < nt; t += 2) {
            const bool last = (t == nt - 2);
            const char* a1 = cA + PG8_KOFFA(t + 1);
            const char* a2 = last ? nA : cA + PG8_KOFFA(t + 2); const char* b2 = last ? nB : cB + PG8_KOFFB(t + 2);
            const char* a3 = a2 + kstep; const char* b3 = b2 + kstep;
            if (last && has_next) S.a_ready(nxt);
            if constexpr (SP2) {
            PG8_LDB(B0, 0, 0); PG8_LDB(B1, 0, 1); PG8_SCHED; PG8_LDA(At, 0, 0); PG8_STAGE(PG8_SA(1, 1), a1 + hstep, voffA);
            PG8_WAIT_V(8); PG8_WAIT_L(0); PG8_BAR; PG8_MMA(0, 0, At, B0); PG8_MMA(0, 1, At, B1); PG8_BAR; PG8_SCHED;
            PG8_LDA(At, 0, 1); PG8_STAGE(PG8_SB(0, 0), b2, voffB); PG8_STAGE(PG8_SB(0, 1), b2 + hstep, voffB); PG8_STAGE(PG8_SA(0, 0), a2, voffA);
            PG8_WAIT_V(8); PG8_WAIT_L(0); PG8_BAR; PG8_MMA(1, 0, At, B0); PG8_MMA(1, 1, At, B1); PG8_BAR; PG8_SCHED;
            PG8_LDB(B0, 1, 0); PG8_LDB(B1, 1, 1); PG8_SCHED; PG8_LDA(At, 1, 0); PG8_STAGE(PG8_SA(0, 1), a2 + hstep, voffA);
            PG8_WAIT_V(8); PG8_WAIT_L(0); PG8_BAR; PG8_MMA(0, 0, At, B0); PG8_MMA(0, 1, At, B1); PG8_BAR; PG8_SCHED;
            PG8_LDA(At, 1, 1); PG8_STAGE(PG8_SB(1, 0), b3, voffB); PG8_STAGE(PG8_SB(1, 1), b3 + hstep, voffB); PG8_STAGE(PG8_SA(1, 0), a3, voffA);
            PG8_WAIT_V(8); PG8_WAIT_L(0); PG8_BAR; PG8_MMA(1, 0, At, B0); PG8_MMA(1, 1, At, B1); PG8_BAR; PG8_SCHED;
            } else {
            PG8_LDB(B0, 0, 0); PG8_SCHED; PG8_LDA(At, 0, 0); PG8_STAGE(PG8_SA(1, 1), a1 + hstep, voffA);
            PG8_WAIT_L(8); PG8_BAR; PG8_WAIT_L(0); PG8_MMA(0, 0, At, B0); PG8_BAR; PG8_SCHED;
            PG8_LDB(B1, 0, 1); PG8_STAGE(PG8_SB(0, 0), b2, voffB);
            PG8_BAR; PG8_WAIT_L(0); PG8_MMA(0, 1, At, B1); PG8_BAR;
            PG8_LDA(At, 0, 1); PG8_STAGE(PG8_SA(0, 0), a2, voffA);
            PG8_BAR; PG8_WAIT_L(0); PG8_MMA(1, 0, At, B0); PG8_BAR; PG8_SCHED;
            PG8_STAGE(PG8_SB(0, 1), b2 + hstep, voffB);
            PG8_WAIT_V(6); PG8_BAR; PG8_MMA(1, 1, At, B1); PG8_BAR;
            PG8_LDB(B0, 1, 0); PG8_SCHED; PG8_LDA(At, 1, 0); PG8_STAGE(PG8_SA(0, 1), a2 + hstep, voffA);
            PG8_WAIT_L(8); PG8_BAR; PG8_WAIT_L(0); PG8_MMA(0, 0, At, B0); PG8_BAR; PG8_SCHED;
            PG8_LDB(B1, 1, 1); PG8_STAGE(PG8_SB(1, 0), b3, voffB);
            PG8_BAR; PG8_WAIT_L(0); PG8_MMA(0, 1, At, B1); PG8_BAR;
            PG8_LDA(At, 1, 1); PG8_STAGE(PG8_SA(1, 0), a3, voffA);
            PG8_BAR; PG8_WAIT_L(0); PG8_MMA(1, 0, At, B0); PG8_BAR; PG8_SCHED;
            PG8_STAGE(PG8_SB(1, 1), b3 + hstep, voffB);
            PG8_WAIT_V(6); PG8_BAR; PG8_MMA(1, 1, At, B1); PG8_BAR;
            }
        }
        if constexpr (ALIGN_EPI) { if (wr == 0) PG8_BAR; }
        if constexpr (!Epi::AFTER_DRAIN) { E(acc, cur, wr, wc, fr, fq); S.done(cur); }
        if (!has_next) break;
#pragma unroll
        for (int a = 0; a < 2; ++a)
#pragma unroll
            for (int b = 0; b < 2; ++b)
#pragma unroll
                for (int m = 0; m < 4; ++m)
#pragma unroll
                    for (int n = 0; n < 2; ++n) acc[a][b][m][n] = (f32x4){0.f, 0.f, 0.f, 0.f};
        cur = nxt; cA = nA; cB = nB; ++ui;
        if constexpr (ALIGN_EPI) { if (wr == 1) PG8_BAR; }
    }
    PG8_WAIT_V(0);
    if constexpr (!ALIGN_EPI) { if (wr == 0) PG8_BAR; }
    PG8_BAR;
    if constexpr (Epi::AFTER_DRAIN) { E.fused(acc, cur, wr, wc, fr, fq, lds, wid, lane); S.done(cur); }
#undef PG8_SA
#undef PG8_KOFFA
#undef PG8_KOFFB
#undef PG8_SB
#undef PG8_STAGE
#undef PG8_LDA
#undef PG8_LDB
#undef PG8_MMA
#undef PG8_WAIT_V
#undef PG8_WAIT_L
#undef PG8_BAR
#undef PG8_SCHED
}
}

namespace att {
typedef unsigned short bf16;
typedef short bf16x8 __attribute__((ext_vector_type(8)));
typedef short s16x4 __attribute__((ext_vector_type(4)));
typedef float f32x16 __attribute__((ext_vector_type(16)));
typedef float f32x4 __attribute__((ext_vector_type(4)));
typedef unsigned u32x4 __attribute__((ext_vector_type(4)));
typedef unsigned u32x2 __attribute__((ext_vector_type(2)));
constexpr int D = 128, PITCH = 2048, SEQ = 4096, NH = 16, NB = 8;
#ifndef ATT_THR
#define ATT_THR 8.f
#endif
constexpr float THR = ATT_THR;
constexpr float SCALE = 0.08838834764831845f;
constexpr float INV_SCALE = 11.313708498984761f;
constexpr float LOG2E = 1.4426950408889634f;
constexpr int NW = 8, QBLK = 32, KVBLK = 64, QB = NW * QBLK;
constexpr int SHM_V = KVBLK * D * 2, SHM_K = KVBLK * D * 2;
constexpr int NVB = 3;
constexpr int LDS_WS = NVB * SHM_V + 2 * SHM_K;
constexpr int LDS_FB = LDS_WS + NW * 64 * 4;
constexpr int LDS_BYTES = LDS_FB + SEQ * 8;
constexpr int W = 1 << 30;

#define KSWZ(row, colB) ((row) * 256 + ((colB) ^ (((row) & 7) << 4)))
#define SBAR() __builtin_amdgcn_sched_barrier(0)
__device__ __forceinline__ int v_st(int k, int c) { const int kk = (k & ~0xC) | ((k & 4) << 1) | ((k & 8) >> 1); return ((kk >> 3) * 4 + (c >> 5)) * 512 + ((kk & 7) * 32 + (c & 31)) * 2; }
__device__ __forceinline__ int v_rd_base(int lane) { return ((lane & 3) << 3) | (((lane >> 2) & 3) << 6) | (((lane >> 4) & 1) << 5) | (((lane >> 5) & 1) << 8); }
constexpr int v_rd_off(int d0, int ks, int half) { return d0 * 512 + ks * 4096 + half * 2048; }
__device__ __forceinline__ int crow(int r, int hi) { return (r & 3) + 8 * (r >> 2) + 4 * hi; }
__device__ __forceinline__ unsigned cvtpk(float lo, float hi) { unsigned r; asm volatile("v_cvt_pk_bf16_f32 %0, %1, %2" : "=v"(r) : "v"(lo), "v"(hi)); return r; }
__device__ __forceinline__ bf16x8 load8(const bf16* p) { return *reinterpret_cast<const bf16x8*>(p); }
__device__ __forceinline__ void mask_tile(f32x16& p0, f32x16& p1, int dq, unsigned Wm) {
    const float NEG = -__builtin_inff();
#pragma unroll
    for (int r = 0; r < 16; ++r) {
        const int c = (r & 3) + 8 * (r >> 2);
        if ((unsigned)(dq - c) >= Wm) p0[r] = NEG;
        if ((unsigned)(dq - c - 32) >= Wm) p1[r] = NEG;
    }
}
__device__ __forceinline__ void split3(float x, unsigned& w0, unsigned& w1) {
    const unsigned xh = cvtpk(x, 0.f) & 0xffffu; const float r1 = x - __uint_as_float(xh << 16);
    const unsigned xm = cvtpk(r1, 0.f) & 0xffffu; const float r2 = r1 - __uint_as_float(xm << 16);
    w0 = xh | (xm << 16); w1 = cvtpk(r2, 0.f) & 0xffffu;
}
__device__ __forceinline__ bf16x8 make_negB(float m_ref, int hi) {
    unsigned n0, n1; split3(-m_ref, n0, n1);
    u32x4 w = {0x3F803F80u, 0x00003F80u | (n0 << 16), (n0 >> 16) | (n1 << 16), 0u};
    if (hi) w = (u32x4){0u, 0u, 0u, 0u};
    return *reinterpret_cast<bf16x8*>(&w);
}
__device__ __forceinline__ void trackmax(const f32x16& p0, const f32x16& p1, bool track, float& mrun) {
    if (track) { float pmax = p0[0]; for (int r = 1; r < 16; ++r) pmax = fmaxf(pmax, p0[r]); for (int r = 0; r < 16; ++r) pmax = fmaxf(pmax, p1[r]);
        auto rr = __builtin_amdgcn_permlane32_swap(__float_as_uint(pmax), __float_as_uint(pmax), false, false);
        mrun = fmaxf(mrun, fmaxf(__uint_as_float(rr[0]), __uint_as_float(rr[1]))); }
}
__device__ __forceinline__ void partialSM(f32x16& p0) {
    for (int r = 0; r < 16; ++r) p0[r] = __builtin_amdgcn_exp2f(p0[r]);
}
__device__ __forceinline__ void finishSM(f32x16& p0, f32x16& p1, float& l_reg, bf16x8& pa0, bf16x8& pa1, bf16x8& pa2, bf16x8& pa3) {
    for (int r = 0; r < 16; ++r) p1[r] = __builtin_amdgcn_exp2f(p1[r]);
    float ps = 0; for (int r = 0; r < 16; ++r) ps += p0[r]; for (int r = 0; r < 16; ++r) ps += p1[r];
    { auto rr = __builtin_amdgcn_permlane32_swap(__float_as_uint(ps), __float_as_uint(ps), false, false);
      ps = __uint_as_float(rr[0]) + __uint_as_float(rr[1]); }
    l_reg += ps;
#define PK4(P, B_, OUT) do { unsigned a0 = cvtpk(P[B_+0], P[B_+1]), a1 = cvtpk(P[B_+2], P[B_+3]);                          \
        unsigned b0 = cvtpk(P[B_+4], P[B_+5]), b1 = cvtpk(P[B_+6], P[B_+7]);                                             \
        auto r0 = __builtin_amdgcn_permlane32_swap(a0, b0, false, false); auto r1 = __builtin_amdgcn_permlane32_swap(a1, b1, false, false); \
        u32x4 w = {r0[0], r1[0], r0[1], r1[1]}; OUT = *reinterpret_cast<bf16x8*>(&w); } while (0)
    PK4(p0, 0, pa0); PK4(p0, 8, pa1); PK4(p1, 0, pa2); PK4(p1, 8, pa3);
#undef PK4
}
#define KRD(dst, a, off) asm volatile("ds_read_b128 %0, %1 offset:%2" : "=&v"(dst) : "v"(a), "i"(off) : "memory")
#define KWAIT(f0, f1, n) asm volatile("s_waitcnt lgkmcnt(%2)" : "+v"(f0), "+v"(f1) : "i"(n) : "memory")
#ifdef ATT_QKT_ORIG
#define qkt qkt_c
#endif
template <int KB>
__device__ __forceinline__ void qkt_c(f32x16& p0, f32x16& p1, const int (&ka)[4], const bf16x8* qr, const char* fb, bf16x8 ones) {
    p0 = f32x16{}; p1 = f32x16{};
#pragma unroll
    for (int d0 = 0; d0 < 8; ++d0) { const __attribute__((address_space(3))) char* a = (const __attribute__((address_space(3))) char*)(uintptr_t)(unsigned)ka[d0 & 3] + KB * SHM_K + (d0 >> 2) * 128;
        bf16x8 b0 = *reinterpret_cast<const __attribute__((address_space(3))) bf16x8*>(a);
        bf16x8 b1 = *reinterpret_cast<const __attribute__((address_space(3))) bf16x8*>(a + 32 * 256);
        p0 = __builtin_amdgcn_mfma_f32_32x32x16_bf16(b0, qr[d0], p0, 0, 0, 0);
        p1 = __builtin_amdgcn_mfma_f32_32x32x16_bf16(b1, qr[d0], p1, 0, 0, 0); }
    { const u32x2 t0 = *reinterpret_cast<const u32x2*>(fb), t1 = *reinterpret_cast<const u32x2*>(fb + 32 * 8);
      u32x4 w0 = {t0.x, t0.y, 0x3F803F80u, 0u}, w1 = {t1.x, t1.y, 0x3F803F80u, 0u};
      p0 = __builtin_amdgcn_mfma_f32_32x32x16_bf16(*reinterpret_cast<bf16x8*>(&w0), ones, p0, 0, 0, 0);
      p1 = __builtin_amdgcn_mfma_f32_32x32x16_bf16(*reinterpret_cast<bf16x8*>(&w1), ones, p1, 0, 0, 0); }
}
#ifndef ATT_QKT_ORIG
template <int KB>
__device__ __forceinline__ void qkt(f32x16& p0, f32x16& p1, const int (&ka)[4], const bf16x8* qr, const char* fb, bf16x8 ones) {
    p0 = f32x16{}; p1 = f32x16{};
    bf16x8 fa0, fa1, fb0, fb1, fc0, fc1;
#define KOFF(d0) (KB * SHM_K + ((d0) >> 2) * 128)
#define KLD(x0, x1, d0) do { KRD(x0, ka[(d0) & 3], KOFF(d0)); KRD(x1, ka[(d0) & 3], KOFF(d0) + 32 * 256); } while (0)
#ifdef ATT_QKT_SBAR
#define KMM(x0, x1, d0, n) do { asm volatile("s_waitcnt lgkmcnt(%0)" :: "i"(n) : "memory"); SBAR(); p0 = __builtin_amdgcn_mfma_f32_32x32x16_bf16(x0, qr[d0], p0, 0, 0, 0); p1 = __builtin_amdgcn_mfma_f32_32x32x16_bf16(x1, qr[d0], p1, 0, 0, 0); SBAR(); } while (0)
#else
#define KMM(x0, x1, d0, n) do { KWAIT(x0, x1, n); p0 = __builtin_amdgcn_mfma_f32_32x32x16_bf16(x0, qr[d0], p0, 0, 0, 0); p1 = __builtin_amdgcn_mfma_f32_32x32x16_bf16(x1, qr[d0], p1, 0, 0, 0); } while (0)
#endif
    KLD(fa0, fa1, 0); KLD(fb0, fb1, 1); KLD(fc0, fc1, 2);
    KMM(fa0, fa1, 0, 4); KLD(fa0, fa1, 3);
    KMM(fb0, fb1, 1, 4); KLD(fb0, fb1, 4);
    KMM(fc0, fc1, 2, 4); KLD(fc0, fc1, 5);
    KMM(fa0, fa1, 3, 4); KLD(fa0, fa1, 6);
    KMM(fb0, fb1, 4, 4); KLD(fb0, fb1, 7);
    KMM(fc0, fc1, 5, 4);
    KMM(fa0, fa1, 6, 2);
    KMM(fb0, fb1, 7, 0);
#undef KMM
#undef KLD
#undef KOFF
    { const u32x2 t0 = *reinterpret_cast<const u32x2*>(fb), t1 = *reinterpret_cast<const u32x2*>(fb + 32 * 8);
      u32x4 w0 = {t0.x, t0.y, 0x3F803F80u, 0u}, w1 = {t1.x, t1.y, 0x3F803F80u, 0u};
      p0 = __builtin_amdgcn_mfma_f32_32x32x16_bf16(*reinterpret_cast<bf16x8*>(&w0), ones, p0, 0, 0, 0);
      p1 = __builtin_amdgcn_mfma_f32_32x32x16_bf16(*reinterpret_cast<bf16x8*>(&w1), ones, p1, 0, 0, 0); }
}
#endif
template <int KB>
__device__ __forceinline__ void qkt_sm(f32x16& p0, f32x16& p1, const int (&ka)[4], const bf16x8* qr, const char* fb, bf16x8 ones,
                                       f32x16& y0, f32x16& y1, float& l_reg, bf16x8& pa0, bf16x8& pa1, bf16x8& pa2, bf16x8& pa3) {
    p0 = f32x16{}; p1 = f32x16{};
    bf16x8 fa0, fa1, fb0, fb1, fc0, fc1; float ps;
#define KOFF(d0) (KB * SHM_K + ((d0) >> 2) * 128)
#define KLD(x0, x1, d0) do { KRD(x0, ka[(d0) & 3], KOFF(d0)); KRD(x1, ka[(d0) & 3], KOFF(d0) + 32 * 256); } while (0)
#define KMM(x0, x1, d0, n) asm volatile("s_waitcnt lgkmcnt(%0)" :: "i"(n) : "memory"); SBAR(); p0 = __builtin_amdgcn_mfma_f32_32x32x16_bf16(x0, qr[d0], p0, 0, 0, 0); p1 = __builtin_amdgcn_mfma_f32_32x32x16_bf16(x1, qr[d0], p1, 0, 0, 0);
#define PK4(P, B_, OUT) do { unsigned a0 = cvtpk(P[B_+0], P[B_+1]), a1 = cvtpk(P[B_+2], P[B_+3]);                          \
        unsigned b0 = cvtpk(P[B_+4], P[B_+5]), b1 = cvtpk(P[B_+6], P[B_+7]);                                             \
        auto r0 = __builtin_amdgcn_permlane32_swap(a0, b0, false, false); auto r1 = __builtin_amdgcn_permlane32_swap(a1, b1, false, false); \
        u32x4 w = {r0[0], r1[0], r0[1], r1[1]}; OUT = *reinterpret_cast<bf16x8*>(&w); } while (0)
#define EX4(B_) do { y1[B_] = __builtin_amdgcn_exp2f(y1[B_]); y1[B_+1] = __builtin_amdgcn_exp2f(y1[B_+1]); y1[B_+2] = __builtin_amdgcn_exp2f(y1[B_+2]); y1[B_+3] = __builtin_amdgcn_exp2f(y1[B_+3]); \
        ps += (y1[B_] + y1[B_+1]) + (y1[B_+2] + y1[B_+3]); } while (0)
    KLD(fa0, fa1, 0); KLD(fb0, fb1, 1); KLD(fc0, fc1, 2);
    KMM(fa0, fa1, 0, 4) ps = (((y0[0] + y0[1]) + (y0[2] + y0[3])) + ((y0[4] + y0[5]) + (y0[6] + y0[7]))) + (((y0[8] + y0[9]) + (y0[10] + y0[11])) + ((y0[12] + y0[13]) + (y0[14] + y0[15]))); SBAR(); KLD(fa0, fa1, 3);
    KMM(fb0, fb1, 1, 4) PK4(y0, 0, pa0); PK4(y0, 8, pa1); SBAR(); KLD(fb0, fb1, 4);
    KMM(fc0, fc1, 2, 4) EX4(0); SBAR(); KLD(fc0, fc1, 5);
    KMM(fa0, fa1, 3, 4) EX4(4); SBAR(); KLD(fa0, fa1, 6);
    KMM(fb0, fb1, 4, 4) EX4(8); SBAR(); KLD(fb0, fb1, 7);
    KMM(fc0, fc1, 5, 4) EX4(12); SBAR();
    KMM(fa0, fa1, 6, 2) PK4(y1, 0, pa2); SBAR();
    KMM(fb0, fb1, 7, 0) PK4(y1, 8, pa3);
    { auto rr = __builtin_amdgcn_permlane32_swap(__float_as_uint(ps), __float_as_uint(ps), false, false); ps = __uint_as_float(rr[0]) + __uint_as_float(rr[1]); }
    l_reg += ps; SBAR();
#undef EX4
#undef PK4
#undef KMM
#undef KLD
#undef KOFF
    { const u32x2 t0 = *reinterpret_cast<const u32x2*>(fb), t1 = *reinterpret_cast<const u32x2*>(fb + 32 * 8);
      u32x4 w0 = {t0.x, t0.y, 0x3F803F80u, 0u}, w1 = {t1.x, t1.y, 0x3F803F80u, 0u};
      p0 = __builtin_amdgcn_mfma_f32_32x32x16_bf16(*reinterpret_cast<bf16x8*>(&w0), ones, p0, 0, 0, 0);
      p1 = __builtin_amdgcn_mfma_f32_32x32x16_bf16(*reinterpret_cast<bf16x8*>(&w1), ones, p1, 0, 0, 0); }
}
template <bool EX = true>
__device__ __forceinline__ void pv_tile(f32x16* o, int vb0  , bf16x8 pa0, bf16x8 pa1, bf16x8 pa2, bf16x8 pa3, f32x16& px) {
#define TRRD(dst, off) asm volatile("ds_read_b64_tr_b16 %0, %1 offset:%2" : "=&v"(dst) : "v"(vb0), "i"(off) : "memory")
#define VLD(x0, x1, x2, x3, hg) do { constexpr int b_ = v_rd_off((hg) >> 1, 2 * ((hg) & 1), 0); TRRD(x0, b_); TRRD(x1, b_ + 2048); TRRD(x2, b_ + 4096); TRRD(x3, b_ + 6144); } while (0)
#define VMM(x0, x1, x2, x3, hg, pq0, pq1, n) do { asm volatile("s_waitcnt lgkmcnt(%0)" :: "i"(n) : "memory"); SBAR();                                   \
        o[(hg) >> 1] = __builtin_amdgcn_mfma_f32_32x32x16_bf16(pq0, (bf16x8){x0[0], x0[1], x0[2], x0[3], x1[0], x1[1], x1[2], x1[3]}, o[(hg) >> 1], 0, 0, 0);                        \
        if (EX) px[2 * (hg)] = __builtin_amdgcn_exp2f(px[2 * (hg)]);                                                                                                                \
        o[(hg) >> 1] = __builtin_amdgcn_mfma_f32_32x32x16_bf16(pq1, (bf16x8){x2[0], x2[1], x2[2], x2[3], x3[0], x3[1], x3[2], x3[3]}, o[(hg) >> 1], 0, 0, 0);                        \
        if (EX) { px[2 * (hg) + 1] = __builtin_amdgcn_exp2f(px[2 * (hg) + 1]); asm volatile("" : "+v"(px[2 * (hg)]), "+v"(px[2 * (hg) + 1])); }     \
        SBAR(); } while (0)
    s16x4 a0, a1, a2, a3, b0, b1, b2, b3;
    VLD(a0, a1, a2, a3, 0); VLD(b0, b1, b2, b3, 1);
    VMM(a0, a1, a2, a3, 0, pa0, pa1, 4); VLD(a0, a1, a2, a3, 2);
    VMM(b0, b1, b2, b3, 1, pa2, pa3, 4); VLD(b0, b1, b2, b3, 3);
    VMM(a0, a1, a2, a3, 2, pa0, pa1, 4); VLD(a0, a1, a2, a3, 4);
    VMM(b0, b1, b2, b3, 3, pa2, pa3, 4); VLD(b0, b1, b2, b3, 5);
    VMM(a0, a1, a2, a3, 4, pa0, pa1, 4); VLD(a0, a1, a2, a3, 6);
    VMM(b0, b1, b2, b3, 5, pa2, pa3, 4); VLD(b0, b1, b2, b3, 7);
    VMM(a0, a1, a2, a3, 6, pa0, pa1, 4);
    VMM(b0, b1, b2, b3, 7, pa2, pa3, 0);
#undef VMM
#undef VLD
#undef TRRD
}
struct BlockRef { const bf16* Q; const bf16* K; const bf16* V; bf16* O; int P0; const float* F; };
struct Seam { bf16x8 qr[8]; bf16x8 st_v0, st_v1, st_k0, st_k1; };
#define ROW(p, k0, rr) ((p) + (size_t)((k0) + (rr)) * PITCH + sc)
#define VMW() asm volatile("s_waitcnt vmcnt(0)" ::: "memory")
#define VMWN(n) asm volatile("s_waitcnt vmcnt(%0)" :: "i"(n) : "memory")
#define SLOAD_H(Kp, Vp, k0) do { S.st_v0 = load8(ROW(Vp, k0, sr)); S.st_v1 = load8(ROW(Vp, k0, 32 + sr));              \
                         S.st_k0 = load8(ROW(Kp, k0, sr)); S.st_k1 = load8(ROW(Kp, k0, 32 + sr)); } while (0)
#define SWRITE_HK(bf) do { *(bf16x8*)(K_lds + (bf) * SHM_K + kws) = S.st_k0; *(bf16x8*)(K_lds + (bf) * SHM_K + kws + 32 * 256) = S.st_k1; } while (0)
#define SWRITE_HV(off) do { *(bf16x8*)(V_lds + (off) + vst0) = S.st_v0; *(bf16x8*)(V_lds + (off) + vst1) = S.st_v1; } while (0)
__device__ __forceinline__ void prime(const BlockRef& cur, char* lds, Seam& S) {
    int tid_ = threadIdx.x; asm volatile("" : "+v"(tid_));
    const int tid = tid_, wid = __builtin_amdgcn_readfirstlane(tid >> 6), lane = tid & 63, r32 = lane & 31, hi = lane >> 5;
    const int sr = tid >> 4, sc = (tid & 15) * 8, kws = KSWZ(sr, sc * 2); char* K_lds = lds + NVB * SHM_V;
    for (int d0 = 0; d0 < 8; ++d0) S.qr[d0] = load8(cur.Q + (size_t)(wid * QBLK + r32) * PITCH + d0 * 16 + hi * 8);
    SLOAD_H(cur.K, cur.V, cur.P0 + QB - KVBLK); VMW(); SWRITE_HK(0);
    __syncthreads();
}
__device__ __forceinline__ void block(const BlockRef& cur, const BlockRef& nxt, char* lds, Seam& S, float thr2) {
    int tid_ = threadIdx.x; asm volatile("" : "+v"(tid_));
    const int tid = tid_, wid = __builtin_amdgcn_readfirstlane(tid >> 6), lane = tid & 63, r32 = lane & 31, hi = lane >> 5;
    const int NTB = cur.P0 / KVBLK + 4; int NT = NTB;
    const int qlo = cur.P0 + wid * QBLK, qm = qlo + r32 - 4 * hi;
    char* V_lds = lds; char* K_lds = lds + NVB * SHM_V;
    float* ws = (float*)(lds + LDS_WS) + wid * 64; float* li_l = ws, * al_l = ws + 32;
    const char* FBl = lds + LDS_FB + r32 * 8;
    const float f_row = cur.F[cur.P0 + wid * QBLK + r32];
    {
        const float* Fcum = cur.F; const int s_end = cur.P0 + QB;
        for (int s = tid * 4; s < s_end; s += 2048) {
            const f32x4 f4 = *(const f32x4*)(Fcum + s); unsigned w0, w1, w2, w3, w4, w5, w6, w7;
            split3(-f4.x * LOG2E, w0, w1); split3(-f4.y * LOG2E, w2, w3); split3(-f4.z * LOG2E, w4, w5); split3(-f4.w * LOG2E, w6, w7);
            *(u32x4*)(lds + LDS_FB + s * 8) = (u32x4){w0, w1 | 0x3F800000u, w2, w3 | 0x3F800000u}; *(u32x4*)(lds + LDS_FB + s * 8 + 16) = (u32x4){w4, w5 | 0x3F800000u, w6, w7 | 0x3F800000u}; }
        __syncthreads();
    }
    float m_reg = -f_row * LOG2E, l_reg = 0; f32x16 o[4] = {};
    bf16x8 ones = make_negB(m_reg, hi);
    const int sr = tid >> 4, sc = (tid & 15) * 8, vst0 = v_st(sr, sc), vst1 = v_st(32 + sr, sc), kws = KSWZ(sr, sc * 2);
    const int vb0 = (int)(uintptr_t)V_lds + v_rd_base(lane);
    int ka[4];
#pragma unroll
    for (int dd = 0; dd < 4; ++dd) ka[dd] = (int)(uintptr_t)K_lds + KSWZ(r32, (dd * 16 + hi * 8) * 2);
    const bf16* Kh = cur.K; const bf16* Vh = cur.V;
#define KBASE(t) ((NTB - 1 - (t)) * KVBLK)
#define MASKT(P0_, P1_, t) do { const int kb_ = KBASE(t); if (kb_ + KVBLK - 1 > qlo) mask_tile(P0_, P1_, qm - kb_, (unsigned)W); } while (0)
    constexpr int NQL = 8;
#define SEAM_K0() do { VMWN(NQL); SWRITE_HK(0); SBAR(); } while (0)
    f32x16 pA0, pA1, pB0, pB1; bf16x8 pa0, pa1, pa2, pa3; float mrun = -3.0e38f;
    SWRITE_HV(0); SBAR();
    if (NT > 1) { SLOAD_H(Kh, Vh, KBASE(1)); }
    SBAR(); qkt<0>(pA0, pA1, ka, S.qr, FBl + KBASE(0) * 8, ones);
    MASKT(pA0, pA1, 0); trackmax(pA0, pA1, true, mrun); partialSM(pA0);
    if (NT > 1) { VMW(); SWRITE_HK(1); SWRITE_HV(SHM_V); }
    __syncthreads();
    int vr = 0, vw = 2 * SHM_V;
#define VNEXT(x) ((x) == (NVB - 1) * SHM_V ? 0 : (x) + SHM_V)
#define HALF_STEP(PX0, PX1, PY0, PY1, t, KB) do {                                                      \
        SBAR(); qkt_sm<KB>(PX0, PX1, ka, S.qr, FBl + KBASE(t) * 8, ones, PY0, PY1, l_reg, pa0, pa1, pa2, pa3); SBAR();                                             \
        if ((t) + 1 < NT) { SLOAD_H(Kh, Vh, KBASE((t) + 1)); SBAR(); }                                               \
        MASKT(PX0, PX1, (t)); trackmax(PX0, PX1, (t) <= 4, mrun); SBAR(); pv_tile<true>(o, vb0 + vr, pa0, pa1, pa2, pa3, PX0);                                        \
        if ((t) + 1 < NT) { VMW(); SWRITE_HK((KB) ^ 1); SWRITE_HV(vw); }     \
        vr = VNEXT(vr); vw = VNEXT(vw);                                                                                        \
        __syncthreads(); } while (0)
    for (int t = 1; t + 1 < NT; t += 2) {
        HALF_STEP(pB0, pB1, pA0, pA1, t, 1);
        HALF_STEP(pA0, pA1, pB0, pB1, t + 1, 0);
#ifndef ATT_NO_EARLY_EXIT
        if (t == 3 && NT > 6) {
            float c = mrun + m_reg;
            c = fminf(c, lane_xor<1>(c)); c = fminf(c, lane_xor<2>(c)); c = fminf(c, lane_xor<4>(c)); c = fminf(c, lane_xor<8>(c)); c = fminf(c, lane_xor<16>(c));
            if (lane == 0) al_l[0] = c;
            __syncthreads();
            float cb = ((const float*)(lds + LDS_WS))[(lane & 7) * 64 + 32];
            cb = fminf(cb, lane_xor<1>(cb)); cb = fminf(cb, lane_xor<2>(cb)); cb = fminf(cb, lane_xor<4>(cb));
            const float lim = cb - thr2;
            const int ti = 5 + 2 * lane, kbi = (NTB - 1 - ti) * KVBLK; bool ok = false;
            if (kbi >= KVBLK) { const u32x2 w = *(const u32x2*)(lds + LDS_FB + (kbi - 1) * 8);
                const float bk = (__uint_as_float(w.x << 16) + __uint_as_float(w.x & 0xffff0000u)) + __uint_as_float(w.y << 16); ok = bk <= lim; }
            const unsigned long long mk = __ballot(ok);
            if (mk) NT = __builtin_amdgcn_readfirstlane(4 + 2 * (int)__ffsll((long long)mk));
        }
#endif
    }
    constexpr bool even = true;
    if (even) { SBAR(); qkt_c<1>(pB0, pB1, ka, S.qr, FBl + KBASE(NT - 1) * 8, ones); SBAR(); }
    SLOAD_H(nxt.K, nxt.V, nxt.P0 + QB - KVBLK); SBAR();
#pragma unroll
    for (int d0 = 0; d0 < 8; ++d0) S.qr[d0] = load8(nxt.Q + (size_t)(wid * QBLK + r32) * PITCH + d0 * 16 + hi * 8);
    SBAR();
    finishSM(pA0, pA1, l_reg, pa0, pa1, pa2, pa3); SBAR();
    MASKT(pB0, pB1, NT - 1); SBAR();
    pv_tile<true>(o, vb0 + vr, pa0, pa1, pa2, pa3, pB0); vr = VNEXT(vr);
    if (even) { __syncthreads();
        finishSM(pB0, pB1, l_reg, pa0, pa1, pa2, pa3); SBAR(); pv_tile<false>(o, vb0 + vr, pa0, pa1, pa2, pa3, pB0); }
    SBAR(); SEAM_K0();
    if (hi == 0) li_l[r32] = l_reg; asm volatile("s_waitcnt lgkmcnt(0)" ::: "memory");
    float rli[16];
#pragma unroll
    for (int r = 0; r < 16; ++r) rli[r] = __builtin_amdgcn_rcpf(li_l[crow(r, hi)]);
    bf16* Ow = cur.O + (size_t)(wid * QBLK) * PITCH;
#pragma unroll
    for (int r = 0; r < 16; ++r) { const int orow = crow(r, hi);
#pragma unroll
        for (int d0 = 0; d0 < 4; ++d0) { const float v = o[d0][r] * rli[r];
            const float vn = __uint_as_float(__builtin_amdgcn_update_dpp(0u, __float_as_uint(v), 0xB1  , 0xF, 0xF, true));
            if ((r32 & 1) == 0) *(unsigned*)(Ow + (size_t)orow * PITCH + d0 * 32 + r32) = cvtpk(v, vn); } }
    __syncthreads();
#undef KBASE
#undef MASKT
#undef SEAM_K0
#undef HALF_STEP
}
#undef ROW
#undef VMW
#undef VMWN
#undef SLOAD_H
#undef SWRITE_HK
#undef SWRITE_HV
#undef SWRITE_H
}


constexpr int NWAVES = 8;
#ifndef MK_N_LAUNCHES
#define MK_N_LAUNCHES 1
#endif
constexpr int BATCH = 8, SEQ = 4096, D = 2048, M = BATCH * SEQ, DEPTH = 4, NA = 2;
constexpr int GH = 3 * D  , GN = 2 * GH  , NG = 8, GD = GH / NG  , GB = 128;
constexpr int NH = 16, HD = 128, FF = 4 * D, NMOD = 6 * D;
constexpr float EPS = 1e-6f;
constexpr size_t MiB = 1u << 20;
constexpr size_t WS_CTL = 0, CTL_ZERO_BYTES = 1 * MiB;
constexpr size_t WS_MOD = 1 * MiB;
constexpr size_t WS_KVMOD = WS_MOD + (size_t)DEPTH * BATCH * NMOD * 4;
constexpr size_t WS_WSM = 3 * MiB;
constexpr size_t WS_LOGF = 4 * MiB, WS_FB = 6 * MiB;
constexpr size_t WS_VSTAT = 8 * MiB;
constexpr size_t WS_JLO = 32 * MiB;
constexpr size_t WS_WT = 40 * MiB;
constexpr size_t WT_WIN = 0, WT_WOUT = WT_WIN + (size_t)2 * GN * D, WT_W1 = WT_WOUT + (size_t)2 * D * GH, WT_W2 = WT_W1 + (size_t)4 * FF * D,
                 WT_WKV = WT_W2 + (size_t)4 * D * FF, WT_WQ = WT_WKV + (size_t)2 * D * D, WT_WO = WT_WQ + (size_t)2 * D * D, WT_END = WT_WO + (size_t)2 * D * D;
static_assert(WT_END * 2 == 448 * MiB, "weights");
constexpr size_t WS_H = 488 * MiB;
constexpr size_t WS_Z = 616 * MiB;
constexpr size_t WS_U = WS_Z, WS_V = WS_Z + 384 * MiB;
constexpr size_t WS_HID = WS_Z;
constexpr size_t WS_Q = WS_Z, WS_O = WS_Z + 128 * MiB, WS_HKV = WS_Z + 256 * MiB, WS_KB = WS_Z + 512 * MiB, WS_VB = WS_Z + 640 * MiB;
constexpr size_t WS_DELTA = WS_Z + 768 * MiB;
constexpr size_t WS_END = WS_Z + 896 * MiB;
constexpr int CW_BAR = 4096;
constexpr int CW_QUEUE = 65536;
static_assert(CW_BAR + 9 * 3456 <= CW_QUEUE && (CW_QUEUE + 4 * 512) * 4 <= 512 * 1024, "control words: barrier regions, queue heads and the zero page (at 512 KiB) must not overlap");
constexpr int RING_BYTES = 131072, LDS_BYTES = 163840, LDSCTL_OFF = LDS_BYTES - 512, MISC_OFF = LDSCTL_OFF + 320;

#define GAS __attribute__((address_space(1)))
#define LAS __attribute__((address_space(3)))
typedef unsigned short bf16;
typedef unsigned v4u __attribute__((ext_vector_type(4)));
typedef unsigned v2u __attribute__((ext_vector_type(2)));
typedef float f32x4 __attribute__((ext_vector_type(4)));
typedef float f32x2 __attribute__((ext_vector_type(2)));
typedef short bf16x8 __attribute__((ext_vector_type(8)));
typedef short s16x4 __attribute__((ext_vector_type(4)));
typedef float f32x16 __attribute__((ext_vector_type(16)));
typedef GAS unsigned gu32;
#define RLX_AGENT __ATOMIC_RELAXED, __HIP_MEMORY_SCOPE_AGENT
#define LDS_WAIT() asm volatile("s_waitcnt lgkmcnt(0)" ::: "memory")
#define VM_WAIT() asm volatile("s_waitcnt vmcnt(0)" ::: "memory")
#define RAW_BAR() do { asm volatile("s_waitcnt lgkmcnt(0)" ::: "memory"); __builtin_amdgcn_s_barrier(); asm volatile("" ::: "memory"); } while (0)
__device__ __forceinline__ unsigned f2bf(float f) { unsigned u = __builtin_bit_cast(unsigned, f); return (u + 0x7fffu + ((u >> 16) & 1u)) >> 16; }
__device__ __forceinline__ unsigned pk2(float lo, float hi) { unsigned r; asm volatile("v_cvt_pk_bf16_f32 %0, %1, %2" : "=v"(r) : "v"(lo), "v"(hi)); return r; }
__device__ __forceinline__ float bflo(unsigned w) { return __uint_as_float(w << 16); }
__device__ __forceinline__ float bfhi(unsigned w) { return __uint_as_float(w & 0xffff0000u); }

#define XB_TMO      128
#define XB_XCNT(j)  (256  + 64 * (j))
#define XB_XSUB(j)  (1280 + 64 * (j))
#define XB_XGEN(j)  (2304 + 64 * (j))
#define XB_TOP      3328
#define XB_TOPGEN   3392
#define XCD_BAR_WORDS 3456
#define XB_SPIN_CAP (1u << 18)
__device__ __forceinline__ unsigned xb_ld(unsigned* p)              { return __hip_atomic_load(p, __ATOMIC_RELAXED, __HIP_MEMORY_SCOPE_AGENT); }
__device__ __forceinline__ unsigned xb_add(unsigned* p, unsigned v) { return __hip_atomic_fetch_add(p, v, __ATOMIC_RELAXED, __HIP_MEMORY_SCOPE_AGENT); }
__device__ __forceinline__ unsigned xb_xcc_id() { return (unsigned)__builtin_amdgcn_s_getreg((3 << 11) | 20) & 0xFu; }
#define XB_SPIN(cond, bar) do { unsigned _sp = 0; while (cond) { __builtin_amdgcn_s_sleep(1); \
    if ((++_sp & 255u) == 0u) { if (xb_ld(&(bar)[XB_TMO])) break; if (_sp > XB_SPIN_CAP) { atomicAdd(&(bar)[XB_TMO], 1u); break; } } } } while (0)
struct XcdBarrier { unsigned* bar; unsigned x; volatile LAS unsigned* st; unsigned gsize; };
__device__ __forceinline__ XcdBarrier xcd_barrier_post(unsigned* bar, volatile LAS unsigned* st, unsigned gsize) {
    XcdBarrier b; b.bar = bar; b.x = xb_xcc_id(); b.st = st; b.gsize = gsize;
    if (threadIdx.x == 0) (void)xb_add(&bar[XB_XCNT(b.x)], 1u);
    return b;
}
__device__ __forceinline__ void xcd_barrier_complete(unsigned* bar, unsigned x, unsigned G, unsigned& nloc, unsigned& nx) {
    unsigned sum, cnt, mine, sp = 0u;
    for (;;) {
        sum = 0u; cnt = 0u; mine = 0u;
#pragma unroll
        for (unsigned j = 0; j < 16; ++j) { const unsigned c = xb_ld(&bar[XB_XCNT(j)]); sum += c; cnt += (c > 0u) ? 1u : 0u; }
        mine = xb_ld(&bar[XB_XCNT(x)]);
        if (sum == G) break;
        __builtin_amdgcn_s_sleep(1);
        if ((++sp & 255u) == 0u) { if (xb_ld(&bar[XB_TMO])) break; if (sp > XB_SPIN_CAP) { atomicAdd(&bar[XB_TMO], 1u); break; } }
    }
    nloc = mine > 0u ? mine : 1u; nx = cnt > 0u ? cnt : 1u;
}
__device__ __forceinline__ void xcd_barrier(const XcdBarrier& b) {
    asm volatile("s_waitcnt vmcnt(0)" ::: "memory");
    __syncthreads();
    if (threadIdx.x == 0) {
        unsigned* bar = b.bar;
        __builtin_amdgcn_s_waitcnt(0);
        unsigned nloc = b.st[0], nx = b.st[1];
        if (nloc == 0u) { xcd_barrier_complete(bar, b.x, b.gsize, nloc, nx); b.st[0] = nloc; b.st[1] = nx; }
        const unsigned old = xb_add(&bar[XB_XSUB(b.x)], 1u);
        const unsigned gen = old / nloc;
        if (old + 1u == (gen + 1u) * nloc) {
            __builtin_amdgcn_fence(__ATOMIC_RELEASE, "agent");
            asm volatile("s_waitcnt vmcnt(0)" ::: "memory");
            const unsigned og = xb_add(&bar[XB_TOP], 1u);
            const unsigned tg = og / nx;
            if (og + 1u == (tg + 1u) * nx) xb_add(&bar[XB_TOPGEN], 1u);
            else XB_SPIN(xb_ld(&bar[XB_TOPGEN]) == tg, bar);
            __builtin_amdgcn_fence(__ATOMIC_ACQUIRE, "agent");
            xb_add(&bar[XB_XGEN(b.x)], 1u);
            asm volatile("s_waitcnt vmcnt(0)" ::: "memory");
        } else {
            XB_SPIN(xb_ld(&bar[XB_XGEN(b.x)]) == gen, bar);
            __builtin_amdgcn_fence(__ATOMIC_ACQUIRE, "agent");
            asm volatile("s_waitcnt vmcnt(0)" ::: "memory");
        }
    }
    __syncthreads();
}

struct Frame {
    LAS unsigned char* lds;
    int vcu, G;
};
constexpr int PT_OUT = 23, PT_WS = 24;
template <class T> __device__ __forceinline__ T* ldptr(const Frame& F, int i) {
    const unsigned long long v = ((const LAS unsigned long long*)(F.lds + LDSCTL_OFF))[i];
    const unsigned lo = __builtin_amdgcn_readfirstlane((unsigned)v), hi = __builtin_amdgcn_readfirstlane((unsigned)(v >> 32));
    return (T*)(GAS T*)(((unsigned long long)hi << 32) | lo);
}
#define INP(i) ldptr<const float>(F, (i))
#define WSP() ldptr<unsigned char>(F, PT_WS)
#define PHASE_IDS int tid_ = threadIdx.x; asm volatile("" : "+v"(tid_)); const int tid = tid_, lane = tid & 63, wave = __builtin_amdgcn_readfirstlane(tid >> 6); (void)lane; (void)wave;
__device__ __forceinline__ float wave_sum(float v) {
    v += lane_xor<1>(v); v += lane_xor<2>(v); v += lane_xor<4>(v); v += lane_xor<8>(v); v += lane_xor<16>(v);
    return lane_sum_halves(v);
}
__device__ __forceinline__ void p0_transpose_item(const GAS float* W, int K, int N, bf16* WT, LAS float* scr, int item, int lane) {
    const int nblk = N / 32, kb = item / nblk, nb = item % nblk, k0 = 64 * kb, n0 = 32 * nb;
#pragma unroll 8
    for (int i = 0; i < 32; ++i) { const int kk = 2 * i + (lane >> 5); scr[kk * 33 + (lane & 31)] = W[(size_t)(k0 + kk) * N + n0 + (lane & 31)]; }
    LDS_WAIT(); asm volatile("" ::: "memory");
    const int c = lane & 7;
#pragma unroll
    for (int j = 0; j < 4; ++j) { const int n = (lane >> 3) + 8 * j; const LAS float* s = scr + (8 * c) * 33 + n;
        v4u o; o.x = pk2(s[0 * 33], s[1 * 33]); o.y = pk2(s[2 * 33], s[3 * 33]); o.z = pk2(s[4 * 33], s[5 * 33]); o.w = pk2(s[6 * 33], s[7 * 33]);
        if (PG8_BT) *(GAS v4u*)(WT + ((size_t)((n0 + n) >> 7) * (K >> 7) + ((k0 + 8 * c) >> 7)) * 16384 + (size_t)((n0 + n) & 127) * 128 + ((k0 + 8 * c) & 127)) = o;
        else *(GAS v4u*)(WT + (size_t)(n0 + n) * K + k0 + 8 * c) = o; }
    LDS_WAIT(); asm volatile("" ::: "memory");
}

struct Args { const float* in[23]; float* out; unsigned char* ws; int ph_lo, ph_hi, li, pad; unsigned nbytes[24]; };
enum { I_X = 0, I_C, I_ADAW, I_ADAB, I_NORMG, I_W1, I_W2, I_WIN, I_LNG, I_LNB, I_WS, I_BS, I_WOUT, I_KVNG, I_KVADAW, I_KVADAB, I_WKV, I_KNG, I_WF, I_BF, I_WQ, I_QNG, I_WO };

__device__ __forceinline__ void p0_prologue(Frame& F, int parts = 3) {
    PHASE_IDS
    unsigned char* const wsp = WSP();
    bf16* WT = (bf16*)(wsp + WS_WT);
    const int NSTRIP = DEPTH * (NMOD / 256) + (2 * D) / 256;
    if (parts & 1) for (int it = blockIdx.x; it < NSTRIP; it += F.G) {
        LAS float* SC = (LAS float*)F.lds;
        LAS float* RED = (LAS float*)(F.lds + 65536);
        const float* c = INP(I_C);
        for (int i = tid; i < BATCH * D; i += NWAVES * 64) { const int b = i / D, k = i % D; const float x = c[i]; SC[k * 8 + b] = x / (1.f + __expf(-x)); }
        __syncthreads();
        const float* W; const float* bias; float* out; int N, n0;
        if (it < DEPTH * (NMOD / 256)) { const int l = it / (NMOD / 256), s = it % (NMOD / 256); W = INP(I_ADAW) + (size_t)l * D * NMOD; N = NMOD; n0 = s * 256; bias = INP(I_ADAB) + l * NMOD; out = (float*)(wsp + WS_MOD) + (size_t)l * BATCH * NMOD; }
        else { const int s = it - DEPTH * (NMOD / 256); W = INP(I_KVADAW); N = 2 * D; n0 = s * 256; bias = INP(I_KVADAB); out = (float*)(wsp + WS_KVMOD); }
        f32x4 acc[8];
#pragma unroll
        for (int b = 0; b < 8; ++b) acc[b] = (f32x4){0.f, 0.f, 0.f, 0.f};
        const float* wp = W + (size_t)(wave * 256) * N + n0 + 4 * lane;
#pragma unroll 8
        for (int k = 0; k < 256; ++k) { const f32x4 wv = *(const f32x4*)(wp + (size_t)k * N);
            const f32x4 s0 = *(const LAS f32x4*)(SC + (wave * 256 + k) * 8), s1 = *(const LAS f32x4*)(SC + (wave * 256 + k) * 8 + 4);
            acc[0] += s0.x * wv; acc[1] += s0.y * wv; acc[2] += s0.z * wv; acc[3] += s0.w * wv; acc[4] += s1.x * wv; acc[5] += s1.y * wv; acc[6] += s1.z * wv; acc[7] += s1.w * wv; }
#pragma unroll
        for (int b = 0; b < 8; ++b) *(LAS f32x4*)(RED + (wave * 8 + b) * 256 + 4 * lane) = acc[b];
        __syncthreads();
#pragma unroll
        for (int i = 0; i < 4; ++i) { const int idx = tid + 512 * i, b = idx >> 8, col = idx & 255; float s = bias[n0 + col];
#pragma unroll
            for (int w = 0; w < 8; ++w) s += RED[(w * 8 + b) * 256 + col];
            out[(size_t)b * N + n0 + col] = s; }
        __syncthreads();
    }
    if (!(parts & 2)) return;
    { float* WSF = (float*)(wsp + WS_WSM); const float* ws_in = INP(I_WS);
      for (int i = blockIdx.x * 512 + tid; i < NA * NG * GB * GB; i += F.G * 512) { const int col = i & 127, row = (i >> 7) & 127; WSF[i] = ((col >> 6) <= (row >> 6)) ? ws_in[i] : 0.f; } }
    LAS float* scr = (LAS float*)(F.lds + wave * 16384);
    const int gw = F.vcu * NWAVES + wave, NGW = F.G * NWAVES;
    constexpr int UNIT = 2048;
    const int NGV = NSTRIP < F.G ? NSTRIP : F.G, nfree = (F.G - NGV) * NWAVES, R1 = (nfree > 0 && F.G == 256) ? 53 : 1 << 30;
    const int fidx = ((int)blockIdx.x - NGV) * NWAVES + wave;
    for (int i = 0;; ++i) {
        int it;
        if (i < R1) { it = gw + NGW * i; if (it >= 56 * UNIT) break; }
        else { if (fidx < 0) break; it = R1 * NGW + fidx + nfree * (i - R1); if (it >= 56 * UNIT) break; }
        const int u = it / UNIT, r = it % UNIT;
        if (u < 12)      { const int l = u / 6, s = u % 6;            p0_transpose_item((const GAS float*)INP(I_WIN) + (size_t)l * D * GN, D, GN, WT + WT_WIN + (size_t)l * GN * D, scr, s * UNIT + r, lane); }
        else if (u < 18) { const int l = (u - 12) / 3, s = (u - 12) % 3; p0_transpose_item((const GAS float*)INP(I_WOUT) + (size_t)l * GH * D, GH, D, WT + WT_WOUT + (size_t)l * D * GH, scr, s * UNIT + r, lane); }
        else if (u < 34) { const int l = (u - 18) / 4, s = (u - 18) % 4; p0_transpose_item((const GAS float*)INP(I_W1) + (size_t)l * D * FF, D, FF, WT + WT_W1 + (size_t)l * FF * D, scr, s * UNIT + r, lane); }
        else if (u < 50) { const int l = (u - 34) / 4, s = (u - 34) % 4; p0_transpose_item((const GAS float*)INP(I_W2) + (size_t)l * FF * D, FF, D, WT + WT_W2 + (size_t)l * D * FF, scr, s * UNIT + r, lane); }
        else if (u < 52) { const int s = u - 50;                      p0_transpose_item((const GAS float*)INP(I_WKV), D, 2 * D, WT + WT_WKV, scr, s * UNIT + r, lane); }
        else if (u < 54) { const int l = u - 52;                      p0_transpose_item((const GAS float*)INP(I_WQ) + (size_t)l * D * D, D, D, WT + WT_WQ + (size_t)l * D * D, scr, r, lane); }
        else             { const int l = u - 54;                      p0_transpose_item((const GAS float*)INP(I_WO) + (size_t)l * D * D, D, D, WT + WT_WO + (size_t)l * D * D, scr, r, lane); }
    }
}

constexpr int XP = 2 * D;
template <bool KV, bool XBI>
__device__ __forceinline__ void norm_phase(Frame& F, const float* xin, const bf16* delta, const bf16* delta2, bf16* xout, const float* g, const float* shift, const float* scale, int modstride, bf16* Hout,
                                           const float* kvg, const float* kvmod, bf16* HKV, const float* w_f, const float* b_f, float* LOGF) {
    PHASE_IDS
    const int gw = F.vcu * NWAVES + wave, NGW = F.G * NWAVES;
    LAS float* WFT = (LAS float*)F.lds;
    if (KV) { for (int i = tid; i < NH * D; i += NWAVES * 64) { const int h = i / D, col = i % D; WFT[i] = w_f[col * NH + h]; } __syncthreads(); }
    for (int it = gw; it < M / 16; it += NGW) {
        const int row0 = it * 16, b = row0 / SEQ;
        f32x4 gs[8], sh[8];
        if (!KV) {
#pragma unroll
        for (int j = 0; j < 8; ++j) { const int c = 4 * lane + 256 * j; const f32x4 gv = *(const f32x4*)(g + c), sc = *(const f32x4*)(scale + (size_t)b * modstride + c);
            gs[j] = gv * (1.f + sc); sh[j] = *(const f32x4*)(shift + (size_t)b * modstride + c);
        } }
#ifdef NT_THIN
#define NP_LD(p) __builtin_nontemporal_load(p)
#else
#define NP_LD(p) (*(p))
#endif
        f32x4 vn[8]; v2u xn[8], dn[8], dn2[8];
#define NP_LOAD(row_) do { if (XBI) { const GAS v2u* xr_ = (const GAS v2u*)((const bf16*)xin + (size_t)(row_) * XP) + lane; _Pragma("unroll") for (int j = 0; j < 8; ++j) xn[j] = NP_LD(xr_ + 64 * j); } \
            else { const GAS f32x4* xr_ = (const GAS f32x4*)(xin + (size_t)(row_) * D) + lane; _Pragma("unroll") for (int j = 0; j < 8; ++j) vn[j] = NP_LD(xr_ + 64 * j); } \
            if (delta) { const GAS v2u* dr_ = (const GAS v2u*)(delta + (size_t)(row_) * D) + lane; _Pragma("unroll") for (int j = 0; j < 8; ++j) dn[j] = NP_LD(dr_ + 64 * j); } \
            if (delta2) { const GAS v2u* dr_ = (const GAS v2u*)(delta2 + (size_t)(row_) * D) + lane; _Pragma("unroll") for (int j = 0; j < 8; ++j) dn2[j] = NP_LD(dr_ + 64 * j); } } while (0)
        NP_LOAD(row0);
#pragma unroll 2
        for (int r = 0; r < 16; ++r) { const int row = row0 + r;
            f32x4 v[8]; float s = 0.f;
#pragma unroll
            for (int j = 0; j < 8; ++j) { v[j] = XBI ? (f32x4){bflo(xn[j].x), bfhi(xn[j].x), bflo(xn[j].y), bfhi(xn[j].y)} : vn[j];
                if (delta) v[j] += (f32x4){bflo(dn[j].x), bfhi(dn[j].x), bflo(dn[j].y), bfhi(dn[j].y)};
                if (delta2) v[j] += (f32x4){bflo(dn2[j].x), bfhi(dn2[j].x), bflo(dn2[j].y), bfhi(dn2[j].y)}; }
            if (r + 1 < 16) NP_LOAD(row + 1);
            __builtin_amdgcn_sched_barrier(0);
            if (xout) { GAS v2u* xo = (GAS v2u*)(xout + (size_t)row * XP) + lane;
#pragma unroll
                for (int j = 0; j < 8; ++j) xo[64 * j] = (v2u){pk2(v[j].x, v[j].y), pk2(v[j].z, v[j].w)}; }
#pragma unroll
            for (int j = 0; j < 8; ++j) s += (v[j].x * v[j].x + v[j].y * v[j].y) + (v[j].z * v[j].z + v[j].w * v[j].w);
            const float rstd = 1.f / sqrtf(wave_sum(s) * (1.f / D) + EPS);
            GAS v2u* o8 = (GAS v2u*)(Hout + (size_t)row * D) + lane;
#pragma unroll
            for (int j = 0; j < 8; ++j) { f32x4 gsj, shj;
                if (KV) { const int c = 4 * lane + 256 * j; gsj = *(const f32x4*)(g + c) * (1.f + *(const f32x4*)(scale + (size_t)b * modstride + c)); shj = *(const f32x4*)(shift + (size_t)b * modstride + c); }
                else { gsj = gs[j]; shj = sh[j]; }
                const f32x4 y = (v[j] * rstd) * gsj + shj; o8[64 * j] = (v2u){pk2(y.x, y.y), pk2(y.z, y.w)}; }
            if (KV) {
                GAS v2u* k8 = (GAS v2u*)(HKV + (size_t)row * D) + lane; f32x4 y[8];
#pragma unroll
                for (int j = 0; j < 8; ++j) { const int c = 4 * lane + 256 * j; const f32x4 g2 = *(const f32x4*)(kvg + c), s2 = *(const f32x4*)(kvmod + (size_t)b * 2 * D + D + c), h2 = *(const f32x4*)(kvmod + (size_t)b * 2 * D + c);
                    y[j] = (v[j] * rstd) * (g2 * (1.f + s2)) + h2; k8[64 * j] = (v2u){pk2(y[j].x, y[j].y), pk2(y[j].z, y[j].w)}; }
                float mine = 0.f;
#pragma unroll 1
                for (int h = 0; h < 16; ++h) { float z = 0.f;
#pragma unroll
                    for (int j = 0; j < 8; ++j) { const f32x4 w = *(const LAS f32x4*)(WFT + h * D + 4 * lane + 256 * j); z += (y[j].x * w.x + y[j].y * w.y) + (y[j].z * w.z + y[j].w * w.w); }
                    const float t = wave_sum(z); if (lane == h) mine = t; }
                if (lane < 16) { const float zz = mine + b_f[lane]; const float ls = fminf(zz, 0.f) - log1pf(__expf(-fabsf(zz)));
                    LOGF[((size_t)b * NH + lane) * SEQ + (row - b * SEQ)] = ls; }
            }
        }
    }
#undef NP_LOAD
#undef NP_LD
    if (KV) __syncthreads();
}
__device__ __forceinline__ void resid_final(Frame& F, const bf16* xb, float* xo_, const bf16* delta) {
    PHASE_IDS
    const int gw = F.vcu * NWAVES + wave, NGW = F.G * NWAVES;
    v2u vn[8], dn[8];
#define RF_LOAD(row_) do { const GAS v2u* xr_ = (const GAS v2u*)(xb + (size_t)(row_) * XP) + lane; const GAS v2u* dr_ = (const GAS v2u*)(delta + (size_t)(row_) * D) + lane; \
        _Pragma("unroll") for (int j = 0; j < 8; ++j) { vn[j] = xr_[64 * j]; dn[j] = dr_[64 * j]; } } while (0)
    RF_LOAD(gw * (M / NGW));
#pragma unroll 2
    for (int rr = 0; rr < M / NGW; ++rr) { const int row = gw * (M / NGW) + rr;
        GAS f32x4* xw = (GAS f32x4*)(xo_ + (size_t)row * D) + lane;
        v2u v[8], d[8];
#pragma unroll
        for (int j = 0; j < 8; ++j) { v[j] = vn[j]; d[j] = dn[j]; }
        if (rr + 1 < M / NGW) RF_LOAD(row + 1);
        __builtin_amdgcn_sched_barrier(0);
#pragma unroll
        for (int j = 0; j < 8; ++j) xw[64 * j] = (f32x4){bflo(v[j].x), bfhi(v[j].x), bflo(v[j].y), bfhi(v[j].y)} + (f32x4){bflo(d[j].x), bfhi(d[j].x), bflo(d[j].y), bfhi(d[j].y)}; }
#undef RF_LOAD
}
__device__ __forceinline__ void headnorm_rows(Frame& F, bf16* T, bf16* Tout, const float* gain) {
    PHASE_IDS
    const int gw = F.vcu * NWAVES + wave, NGW = F.G * NWAVES;
    const int d0 = (8 * lane) & 127; const f32x4 g0 = *(const f32x4*)(gain + d0), g1 = *(const f32x4*)(gain + d0 + 4);
    for (int it = gw; it < M / 16; it += NGW) {
        for (int r = 0; r < 16; ++r) { GAS v4u* p = (GAS v4u*)(T + (size_t)(it * 16 + r) * D) + lane; GAS v4u* po = (GAS v4u*)(Tout + (size_t)(it * 16 + r) * D) + lane;
            v4u w[4];
#pragma unroll
            for (int j = 0; j < 4; ++j) w[j] = p[64 * j];
#pragma unroll
            for (int j = 0; j < 4; ++j) { float x[8] = {bflo(w[j].x), bfhi(w[j].x), bflo(w[j].y), bfhi(w[j].y), bflo(w[j].z), bfhi(w[j].z), bflo(w[j].w), bfhi(w[j].w)};
                float s = 0.f;
#pragma unroll
                for (int e = 0; e < 8; ++e) s += x[e] * x[e];
                s += lane_xor<1>(s); s += lane_xor<2>(s); s += lane_xor<4>(s); s += lane_xor<8>(s);
                const float rstd = 1.f / sqrtf(s * (1.f / HD) + EPS);
                v4u o; o.x = pk2(x[0] * rstd * g0.x, x[1] * rstd * g0.y); o.y = pk2(x[2] * rstd * g0.z, x[3] * rstd * g0.w); o.z = pk2(x[4] * rstd * g1.x, x[5] * rstd * g1.y); o.w = pk2(x[6] * rstd * g1.z, x[7] * rstd * g1.w);
                po[64 * j] = o; } }
    }
}
__device__ __forceinline__ void cumsum_phase(Frame& F, const float* LOGF, float* FB, const float* qgain  , const float* kgain  , int* JLO) {
    PHASE_IDS
    const int grp = blockIdx.x & 7, lw = (int)(blockIdx.x >> 3) * NWAVES + wave;
    for (int bh = grp * NH + lw; lw < NH && bh < (grp + 1) * NH; bh += BATCH * NH) {
        const f32x4* src = (const f32x4*)(LOGF + (size_t)bh * SEQ + 64 * lane); f32x4 v[16]; float run = 0.f;
#pragma unroll
        for (int i = 0; i < 16; ++i) { v[i] = src[i]; run += v[i].x; v[i].x = run; run += v[i].y; v[i].y = run; run += v[i].z; v[i].z = run; run += v[i].w; v[i].w = run; }
        float incl = run;
#define CS_DPP(x, ctrl, rmask, bc) __uint_as_float((unsigned)__builtin_amdgcn_update_dpp(0, (int)__float_as_uint(x), ctrl, rmask, 0xF, bc))
        incl += CS_DPP(incl, 0x111, 0xF, true); incl += CS_DPP(incl, 0x112, 0xF, true); incl += CS_DPP(incl, 0x114, 0xF, true); incl += CS_DPP(incl, 0x118, 0xF, true);
        incl += CS_DPP(incl, 0x142, 0xA, false); incl += CS_DPP(incl, 0x143, 0xC, false);
#undef CS_DPP
        const float off = incl - run;
        f32x4* dst = (f32x4*)(FB + (size_t)bh * SEQ + 64 * lane);
#pragma unroll
        for (int i = 0; i < 16; ++i) dst[i] = v[i] + off;
        float gq = fmaxf(fmaxf(fabsf(qgain[lane]), fabsf(qgain[64 + lane])), fmaxf(fabsf(qgain[128 + lane]), fabsf(qgain[192 + lane]))), gk = fmaxf(fabsf(kgain[lane]), fabsf(kgain[64 + lane]));
        { gq = fmaxf(gq, lane_xor<1>(gq)); gq = fmaxf(gq, lane_xor<2>(gq)); gq = fmaxf(gq, lane_xor<4>(gq)); gq = fmaxf(gq, lane_xor<8>(gq)); gq = fmaxf(gq, lane_xor<16>(gq)); gq = lane_max_halves(gq);
          gk = fmaxf(gk, lane_xor<1>(gk)); gk = fmaxf(gk, lane_xor<2>(gk)); gk = fmaxf(gk, lane_xor<4>(gk)); gk = fmaxf(gk, lane_xor<8>(gk)); gk = fmaxf(gk, lane_xor<16>(gk)); gk = lane_max_halves(gk); }
        const float BL = (float)HD * gq * gk * 1.02f * 0.08838834764831845f, thr = 2.f * BL + 25.f;
        const float fend = v[15].w + off, ffirst = v[0].x + off; int myj = 0;
#pragma unroll
        for (int qb = 0; qb < SEQ / 256; ++qb) { const float fp0 = __uint_as_float((unsigned)__builtin_amdgcn_readlane((int)__float_as_uint(ffirst), 4 * qb)); const bool skip = (lane < 4 * qb) && (fend - fp0 >= thr);
            const int cnt = __popcll(__ballot(skip)); if (lane == qb) myj = cnt; }
#ifdef NO_STATIC_SKIP
        myj = 0;
#endif
        if (lane < SEQ / 256) JLO[bh * (SEQ / 256) + lane] = myj;
        if (lane == 0) ((float*)JLO)[BATCH * NH * (SEQ / 256) + grp] = BL * 1.4426950408889634f + 36.2f;
    }
}

constexpr int SG_NCH = GH / 128;
constexpr int SG_VT = 0, SG_STG = 65536, SG_STG_ROW = 144, SG_STG_WAVE = 32 * SG_STG_ROW, SG_MEAN = SG_STG + 8 * SG_STG_WAVE  , SG_RSTD = SG_MEAN + 512, SG_RED = SG_RSTD + 512, SG_MT = SG_RED + 4096  , SG_END = SG_MT + 8 * 384;
__device__ __forceinline__ void sg_phase(Frame& F, int layer, bf16* U, const bf16* V, const f32x2* vstat, const float* ln_g, const float* ln_b, const float* WSF, const float* bs, bool do_store) {
    PHASE_IDS
    const int wid = wave, r32 = lane & 31, hi = lane >> 5, wq = wid & 3, ch = wid >> 2;
    LAS unsigned char* lds = F.lds;
    LAS float* MEAN = (LAS float*)(lds + SG_MEAN); LAS float* RSTD = (LAS float*)(lds + SG_RSTD); LAS f32x2* RED = (LAS f32x2*)(lds + SG_RED);
    LAS float* MT = (LAS float*)(lds + SG_MT + wid * 384);
    const unsigned vbase = (unsigned)(uintptr_t)(lds + SG_VT) + (unsigned)att::v_rd_base(lane);
    LAS unsigned char* stg = lds + SG_STG + wid * SG_STG_WAVE;
    { const int nb = F.vcu;
        const int r0 = nb * GB;
        { const int row = tid & 127, part = tid >> 7; float s = 0.f, ss = 0.f; const f32x2* vp = vstat + (size_t)(part * 24) * M + r0 + row;
#pragma unroll 1
          for (int q0 = 0; q0 < 24; q0 += 8) { f32x2 p[8];
#pragma unroll
            for (int q = 0; q < 8; ++q) p[q] = vp[(size_t)(q0 + q) * M];
#pragma unroll
            for (int q = 0; q < 8; ++q) { s += p[q].x; ss += p[q].y; } }
          RED[part * 128 + row] = (f32x2){s, ss}; }
        __syncthreads();
        if (tid < 128) { const f32x2 a = RED[tid], b = RED[128 + tid], c = RED[256 + tid], d = RED[384 + tid];
            const float mean = ((a.x + b.x) + (c.x + d.x)) * (1.f / GH); const float var = ((a.y + b.y) + (c.y + d.y)) * (1.f / GH) - mean * mean;
            MEAN[tid] = mean; RSTD[tid] = 1.f / sqrtf(fmaxf(var, 0.f) + EPS); }
        __syncthreads();
        const unsigned char* Vt = (const unsigned char*)V + (size_t)nb * SG_NCH * 32768;
        unsigned char* Ut = (unsigned char*)U + (size_t)nb * SG_NCH * 32768 + (size_t)(32 * wq) * 256 + (size_t)(64 * ch) * 2;
        v4u vr[4], ur[2][4]; float lg[2][2], lb[2][2];
#define SG_VLOAD(t) do { _Pragma("unroll") for (int q = 0; q < 4; ++q) vr[q] = *(const GAS v4u*)(Vt + (size_t)(t) * 32768 + (size_t)(tid + 512 * q) * 16); } while (0)
#define SG_VWRITE(buf) do { _Pragma("unroll") for (int q = 0; q < 4; ++q) *(LAS v4u*)(lds + SG_VT + (buf) * 32768 + (tid + 512 * q) * 16) = vr[q]; } while (0)
#define SG_ULOAD(t, slot) do { _Pragma("unroll") for (int q = 0; q < 4; ++q) { const int p = lane + 64 * q; ur[slot][q] = *(const GAS v4u*)(Ut + (size_t)(t) * 32768 + (p >> 3) * 256 + (p & 7) * 16); } } while (0)
#define SG_GBLOAD(t, slot) do { _Pragma("unroll") for (int dd = 0; dd < 2; ++dd) { const int c = (t) * 128 + 64 * ch + 32 * dd + r32; lg[slot][dd] = ln_g[c]; lb[slot][dd] = ln_b[c]; } } while (0)
        SG_VLOAD(0); SG_ULOAD(0, 0); SG_GBLOAD(0, 0);
        SG_VWRITE(0);
        RAW_BAR();
#pragma unroll 1
        for (int g = 0; g < NG; ++g) {
            bf16x8 wf[2][4];
            { const float* wp = WSF + ((size_t)(layer * NG + g) * GB + 32 * wq + r32) * GB + 8 * hi; float msum = 0.f, ssum = 0.f;
#pragma unroll
              for (int jt = 0; jt < 2; ++jt)
#pragma unroll
                for (int ks = 0; ks < 4; ++ks) { const int j0 = 64 * jt + 16 * ks + 8 * hi; v4u w = {0u, 0u, 0u, 0u};
                    if (jt == 0 || wq >= 2) { const f32x4 w0 = *(const f32x4*)(wp + 64 * jt + 16 * ks), w1 = *(const f32x4*)(wp + 64 * jt + 16 * ks + 4);
                        const f32x4 r0v = *(const LAS f32x4*)(RSTD + j0), r1v = *(const LAS f32x4*)(RSTD + j0 + 4), m0v = *(const LAS f32x4*)(MEAN + j0), m1v = *(const LAS f32x4*)(MEAN + j0 + 4);
                        w.x = pk2(w0.x * r0v.x, w0.y * r0v.y); w.y = pk2(w0.z * r0v.z, w0.w * r0v.w); w.z = pk2(w1.x * r1v.x, w1.y * r1v.y); w.w = pk2(w1.z * r1v.z, w1.w * r1v.w);
                        msum += (bflo(w.x) * m0v.x + bfhi(w.x) * m0v.y) + (bflo(w.y) * m0v.z + bfhi(w.y) * m0v.w) + (bflo(w.z) * m1v.x + bfhi(w.z) * m1v.y) + (bflo(w.w) * m1v.z + bfhi(w.w) * m1v.w);
                        ssum += ((w0.x + w0.y) + (w0.z + w0.w)) + ((w1.x + w1.y) + (w1.z + w1.w)); }
                    wf[jt][ks] = __builtin_bit_cast(bf16x8, w); }
              msum = lane_sum_halves(msum); ssum = lane_sum_halves(ssum);
              if (hi == 0) { MT[r32] = -msum; MT[32 + r32] = ssum; MT[64 + r32] = bs[(size_t)(layer * NG + g) * GB + 32 * wq + r32]; }
              LDS_WAIT(); }
#define SG_TRRD(dst, off) asm volatile("ds_read_b64_tr_b16 %0, %1 offset:%2" : "=&v"(dst) : "v"(va), "i"(off) : "memory")
#define SG_PV(dd, jt, buf) do { const unsigned va = vbase + (unsigned)(((buf) * 2 + (jt)) * 16384 + (2 * ch + (dd)) * 512); s16x4 l0, l1, l2, l3, h0, h1, h2, h3; \
            SG_TRRD(l0, 0); SG_TRRD(h0, 2048); SG_TRRD(l1, 4096); SG_TRRD(h1, 6144); SG_TRRD(l2, 8192); SG_TRRD(h2, 10240); SG_TRRD(l3, 12288); SG_TRRD(h3, 14336); \
            asm volatile("s_waitcnt lgkmcnt(0)" ::: "memory"); __builtin_amdgcn_sched_barrier(0); \
            o[dd] = __builtin_amdgcn_mfma_f32_32x32x16_bf16(wf[jt][0], (bf16x8){l0[0], l0[1], l0[2], l0[3], h0[0], h0[1], h0[2], h0[3]}, o[dd], 0, 0, 0); \
            o[dd] = __builtin_amdgcn_mfma_f32_32x32x16_bf16(wf[jt][1], (bf16x8){l1[0], l1[1], l1[2], l1[3], h1[0], h1[1], h1[2], h1[3]}, o[dd], 0, 0, 0); \
            o[dd] = __builtin_amdgcn_mfma_f32_32x32x16_bf16(wf[jt][2], (bf16x8){l2[0], l2[1], l2[2], l2[3], h2[0], h2[1], h2[2], h2[3]}, o[dd], 0, 0, 0); \
            o[dd] = __builtin_amdgcn_mfma_f32_32x32x16_bf16(wf[jt][3], (bf16x8){l3[0], l3[1], l3[2], l3[3], h3[0], h3[1], h3[2], h3[3]}, o[dd], 0, 0, 0); } while (0)
#define SG_CHUNK(s) do { const int t = 6 * g + 2 * s2 + (s); \
            if (t + 1 < SG_NCH) { SG_VLOAD(t + 1); SG_ULOAD(t + 1, ((s) + 1) & 1); SG_GBLOAD(t + 1, ((s) + 1) & 1); } \
            asm volatile("" ::: "memory"); __builtin_amdgcn_sched_barrier(0); \
            f32x16 o[2] = {}; \
            SG_PV(0, 0, (s) & 1); SG_PV(1, 0, (s) & 1); \
            if (wq >= 2) { SG_PV(0, 1, (s) & 1); SG_PV(1, 1, (s) & 1); } \
            _Pragma("unroll") for (int dd = 0; dd < 2; ++dd) { const float gg = lg[(s) & 1][dd], bb = lb[(s) & 1][dd]; \
                _Pragma("unroll") for (int q = 0; q < 4; ++q) { const f32x4 Aq = *(const LAS f32x4*)(MT + 8 * q + 4 * hi), Bq = *(const LAS f32x4*)(MT + 32 + 8 * q + 4 * hi), Cq = *(const LAS f32x4*)(MT + 64 + 8 * q + 4 * hi); \
                  _Pragma("unroll") for (int e = 0; e < 4; ++e) { const int r = 4 * q + e; const float val = gg * (o[dd][r] + Aq[e]) + (bb * Bq[e] + Cq[e]); \
                    *(LAS unsigned short*)(stg + att::crow(r, hi) * SG_STG_ROW + (dd * 32 + r32) * 2) = (unsigned short)pk2(val, val); } } } \
            LDS_WAIT(); \
            _Pragma("unroll") for (int q = 0; q < 4; ++q) { const int p = lane + 64 * q; const v4u sv = *(const LAS v4u*)(stg + (p >> 3) * SG_STG_ROW + (p & 7) * 16); const v4u uu = ur[(s) & 1][q]; v4u w; \
                const pg8::f32x2 gx = pg8::gelu_pk((pg8::f32x2){bflo(uu.x), bfhi(uu.x)}), gy = pg8::gelu_pk((pg8::f32x2){bflo(uu.y), bfhi(uu.y)}), gz = pg8::gelu_pk((pg8::f32x2){bflo(uu.z), bfhi(uu.z)}), gw = pg8::gelu_pk((pg8::f32x2){bflo(uu.w), bfhi(uu.w)});     \
                w.x = pk2(gx.x * bflo(sv.x), gx.y * bfhi(sv.x)); w.y = pk2(gy.x * bflo(sv.y), gy.y * bfhi(sv.y)); \
                w.z = pk2(gz.x * bflo(sv.z), gz.y * bfhi(sv.z)); w.w = pk2(gw.x * bflo(sv.w), gw.y * bfhi(sv.w)); \
                if (do_store) *(GAS v4u*)(Ut + (size_t)t * 32768 + (p >> 3) * 256 + (p & 7) * 16) = w; } \
            asm volatile("" ::: "memory"); __builtin_amdgcn_sched_barrier(0); \
            if (t + 1 < SG_NCH) SG_VWRITE(((s) + 1) & 1); \
            RAW_BAR(); } while (0)
#pragma unroll 1
            for (int s2 = 0; s2 < 3; ++s2) { SG_CHUNK(0); SG_CHUNK(1); }
        }
#undef SG_VLOAD
#undef SG_VWRITE
#undef SG_ULOAD
#undef SG_GBLOAD
#undef SG_TRRD
#undef SG_PV
#undef SG_CHUNK
        __syncthreads();
    }
}


#ifdef SG_V1
constexpr int SG1_VT = 0, SG1_STG = 65536, SG1_STG_ROW = 144, SG1_STG_WAVE = 32 * SG1_STG_ROW, SG1_TAB = SG1_STG + 8 * SG1_STG_WAVE, SG1_RED = SG1_TAB + 1024;
__device__ __forceinline__ void sg_phase_v1(Frame& F, int layer, bf16* U, const bf16* V, const f32x2* vstat, const float* ln_g, const float* ln_b, const float* WSF, const float* bs) {
    PHASE_IDS
    const int wid = wave, r32 = lane & 31, hi = lane >> 5, wq = wid & 3, ch = wid >> 2;
    LAS unsigned char* lds = F.lds;
    LAS f32x2* TAB = (LAS f32x2*)(lds + SG1_TAB); LAS f32x2* RED = (LAS f32x2*)(lds + SG1_RED);
    const int sr = tid >> 4, sc = (tid & 15) * 8, vst0 = att::v_st(sr, sc), vst1 = att::v_st(32 + sr, sc);
    const unsigned vbase = (unsigned)(uintptr_t)(lds + SG1_VT) + (unsigned)att::v_rd_base(lane);
    LAS unsigned char* stg = lds + SG1_STG + wid * SG1_STG_WAVE;
    for (int nb = blockIdx.x; nb < M / GB; nb += F.G) {
        const int r0 = nb * GB;
        { const int row = tid & 127, part = tid >> 7; float s = 0.f, ss = 0.f;
#pragma unroll 8
          for (int q = 0; q < 24; ++q) { const f32x2 p = vstat[(size_t)(part * 24 + q) * M + r0 + row]; s += p.x; ss += p.y; }
          RED[part * 128 + row] = (f32x2){s, ss}; }
        __syncthreads();
        if (tid < 128) { const f32x2 a = RED[tid], b = RED[128 + tid], c = RED[256 + tid], d = RED[384 + tid];
            const float mean = ((a.x + b.x) + (c.x + d.x)) * (1.f / GH); const float var = ((a.y + b.y) + (c.y + d.y)) * (1.f / GH) - mean * mean;
            TAB[tid] = (f32x2){mean, 1.f / sqrtf(fmaxf(var, 0.f) + EPS)}; }
        __syncthreads();
        f32x2 st[4];
#pragma unroll
        for (int q = 0; q < 4; ++q) st[q] = TAB[(q >> 1) * 64 + (q & 1) * 32 + sr];
        const bf16* Vb = V + (size_t)r0 * GH; bf16* Ub = U + (size_t)r0 * GH;
        v4u vr[4], ur[4];
#define SG1_VLOAD(c0) do { _Pragma("unroll") for (int q = 0; q < 4; ++q) vr[q] = *(const GAS v4u*)(Vb + (size_t)((q >> 1) * 64 + (q & 1) * 32 + sr) * GH + (c0) + sc); } while (0)
#define SG1_VWRITE(c0, buf) do { const f32x4 g0 = *(const f32x4*)(ln_g + (c0) + sc), g1 = *(const f32x4*)(ln_g + (c0) + sc + 4), b0 = *(const f32x4*)(ln_b + (c0) + sc), b1 = *(const f32x4*)(ln_b + (c0) + sc + 4); \
        _Pragma("unroll") for (int q = 0; q < 4; ++q) { const float mu = st[q].x, rs = st[q].y; v4u o; \
            o.x = pk2((bflo(vr[q].x) - mu) * rs * g0.x + b0.x, (bfhi(vr[q].x) - mu) * rs * g0.y + b0.y); o.y = pk2((bflo(vr[q].y) - mu) * rs * g0.z + b0.z, (bfhi(vr[q].y) - mu) * rs * g0.w + b0.w); \
            o.z = pk2((bflo(vr[q].z) - mu) * rs * g1.x + b1.x, (bfhi(vr[q].z) - mu) * rs * g1.y + b1.y); o.w = pk2((bflo(vr[q].w) - mu) * rs * g1.z + b1.z, (bfhi(vr[q].w) - mu) * rs * g1.w + b1.w); \
            *(LAS v4u*)(lds + SG1_VT + ((buf) * 2 + (q >> 1)) * 16384 + ((q & 1) ? vst1 : vst0)) = o; } } while (0)
        SG1_VLOAD(0); SG1_VWRITE(0, 0);
        RAW_BAR();
        bf16x8 wf[2][4]; f32x4 bsv[4];
        for (int t = 0; t < GH / 128; ++t) {
            const int c0 = t * 128, buf = t & 1, g = t / 6;
#pragma unroll
            for (int q = 0; q < 4; ++q) { const int p = lane + 64 * q; ur[q] = *(const GAS v4u*)(Ub + (size_t)(32 * wq + (p >> 3)) * GH + c0 + 64 * ch + 8 * (p & 7)); }
            if (t + 1 < GH / 128) SG1_VLOAD(c0 + 128);
            if (t % 6 == 0) {
                const float* wp = WSF + ((size_t)(layer * NG + g) * GB + 32 * wq + r32) * GB + 8 * hi;
#pragma unroll
                for (int jt = 0; jt < 2; ++jt)
#pragma unroll
                    for (int ks = 0; ks < 4; ++ks) { const f32x4 w0 = *(const f32x4*)(wp + 64 * jt + 16 * ks), w1 = *(const f32x4*)(wp + 64 * jt + 16 * ks + 4); v4u w = {pk2(w0.x, w0.y), pk2(w0.z, w0.w), pk2(w1.x, w1.y), pk2(w1.z, w1.w)}; wf[jt][ks] = __builtin_bit_cast(bf16x8, w); }
                const float* bp = bs + (size_t)(layer * NG + g) * GB + 32 * wq + 4 * hi;
#pragma unroll
                for (int q = 0; q < 4; ++q) bsv[q] = *(const f32x4*)(bp + 8 * q);
            }
            f32x16 o[2] = {};
#define SG1_TRRD(dst, off) asm volatile("ds_read_b64_tr_b16 %0, %1 offset:%2" : "=&v"(dst) : "v"(va), "i"(off) : "memory")
#define SG1_PV(dd, jt) do { const unsigned va = vbase + (unsigned)((buf * 2 + (jt)) * 16384 + (2 * ch + (dd)) * 512); s16x4 l0, l1, l2, l3, h0, h1, h2, h3; \
            SG1_TRRD(l0, 0); SG1_TRRD(h0, 2048); SG1_TRRD(l1, 4096); SG1_TRRD(h1, 6144); SG1_TRRD(l2, 8192); SG1_TRRD(h2, 10240); SG1_TRRD(l3, 12288); SG1_TRRD(h3, 14336); \
            asm volatile("s_waitcnt lgkmcnt(0)" ::: "memory"); __builtin_amdgcn_sched_barrier(0); \
            o[dd] = __builtin_amdgcn_mfma_f32_32x32x16_bf16(wf[jt][0], (bf16x8){l0[0], l0[1], l0[2], l0[3], h0[0], h0[1], h0[2], h0[3]}, o[dd], 0, 0, 0); \
            o[dd] = __builtin_amdgcn_mfma_f32_32x32x16_bf16(wf[jt][1], (bf16x8){l1[0], l1[1], l1[2], l1[3], h1[0], h1[1], h1[2], h1[3]}, o[dd], 0, 0, 0); \
            o[dd] = __builtin_amdgcn_mfma_f32_32x32x16_bf16(wf[jt][2], (bf16x8){l2[0], l2[1], l2[2], l2[3], h2[0], h2[1], h2[2], h2[3]}, o[dd], 0, 0, 0); \
            o[dd] = __builtin_amdgcn_mfma_f32_32x32x16_bf16(wf[jt][3], (bf16x8){l3[0], l3[1], l3[2], l3[3], h3[0], h3[1], h3[2], h3[3]}, o[dd], 0, 0, 0); } while (0)
            SG1_PV(0, 0); SG1_PV(1, 0);
            if (wq >= 2) { SG1_PV(0, 1); SG1_PV(1, 1); }
#pragma unroll
            for (int dd = 0; dd < 2; ++dd)
#pragma unroll
                for (int r = 0; r < 16; ++r) { const float val = o[dd][r] + bsv[r >> 2][r & 3];
                    *(LAS unsigned short*)(stg + att::crow(r, hi) * SG1_STG_ROW + (dd * 32 + r32) * 2) = (unsigned short)f2bf(val); }
            LDS_WAIT();
#pragma unroll
            for (int q = 0; q < 4; ++q) { const int p = lane + 64 * q; const v4u sv = *(const LAS v4u*)(stg + (p >> 3) * SG1_STG_ROW + (p & 7) * 16); const v4u uu = ur[q]; v4u w;
                w.x = pk2(bflo(uu.x) * bflo(sv.x), bfhi(uu.x) * bfhi(sv.x)); w.y = pk2(bflo(uu.y) * bflo(sv.y), bfhi(uu.y) * bfhi(sv.y));
                w.z = pk2(bflo(uu.z) * bflo(sv.z), bfhi(uu.z) * bfhi(sv.z)); w.w = pk2(bflo(uu.w) * bflo(sv.w), bfhi(uu.w) * bfhi(sv.w));
                *(GAS v4u*)(Ub + (size_t)(32 * wq + (p >> 3)) * GH + c0 + 64 * ch + 8 * (p & 7)) = w; }
            if (t + 1 < GH / 128) SG1_VWRITE(c0 + 128, buf ^ 1);
            RAW_BAR();
        }
#undef SG1_VLOAD
#undef SG1_VWRITE
#undef SG1_TRRD
#undef SG1_PV
        __syncthreads();
    }
}


#endif

__device__ __forceinline__ att::BlockRef att_ref(unsigned k, int cls, const bf16* Q, const bf16* K, const bf16* V, bf16* O, const float* FB, const int* JLO) {
#ifndef ATT_QUADS
    const int h = k & 15, qb = 15 - (int)(k >> 4), b = cls, bh = b * NH + h;
#else
    const int r = k & 63, h = r >> 2, qb = 15 - 4 * (int)(k >> 6) - (r & 3), b = (cls - h) & 7, bh = b * NH + h;
#endif
    const size_t base = (size_t)b * SEQ * D + (size_t)h * HD, qoff = base + (size_t)qb * 256 * D;
    const int s0 = (JLO[bh * (SEQ / 256) + qb] >> 1) * 128;
    att::BlockRef rf; rf.Q = Q + qoff; rf.O = O + qoff; rf.K = K + base + (size_t)s0 * D; rf.V = V + base + (size_t)s0 * D; rf.P0 = qb * 256 - s0; rf.F = FB + (size_t)bh * SEQ + s0; return rf;
}
__device__ __forceinline__ void attn_phase(Frame& F, char* lds, const bf16* Q, const bf16* K, const bf16* V, bf16* O, const float* FB, const int* JLO, unsigned* qword) {
    constexpr unsigned NTK = 256;
    const int cls = blockIdx.x & 7; unsigned* qw = qword + 64 * cls;
    volatile LAS unsigned* TK = (volatile LAS unsigned*)(F.lds + att::LDS_BYTES);
    if (threadIdx.x == 0) { const unsigned t0 = __hip_atomic_fetch_add(qw, 1u, __ATOMIC_RELAXED, __HIP_MEMORY_SCOPE_AGENT), t1 = __hip_atomic_fetch_add(qw, 1u, __ATOMIC_RELAXED, __HIP_MEMORY_SCOPE_AGENT); TK[0] = t0; TK[1] = t1; }
    __syncthreads();
    unsigned cur_t = __builtin_amdgcn_readfirstlane(TK[0]), nxt_t = __builtin_amdgcn_readfirstlane(TK[1]);
    __syncthreads();
    if (cur_t >= NTK) return;
    att::BlockRef cur = att_ref(cur_t, cls, Q, K, V, O, FB, JLO);
    const float thr2 = ((const float*)JLO)[BATCH * NH * (SEQ / 256) + cls];
    att::Seam S;
    att::prime(cur, lds, S);
    for (;;) {
        const bool has_next = nxt_t < NTK;
        const att::BlockRef nxt = has_next ? att_ref(nxt_t, cls, Q, K, V, O, FB, JLO) : cur;
        att::block(cur, nxt, lds, S, thr2);
        if (threadIdx.x == 0 && has_next) TK[0] = __hip_atomic_fetch_add(qw, 1u, __ATOMIC_RELAXED, __HIP_MEMORY_SCOPE_AGENT);
        __syncthreads();
        if (!has_next) break;
        cur = nxt; cur_t = nxt_t; nxt_t = __builtin_amdgcn_readfirstlane(TK[0]);
        __syncthreads();
    }
}

#define ZBV(off_mib, per_batch_mib) (WS_Z + (size_t)(blockIdx.x & 7) * (size_t)(96 - (per_batch_mib)) * MiB + (size_t)(off_mib) * MiB)
#define ZB_U ZBV(0, 48)
#define ZB_V ZBV(48, 48)
#define ZB_HID ZBV(0, 64)
#define ZB_Q ZBV(0, 16)
#define ZB_O ZBV(16, 16)
#define ZB_HKV ZBV(32, 16)
#define ZB_KB ZBV(64, 16)
#define ZB_VB ZBV(80, 16)
#define ZB_D1A ZBV(64, 16)

#ifndef DUPMASK
#define DUPMASK 0
#endif
#ifndef EN_MASK
#define EN_MASK 0xFFFF
#endif
#define EN(k) ((EN_MASK >> (k)) & 1)
#ifndef GELU_PROBE
#define GELU_PROBE 0
#endif
#ifndef HID_TILED
#define HID_TILED true
#endif
#ifndef PG8_ALIGN_SET
#define PG8_ALIGN_SET true
#endif
#ifndef PG8_SP2_SET
#define PG8_SP2_SET true
#endif
#ifndef WGM_G1
#define WGM_G1 4
#endif
#ifndef WGM_QKV
#define WGM_QKV 4
#endif
#ifndef WGM_M1
#define WGM_M1 4
#endif
#ifndef WGM_RES
#define WGM_RES 4
#endif
#define NREP(c) (((DUPMASK >> (c)) & 1) ? 2 : 1)
__global__ void __launch_bounds__(NWAVES * 64, 2) yoco_fwd(Args args) {
    extern __shared__ __attribute__((aligned(16))) unsigned char lds[];
    Frame F;
    F.lds = (LAS unsigned char*)lds;
    F.G = gridDim.x; { const int bx = blockIdx.x; F.vcu = (F.G % 8 == 0) ? (bx % 8) * (F.G / 8) + bx / 8 : bx; }
    volatile LAS unsigned* MISC = (volatile LAS unsigned*)(F.lds + MISC_OFF);
    for (int u = threadIdx.x; u < (LDS_BYTES - LDSCTL_OFF) / 4; u += NWAVES * 64) ((LAS unsigned*)(F.lds + LDSCTL_OFF))[u] = 0u;
    __syncthreads();
    if (threadIdx.x < 25) { LAS unsigned long long* PT = (LAS unsigned long long*)(F.lds + LDSCTL_OFF); const int i = threadIdx.x;
        PT[i] = i < 23 ? (unsigned long long)args.in[i] : (i == 23 ? (unsigned long long)args.out : (unsigned long long)args.ws); }
    const int lo = args.ph_lo, hi = args.ph_hi;
    XcdBarrier gbar = xcd_barrier_post((unsigned*)(args.ws + WS_CTL) + CW_BAR, MISC + 8, gridDim.x);
    XcdBarrier bar = xcd_barrier_post((unsigned*)(args.ws + WS_CTL) + CW_BAR + (size_t)(1 + (blockIdx.x & 7)) * XCD_BAR_WORDS, MISC + 10, gridDim.x >> 3);
    __syncthreads();
    int ph = 0; int l_cur = 0;
#define RUN(c) (ph >= lo && ph < hi && EN(c))
#define SEAM() do { if (ph >= lo && ph + 1 < hi) xcd_barrier(bar); ++ph; } while (0)
#ifndef DUP_LMASK
#define DUP_LMASK 0xF
#endif
#define REPEAT(c) const int nrep_ = (NREP(c) == 2 && c != 0 && !((DUP_LMASK >> l_cur) & 1)) ? 1 : NREP(c); _Pragma("unroll 1") for (int rep = 0; rep < nrep_; ++rep)
#define REP_BAR() do { if (rep) xcd_barrier(bar); } while (0)
#define MODP(l) ((const float*)(ws + WS_MOD) + (size_t)(l) * BATCH * NMOD)

#ifdef TLB_WARM
    {
      const int rank = blockIdx.x >> 3, nrank = (int)gridDim.x >> 3; unsigned acc_ = 0;
      for (int bi = 0; bi < 25; ++bi) { const char* base = (const char*)ldptr<char>(F, bi); const size_t bytes = bi < 23 ? (size_t)args.nbytes[bi] : (bi == 23 ? (size_t)M * D * 4 : (size_t)WS_END);
          for (size_t off = ((size_t)rank * 512 + threadIdx.x) * (size_t)TLB_WARM; off < bytes; off += (size_t)nrank * 512 * (size_t)TLB_WARM) acc_ += *(const volatile unsigned*)(base + off); }
      if (acc_ == 0x12345678u) ((volatile unsigned*)(args.ws + WS_CTL))[64] = acc_; }
    __syncthreads();
#endif
#ifdef WARM_READ_MB
    {
      const float* xw = ldptr<const float>(F, I_X); f32x4 acc_ = {0.f, 0.f, 0.f, 0.f}; const size_t nv = (size_t)WARM_READ_MB * 65536;
      for (size_t i = (size_t)blockIdx.x * 512 + threadIdx.x; i < nv; i += (size_t)gridDim.x * 512) acc_ += ((const f32x4*)xw)[i];
      if (acc_.x + acc_.y + acc_.z + acc_.w == 1.2345e30f) ((volatile float*)(args.ws + WS_CTL))[65] = acc_.x; }
    __syncthreads();
#endif
#ifdef MFMA_PROBE_ITERS
    {
      typedef short pb8 __attribute__((ext_vector_type(8))); typedef float pf4 __attribute__((ext_vector_type(4)));
      const unsigned lid = threadIdx.x * 2654435761u; unsigned pw[4] = {lid | 0x3f803f80u, (lid >> 3) | 0x3f003f00u, (lid << 5) ^ 0x40004000u, (lid >> 7) | 0x3e803e80u};
      pb8 pa = __builtin_bit_cast(pb8, *(v4u*)pw), pbb = pa; pf4 c0 = {0,0,0,0}, c1 = c0, c2 = c0, c3 = c0;
      for (int it = 0; it < MFMA_PROBE_ITERS; ++it) {
#pragma unroll
        for (int q = 0; q < 16; ++q) { c0 = __builtin_amdgcn_mfma_f32_16x16x32_bf16(pa, pbb, c0, 0, 0, 0); c1 = __builtin_amdgcn_mfma_f32_16x16x32_bf16(pbb, pa, c1, 0, 0, 0);
            c2 = __builtin_amdgcn_mfma_f32_16x16x32_bf16(pa, pa, c2, 0, 0, 0); c3 = __builtin_amdgcn_mfma_f32_16x16x32_bf16(pbb, pbb, c3, 0, 0, 0); }
        c0 *= 0.5f; c1 *= 0.5f; c2 *= 0.5f; c3 *= 0.5f; }
      if (c0[0] + c1[1] + c2[2] + c3[3] == 1.2345e30f) ((volatile float*)(args.ws + WS_CTL))[66] = c0[0]; }
    __syncthreads();
#endif
#ifdef START_DELAY_US
    { const unsigned long long t0 = __builtin_amdgcn_s_memrealtime(); while (__builtin_amdgcn_s_memrealtime() - t0 < (unsigned long long)START_DELAY_US * 100ull) __builtin_amdgcn_s_sleep(32); }
#endif
#if defined(FIX_P0_US) || defined(FIX_A_US)
    const unsigned long long t_start = __builtin_amdgcn_s_memrealtime();
#endif
#ifdef P0_SPLIT
    p0_prologue(F, 1); xcd_barrier(gbar);
#ifdef FIX_A_US
    while (__builtin_amdgcn_s_memrealtime() - t_start < (unsigned long long)FIX_A_US * 100ull) __builtin_amdgcn_s_sleep(32);
#endif
    p0_prologue(F, 2);
#else
    if (RUN(0)) { REPEAT(0) { if (rep) xcd_barrier(gbar); p0_prologue(F); } }
#endif
    if (ph >= lo && ph + 1 < hi) xcd_barrier(gbar);
    ++ph;
#ifndef GROUP_STAGGER_MODE
#define GROUP_STAGGER_MODE 0
#endif
#ifdef GROUP_STAGGER_TICKS
    { const unsigned long long t0 = __builtin_amdgcn_s_memrealtime(), w = (unsigned long long)(GROUP_STAGGER_MODE == 1 ? (blockIdx.x & 1) : (blockIdx.x & 7)) * GROUP_STAGGER_TICKS; while (__builtin_amdgcn_s_memrealtime() - t0 < w) __builtin_amdgcn_s_sleep(8); }
#endif
#ifdef FIX_P0_US
    while (__builtin_amdgcn_s_memrealtime() - t_start < (unsigned long long)FIX_P0_US * 100ull) __builtin_amdgcn_s_sleep(32);
#endif
#ifdef EXTRA_BARS
    for (int eb = 0; eb < EXTRA_BARS; ++eb) xcd_barrier(gbar);
#endif
#pragma unroll 1
    for (int l = 0; l < DEPTH; ++l) { l_cur = l;
#define D1P(ll) ((const bf16*)(ws + ((ll) < NA ? ZB_D1A : WS_DELTA)))
        if (RUN(1)) { unsigned char* ws = WSP(); const float* mod = MODP(l); bf16* xb = (bf16*)ldptr<float>(F, PT_OUT) + D;
              const bf16* d1 = (l == 0 || l - 1 >= NA) ? (const bf16*)nullptr : D1P(l - 1); const bf16* d2 = (l == 0) ? (const bf16*)nullptr : (const bf16*)(ws + WS_DELTA);
            if (l == NA) norm_phase<true, true>(F, (const float*)xb, d1, d2, xb, INP(I_NORMG) + (size_t)(2 * l) * D, mod, mod + D, NMOD, (bf16*)(ws + WS_H), INP(I_KVNG), (const float*)(ws + WS_KVMOD), (bf16*)(ws + ZB_HKV), INP(I_WF), INP(I_BF), (float*)(ws + WS_LOGF));
            else if (l <= 1) norm_phase<false, false>(F, INP(I_X), d1, d2, (l == 0) ? (bf16*)nullptr : xb, INP(I_NORMG) + (size_t)(2 * l) * D, mod, mod + D, NMOD, (bf16*)(ws + WS_H), nullptr, nullptr, nullptr, nullptr, nullptr, nullptr);
            else norm_phase<false, true>(F, (const float*)xb, d1, d2, xb, INP(I_NORMG) + (size_t)(2 * l) * D, mod, mod + D, NMOD, (bf16*)(ws + WS_H), nullptr, nullptr, nullptr, nullptr, nullptr, nullptr); }
        SEAM();
        if (l < NA) {
            if (RUN(2)) { REPEAT(2) { REP_BAR(); unsigned char* ws = WSP();
                pg8::Gemm g{(const bf16*)(ws + WS_H), (const bf16*)(ws + WS_WT) + WT_WIN + (size_t)l * GN * D, M, GN, D, 0}; pg8::StaticOrder S; S.init(M, GN, F.G, (int)blockIdx.x, WGM_G1);
#ifdef SG_V1
                pg8::EpiBf16<1, true> E{(bf16*)(ws + ZB_U), GH, GH, (size_t)(ZB_V - ZB_U) / 2, (pg8::f32x2v*)(ws + WS_VSTAT), M};
                pg8::gemm_phase<pg8::EpiBf16<1, true>, pg8::StaticOrder, PG8_ALIGN_SET, PG8_SP2_SET>(F.lds, g, S, E); } }
#else
                pg8::EpiGmlpIn E{(bf16*)(ws + ZB_U), (bf16*)(ws + ZB_V), (pg8::f32x2v*)(ws + WS_VSTAT), M, GH, (GELU_PROBE && rep < nrep_ - 1) ? 0 : 1};
                pg8::gemm_phase<pg8::EpiGmlpIn, pg8::StaticOrder, PG8_ALIGN_SET, PG8_SP2_SET>(F.lds, g, S, E); } }
#endif
            SEAM();
            if (RUN(3)) { REPEAT(3) { REP_BAR(); unsigned char* ws = WSP();
#ifdef SG_V1
                sg_phase_v1(F, l, (bf16*)(ws + ZB_U), (const bf16*)(ws + ZB_V), (const f32x2*)(ws + WS_VSTAT), INP(I_LNG) + (size_t)l * GH, INP(I_LNB) + (size_t)l * GH, (const float*)(ws + WS_WSM), INP(I_BS)); } }
#else
                sg_phase(F, l, (bf16*)(ws + ZB_U), (const bf16*)(ws + ZB_V), (const f32x2*)(ws + WS_VSTAT), INP(I_LNG) + (size_t)l * GH, INP(I_LNB) + (size_t)l * GH, (const float*)(ws + WS_WSM), INP(I_BS), rep == nrep_ - 1); } }
#endif
            SEAM();
        } else {
            const int bl = l - NA;
            if (RUN(4)) { REPEAT(4) { REP_BAR(); unsigned char* ws = WSP();
                if (l == NA) cumsum_phase(F, (const float*)(ws + WS_LOGF), (float*)(ws + WS_FB), INP(I_QNG), INP(I_KNG), (int*)(ws + WS_JLO));
#pragma unroll 1
                for (int s = (l == NA ? 0 : 1); s < 2; ++s) {
                    pg8::Gemm g{(const bf16*)(ws + (s == 0 ? ZB_HKV : WS_H)), (const bf16*)(ws + WS_WT) + (s == 0 ? WT_WKV : WT_WQ + (size_t)bl * D * D), M, s == 0 ? 2 * D : D, D, 0};
                    pg8::StaticOrder S; S.init(M, g.N, F.G, (int)blockIdx.x, WGM_QKV);
                    pg8::EpiHeadNorm E{(bf16*)(ws + (s == 0 ? ZB_KB : ZB_Q)), D, s == 0 ? D : 0, (size_t)(ZB_VB - ZB_KB) / 2, 1, s == 0 ? INP(I_KNG) : INP(I_QNG) + bl * HD, EPS, (LAS float*)(F.lds + RING_BYTES), s == 0 ? 1.0f : att::SCALE * att::LOG2E};
                    pg8::gemm_phase<pg8::EpiHeadNorm, pg8::StaticOrder, true, PG8_SP2_SET>(F.lds, g, S, E);
                } } }
            SEAM();
            if (RUN(6)) { REPEAT(6) { REP_BAR(); unsigned char* ws = WSP();
                attn_phase(F, (char*)lds, (const bf16*)(ws + ZB_Q), (const bf16*)(ws + ZB_KB), (const bf16*)(ws + ZB_VB), (bf16*)(ws + ZB_O), (const float*)(ws + WS_FB), (const int*)(ws + WS_JLO),
                           (unsigned*)(ws + WS_CTL) + CW_QUEUE + 512 * (2 * bl + rep)); } }
            SEAM();
        }
        if (RUN(7)) { REPEAT(7) { REP_BAR(); unsigned char* ws = WSP();
            pg8::StaticOrder S; S.init(M, D, F.G, (int)blockIdx.x, WGM_RES);
            pg8::EpiDelta E{(bf16*)D1P(l), D, MODP(l) + 2 * D, NMOD, SEQ / 256};
            if (l < NA) { pg8::Gemm g{(const bf16*)(ws + ZB_U), (const bf16*)(ws + WS_WT) + WT_WOUT + (size_t)l * D * GH, M, D, GH, 1};
                pg8::gemm_phase<pg8::EpiDelta, pg8::StaticOrder, PG8_ALIGN_SET, PG8_SP2_SET>(F.lds, g, S, E); }
            else { pg8::Gemm g{(const bf16*)(ws + ZB_O), (const bf16*)(ws + WS_WT) + WT_WO + (size_t)(l - NA) * D * D, M, D, D, 0};
                pg8::gemm_phase<pg8::EpiDelta, pg8::StaticOrder, PG8_ALIGN_SET, PG8_SP2_SET>(F.lds, g, S, E); } } }
        SEAM();
        if (RUN(8)) { unsigned char* ws = WSP(); const float* mod = MODP(l); bf16* xb = (bf16*)ldptr<float>(F, PT_OUT) + D;
            if (l == 0) norm_phase<false, false>(F, INP(I_X), D1P(l), nullptr, nullptr, INP(I_NORMG) + (size_t)(2 * l + 1) * D, mod + 3 * D, mod + 4 * D, NMOD, (bf16*)(ws + WS_H), nullptr, nullptr, nullptr, nullptr, nullptr, nullptr);
            else norm_phase<false, true>(F, (const float*)xb, D1P(l), nullptr, l < NA ? (bf16*)nullptr : xb, INP(I_NORMG) + (size_t)(2 * l + 1) * D, mod + 3 * D, mod + 4 * D, NMOD, (bf16*)(ws + WS_H), nullptr, nullptr, nullptr, nullptr, nullptr, nullptr); }
        SEAM();
#ifdef CLOCK_PROBE
        const unsigned long long cp_c0 = __builtin_amdgcn_s_memtime(), cp_r0 = __builtin_amdgcn_s_memrealtime();
#endif
        if (RUN(9)) { REPEAT(9) { REP_BAR(); unsigned char* ws = WSP();
            pg8::Gemm g{(const bf16*)(ws + WS_H), (const bf16*)(ws + WS_WT) + WT_W1 + (size_t)l * FF * D, M, FF, D, 0}; pg8::StaticOrder S; S.init(M, FF, F.G, (int)blockIdx.x, WGM_M1);
            pg8::EpiBf16<2, false, HID_TILED> E{(bf16*)(ws + ZB_HID), FF, 0, 0, nullptr, M};
            pg8::gemm_phase<pg8::EpiBf16<2, false, HID_TILED>, pg8::StaticOrder, PG8_ALIGN_SET, PG8_SP2_SET>(F.lds, g, S, E); } }
#ifdef CLOCK_PROBE
        if (l == CLOCK_PROBE && blockIdx.x == 0) {
            const unsigned long long dc = __builtin_amdgcn_s_memtime() - cp_c0, dr = __builtin_amdgcn_s_memrealtime() - cp_r0;
            const unsigned long long mhz = dc * 100ull / dr; const unsigned long long wait_ticks = (mhz > 1000ull ? mhz - 1000ull : 0ull) * 100ull;
            const unsigned long long t0 = __builtin_amdgcn_s_memrealtime(); while (__builtin_amdgcn_s_memrealtime() - t0 < wait_ticks) __builtin_amdgcn_s_sleep(32); }
#endif
        SEAM();
        if (RUN(10)) { REPEAT(10) { REP_BAR(); unsigned char* ws = WSP();
            pg8::Gemm g{(const bf16*)(ws + ZB_HID), (const bf16*)(ws + WS_WT) + WT_W2 + (size_t)l * D * FF, M, D, FF, HID_TILED ? 1 : 0}; pg8::StaticOrder S; S.init(M, D, F.G, (int)blockIdx.x, WGM_RES);
            pg8::EpiDelta E{(bf16*)(ws + WS_DELTA), D, MODP(l) + 5 * D, NMOD, SEQ / 256};
            pg8::gemm_phase<pg8::EpiDelta, pg8::StaticOrder, PG8_ALIGN_SET, PG8_SP2_SET>(F.lds, g, S, E); } }
        SEAM();
    }
    if (RUN(11)) { l_cur = 0; REPEAT(11) { REP_BAR(); unsigned char* ws = WSP(); float* out = ldptr<float>(F, PT_OUT); resid_final(F, (const bf16*)out + D, rep == nrep_ - 1 ? out : (float*)(ws + WS_Z), (const bf16*)(ws + WS_DELTA)); } }
#undef RUN
#undef SEAM
}

extern "C" void kernel_launch(void* const* d_in, const int* in_sizes, int n_in, void* d_out, int out_size, void* d_ws, size_t ws_size, hipStream_t stream) {
    static int grid = 0;
    if (grid == 0) {
        if (n_in != 23 || in_sizes[0] != M * D || out_size != M * D || ws_size < WS_END) { fprintf(stderr, "kernel_launch: shape/workspace mismatch (n_in %d in0 %d out %d ws %zu, need %zu)\n", n_in, n_in > 0 ? in_sizes[0] : -1, out_size, ws_size, (size_t)WS_END); grid = -1; return; }
        int dev = 0, cus = 0, per_cu = 0;
        if (hipGetDevice(&dev) != hipSuccess || hipDeviceGetAttribute(&cus, hipDeviceAttributeMultiprocessorCount, dev) != hipSuccess) { grid = -1; return; }
        if (hipFuncSetAttribute((const void*)yoco_fwd, hipFuncAttributeMaxDynamicSharedMemorySize, LDS_BYTES) != hipSuccess) { fprintf(stderr, "kernel_launch: hipFuncSetAttribute failed\n"); grid = -1; return; }
        if (hipOccupancyMaxActiveBlocksPerMultiprocessor(&per_cu, (const void*)yoco_fwd, NWAVES * 64, LDS_BYTES) != hipSuccess || per_cu < 1) { fprintf(stderr, "kernel_launch: occupancy query says %d\n", per_cu); }
        (void)hipGetLastError();
        grid = cus;
        if (grid != M / GB) { fprintf(stderr, "kernel_launch: this kernel needs exactly %d CUs (got %d)\n", M / GB, cus); grid = -1; return; }
    }
    if (grid < 0) return;
    if (hipMemsetAsync((char*)d_ws + WS_CTL, 0, CTL_ZERO_BYTES, stream) != hipSuccess) return;
    Args a{};
    for (int i = 0; i < 23; ++i) { a.in[i] = (const float*)d_in[i]; a.nbytes[i] = (unsigned)in_sizes[i] * 4u; }
    a.out = (float*)d_out; a.ws = (unsigned char*)d_ws;
#if MK_N_LAUNCHES == 1
    a.ph_lo = 0; a.ph_hi = 1000; a.li = 0; a.pad = 0;
    hipLaunchKernelGGL(yoco_fwd, dim3(grid), dim3(NWAVES * 64), LDS_BYTES, stream, a);
#else
    for (int li = 0; li < 64; ++li) { a.ph_lo = li; a.ph_hi = li + 1; a.li = li; a.pad = 0;
        hipLaunchKernelGGL(yoco_fwd, dim3(grid), dim3(NWAVES * 64), LDS_BYTES, stream, a); }
#endif
}
```

```cpp
#include <hip/hip_runtime.h>
#include <cstdio>
#include <cstdint>

template <int XM> __device__ __forceinline__ float lane_xor(float v) {
    static_assert(XM >= 1 && XM < 32, "lane_xor: in-half xor only");
    return __uint_as_float((unsigned)__builtin_amdgcn_ds_swizzle((int)__float_as_uint(v), (XM << 10) | 0x1F));
}
__device__ __forceinline__ float lane_sum_halves(float v) {
    auto rr = __builtin_amdgcn_permlane32_swap(__float_as_uint(v), __float_as_uint(v), false, false);
    return __uint_as_float(rr[0]) + __uint_as_float(rr[1]);
}
__device__ __forceinline__ float lane_max_halves(float v) {
    auto rr = __builtin_amdgcn_permlane32_swap(__float_as_uint(v), __float_as_uint(v), false, false);
    return fmaxf(__uint_as_float(rr[0]), __uint_as_float(rr[1]));
}
#ifndef PG8_BT
#define PG8_BT 1
#endif
#ifndef WGM_SET
#define WGM_SET 4
#endif
namespace pg8 {
#define PG8_LAS __attribute__((address_space(3)))
typedef unsigned short bf16_t;
typedef short bf16x8 __attribute__((ext_vector_type(8)));
typedef float f32x4 __attribute__((ext_vector_type(4)));
typedef unsigned u32x4 __attribute__((ext_vector_type(4)));
constexpr int BM = 256, BK = 64, HALF = 128, HTB = HALF * BK * 2  , STAGE_BYTES = 8 * HTB, NXCD = 8, WGM = WGM_SET;

__host__ __device__ __forceinline__ int lds_byte(int r, int c) { const int st = (r >> 4) * 2 + (c >> 5), rr = r & 15, cc = c & 31, ob = rr * 64 + cc * 2; return st * 1024 + (ob ^ (((ob >> 9) & 1) << 5)); }
__host__ __device__ __forceinline__ void stage_rc(int b, int& R, int& C) { const int st = b / 1024, sb = b % 1024, swz = sb ^ (((sb >> 9) & 1) << 5); R = (st >> 1) * 16 + swz / 64; C = (st & 1) * 32 + (swz % 64) / 2; }
__host__ __device__ __forceinline__ int perm32(int rho) { const int n = rho >> 4, i = rho & 15; return 8 * (i >> 2) + 4 * n + (i & 3); }

struct Unit { int pm, pn; };
struct Gemm { const bf16_t* A; const bf16_t* Bt; int M, N, K; int a_tiled; };

struct StaticOrder {
    int nM, nN, nwg, G, c, wgm;
    __host__ __device__ void init(int M, int N, int G_, int c_, int wgm_ = WGM) { nM = M / BM; nN = N / BM; nwg = nM * nN; G = G_; c = c_; wgm = wgm_; }
    __host__ __device__ bool next(int i, Unit& u) const {
        const long L = (long)i * G + c; if (L >= nwg) return false;
        int wgid = (int)L; { const int q = nwg / NXCD, r = nwg % NXCD, xcd = wgid % NXCD, off = wgid / NXCD; wgid = (xcd < r ? xcd * (q + 1) : r * (q + 1) + (xcd - r) * q) + off; }
        const int nig = wgm * nN, gid = wgid / nig, fm = gid * wgm, gsz = (nM - fm) < wgm ? (nM - fm) : wgm;
        u.pm = fm + ((wgid % nig) % gsz); u.pn = (wgid % nig) / gsz; return true;
    }
    __device__ __forceinline__ void a_ready(const Unit&) const {}
    __device__ __forceinline__ void done(const Unit&) const {}
};

__device__ __forceinline__ unsigned cvt_pk_bf16(float lo, float hi) { unsigned r; asm volatile("v_cvt_pk_bf16_f32 %0, %1, %2" : "=v"(r) : "v"(lo), "v"(hi)); return r; }
typedef float f32x2 __attribute__((ext_vector_type(2)));
#ifdef GELU_AS
__device__ __forceinline__ f32x2 gelu_pk(f32x2 v) {
    const f32x2 av = __builtin_elementwise_abs(v), d = av * 0.2316418882f + 1.0f;
    f32x2 t; t.x = __builtin_amdgcn_rcpf(d.x); t.y = __builtin_amdgcn_rcpf(d.y);
    f32x2 q = t * 0.5307027145f + (-0.7265760135f); q = q * t + 0.7107068705f; q = q * t + (-0.142248368f); q = q * t + 0.127414796f; q = q * t;
    const f32x2 s = (v * v) * (-0.72134752044f);
    f32x2 e; e.x = __builtin_amdgcn_exp2f(s.x); e.y = __builtin_amdgcn_exp2f(s.y);
    const f32x2 m = v * (q * e), r = v - m;
    f32x2 o; o.x = v.x < 0.f ? m.x : r.x; o.y = v.y < 0.f ? m.y : r.y; return o;
}
#else
__device__ __forceinline__ float relu1(float x) { float r; asm("v_max_f32_e32 %0, 0, %1" : "=v"(r) : "v"(x)); return r; }
__device__ __forceinline__ float absmin1(float x, float c) { float r; asm("v_min_f32_e64 %0, |%1|, %2" : "=v"(r) : "v"(x), "s"(c)); return r; }
__device__ __forceinline__ f32x2 gelu_pk(f32x2 v) {
    f32x2 a; a.x = absmin1(v.x, 12.f); a.y = absmin1(v.y, 12.f);
    f32x2 p = a * 3.3104759495472535e-05f + (-0.0007693342049606144f); p = p * a + 0.00808112882077694f; p = p * a + (-0.053412798792123795f); p = p * a + (-0.45877042412757874f);
    p = p * a + (-1.151201844215393f); p = p * a + (-0.9999930262565613f);
    f32x2 e; e.x = __builtin_amdgcn_exp2f(p.x); e.y = __builtin_amdgcn_exp2f(p.y);
    f32x2 r; r.x = relu1(v.x); r.y = relu1(v.y);
    return r - a * e;
}
#endif


#ifdef SC1_STORES
#define PG8_BIGSTORE(ptr, val) asm volatile("global_store_dwordx4 %0, %1, off sc1" :: "v"(ptr), "v"(val) : "memory")
#elif defined(NT_STORES)
#define PG8_BIGSTORE(ptr, val) __builtin_nontemporal_store((val), (ptr))
#else
#define PG8_BIGSTORE(ptr, val) (*(ptr) = (val))
#endif

typedef float f32x2v __attribute__((ext_vector_type(2)));
template <int ACT, bool VSTAT, bool TILED = false> struct EpiBf16 {
    static constexpr bool PERM = true, AFTER_DRAIN = false;
    bf16_t* O; int ldc; int split_cols; size_t split_stride; f32x2v* vstat; int Mrows;
    __device__ __forceinline__ void operator()(const f32x4 (&acc)[2][2][4][2], const Unit& u, int wr, int wc, int fr, int fq) const {
        const int row0 = u.pm * BM + wr * 64 + fr; int colt = u.pn * BM; bf16_t* base = O; int t = 0;
        if (split_cols) { t = colt / split_cols; base += (size_t)t * split_stride; colt -= t * split_cols; }
        const int col0 = colt + wc * 32 + 8 * fq;
        bf16_t* p0; size_t s_ai, s_m, s_bj;
        if (TILED) { const int nch = ldc >> 7; p0 = base + ((size_t)((u.pm * 2) * nch + (colt >> 7)) * 128 + wr * 64 + fr) * 128 + wc * 32 + 8 * fq; s_ai = (size_t)nch * 16384; s_m = 16 * 128; s_bj = 16384; }
        else { p0 = base + (size_t)row0 * ldc + col0; s_ai = (size_t)HALF * ldc; s_m = (size_t)16 * ldc; s_bj = HALF; }
#pragma unroll
        for (int ai = 0; ai < 2; ++ai)
#pragma unroll
            for (int m = 0; m < 4; ++m) { const int row = row0 + ai * HALF + m * 16;
                float s = 0.f, ss = 0.f;
#pragma unroll
                for (int bj = 0; bj < 2; ++bj) { f32x4 v0 = acc[ai][bj][m][0], v1 = acc[ai][bj][m][1];
                    if (ACT == 1) { f32x2 a = gelu_pk((f32x2){v0[0], v0[1]}), b = gelu_pk((f32x2){v0[2], v0[3]}), c = gelu_pk((f32x2){v1[0], v1[1]}), d = gelu_pk((f32x2){v1[2], v1[3]});
                        v0 = (f32x4){a.x, a.y, b.x, b.y}; v1 = (f32x4){c.x, c.y, d.x, d.y}; }
                    if (ACT == 2) {
#pragma unroll
                        for (int e = 0; e < 4; ++e) { const float a = relu1(v0[e]), b = relu1(v1[e]); v0[e] = a * a; v1[e] = b * b; } }
                    if (VSTAT) { s += ((v0[0] + v0[1]) + (v0[2] + v0[3])) + ((v1[0] + v1[1]) + (v1[2] + v1[3]));
                        ss += ((v0[0] * v0[0] + v0[1] * v0[1]) + (v0[2] * v0[2] + v0[3] * v0[3])) + ((v1[0] * v1[0] + v1[1] * v1[1]) + (v1[2] * v1[2] + v1[3] * v1[3])); }
                    u32x4 w; w.x = cvt_pk_bf16(v0[0], v0[1]); w.y = cvt_pk_bf16(v0[2], v0[3]); w.z = cvt_pk_bf16(v1[0], v1[1]); w.w = cvt_pk_bf16(v1[2], v1[3]);
                    PG8_BIGSTORE((u32x4*)(p0 + ai * s_ai + m * s_m + bj * s_bj), w); }
                if (VSTAT) { if (t == 1) { s += lane_xor<16>(s); s = lane_sum_halves(s); ss += lane_xor<16>(ss); ss = lane_sum_halves(ss);
                    if (fq == 0) vstat[(size_t)((colt >> 8) * 4 + wc) * Mrows + row] = (f32x2v){s, ss}; } } }
    }
};
struct EpiResid {
    static constexpr bool PERM = false, AFTER_DRAIN = false;
    const float* base; float* out; int ldc; const float* gate; int gstride; int tiles_per_batch;
    __device__ __forceinline__ void operator()(const f32x4 (&acc)[2][2][4][2], const Unit& u, int wr, int wc, int fr, int fq) const {
        const int col0 = u.pn * BM + wc * 32 + 4 * fq; const float* g = gate + (size_t)(u.pm / tiles_per_batch) * gstride + col0;
        f32x4 gv[2][2];
#pragma unroll
        for (int bj = 0; bj < 2; ++bj)
#pragma unroll
            for (int n = 0; n < 2; ++n) gv[bj][n] = *(const f32x4*)(g + bj * HALF + n * 16);
#pragma unroll
        for (int ai = 0; ai < 2; ++ai)
#pragma unroll
            for (int m = 0; m < 4; ++m) { const size_t off = (size_t)(u.pm * BM + ai * HALF + wr * 64 + m * 16 + fr) * ldc + col0;
#pragma unroll
                for (int bj = 0; bj < 2; ++bj)
#pragma unroll
                    for (int n = 0; n < 2; ++n) { const f32x4 bs = *(const f32x4*)(base + off + bj * HALF + n * 16); const f32x4 o = bs + gv[bj][n] * acc[ai][bj][m][n];
                        *(f32x4*)(out + off + bj * HALF + n * 16) = o; }
                if (m & 1) asm volatile("" ::: "memory"); }
    }
};


struct EpiGmlpIn {
    static constexpr bool PERM = true, AFTER_DRAIN = false;
    bf16_t* U; bf16_t* V; f32x2v* vstat; int Mrows; int GHc; int do_gelu;
    __device__ __forceinline__ void operator()(const f32x4 (&acc)[2][2][4][2], const Unit& u, int wr, int wc, int fr, int fq) const {
        const int colt_all = u.pn * BM; const int t = colt_all >= GHc ? 1 : 0; const int colt = colt_all - t * GHc; const int nch = GHc >> 7;
        const int frs = (fr & ~0xC) | ((fr & 4) << 1) | ((fr & 8) >> 1);
        const int row0 = u.pm * BM + wr * 64 + fr;
        char* p; size_t s_ai, s_m, s_bj;
        if (t == 0) { p = (char*)U + ((size_t)(u.pm * 2) * nch + (colt >> 7)) * 32768 + (size_t)(wr * 64 + fr) * 256 + (wc * 32 + 8 * fq) * 2; s_ai = (size_t)nch * 32768; s_m = 16 * 256; s_bj = 32768; }
        else { p = (char*)V + ((size_t)((u.pm * 2) * nch + (colt >> 7)) * 2 + wr) * 16384 + ((frs >> 3) * 4 + wc) * 512 + ((frs & 7) * 32 + 8 * fq) * 2; s_ai = (size_t)nch * 32768; s_m = 4096; s_bj = 32768; }
        f32x2v* vs = vstat + (size_t)((colt >> 8) * 4 + wc) * Mrows + row0;
        if (t == 0) body<false>(acc, p, s_ai, s_m, s_bj, vs, fq); else body<true>(acc, p, s_ai, s_m, s_bj, vs, fq);
    }
    template <bool STATS>
    __device__ __forceinline__ void body(const f32x4 (&acc)[2][2][4][2], char* p, size_t s_ai, size_t s_m, size_t s_bj, f32x2v* vs, int fq) const {
#pragma unroll
        for (int ai = 0; ai < 2; ++ai)
#pragma unroll
            for (int m = 0; m < 4; ++m) {
                f32x2 s2 = {0.f, 0.f}, q2 = {0.f, 0.f};
#pragma unroll
                for (int bj = 0; bj < 2; ++bj) { const f32x4 v0 = acc[ai][bj][m][0], v1 = acc[ai][bj][m][1];
                    f32x2 a = {v0[0], v0[1]}, b = {v0[2], v0[3]}, c = {v1[0], v1[1]}, d = {v1[2], v1[3]};
                    if (STATS && do_gelu) { a = gelu_pk(a); b = gelu_pk(b); c = gelu_pk(c); d = gelu_pk(d); }
                    if (STATS) { s2 += (a + b) + (c + d); q2 = a * a + q2; q2 = b * b + q2; q2 = c * c + q2; q2 = d * d + q2; }
                    u32x4 w; w.x = cvt_pk_bf16(a.x, a.y); w.y = cvt_pk_bf16(b.x, b.y); w.z = cvt_pk_bf16(c.x, c.y); w.w = cvt_pk_bf16(d.x, d.y);
                    PG8_BIGSTORE((u32x4*)(p + ai * s_ai + m * s_m + bj * s_bj), w); }
                if (STATS) { float s = s2.x + s2.y, ss = q2.x + q2.y; s += lane_xor<16>(s); s = lane_sum_halves(s); ss += lane_xor<16>(ss); ss = lane_sum_halves(ss);
                    if (fq == 0) vs[ai * HALF + m * 16] = (f32x2v){s, ss}; } }
    }
};

struct EpiDelta {
    static constexpr bool PERM = true, AFTER_DRAIN = false;
    bf16_t* O; int ldc; const float* gate; int gstride; int tiles_per_batch;
    __device__ __forceinline__ void operator()(const f32x4 (&acc)[2][2][4][2], const Unit& u, int wr, int wc, int fr, int fq) const {
        const int row0 = u.pm * BM + wr * 64 + fr, col0 = u.pn * BM + wc * 32 + 8 * fq; const float* g = gate + (size_t)(u.pm / tiles_per_batch) * gstride + col0;
        f32x4 gv[2][2];
#pragma unroll
        for (int bj = 0; bj < 2; ++bj)
#pragma unroll
            for (int n = 0; n < 2; ++n) gv[bj][n] = *(const f32x4*)(g + bj * HALF + 4 * n);
#pragma unroll
        for (int ai = 0; ai < 2; ++ai)
#pragma unroll
            for (int m = 0; m < 4; ++m) { bf16_t* rowp = O + (size_t)(row0 + ai * HALF + m * 16) * ldc + col0;
#pragma unroll
                for (int bj = 0; bj < 2; ++bj) { const f32x4 v0 = acc[ai][bj][m][0] * gv[bj][0], v1 = acc[ai][bj][m][1] * gv[bj][1];
                    u32x4 w; w.x = cvt_pk_bf16(v0[0], v0[1]); w.y = cvt_pk_bf16(v0[2], v0[3]); w.z = cvt_pk_bf16(v1[0], v1[1]); w.w = cvt_pk_bf16(v1[2], v1[3]);
                    PG8_BIGSTORE((u32x4*)(rowp + bj * HALF), w); } }
    }
};

struct EpiHeadNorm {
    static constexpr bool PERM = true, AFTER_DRAIN = false;
    bf16_t* O; int ldc; int split_cols; size_t split_stride; int norm_parts; const float* gain; float eps; PG8_LAS float* P; float gscale;
    __device__ __forceinline__ void operator()(const f32x4 (&acc)[2][2][4][2], const Unit& u, int wr, int wc, int fr, int fq) const {
        const int row0 = u.pm * BM + wr * 64 + fr; int colt = u.pn * BM; bf16_t* base = O; int t = 0;
        if (split_cols) { t = colt / split_cols; base += (size_t)t * split_stride; colt -= t * split_cols; }
        const int col0 = colt + wc * 32 + 8 * fq;
        const bool norm = t < norm_parts;
        if (norm) {
#pragma unroll
            for (int ai = 0; ai < 2; ++ai)
#pragma unroll
                for (int m = 0; m < 4; ++m)
#pragma unroll
                    for (int bj = 0; bj < 2; ++bj) { const f32x4 v0 = acc[ai][bj][m][0], v1 = acc[ai][bj][m][1];
                        float s = ((v0[0] * v0[0] + v0[1] * v0[1]) + (v0[2] * v0[2] + v0[3] * v0[3])) + ((v1[0] * v1[0] + v1[1] * v1[1]) + (v1[2] * v1[2] + v1[3] * v1[3]));
                        s += lane_xor<16>(s); s = lane_sum_halves(s);
                        if (fq == 0) P[(ai * HALF + wr * 64 + m * 16 + fr) * 8 + bj * 4 + wc] = s; }
            asm volatile("s_waitcnt lgkmcnt(0)" ::: "memory"); __builtin_amdgcn_s_barrier(); asm volatile("" ::: "memory");
        }
        f32x4 g0 = {1.f, 1.f, 1.f, 1.f}, g1 = {1.f, 1.f, 1.f, 1.f};
        if (norm) { g0 = *(const f32x4*)(gain + wc * 32 + 8 * fq) * gscale; g1 = *(const f32x4*)(gain + wc * 32 + 8 * fq + 4) * gscale; }
#pragma unroll
        for (int ai = 0; ai < 2; ++ai)
#pragma unroll
            for (int m = 0; m < 4; ++m) { bf16_t* rowp = base + (size_t)(row0 + ai * HALF + m * 16) * ldc + col0;
#pragma unroll
                for (int bj = 0; bj < 2; ++bj) { f32x4 v0 = acc[ai][bj][m][0], v1 = acc[ai][bj][m][1];
                    if (norm) { const f32x4 p = *(const PG8_LAS f32x4*)(P + (ai * HALF + wr * 64 + m * 16 + fr) * 8 + bj * 4);
                        const float r = 1.0f / sqrtf(((p[0] + p[1]) + (p[2] + p[3])) * (1.0f / 128.0f) + eps); v0 = v0 * r * g0; v1 = v1 * r * g1; }
                    u32x4 w; w.x = cvt_pk_bf16(v0[0], v0[1]); w.y = cvt_pk_bf16(v0[2], v0[3]); w.z = cvt_pk_bf16(v1[0], v1[1]); w.w = cvt_pk_bf16(v1[2], v1[3]);
                    PG8_BIGSTORE((u32x4*)(rowp + bj * HALF), w); } }
    }
};

template <class Epi, class Sched, bool ALIGN_EPI = false, bool SP2 = false>
__device__ __forceinline__ void gemm_phase(PG8_LAS unsigned char* lds, const Gemm g, const Sched& S, const Epi& E) {
    int tid_ = threadIdx.x; asm volatile("" : "+v"(tid_));
    const int tid = tid_, wid = __builtin_amdgcn_readfirstlane(tid >> 6), lane = tid & 63, wr = wid >> 2, wc = wid & 3, fr = lane & 15, fq = lane >> 4;
    const int K = g.K, nt = K / BK, rsA = g.a_tiled ? 128 : K;
#define PG8_KOFFA(t) (g.a_tiled ? ((size_t)((t) >> 1) * 32768 + (size_t)((t) & 1) * 128) : (size_t)(t) * kstep)
#define PG8_KOFFB(t) (PG8_BT ? ((size_t)((t) >> 1) * 32768 + (size_t)((t) & 1) * 128) : (size_t)(t) * kstep)
    unsigned voffA[2], voffB[2];
#pragma unroll
    for (int i = 0; i < 2; ++i) { int R, C; stage_rc(tid * 16 + i * 8192, R, C); const int Rb = Epi::PERM ? ((R & ~31) + perm32(R & 31)) : R;
        voffA[i] = (unsigned)(R * rsA + C) * 2u; voffB[i] = (unsigned)(Rb * (PG8_BT ? 128 : K) + C) * 2u; }
    const size_t kstep = (size_t)(BK * 2);
    const size_t hstep = (size_t)HALF * K * 2;
    const size_t tstep = 2 * hstep;
    const unsigned ldsw = (unsigned)wid * 1024u;
    const int aoff = lds_byte(wr * 64 + fr, fq * 8), boff = lds_byte(wc * 32 + fr, fq * 8);
#define PG8_SA(b, h) (((b) * 2 + (h)) * HTB)
#define PG8_SB(b, h) ((4 + (b) * 2 + (h)) * HTB)
#define PG8_STAGE(bufoff, gbase, voff) do { _Pragma("unroll") for (int _i = 0; _i < 2; ++_i) \
        __builtin_amdgcn_global_load_lds((const unsigned*)((const char*)(gbase) + (voff)[_i]), (PG8_LAS unsigned*)(lds + (bufoff) + ldsw + _i * 8192), 16, 0, 0); } while (0)
#define PG8_LDA(dst, b, h) do { _Pragma("unroll") for (int m = 0; m < 4; ++m) _Pragma("unroll") for (int k = 0; k < 2; ++k) dst[m][k] = *(const PG8_LAS bf16x8*)(lds + PG8_SA(b, h) + aoff + m * 2048 + k * 1024); } while (0)
#define PG8_LDB(dst, b, h) do { _Pragma("unroll") for (int n = 0; n < 2; ++n) _Pragma("unroll") for (int k = 0; k < 2; ++k) dst[n][k] = *(const PG8_LAS bf16x8*)(lds + PG8_SB(b, h) + boff + n * 2048 + k * 1024); } while (0)
#define PG8_MMA(ai, bj, At, Bt) do { __builtin_amdgcn_s_setprio(1); _Pragma("unroll") for (int m = 0; m < 4; ++m) _Pragma("unroll") for (int n = 0; n < 2; ++n) _Pragma("unroll") for (int k = 0; k < 2; ++k) \
        acc[ai][bj][m][n] = __builtin_amdgcn_mfma_f32_16x16x32_bf16(Bt[n][k], At[m][k], acc[ai][bj][m][n], 0, 0, 0); __builtin_amdgcn_s_setprio(0); } while (0)
#define PG8_WAIT_V(n) asm volatile("s_waitcnt vmcnt(" #n ")" ::: "memory")
#define PG8_WAIT_L(n) asm volatile("s_waitcnt lgkmcnt(" #n ")" ::: "memory")
#define PG8_BAR __builtin_amdgcn_s_barrier()
#define PG8_SCHED __builtin_amdgcn_sched_barrier(0)
    Unit cur, nxt; int ui = 0;
    if (!S.next(0, cur)) return;
#ifdef STAGGER_TICKS
    { const unsigned grp = (blockIdx.x >> 3) & 3u; if (grp) { const unsigned long long t0 = __builtin_amdgcn_s_memrealtime(); while (__builtin_amdgcn_s_memrealtime() - t0 < (unsigned long long)(grp * STAGGER_TICKS)) __builtin_amdgcn_s_sleep(2); } }
#endif
    f32x4 acc[2][2][4][2];
#pragma unroll
    for (int a = 0; a < 2; ++a)
#pragma unroll
        for (int b = 0; b < 2; ++b)
#pragma unroll
            for (int m = 0; m < 4; ++m)
#pragma unroll
                for (int n = 0; n < 2; ++n) acc[a][b][m][n] = (f32x4){0.f, 0.f, 0.f, 0.f};
    bf16x8 At[4][2], B0[2][2], B1[2][2];
    const char* cA = (const char*)g.A + (size_t)cur.pm * tstep; const char* cB = (const char*)g.Bt + (size_t)cur.pn * tstep;
    S.a_ready(cur);
    if constexpr (SP2) {
        PG8_STAGE(PG8_SB(0, 0), cB, voffB); PG8_STAGE(PG8_SB(0, 1), cB + hstep, voffB); PG8_STAGE(PG8_SA(0, 0), cA, voffA); PG8_STAGE(PG8_SA(0, 1), cA + hstep, voffA);
        if (wr == 1) PG8_BAR;
        PG8_WAIT_V(2); PG8_BAR;
        PG8_STAGE(PG8_SB(1, 0), cB + kstep, voffB); PG8_STAGE(PG8_SA(1, 0), cA + kstep, voffA); PG8_STAGE(PG8_SB(1, 1), cB + hstep + kstep, voffB);
        PG8_WAIT_V(6); PG8_BAR;
    } else {
        PG8_STAGE(PG8_SB(0, 0), cB, voffB); PG8_STAGE(PG8_SA(0, 0), cA, voffA); PG8_STAGE(PG8_SB(0, 1), cB + hstep, voffB); PG8_STAGE(PG8_SA(0, 1), cA + hstep, voffA);
        if (wr == 1) PG8_BAR;
        PG8_WAIT_V(4); PG8_BAR;
        PG8_STAGE(PG8_SB(1, 0), cB + kstep, voffB); PG8_STAGE(PG8_SA(1, 0), cA + kstep, voffA); PG8_STAGE(PG8_SB(1, 1), cB + hstep + kstep, voffB);
        PG8_WAIT_V(6); PG8_BAR;
    }
    for (;;) {
        const bool has_next = S.next(ui + 1, nxt);
        const char* nA = has_next ? (const char*)g.A + (size_t)nxt.pm * tstep : cA; const char* nB = has_next ? (const char*)g.Bt + (size_t)nxt.pn * tstep : cB;
        for (int t = 0; t < nt; t += 2) {
            const bool last = (t == nt - 2);
            const char* a1 = cA + PG8_KOFFA(t + 1);
            const char* a2 = last ? nA : cA + PG8_KOFFA(t + 2); const char* b2 = last ? nB : cB + PG8_KOFFB(t + 2);
            const char* a3 = a2 + kstep; const char* b3 = b2 + kstep;
            if (last && has_next) S.a_ready(nxt);
            if constexpr (SP2) {
            PG8_LDB(B0, 0, 0); PG8_LDB(B1, 0, 1); PG8_SCHED; PG8_LDA(At, 0, 0); PG8_STAGE(PG8_SA(1, 1), a1 + hstep, voffA);
            PG8_WAIT_V(8); PG8_WAIT_L(0); PG8_BAR; PG8_MMA(0, 0, At, B0); PG8_MMA(0, 1, At, B1); PG8_BAR; PG8_SCHED;
            PG8_LDA(At, 0, 1); PG8_STAGE(PG8_SB(0, 0), b2, voffB); PG8_STAGE(PG8_SB(0, 1), b2 + hstep, voffB); PG8_STAGE(PG8_SA(0, 0), a2, voffA);
            PG8_WAIT_V(8); PG8_WAIT_L(0); PG8_BAR; PG8_MMA(1, 0, At, B0); PG8_MMA(1, 1, At, B1); PG8_BAR; PG8_SCHED;
            PG8_LDB(B0, 1, 0); PG8_LDB(B1, 1, 1); PG8_SCHED; PG8_LDA(At, 1, 0); PG8_STAGE(PG8_SA(0, 1), a2 + hstep, voffA);
            PG8_WAIT_V(8); PG8_WAIT_L(0); PG8_BAR; PG8_MMA(0, 0, At, B0); PG8_MMA(0, 1, At, B1); PG8_BAR; PG8_SCHED;
            PG8_LDA(At, 1, 1); PG8_STAGE(PG8_SB(1, 0), b3, voffB); PG8_STAGE(PG8_SB(1, 1), b3 + hstep, voffB); PG8_STAGE(PG8_SA(1, 0), a3, voffA);
            PG8_WAIT_V(8); PG8_WAIT_L(0); PG8_BAR; PG8_MMA(1, 0, At, B0); PG8_MMA(1, 1, At, B1); PG8_BAR; PG8_SCHED;
            } else {
            PG8_LDB(B0, 0, 0); PG8_SCHED; PG8_LDA(At, 0, 0); PG8_STAGE(PG8_SA(1, 1), a1 + hstep, voffA);
            PG8_WAIT_L(8); PG8_BAR; PG8_WAIT_L(0); PG8_MMA(0, 0, At, B0); PG8_BAR; PG8_SCHED;
            PG8_LDB(B1, 0, 1); PG8_STAGE(PG8_SB(0, 0), b2, voffB);
            PG8_BAR; PG8_WAIT_L(0); PG8_MMA(0, 1, At, B1); PG8_BAR;
            PG8_LDA(At, 0, 1); PG8_STAGE(PG8_SA(0, 0), a2, voffA);
            PG8_BAR; PG8_WAIT_L(0); PG8_MMA(1, 0, At, B0); PG8_BAR; PG8_SCHED;
            PG8_STAGE(PG8_SB(0, 1), b2 + hstep, voffB);
            PG8_WAIT_V(6); PG8_BAR; PG8_MMA(1, 1, At, B1); PG8_BAR;
            PG8_LDB(B0, 1, 0); PG8_SCHED; PG8_LDA(At, 1, 0); PG8_STAGE(PG8_SA(0, 1), a2 + hstep, voffA);
            PG8_WAIT_L(8); PG8_BAR; PG8_WAIT_L(0); PG8_MMA(0, 0, At, B0); PG8_BAR; PG8_SCHED;
            PG8_LDB(B1, 1, 1); PG8_STAGE(PG8_SB(1, 0), b3, voffB);
            PG8_BAR; PG8_WAIT_L(0); PG8_MMA(0, 1, At, B1); PG8_BAR;
            PG8_LDA(At, 1, 1); PG8_STAGE(PG8_SA(1, 0), a3, voffA);
            PG8_BAR; PG8_WAIT_L(0); PG8_MMA(1, 0, At, B0); PG8_BAR; PG8_SCHED;
            PG8_STAGE(PG8_SB(1, 1), b3 + hstep, voffB);
            PG8_WAIT_V(6); PG8_BAR; PG8_MMA(1, 1, At, B1); PG8_BAR;
            }
        }
        if constexpr (ALIGN_EPI) { if (wr == 0) PG8_BAR; }
        if constexpr (!Epi::AFTER_DRAIN) { E(acc, cur, wr, wc, fr, fq); S.done(cur); }
        if (!has_next) break;
#pragma unroll
        for (int a = 0; a < 2; ++a)
#pragma unroll
            for (int b = 0; b < 2; ++b)
#pragma unroll
                for (int m = 0; m < 4; ++m)
#pragma unroll
                    for (int n = 0; n < 2; ++n) acc[a][b][m][n] = (f32x4){0.f, 0.f, 0.f, 0.f};
        cur = nxt; cA = nA; cB = nB; ++ui;
        if constexpr (ALIGN_EPI) { if (wr == 1) PG8_BAR; }
    }
    PG8_WAIT_V(0);
    if constexpr (!ALIGN_EPI) { if (wr == 0) PG8_BAR; }
    PG8_BAR;
    if constexpr (Epi::AFTER_DRAIN) { E.fused(acc, cur, wr, wc, fr, fq, lds, wid, lane); S.done(cur); }
#undef PG8_SA
#undef PG8_KOFFA
#undef PG8_KOFFB
#undef PG8_SB
#undef PG8_STAGE
#undef PG8_LDA
#undef PG8_LDB
#undef PG8_MMA
#undef PG8_WAIT_V
#undef PG8_WAIT_L
#undef PG8_BAR
#undef PG8_SCHED
}
}

namespace att {
typedef unsigned short bf16;
typedef short bf16x8 __attribute__((ext_vector_type(8)));
typedef short s16x4 __attribute__((ext_vector_type(4)));
typedef float f32x16 __attribute__((ext_vector_type(16)));
typedef float f32x4 __attribute__((ext_vector_type(4)));
typedef unsigned u32x4 __attribute__((ext_vector_type(4)));
typedef unsigned u32x2 __attribute__((ext_vector_type(2)));
constexpr int D = 128, PITCH = 2048, SEQ = 4096, NH = 16, NB = 8;
#ifndef ATT_THR
#define ATT_THR 8.f
#endif
constexpr float THR = ATT_THR;
constexpr float SCALE = 0.08838834764831845f;
constexpr float INV_SCALE = 11.313708498984761f;
constexpr float LOG2E = 1.4426950408889634f;
constexpr int NW = 8, QBLK = 32, KVBLK = 64, QB = NW * QBLK;
constexpr int SHM_V = KVBLK * D * 2, SHM_K = KVBLK * D * 2;
constexpr int NVB = 3;
constexpr int LDS_WS = NVB * SHM_V + 2 * SHM_K;
constexpr int LDS_FB = LDS_WS + NW * 64 * 4;
constexpr int LDS_BYTES = LDS_FB + SEQ * 8;
constexpr int W = 1 << 30;

#define KSWZ(row, colB) ((row) * 256 + ((colB) ^ (((row) & 7) << 4)))
#define SBAR() __builtin_amdgcn_sched_barrier(0)
__device__ __forceinline__ int v_st(int k, int c) { const int kk = (k & ~0xC) | ((k & 4) << 1) | ((k & 8) >> 1); return ((kk >> 3) * 4 + (c >> 5)) * 512 + ((kk & 7) * 32 + (c & 31)) * 2; }
__device__ __forceinline__ int v_rd_base(int lane) { return ((lane & 3) << 3) | (((lane >> 2) & 3) << 6) | (((lane >> 4) & 1) << 5) | (((lane >> 5) & 1) << 8); }
constexpr int v_rd_off(int d0, int ks, int half) { return d0 * 512 + ks * 4096 + half * 2048; }
__device__ __forceinline__ int crow(int r, int hi) { return (r & 3) + 8 * (r >> 2) + 4 * hi; }
__device__ __forceinline__ unsigned cvtpk(float lo, float hi) { unsigned r; asm volatile("v_cvt_pk_bf16_f32 %0, %1, %2" : "=v"(r) : "v"(lo), "v"(hi)); return r; }
__device__ __forceinline__ bf16x8 load8(const bf16* p) { return *reinterpret_cast<const bf16x8*>(p); }
__device__ __forceinline__ void mask_tile(f32x16& p0, f32x16& p1, int dq, unsigned Wm) {
    const float NEG = -__builtin_inff();
#pragma unroll
    for (int r = 0; r < 16; ++r) {
        const int c = (r & 3) + 8 * (r >> 2);
        if ((unsigned)(dq - c) >= Wm) p0[r] = NEG;
        if ((unsigned)(dq - c - 32) >= Wm) p1[r] = NEG;
    }
}
__device__ __forceinline__ void split3(float x, unsigned& w0, unsigned& w1) {
    const unsigned xh = cvtpk(x, 0.f) & 0xffffu; const float r1 = x - __uint_as_float(xh << 16);
    const unsigned xm = cvtpk(r1, 0.f) & 0xffffu; const float r2 = r1 - __uint_as_float(xm << 16);
    w0 = xh | (xm << 16); w1 = cvtpk(r2, 0.f) & 0xffffu;
}
__device__ __forceinline__ bf16x8 make_negB(float m_ref, int hi) {
    unsigned n0, n1; split3(-m_ref, n0, n1);
    u32x4 w = {0x3F803F80u, 0x00003F80u | (n0 << 16), (n0 >> 16) | (n1 << 16), 0u};
    if (hi) w = (u32x4){0u, 0u, 0u, 0u};
    return *reinterpret_cast<bf16x8*>(&w);
}
__device__ __forceinline__ void trackmax(const f32x16& p0, const f32x16& p1, bool track, float& mrun) {
    if (track) { float pmax = p0[0]; for (int r = 1; r < 16; ++r) pmax = fmaxf(pmax, p0[r]); for (int r = 0; r < 16; ++r) pmax = fmaxf(pmax, p1[r]);
        auto rr = __builtin_amdgcn_permlane32_swap(__float_as_uint(pmax), __float_as_uint(pmax), false, false);
        mrun = fmaxf(mrun, fmaxf(__uint_as_float(rr[0]), __uint_as_float(rr[1]))); }
}
__device__ __forceinline__ void partialSM(f32x16& p0) {
    for (int r = 0; r < 16; ++r) p0[r] = __builtin_amdgcn_exp2f(p0[r]);
}
__device__ __forceinline__ void finishSM(f32x16& p0, f32x16& p1, float& l_reg, bf16x8& pa0, bf16x8& pa1, bf16x8& pa2, bf16x8& pa3) {
    for (int r = 0; r < 16; ++r) p1[r] = __builtin_amdgcn_exp2f(p1[r]);
    float ps = 0; for (int r = 0; r < 16; ++r) ps += p0[r]; for (int r = 0; r < 16; ++r) ps += p1[r];
    { auto rr = __builtin_amdgcn_permlane32_swap(__float_as_uint(ps), __float_as_uint(ps), false, false);
      ps = __uint_as_float(rr[0]) + __uint_as_float(rr[1]); }
    l_reg += ps;
#define PK4(P, B_, OUT) do { unsigned a0 = cvtpk(P[B_+0], P[B_+1]), a1 = cvtpk(P[B_+2], P[B_+3]);                          \
        unsigned b0 = cvtpk(P[B_+4], P[B_+5]), b1 = cvtpk(P[B_+6], P[B_+7]);                                             \
        auto r0 = __builtin_amdgcn_permlane32_swap(a0, b0, false, false); auto r1 = __builtin_amdgcn_permlane32_swap(a1, b1, false, false); \
        u32x4 w = {r0[0], r1[0], r0[1], r1[1]}; OUT = *reinterpret_cast<bf16x8*>(&w); } while (0)
    PK4(p0, 0, pa0); PK4(p0, 8, pa1); PK4(p1, 0, pa2); PK4(p1, 8, pa3);
#undef PK4
}
#define KRD(dst, a, off) asm volatile("ds_read_b128 %0, %1 offset:%2" : "=&v"(dst) : "v"(a), "i"(off) : "memory")
#define KWAIT(f0, f1, n) asm volatile("s_waitcnt lgkmcnt(%2)" : "+v"(f0), "+v"(f1) : "i"(n) : "memory")
#ifdef ATT_QKT_ORIG
#define qkt qkt_c
#endif
template <int KB>
__device__ __forceinline__ void qkt_c(f32x16& p0, f32x16& p1, const int (&ka)[4], const bf16x8* qr, const char* fb, bf16x8 ones) {
    p0 = f32x16{}; p1 = f32x16{};
#pragma unroll
    for (int d0 = 0; d0 < 8; ++d0) { const __attribute__((address_space(3))) char* a = (const __attribute__((address_space(3))) char*)(uintptr_t)(unsigned)ka[d0 & 3] + KB * SHM_K + (d0 >> 2) * 128;
        bf16x8 b0 = *reinterpret_cast<const __attribute__((address_space(3))) bf16x8*>(a);
        bf16x8 b1 = *reinterpret_cast<const __attribute__((address_space(3))) bf16x8*>(a + 32 * 256);
        p0 = __builtin_amdgcn_mfma_f32_32x32x16_bf16(b0, qr[d0], p0, 0, 0, 0);
        p1 = __builtin_amdgcn_mfma_f32_32x32x16_bf16(b1, qr[d0], p1, 0, 0, 0); }
    { const u32x2 t0 = *reinterpret_cast<const u32x2*>(fb), t1 = *reinterpret_cast<const u32x2*>(fb + 32 * 8);
      u32x4 w0 = {t0.x, t0.y, 0x3F803F80u, 0u}, w1 = {t1.x, t1.y, 0x3F803F80u, 0u};
      p0 = __builtin_amdgcn_mfma_f32_32x32x16_bf16(*reinterpret_cast<bf16x8*>(&w0), ones, p0, 0, 0, 0);
      p1 = __builtin_amdgcn_mfma_f32_32x32x16_bf16(*reinterpret_cast<bf16x8*>(&w1), ones, p1, 0, 0, 0); }
}
#ifndef ATT_QKT_ORIG
template <int KB>
__device__ __forceinline__ void qkt(f32x16& p0, f32x16& p1, const int (&ka)[4], const bf16x8* qr, const char* fb, bf16x8 ones) {
    p0 = f32x16{}; p1 = f32x16{};
    bf16x8 fa0, fa1, fb0, fb1, fc0, fc1;
#define KOFF(d0) (KB * SHM_K + ((d0) >> 2) * 128)
#define KLD(x0, x1, d0) do { KRD(x0, ka[(d0) & 3], KOFF(d0)); KRD(x1, ka[(d0) & 3], KOFF(d0) + 32 * 256); } while (0)
#ifdef ATT_QKT_SBAR
#define KMM(x0, x1, d0, n) do { asm volatile("s_waitcnt lgkmcnt(%0)" :: "i"(n) : "memory"); SBAR(); p0 = __builtin_amdgcn_mfma_f32_32x32x16_bf16(x0, qr[d0], p0, 0, 0, 0); p1 = __builtin_amdgcn_mfma_f32_32x32x16_bf16(x1, qr[d0], p1, 0, 0, 0); SBAR(); } while (0)
#else
#define KMM(x0, x1, d0, n) do { KWAIT(x0, x1, n); p0 = __builtin_amdgcn_mfma_f32_32x32x16_bf16(x0, qr[d0], p0, 0, 0, 0); p1 = __builtin_amdgcn_mfma_f32_32x32x16_bf16(x1, qr[d0], p1, 0, 0, 0); } while (0)
#endif
    KLD(fa0, fa1, 0); KLD(fb0, fb1, 1); KLD(fc0, fc1, 2);
    KMM(fa0, fa1, 0, 4); KLD(fa0, fa1, 3);
    KMM(fb0, fb1, 1, 4); KLD(fb0, fb1, 4);
    KMM(fc0, fc1, 2, 4); KLD(fc0, fc1, 5);
    KMM(fa0, fa1, 3, 4); KLD(fa0, fa1, 6);
    KMM(fb0, fb1, 4, 4); KLD(fb0, fb1, 7);
    KMM(fc0, fc1, 5, 4);
    KMM(fa0, fa1, 6, 2);
    KMM(fb0, fb1, 7, 0);
#undef KMM
#undef KLD
#undef KOFF
    { const u32x2 t0 = *reinterpret_cast<const u32x2*>(fb), t1 = *reinterpret_cast<const u32x2*>(fb + 32 * 8);
      u32x4 w0 = {t0.x, t0.y, 0x3F803F80u, 0u}, w1 = {t1.x, t1.y, 0x3F803F80u, 0u};
      p0 = __builtin_amdgcn_mfma_f32_32x32x16_bf16(*reinterpret_cast<bf16x8*>(&w0), ones, p0, 0, 0, 0);
      p1 = __builtin_amdgcn_mfma_f32_32x32x16_bf16(*reinterpret_cast<bf16x8*>(&w1), ones, p1, 0, 0, 0); }
}
#endif
template <int KB>
__device__ __forceinline__ void qkt_sm(f32x16& p0, f32x16& p1, const int (&ka)[4], const bf16x8* qr, const char* fb, bf16x8 ones,
                                       f32x16& y0, f32x16& y1, float& l_reg, bf16x8& pa0, bf16x8& pa1, bf16x8& pa2, bf16x8& pa3) {
    p0 = f32x16{}; p1 = f32x16{};
    bf16x8 fa0, fa1, fb0, fb1, fc0, fc1; float ps;
#define KOFF(d0) (KB * SHM_K + ((d0) >> 2) * 128)
#define KLD(x0, x1, d0) do { KRD(x0, ka[(d0) & 3], KOFF(d0)); KRD(x1, ka[(d0) & 3], KOFF(d0) + 32 * 256); } while (0)
#define KMM(x0, x1, d0, n) asm volatile("s_waitcnt lgkmcnt(%0)" :: "i"(n) : "memory"); SBAR(); p0 = __builtin_amdgcn_mfma_f32_32x32x16_bf16(x0, qr[d0], p0, 0, 0, 0); p1 = __builtin_amdgcn_mfma_f32_32x32x16_bf16(x1, qr[d0], p1, 0, 0, 0);
#define PK4(P, B_, OUT) do { unsigned a0 = cvtpk(P[B_+0], P[B_+1]), a1 = cvtpk(P[B_+2], P[B_+3]);                          \
        unsigned b0 = cvtpk(P[B_+4], P[B_+5]), b1 = cvtpk(P[B_+6], P[B_+7]);                                             \
        auto r0 = __builtin_amdgcn_permlane32_swap(a0, b0, false, false); auto r1 = __builtin_amdgcn_permlane32_swap(a1, b1, false, false); \
        u32x4 w = {r0[0], r1[0], r0[1], r1[1]}; OUT = *reinterpret_cast<bf16x8*>(&w); } while (0)
#define EX4(B_) do { y1[B_] = __builtin_amdgcn_exp2f(y1[B_]); y1[B_+1] = __builtin_amdgcn_exp2f(y1[B_+1]); y1[B_+2] = __builtin_amdgcn_exp2f(y1[B_+2]); y1[B_+3] = __builtin_amdgcn_exp2f(y1[B_+3]); \
        ps += (y1[B_] + y1[B_+1]) + (y1[B_+2] + y1[B_+3]); } while (0)
    KLD(fa0, fa1, 0); KLD(fb0, fb1, 1); KLD(fc0, fc1, 2);
    KMM(fa0, fa1, 0, 4) ps = (((y0[0] + y0[1]) + (y0[2] + y0[3])) + ((y0[4] + y0[5]) + (y0[6] + y0[7]))) + (((y0[8] + y0[9]) + (y0[10] + y0[11])) + ((y0[12] + y0[13]) + (y0[14] + y0[15]))); SBAR(); KLD(fa0, fa1, 3);
    KMM(fb0, fb1, 1, 4) PK4(y0, 0, pa0); PK4(y0, 8, pa1); SBAR(); KLD(fb0, fb1, 4);
    KMM(fc0, fc1, 2, 4) EX4(0); SBAR(); KLD(fc0, fc1, 5);
    KMM(fa0, fa1, 3, 4) EX4(4); SBAR(); KLD(fa0, fa1, 6);
    KMM(fb0, fb1, 4, 4) EX4(8); SBAR(); KLD(fb0, fb1, 7);
    KMM(fc0, fc1, 5, 4) EX4(12); SBAR();
    KMM(fa0, fa1, 6, 2) PK4(y1, 0, pa2); SBAR();
    KMM(fb0, fb1, 7, 0) PK4(y1, 8, pa3);
    { auto rr = __builtin_amdgcn_permlane32_swap(__float_as_uint(ps), __float_as_uint(ps), false, false); ps = __uint_as_float(rr[0]) + __uint_as_float(rr[1]); }
    l_reg += ps; SBAR();
#undef EX4
#undef PK4
#undef KMM
#undef KLD
#undef KOFF
    { const u32x2 t0 = *reinterpret_cast<const u32x2*>(fb), t1 = *reinterpret_cast<const u32x2*>(fb + 32 * 8);
      u32x4 w0 = {t0.x, t0.y, 0x3F803F80u, 0u}, w1 = {t1.x, t1.y, 0x3F803F80u, 0u};
      p0 = __builtin_amdgcn_mfma_f32_32x32x16_bf16(*reinterpret_cast<bf16x8*>(&w0), ones, p0, 0, 0, 0);
      p1 = __builtin_amdgcn_mfma_f32_32x32x16_bf16(*reinterpret_cast<bf16x8*>(&w1), ones, p1, 0, 0, 0); }
}
template <bool EX = true>
__device__ __forceinline__ void pv_tile(f32x16* o, int vb0  , bf16x8 pa0, bf16x8 pa1, bf16x8 pa2, bf16x8 pa3, f32x16& px) {
#define TRRD(dst, off) asm volatile("ds_read_b64_tr_b16 %0, %1 offset:%2" : "=&v"(dst) : "v"(vb0), "i"(off) : "memory")
#define VLD(x0, x1, x2, x3, hg) do { constexpr int b_ = v_rd_off((hg) >> 1, 2 * ((hg) & 1), 0); TRRD(x0, b_); TRRD(x1, b_ + 2048); TRRD(x2, b_ + 4096); TRRD(x3, b_ + 6144); } while (0)
#define VMM(x0, x1, x2, x3, hg, pq0, pq1, n) do { asm volatile("s_waitcnt lgkmcnt(%0)" :: "i"(n) : "memory"); SBAR();                                   \
        o[(hg) >> 1] = __builtin_amdgcn_mfma_f32_32x32x16_bf16(pq0, (bf16x8){x0[0], x0[1], x0[2], x0[3], x1[0], x1[1], x1[2], x1[3]}, o[(hg) >> 1], 0, 0, 0);                        \
        if (EX) px[2 * (hg)] = __builtin_amdgcn_exp2f(px[2 * (hg)]);                                                                                                                \
        o[(hg) >> 1] = __builtin_amdgcn_mfma_f32_32x32x16_bf16(pq1, (bf16x8){x2[0], x2[1], x2[2], x2[3], x3[0], x3[1], x3[2], x3[3]}, o[(hg) >> 1], 0, 0, 0);                        \
        if (EX) { px[2 * (hg) + 1] = __builtin_amdgcn_exp2f(px[2 * (hg) + 1]); asm volatile("" : "+v"(px[2 * (hg)]), "+v"(px[2 * (hg) + 1])); }     \
        SBAR(); } while (0)
    s16x4 a0, a1, a2, a3, b0, b1, b2, b3;
    VLD(a0, a1, a2, a3, 0); VLD(b0, b1, b2, b3, 1);
    VMM(a0, a1, a2, a3, 0, pa0, pa1, 4); VLD(a0, a1, a2, a3, 2);
    VMM(b0, b1, b2, b3, 1, pa2, pa3, 4); VLD(b0, b1, b2, b3, 3);
    VMM(a0, a1, a2, a3, 2, pa0, pa1, 4); VLD(a0, a1, a2, a3, 4);
    VMM(b0, b1, b2, b3, 3, pa2, pa3, 4); VLD(b0, b1, b2, b3, 5);
    VMM(a0, a1, a2, a3, 4, pa0, pa1, 4); VLD(a0, a1, a2, a3, 6);
    VMM(b0, b1, b2, b3, 5, pa2, pa3, 4); VLD(b0, b1, b2, b3, 7);
    VMM(a0, a1, a2, a3, 6, pa0, pa1, 4);
    VMM(b0, b1, b2, b3, 7, pa2, pa3, 0);
#undef VMM
#undef VLD
#undef TRRD
}
struct BlockRef { const bf16* Q; const bf16* K; const bf16* V; bf16* O; int P0; const float* F; };
struct Seam { bf16x8 qr[8]; bf16x8 st_v0, st_v1, st_k0, st_k1; };
#define ROW(p, k0, rr) ((p) + (size_t)((k0) + (rr)) * PITCH + sc)
#define VMW() asm volatile("s_waitcnt vmcnt(0)" ::: "memory")
#define VMWN(n) asm volatile("s_waitcnt vmcnt(%0)" :: "i"(n) : "memory")
#define SLOAD_H(Kp, Vp, k0) do { S.st_v0 = load8(ROW(Vp, k0, sr)); S.st_v1 = load8(ROW(Vp, k0, 32 + sr));              \
                         S.st_k0 = load8(ROW(Kp, k0, sr)); S.st_k1 = load8(ROW(Kp, k0, 32 + sr)); } while (0)
#define SWRITE_HK(bf) do { *(bf16x8*)(K_lds + (bf) * SHM_K + kws) = S.st_k0; *(bf16x8*)(K_lds + (bf) * SHM_K + kws + 32 * 256) = S.st_k1; } while (0)
#define SWRITE_HV(off) do { *(bf16x8*)(V_lds + (off) + vst0) = S.st_v0; *(bf16x8*)(V_lds + (off) + vst1) = S.st_v1; } while (0)
__device__ __forceinline__ void prime(const BlockRef& cur, char* lds, Seam& S) {
    int tid_ = threadIdx.x; asm volatile("" : "+v"(tid_));
    const int tid = tid_, wid = __builtin_amdgcn_readfirstlane(tid >> 6), lane = tid & 63, r32 = lane & 31, hi = lane >> 5;
    const int sr = tid >> 4, sc = (tid & 15) * 8, kws = KSWZ(sr, sc * 2); char* K_lds = lds + NVB * SHM_V;
    for (int d0 = 0; d0 < 8; ++d0) S.qr[d0] = load8(cur.Q + (size_t)(wid * QBLK + r32) * PITCH + d0 * 16 + hi * 8);
    SLOAD_H(cur.K, cur.V, cur.P0 + QB - KVBLK); VMW(); SWRITE_HK(0);
    __syncthreads();
}
__device__ __forceinline__ void block(const BlockRef& cur, const BlockRef& nxt, char* lds, Seam& S, float thr2) {
    int tid_ = threadIdx.x; asm volatile("" : "+v"(tid_));
    const int tid = tid_, wid = __builtin_amdgcn_readfirstlane(tid >> 6), lane = tid & 63, r32 = lane & 31, hi = lane >> 5;
    const int NTB = cur.P0 / KVBLK + 4; int NT = NTB;
    const int qlo = cur.P0 + wid * QBLK, qm = qlo + r32 - 4 * hi;
    char* V_lds = lds; char* K_lds = lds + NVB * SHM_V;
    float* ws = (float*)(lds + LDS_WS) + wid * 64; float* li_l = ws, * al_l = ws + 32;
    const char* FBl = lds + LDS_FB + r32 * 8;
    const float f_row = cur.F[cur.P0 + wid * QBLK + r32];
    {
        const float* Fcum = cur.F; const int s_end = cur.P0 + QB;
        for (int s = tid * 4; s < s_end; s += 2048) {
            const f32x4 f4 = *(const f32x4*)(Fcum + s); unsigned w0, w1, w2, w3, w4, w5, w6, w7;
            split3(-f4.x * LOG2E, w0, w1); split3(-f4.y * LOG2E, w2, w3); split3(-f4.z * LOG2E, w4, w5); split3(-f4.w * LOG2E, w6, w7);
            *(u32x4*)(lds + LDS_FB + s * 8) = (u32x4){w0, w1 | 0x3F800000u, w2, w3 | 0x3F800000u}; *(u32x4*)(lds + LDS_FB + s * 8 + 16) = (u32x4){w4, w5 | 0x3F800000u, w6, w7 | 0x3F800000u}; }
        __syncthreads();
    }
    float m_reg = -f_row * LOG2E, l_reg = 0; f32x16 o[4] = {};
    bf16x8 ones = make_negB(m_reg, hi);
    const int sr = tid >> 4, sc = (tid & 15) * 8, vst0 = v_st(sr, sc), vst1 = v_st(32 + sr, sc), kws = KSWZ(sr, sc * 2);
    const int vb0 = (int)(uintptr_t)V_lds + v_rd_base(lane);
    int ka[4];
#pragma unroll
    for (int dd = 0; dd < 4; ++dd) ka[dd] = (int)(uintptr_t)K_lds + KSWZ(r32, (dd * 16 + hi * 8) * 2);
    const bf16* Kh = cur.K; const bf16* Vh = cur.V;
#define KBASE(t) ((NTB - 1 - (t)) * KVBLK)
#define MASKT(P0_, P1_, t) do { const int kb_ = KBASE(t); if (kb_ + KVBLK - 1 > qlo) mask_tile(P0_, P1_, qm - kb_, (unsigned)W); } while (0)
    constexpr int NQL = 8;
#define SEAM_K0() do { VMWN(NQL); SWRITE_HK(0); SBAR(); } while (0)
    f32x16 pA0, pA1, pB0, pB1; bf16x8 pa0, pa1, pa2, pa3; float mrun = -3.0e38f;
    SWRITE_HV(0); SBAR();
    if (NT > 1) { SLOAD_H(Kh, Vh, KBASE(1)); }
    SBAR(); qkt<0>(pA0, pA1, ka, S.qr, FBl + KBASE(0) * 8, ones);
    MASKT(pA0, pA1, 0); trackmax(pA0, pA1, true, mrun); partialSM(pA0);
    if (NT > 1) { VMW(); SWRITE_HK(1); SWRITE_HV(SHM_V); }
    __syncthreads();
    int vr = 0, vw = 2 * SHM_V;
#define VNEXT(x) ((x) == (NVB - 1) * SHM_V ? 0 : (x) + SHM_V)
#define HALF_STEP(PX0, PX1, PY0, PY1, t, KB) do {                                                      \
        SBAR(); qkt_sm<KB>(PX0, PX1, ka, S.qr, FBl + KBASE(t) * 8, ones, PY0, PY1, l_reg, pa0, pa1, pa2, pa3); SBAR();                                             \
        if ((t) + 1 < NT) { SLOAD_H(Kh, Vh, KBASE((t) + 1)); SBAR(); }                                               \
        MASKT(PX0, PX1, (t)); trackmax(PX0, PX1, (t) <= 4, mrun); SBAR(); pv_tile<true>(o, vb0 + vr, pa0, pa1, pa2, pa3, PX0);                                        \
        if ((t) + 1 < NT) { VMW(); SWRITE_HK((KB) ^ 1); SWRITE_HV(vw); }     \
        vr = VNEXT(vr); vw = VNEXT(vw);                                                                                        \
        __syncthreads(); } while (0)
    for (int t = 1; t + 1 < NT; t += 2) {
        HALF_STEP(pB0, pB1, pA0, pA1, t, 1);
        HALF_STEP(pA0, pA1, pB0, pB1, t + 1, 0);
#ifndef ATT_NO_EARLY_EXIT
        if (t == 3 && NT > 6) {
            float c = mrun + m_reg;
            c = fminf(c, lane_xor<1>(c)); c = fminf(c, lane_xor<2>(c)); c = fminf(c, lane_xor<4>(c)); c = fminf(c, lane_xor<8>(c)); c = fminf(c, lane_xor<16>(c));
            if (lane == 0) al_l[0] = c;
            __syncthreads();
            float cb = ((const float*)(lds + LDS_WS))[(lane & 7) * 64 + 32];
            cb = fminf(cb, lane_xor<1>(cb)); cb = fminf(cb, lane_xor<2>(cb)); cb = fminf(cb, lane_xor<4>(cb));
            const float lim = cb - thr2;
            const int ti = 5 + 2 * lane, kbi = (NTB - 1 - ti) * KVBLK; bool ok = false;
            if (kbi >= KVBLK) { const u32x2 w = *(const u32x2*)(lds + LDS_FB + (kbi - 1) * 8);
                const float bk = (__uint_as_float(w.x << 16) + __uint_as_float(w.x & 0xffff0000u)) + __uint_as_float(w.y << 16); ok = bk <= lim; }
            const unsigned long long mk = __ballot(ok);
            if (mk) NT = __builtin_amdgcn_readfirstlane(4 + 2 * (int)__ffsll((long long)mk));
        }
#endif
    }
    constexpr bool even = true;
    if (even) { SBAR(); qkt_c<1>(pB0, pB1, ka, S.qr, FBl + KBASE(NT - 1) * 8, ones); SBAR(); }
    SLOAD_H(nxt.K, nxt.V, nxt.P0 + QB - KVBLK); SBAR();
#pragma unroll
    for (int d0 = 0; d0 < 8; ++d0) S.qr[d0] = load8(nxt.Q + (size_t)(wid * QBLK + r32) * PITCH + d0 * 16 + hi * 8);
    SBAR();
    finishSM(pA0, pA1, l_reg, pa0, pa1, pa2, pa3); SBAR();
    MASKT(pB0, pB1, NT - 1); SBAR();
    pv_tile<true>(o, vb0 + vr, pa0, pa1, pa2, pa3, pB0); vr = VNEXT(vr);
    if (even) { __syncthreads();
        finishSM(pB0, pB1, l_reg, pa0, pa1, pa2, pa3); SBAR(); pv_tile<false>(o, vb0 + vr, pa0, pa1, pa2, pa3, pB0); }
    SBAR(); SEAM_K0();
    if (hi == 0) li_l[r32] = l_reg; asm volatile("s_waitcnt lgkmcnt(0)" ::: "memory");
    float rli[16];
#pragma unroll
    for (int r = 0; r < 16; ++r) rli[r] = __builtin_amdgcn_rcpf(li_l[crow(r, hi)]);
    bf16* Ow = cur.O + (size_t)(wid * QBLK) * PITCH;
#pragma unroll
    for (int r = 0; r < 16; ++r) { const int orow = crow(r, hi);
#pragma unroll
        for (int d0 = 0; d0 < 4; ++d0) { const float v = o[d0][r] * rli[r];
            const float vn = __uint_as_float(__builtin_amdgcn_update_dpp(0u, __float_as_uint(v), 0xB1  , 0xF, 0xF, true));
            if ((r32 & 1) == 0) *(unsigned*)(Ow + (size_t)orow * PITCH + d0 * 32 + r32) = cvtpk(v, vn); } }
    __syncthreads();
#undef KBASE
#undef MASKT
#undef SEAM_K0
#undef HALF_STEP
}
#undef ROW
#undef VMW
#undef VMWN
#undef SLOAD_H
#undef SWRITE_HK
#undef SWRITE_HV
#undef SWRITE_H
}


constexpr int NWAVES = 8;
#ifndef MK_N_LAUNCHES
#define MK_N_LAUNCHES 1
#endif
constexpr int BATCH = 8, SEQ = 4096, D = 2048, M = BATCH * SEQ, DEPTH = 4, NA = 2;
constexpr int GH = 3 * D  , GN = 2 * GH  , NG = 8, GD = GH / NG  , GB = 128;
constexpr int NH = 16, HD = 128, FF = 4 * D, NMOD = 6 * D;
constexpr float EPS = 1e-6f;
constexpr size_t MiB = 1u << 20;
constexpr size_t WS_CTL = 0, CTL_ZERO_BYTES = 1 * MiB;
constexpr size_t WS_MOD = 1 * MiB;
constexpr size_t WS_KVMOD = WS_MOD + (size_t)DEPTH * BATCH * NMOD * 4;
constexpr size_t WS_WSM = 3 * MiB;
constexpr size_t WS_LOGF = 4 * MiB, WS_FB = 6 * MiB;
constexpr size_t WS_VSTAT = 8 * MiB;
constexpr size_t WS_JLO = 32 * MiB;
constexpr size_t WS_WT = 40 * MiB;
constexpr size_t WT_WIN = 0, WT_WOUT = WT_WIN + (size_t)2 * GN * D, WT_W1 = WT_WOUT + (size_t)2 * D * GH, WT_W2 = WT_W1 + (size_t)4 * FF * D,
                 WT_WKV = WT_W2 + (size_t)4 * D * FF, WT_WQ = WT_WKV + (size_t)2 * D * D, WT_WO = WT_WQ + (size_t)2 * D * D, WT_END = WT_WO + (size_t)2 * D * D;
static_assert(WT_END * 2 == 448 * MiB, "weights");
constexpr size_t WS_H = 488 * MiB;
constexpr size_t WS_Z = 616 * MiB;
constexpr size_t WS_U = WS_Z, WS_V = WS_Z + 384 * MiB;
constexpr size_t WS_HID = WS_Z;
constexpr size_t WS_Q = WS_Z, WS_O = WS_Z + 128 * MiB, WS_HKV = WS_Z + 256 * MiB, WS_KB = WS_Z + 512 * MiB, WS_VB = WS_Z + 640 * MiB;
constexpr size_t WS_DELTA = WS_Z + 768 * MiB;
constexpr size_t WS_END = WS_Z + 896 * MiB;
constexpr int CW_BAR = 4096;
constexpr int CW_QUEUE = 65536;
static_assert(CW_BAR + 9 * 3456 <= CW_QUEUE && (CW_QUEUE + 4 * 512) * 4 <= 512 * 1024, "control words: barrier regions, queue heads and the zero page (at 512 KiB) must not overlap");
constexpr int RING_BYTES = 131072, LDS_BYTES = 163840, LDSCTL_OFF = LDS_BYTES - 512, MISC_OFF = LDSCTL_OFF + 320;

#define GAS __attribute__((address_space(1)))
#define LAS __attribute__((address_space(3)))
typedef unsigned short bf16;
typedef unsigned v4u __attribute__((ext_vector_type(4)));
typedef unsigned v2u __attribute__((ext_vector_type(2)));
typedef float f32x4 __attribute__((ext_vector_type(4)));
typedef float f32x2 __attribute__((ext_vector_type(2)));
typedef short bf16x8 __attribute__((ext_vector_type(8)));
typedef short s16x4 __attribute__((ext_vector_type(4)));
typedef float f32x16 __attribute__((ext_vector_type(16)));
typedef GAS unsigned gu32;
#define RLX_AGENT __ATOMIC_RELAXED, __HIP_MEMORY_SCOPE_AGENT
#define LDS_WAIT() asm volatile("s_waitcnt lgkmcnt(0)" ::: "memory")
#define VM_WAIT() asm volatile("s_waitcnt vmcnt(0)" ::: "memory")
#define RAW_BAR() do { asm volatile("s_waitcnt lgkmcnt(0)" ::: "memory"); __builtin_amdgcn_s_barrier(); asm volatile("" ::: "memory"); } while (0)
__device__ __forceinline__ unsigned f2bf(float f) { unsigned u = __builtin_bit_cast(unsigned, f); return (u + 0x7fffu + ((u >> 16) & 1u)) >> 16; }
__device__ __forceinline__ unsigned pk2(float lo, float hi) { unsigned r; asm volatile("v_cvt_pk_bf16_f32 %0, %1, %2" : "=v"(r) : "v"(lo), "v"(hi)); return r; }
__device__ __forceinline__ float bflo(unsigned w) { return __uint_as_float(w << 16); }
__device__ __forceinline__ float bfhi(unsigned w) { return __uint_as_float(w & 0xffff0000u); }

#define XB_TMO      128
#define XB_XCNT(j)  (256  + 64 * (j))
#define XB_XSUB(j)  (1280 + 64 * (j))
#define XB_XGEN(j)  (2304 + 64 * (j))
#define XB_TOP      3328
#define XB_TOPGEN   3392
#define XCD_BAR_WORDS 3456
#define XB_SPIN_CAP (1u << 18)
__device__ __forceinline__ unsigned xb_ld(unsigned* p)              { return __hip_atomic_load(p, __ATOMIC_RELAXED, __HIP_MEMORY_SCOPE_AGENT); }
__device__ __forceinline__ unsigned xb_add(unsigned* p, unsigned v) { return __hip_atomic_fetch_add(p, v, __ATOMIC_RELAXED, __HIP_MEMORY_SCOPE_AGENT); }
__device__ __forceinline__ unsigned xb_xcc_id() { return (unsigned)__builtin_amdgcn_s_getreg((3 << 11) | 20) & 0xFu; }
#define XB_SPIN(cond, bar) do { unsigned _sp = 0; while (cond) { __builtin_amdgcn_s_sleep(1); \
    if ((++_sp & 255u) == 0u) { if (xb_ld(&(bar)[XB_TMO])) break; if (_sp > XB_SPIN_CAP) { atomicAdd(&(bar)[XB_TMO], 1u); break; } } } } while (0)
struct XcdBarrier { unsigned* bar; unsigned x; volatile LAS unsigned* st; unsigned gsize; };
__device__ __forceinline__ XcdBarrier xcd_barrier_post(unsigned* bar, volatile LAS unsigned* st, unsigned gsize) {
    XcdBarrier b; b.bar = bar; b.x = xb_xcc_id(); b.st = st; b.gsize = gsize;
    if (threadIdx.x == 0) (void)xb_add(&bar[XB_XCNT(b.x)], 1u);
    return b;
}
__device__ __forceinline__ void xcd_barrier_complete(unsigned* bar, unsigned x, unsigned G, unsigned& nloc, unsigned& nx) {
    unsigned sum, cnt, mine, sp = 0u;
    for (;;) {
        sum = 0u; cnt = 0u; mine = 0u;
#pragma unroll
        for (unsigned j = 0; j < 16; ++j) { const unsigned c = xb_ld(&bar[XB_XCNT(j)]); sum += c; cnt += (c > 0u) ? 1u : 0u; }
        mine = xb_ld(&bar[XB_XCNT(x)]);
        if (sum == G) break;
        __builtin_amdgcn_s_sleep(1);
        if ((++sp & 255u) == 0u) { if (xb_ld(&bar[XB_TMO])) break; if (sp > XB_SPIN_CAP) { atomicAdd(&bar[XB_TMO], 1u); break; } }
    }
    nloc = mine > 0u ? mine : 1u; nx = cnt > 0u ? cnt : 1u;
}
__device__ __forceinline__ void xcd_barrier(const XcdBarrier& b) {
    asm volatile("s_waitcnt vmcnt(0)" ::: "memory");
    __syncthreads();
    if (threadIdx.x == 0) {
        unsigned* bar = b.bar;
        __builtin_amdgcn_s_waitcnt(0);
        unsigned nloc = b.st[0], nx = b.st[1];
        if (nloc == 0u) { xcd_barrier_complete(bar, b.x, b.gsize, nloc, nx); b.st[0] = nloc; b.st[1] = nx; }
        const unsigned old = xb_add(&bar[XB_XSUB(b.x)], 1u);
        const unsigned gen = old / nloc;
        if (old + 1u == (gen + 1u) * nloc) {
            __builtin_amdgcn_fence(__ATOMIC_RELEASE, "agent");
            asm volatile("s_waitcnt vmcnt(0)" ::: "memory");
            const unsigned og = xb_add(&bar[XB_TOP], 1u);
            const unsigned tg = og / nx;
            if (og + 1u == (tg + 1u) * nx) xb_add(&bar[XB_TOPGEN], 1u);
            else XB_SPIN(xb_ld(&bar[XB_TOPGEN]) == tg, bar);
            __builtin_amdgcn_fence(__ATOMIC_ACQUIRE, "agent");
            xb_add(&bar[XB_XGEN(b.x)], 1u);
            asm volatile("s_waitcnt vmcnt(0)" ::: "memory");
        } else {
            XB_SPIN(xb_ld(&bar[XB_XGEN(b.x)]) == gen, bar);
            __builtin_amdgcn_fence(__ATOMIC_ACQUIRE, "agent");
            asm volatile("s_waitcnt vmcnt(0)" ::: "memory");
        }
    }
    __syncthreads();
}

struct Frame {
    LAS unsigned char* lds;
    int vcu, G;
};
constexpr int PT_OUT = 23, PT_WS = 24;
template <class T> __device__ __forceinline__ T* ldptr(const Frame& F, int i) {
    const unsigned long long v = ((const LAS unsigned long long*)(F.lds + LDSCTL_OFF))[i];
    const unsigned lo = __builtin_amdgcn_readfirstlane((unsigned)v), hi = __builtin_amdgcn_readfirstlane((unsigned)(v >> 32));
    return (T*)(GAS T*)(((unsigned long long)hi << 32) | lo);
}
#define INP(i) ldptr<const float>(F, (i))
#define WSP() ldptr<unsigned char>(F, PT_WS)
#define PHASE_IDS int tid_ = threadIdx.x; asm volatile("" : "+v"(tid_)); const int tid = tid_, lane = tid & 63, wave = __builtin_amdgcn_readfirstlane(tid >> 6); (void)lane; (void)wave;
__device__ __forceinline__ float wave_sum(float v) {
    v += lane_xor<1>(v); v += lane_xor<2>(v); v += lane_xor<4>(v); v += lane_xor<8>(v); v += lane_xor<16>(v);
    return lane_sum_halves(v);
}
__device__ __forceinline__ void p0_transpose_item(const GAS float* W, int K, int N, bf16* WT, LAS float* scr, int item, int lane) {
    const int nblk = N / 32, kb = item / nblk, nb = item % nblk, k0 = 64 * kb, n0 = 32 * nb;
#pragma unroll 8
    for (int i = 0; i < 32; ++i) { const int kk = 2 * i + (lane >> 5); scr[kk * 33 + (lane & 31)] = W[(size_t)(k0 + kk) * N + n0 + (lane & 31)]; }
    LDS_WAIT(); asm volatile("" ::: "memory");
    const int c = lane & 7;
#pragma unroll
    for (int j = 0; j < 4; ++j) { const int n = (lane >> 3) + 8 * j; const LAS float* s = scr + (8 * c) * 33 + n;
        v4u o; o.x = pk2(s[0 * 33], s[1 * 33]); o.y = pk2(s[2 * 33], s[3 * 33]); o.z = pk2(s[4 * 33], s[5 * 33]); o.w = pk2(s[6 * 33], s[7 * 33]);
        if (PG8_BT) *(GAS v4u*)(WT + ((size_t)((n0 + n) >> 7) * (K >> 7) + ((k0 + 8 * c) >> 7)) * 16384 + (size_t)((n0 + n) & 127) * 128 + ((k0 + 8 * c) & 127)) = o;
        else *(GAS v4u*)(WT + (size_t)(n0 + n) * K + k0 + 8 * c) = o; }
    LDS_WAIT(); asm volatile("" ::: "memory");
}

struct Args { const float* in[23]; float* out; unsigned char* ws; int ph_lo, ph_hi, li, pad; unsigned nbytes[24]; };
enum { I_X = 0, I_C, I_ADAW, I_ADAB, I_NORMG, I_W1, I_W2, I_WIN, I_LNG, I_LNB, I_WS, I_BS, I_WOUT, I_KVNG, I_KVADAW, I_KVADAB, I_WKV, I_KNG, I_WF, I_BF, I_WQ, I_QNG, I_WO };

constexpr int P0_UNIT = 2048;
constexpr int P0A_UNITS = 17, P0D_UNITS = 39;
__device__ __forceinline__ void p0_convert_item(Frame& F, bf16* WT, LAS float* scr, int u, int r, int lane) {
    const GAS float* W; int K, N; bf16* T; int item;
    if (u < 12)      { const int l = u / 6, s = u % 6;            W = (const GAS float*)INP(I_WIN) + (size_t)l * D * GN;  K = D;  N = GN;    T = WT + WT_WIN + (size_t)l * GN * D;  item = s * P0_UNIT + r; }
    else if (u < 18) { const int l = (u - 12) / 3, s = (u - 12) % 3; W = (const GAS float*)INP(I_WOUT) + (size_t)l * GH * D; K = GH; N = D;     T = WT + WT_WOUT + (size_t)l * D * GH; item = s * P0_UNIT + r; }
    else if (u < 34) { const int l = (u - 18) / 4, s = (u - 18) % 4; W = (const GAS float*)INP(I_W1) + (size_t)l * D * FF;   K = D;  N = FF;    T = WT + WT_W1 + (size_t)l * FF * D;   item = s * P0_UNIT + r; }
    else if (u < 50) { const int l = (u - 34) / 4, s = (u - 34) % 4; W = (const GAS float*)INP(I_W2) + (size_t)l * FF * D;   K = FF; N = D;     T = WT + WT_W2 + (size_t)l * D * FF;   item = s * P0_UNIT + r; }
    else if (u < 52) { const int s = u - 50;                      W = (const GAS float*)INP(I_WKV);                       K = D;  N = 2 * D; T = WT + WT_WKV;                       item = s * P0_UNIT + r; }
    else if (u < 54) { const int l = u - 52;                      W = (const GAS float*)INP(I_WQ) + (size_t)l * D * D;    K = D;  N = D;     T = WT + WT_WQ + (size_t)l * D * D;    item = r; }
    else             { const int l = u - 54;                      W = (const GAS float*)INP(I_WO) + (size_t)l * D * D;    K = D;  N = D;     T = WT + WT_WO + (size_t)l * D * D;    item = r; }
    p0_transpose_item(W, K, N, T, scr, item, lane);
}
struct ConvDesc { const GAS float* W; int K, N; bf16* T; int k0, n0; };
__device__ __forceinline__ ConvDesc p0_conv_desc(Frame& F, bf16* WT, int u, int r) {
    ConvDesc d; int item;
    if (u < 12)      { const int l = u / 6, s = u % 6;            d.W = (const GAS float*)INP(I_WIN) + (size_t)l * D * GN;  d.K = D;  d.N = GN;    d.T = WT + WT_WIN + (size_t)l * GN * D;  item = s * P0_UNIT + r; }
    else if (u < 18) { const int l = (u - 12) / 3, s = (u - 12) % 3; d.W = (const GAS float*)INP(I_WOUT) + (size_t)l * GH * D; d.K = GH; d.N = D;     d.T = WT + WT_WOUT + (size_t)l * D * GH; item = s * P0_UNIT + r; }
    else if (u < 34) { const int l = (u - 18) / 4, s = (u - 18) % 4; d.W = (const GAS float*)INP(I_W1) + (size_t)l * D * FF;   d.K = D;  d.N = FF;    d.T = WT + WT_W1 + (size_t)l * FF * D;   item = s * P0_UNIT + r; }
    else if (u < 50) { const int l = (u - 34) / 4, s = (u - 34) % 4; d.W = (const GAS float*)INP(I_W2) + (size_t)l * FF * D;   d.K = FF; d.N = D;     d.T = WT + WT_W2 + (size_t)l * D * FF;   item = s * P0_UNIT + r; }
    else if (u < 52) { const int s = u - 50;                      d.W = (const GAS float*)INP(I_WKV);                       d.K = D;  d.N = 2 * D; d.T = WT + WT_WKV;                       item = s * P0_UNIT + r; }
    else if (u < 54) { const int l = u - 52;                      d.W = (const GAS float*)INP(I_WQ) + (size_t)l * D * D;    d.K = D;  d.N = D;     d.T = WT + WT_WQ + (size_t)l * D * D;    item = r; }
    else             { const int l = u - 54;                      d.W = (const GAS float*)INP(I_WO) + (size_t)l * D * D;    d.K = D;  d.N = D;     d.T = WT + WT_WO + (size_t)l * D * D;    item = r; }
    const int nblk = d.N / 32; d.k0 = 64 * (item / nblk); d.n0 = 32 * (item % nblk);
    return d;
}
__device__ __forceinline__ void p0_deferred(Frame& F) {
    PHASE_IDS
    bf16* WT = (bf16*)(WSP() + WS_WT);
    __syncthreads();
    LAS float* scr = (LAS float*)(F.lds + wave * 16384);
    const int grp = blockIdx.x & 7, r = grp * 256 + (int)(blockIdx.x >> 3) * NWAVES + wave;
    f32x4 ld[4][8];
#define DF_U(i) ((i) < 6 ? 6 + (i) : ((i) < 9 ? 15 + ((i) - 6) : ((i) < 21 ? 22 + ((i) - 9) : ((i) < 33 ? 38 + ((i) - 21) : 50 + ((i) - 33)))))
#define DF_LD(slot, i) do { if ((i) < P0D_UNITS) { const ConvDesc d_ = p0_conv_desc(F, WT, DF_U(i), r); const GAS float* wp_ = d_.W + (size_t)(d_.k0 + (lane >> 3)) * d_.N + d_.n0 + 4 * (lane & 7); \
        _Pragma("unroll") for (int j = 0; j < 8; ++j) ld[slot][j] = *(const GAS f32x4*)(wp_ + (size_t)(8 * j) * d_.N); } } while (0)
#define DF_ST(slot, i) do { if ((i) < P0D_UNITS) { const ConvDesc d_ = p0_conv_desc(F, WT, DF_U(i), r); \
        _Pragma("unroll") for (int j = 0; j < 8; ++j) { LAS float* w_ = scr + (8 * j + (lane >> 3)) * 33 + 4 * (lane & 7); w_[0] = ld[slot][j].x; w_[1] = ld[slot][j].y; w_[2] = ld[slot][j].z; w_[3] = ld[slot][j].w; } \
        LDS_WAIT(); asm volatile("" ::: "memory"); const int c = lane & 7; \
        _Pragma("unroll") for (int j = 0; j < 4; ++j) { const int n = (lane >> 3) + 8 * j; const LAS float* s_ = scr + (8 * c) * 33 + n; \
            v4u o; o.x = pk2(s_[0 * 33], s_[1 * 33]); o.y = pk2(s_[2 * 33], s_[3 * 33]); o.z = pk2(s_[4 * 33], s_[5 * 33]); o.w = pk2(s_[6 * 33], s_[7 * 33]); \
            if (PG8_BT) *(GAS v4u*)(d_.T + ((size_t)((d_.n0 + n) >> 7) * (d_.K >> 7) + ((d_.k0 + 8 * c) >> 7)) * 16384 + (size_t)((d_.n0 + n) & 127) * 128 + ((d_.k0 + 8 * c) & 127)) = o; \
            else *(GAS v4u*)(d_.T + (size_t)(d_.n0 + n) * d_.K + d_.k0 + 8 * c) = o; } \
        LDS_WAIT(); asm volatile("" ::: "memory"); } } while (0)
    DF_LD(0, 0); DF_LD(1, 1); DF_LD(2, 2);
#pragma unroll 1
    for (int base = 0; base < P0D_UNITS; base += 4) {
        DF_LD(3, base + 3); DF_ST(0, base + 0);
        DF_LD(0, base + 4); DF_ST(1, base + 1);
        DF_LD(1, base + 5); DF_ST(2, base + 2);
        DF_LD(2, base + 6); DF_ST(3, base + 3);
    }
#undef DF_ST
#undef DF_LD
#undef DF_U
    __syncthreads();
}
__device__ __forceinline__ void p0_prologue(Frame& F, int parts = 3) {
    PHASE_IDS
    unsigned char* const wsp = WSP();
    bf16* WT = (bf16*)(wsp + WS_WT);
    const int NSTRIP = DEPTH * (NMOD / 256) + (2 * D) / 256;
    if (parts & 1) for (int it = blockIdx.x; it < NSTRIP; it += F.G) {
        LAS float* SC = (LAS float*)F.lds;
        LAS float* RED = (LAS float*)(F.lds + 65536);
        const float* c = INP(I_C);
        for (int i = tid; i < BATCH * D; i += NWAVES * 64) { const int b = i / D, k = i % D; const float x = c[i]; SC[k * 8 + b] = x / (1.f + __expf(-x)); }
        __syncthreads();
        const float* W; const float* bias; float* out; int N, n0;
        if (it < DEPTH * (NMOD / 256)) { const int l = it / (NMOD / 256), s = it % (NMOD / 256); W = INP(I_ADAW) + (size_t)l * D * NMOD; N = NMOD; n0 = s * 256; bias = INP(I_ADAB) + l * NMOD; out = (float*)(wsp + WS_MOD) + (size_t)l * BATCH * NMOD; }
        else { const int s = it - DEPTH * (NMOD / 256); W = INP(I_KVADAW); N = 2 * D; n0 = s * 256; bias = INP(I_KVADAB); out = (float*)(wsp + WS_KVMOD); }
        f32x4 acc[8];
#pragma unroll
        for (int b = 0; b < 8; ++b) acc[b] = (f32x4){0.f, 0.f, 0.f, 0.f};
        const float* wp = W + (size_t)(wave * 256) * N + n0 + 4 * lane;
#pragma unroll 8
        for (int k = 0; k < 256; ++k) { const f32x4 wv = *(const f32x4*)(wp + (size_t)k * N);
            const f32x4 s0 = *(const LAS f32x4*)(SC + (wave * 256 + k) * 8), s1 = *(const LAS f32x4*)(SC + (wave * 256 + k) * 8 + 4);
            acc[0] += s0.x * wv; acc[1] += s0.y * wv; acc[2] += s0.z * wv; acc[3] += s0.w * wv; acc[4] += s1.x * wv; acc[5] += s1.y * wv; acc[6] += s1.z * wv; acc[7] += s1.w * wv; }
#pragma unroll
        for (int b = 0; b < 8; ++b) *(LAS f32x4*)(RED + (wave * 8 + b) * 256 + 4 * lane) = acc[b];
        __syncthreads();
#pragma unroll
        for (int i = 0; i < 4; ++i) { const int idx = tid + 512 * i, b = idx >> 8, col = idx & 255; float s = bias[n0 + col];
#pragma unroll
            for (int w = 0; w < 8; ++w) s += RED[(w * 8 + b) * 256 + col];
            out[(size_t)b * N + n0 + col] = s; }
        __syncthreads();
    }
    if (!(parts & 2)) return;
    { float* WSF = (float*)(wsp + WS_WSM); const float* ws_in = INP(I_WS);
      for (int i = blockIdx.x * 512 + tid; i < NA * NG * GB * GB; i += F.G * 512) { const int col = i & 127, row = (i >> 7) & 127; WSF[i] = ((col >> 6) <= (row >> 6)) ? ws_in[i] : 0.f; } }
    LAS float* scr = (LAS float*)(F.lds + wave * 16384);
    const int gw = F.vcu * NWAVES + wave, NGW = F.G * NWAVES;
    const int NGV = NSTRIP < F.G ? NSTRIP : F.G, nfree = (F.G - NGV) * NWAVES, R1 = (nfree > 0 && F.G == 256) ? 14 : 1 << 30;
    const int fidx = ((int)blockIdx.x - NGV) * NWAVES + wave;
    for (int i = 0;; ++i) {
        int it;
        if (i < R1) { it = gw + NGW * i; if (it >= P0A_UNITS * P0_UNIT) break; }
        else { if (fidx < 0) break; it = R1 * NGW + fidx + nfree * (i - R1); if (it >= P0A_UNITS * P0_UNIT) break; }
        const int k = it / P0_UNIT, r = it % P0_UNIT;
        const int u = k < 6 ? k : (k < 9 ? 12 + (k - 6) : (k < 13 ? 18 + (k - 9) : 34 + (k - 13)));
        p0_convert_item(F, WT, scr, u, r, lane);
    }
}

constexpr int XP = 2 * D;
template <bool KV, bool XBI>
__device__ __forceinline__ void norm_phase(Frame& F, const float* xin, const bf16* delta, const bf16* delta2, bf16* xout, const float* g, const float* shift, const float* scale, int modstride, bf16* Hout,
                                           const float* kvg, const float* kvmod, bf16* HKV, const float* w_f, const float* b_f, float* LOGF) {
    PHASE_IDS
    const int gw = F.vcu * NWAVES + wave, NGW = F.G * NWAVES;
    LAS float* WFT = (LAS float*)F.lds;
    if (KV) { for (int i = tid; i < NH * D; i += NWAVES * 64) { const int h = i / D, col = i % D; WFT[i] = w_f[col * NH + h]; } __syncthreads(); }
    for (int it = gw; it < M / 16; it += NGW) {
        const int row0 = it * 16, b = row0 / SEQ;
        f32x4 gs[8], sh[8];
        if (!KV) {
#pragma unroll
        for (int j = 0; j < 8; ++j) { const int c = 4 * lane + 256 * j; const f32x4 gv = *(const f32x4*)(g + c), sc = *(const f32x4*)(scale + (size_t)b * modstride + c);
            gs[j] = gv * (1.f + sc); sh[j] = *(const f32x4*)(shift + (size_t)b * modstride + c);
        } }
#ifdef NT_THIN
#define NP_LD(p) __builtin_nontemporal_load(p)
#else
#define NP_LD(p) (*(p))
#endif
        f32x4 vn[8]; v2u xn[8], dn[8], dn2[8];
#define NP_LOAD(row_) do { if (XBI) { const GAS v2u* xr_ = (const GAS v2u*)((const bf16*)xin + (size_t)(row_) * XP) + lane; _Pragma("unroll") for (int j = 0; j < 8; ++j) xn[j] = NP_LD(xr_ + 64 * j); } \
            else { const GAS f32x4* xr_ = (const GAS f32x4*)(xin + (size_t)(row_) * D) + lane; _Pragma("unroll") for (int j = 0; j < 8; ++j) vn[j] = NP_LD(xr_ + 64 * j); } \
            if (delta) { const GAS v2u* dr_ = (const GAS v2u*)(delta + (size_t)(row_) * D) + lane; _Pragma("unroll") for (int j = 0; j < 8; ++j) dn[j] = NP_LD(dr_ + 64 * j); } \
            if (delta2) { const GAS v2u* dr_ = (const GAS v2u*)(delta2 + (size_t)(row_) * D) + lane; _Pragma("unroll") for (int j = 0; j < 8; ++j) dn2[j] = NP_LD(dr_ + 64 * j); } } while (0)
        NP_LOAD(row0);
#pragma unroll 2
        for (int r = 0; r < 16; ++r) { const int row = row0 + r;
            f32x4 v[8]; float s = 0.f;
#pragma unroll
            for (int j = 0; j < 8; ++j) { v[j] = XBI ? (f32x4){bflo(xn[j].x), bfhi(xn[j].x), bflo(xn[j].y), bfhi(xn[j].y)} : vn[j];
                if (delta) v[j] += (f32x4){bflo(dn[j].x), bfhi(dn[j].x), bflo(dn[j].y), bfhi(dn[j].y)};
                if (delta2) v[j] += (f32x4){bflo(dn2[j].x), bfhi(dn2[j].x), bflo(dn2[j].y), bfhi(dn2[j].y)}; }
            if (r + 1 < 16) NP_LOAD(row + 1);
            __builtin_amdgcn_sched_barrier(0);
            if (xout) { GAS v2u* xo = (GAS v2u*)(xout + (size_t)row * XP) + lane;
#pragma unroll
                for (int j = 0; j < 8; ++j) xo[64 * j] = (v2u){pk2(v[j].x, v[j].y), pk2(v[j].z, v[j].w)}; }
#pragma unroll
            for (int j = 0; j < 8; ++j) s += (v[j].x * v[j].x + v[j].y * v[j].y) + (v[j].z * v[j].z + v[j].w * v[j].w);
            const float rstd = 1.f / sqrtf(wave_sum(s) * (1.f / D) + EPS);
            GAS v2u* o8 = (GAS v2u*)(Hout + (size_t)row * D) + lane;
#pragma unroll
            for (int j = 0; j < 8; ++j) { f32x4 gsj, shj;
                if (KV) { const int c = 4 * lane + 256 * j; gsj = *(const f32x4*)(g + c) * (1.f + *(const f32x4*)(scale + (size_t)b * modstride + c)); shj = *(const f32x4*)(shift + (size_t)b * modstride + c); }
                else { gsj = gs[j]; shj = sh[j]; }
                const f32x4 y = (v[j] * rstd) * gsj + shj; o8[64 * j] = (v2u){pk2(y.x, y.y), pk2(y.z, y.w)}; }
            if (KV) {
                GAS v2u* k8 = (GAS v2u*)(HKV + (size_t)row * D) + lane; f32x4 y[8];
#pragma unroll
                for (int j = 0; j < 8; ++j) { const int c = 4 * lane + 256 * j; const f32x4 g2 = *(const f32x4*)(kvg + c), s2 = *(const f32x4*)(kvmod + (size_t)b * 2 * D + D + c), h2 = *(const f32x4*)(kvmod + (size_t)b * 2 * D + c);
                    y[j] = (v[j] * rstd) * (g2 * (1.f + s2)) + h2; k8[64 * j] = (v2u){pk2(y[j].x, y[j].y), pk2(y[j].z, y[j].w)}; }
                float mine = 0.f;
#pragma unroll 1
                for (int h = 0; h < 16; ++h) { float z = 0.f;
#pragma unroll
                    for (int j = 0; j < 8; ++j) { const f32x4 w = *(const LAS f32x4*)(WFT + h * D + 4 * lane + 256 * j); z += (y[j].x * w.x + y[j].y * w.y) + (y[j].z * w.z + y[j].w * w.w); }
                    const float t = wave_sum(z); if (lane == h) mine = t; }
                if (lane < 16) { const float zz = mine + b_f[lane]; const float ls = fminf(zz, 0.f) - log1pf(__expf(-fabsf(zz)));
                    LOGF[((size_t)b * NH + lane) * SEQ + (row - b * SEQ)] = ls; }
            }
        }
    }
#undef NP_LOAD
#undef NP_LD
    if (KV) __syncthreads();
}
__device__ __forceinline__ void resid_final(Frame& F, const bf16* xb, float* xo_, const bf16* delta) {
    PHASE_IDS
    const int gw = F.vcu * NWAVES + wave, NGW = F.G * NWAVES;
    for (int rr = 0; rr < M / NGW; ++rr) { const int row = gw * (M / NGW) + rr;
        const GAS v2u* xr = (const GAS v2u*)(xb + (size_t)row * XP) + lane; GAS f32x4* xw = (GAS f32x4*)(xo_ + (size_t)row * D) + lane; const GAS v2u* dr = (const GAS v2u*)(delta + (size_t)row * D) + lane;
        v2u v[8], d[8];
#pragma unroll
        for (int j = 0; j < 8; ++j) { v[j] = xr[64 * j]; d[j] = dr[64 * j]; }
        asm volatile("s_waitcnt vmcnt(0)" ::: "memory");
#pragma unroll
        for (int j = 0; j < 8; ++j) xw[64 * j] = (f32x4){bflo(v[j].x), bfhi(v[j].x), bflo(v[j].y), bfhi(v[j].y)} + (f32x4){bflo(d[j].x), bfhi(d[j].x), bflo(d[j].y), bfhi(d[j].y)}; }
}
__device__ __forceinline__ void headnorm_rows(Frame& F, bf16* T, bf16* Tout, const float* gain) {
    PHASE_IDS
    const int gw = F.vcu * NWAVES + wave, NGW = F.G * NWAVES;
    const int d0 = (8 * lane) & 127; const f32x4 g0 = *(const f32x4*)(gain + d0), g1 = *(const f32x4*)(gain + d0 + 4);
    for (int it = gw; it < M / 16; it += NGW) {
        for (int r = 0; r < 16; ++r) { GAS v4u* p = (GAS v4u*)(T + (size_t)(it * 16 + r) * D) + lane; GAS v4u* po = (GAS v4u*)(Tout + (size_t)(it * 16 + r) * D) + lane;
            v4u w[4];
#pragma unroll
            for (int j = 0; j < 4; ++j) w[j] = p[64 * j];
#pragma unroll
            for (int j = 0; j < 4; ++j) { float x[8] = {bflo(w[j].x), bfhi(w[j].x), bflo(w[j].y), bfhi(w[j].y), bflo(w[j].z), bfhi(w[j].z), bflo(w[j].w), bfhi(w[j].w)};
                float s = 0.f;
#pragma unroll
                for (int e = 0; e < 8; ++e) s += x[e] * x[e];
                s += lane_xor<1>(s); s += lane_xor<2>(s); s += lane_xor<4>(s); s += lane_xor<8>(s);
                const float rstd = 1.f / sqrtf(s * (1.f / HD) + EPS);
                v4u o; o.x = pk2(x[0] * rstd * g0.x, x[1] * rstd * g0.y); o.y = pk2(x[2] * rstd * g0.z, x[3] * rstd * g0.w); o.z = pk2(x[4] * rstd * g1.x, x[5] * rstd * g1.y); o.w = pk2(x[6] * rstd * g1.z, x[7] * rstd * g1.w);
                po[64 * j] = o; } }
    }
}
__device__ __forceinline__ void cumsum_phase(Frame& F, const float* LOGF, float* FB, const float* qgain  , const float* kgain  , int* JLO) {
    PHASE_IDS
    const int grp = blockIdx.x & 7, lw = (int)(blockIdx.x >> 3) * NWAVES + wave;
    for (int bh = grp * NH + lw; lw < NH && bh < (grp + 1) * NH; bh += BATCH * NH) {
        const f32x4* src = (const f32x4*)(LOGF + (size_t)bh * SEQ + 64 * lane); f32x4 v[16]; float run = 0.f;
#pragma unroll
        for (int i = 0; i < 16; ++i) { v[i] = src[i]; run += v[i].x; v[i].x = run; run += v[i].y; v[i].y = run; run += v[i].z; v[i].z = run; run += v[i].w; v[i].w = run; }
        float incl = run;
#define CS_DPP(x, ctrl, rmask, bc) __uint_as_float((unsigned)__builtin_amdgcn_update_dpp(0, (int)__float_as_uint(x), ctrl, rmask, 0xF, bc))
        incl += CS_DPP(incl, 0x111, 0xF, true); incl += CS_DPP(incl, 0x112, 0xF, true); incl += CS_DPP(incl, 0x114, 0xF, true); incl += CS_DPP(incl, 0x118, 0xF, true);
        incl += CS_DPP(incl, 0x142, 0xA, false); incl += CS_DPP(incl, 0x143, 0xC, false);
#undef CS_DPP
        const float off = incl - run;
        f32x4* dst = (f32x4*)(FB + (size_t)bh * SEQ + 64 * lane);
#pragma unroll
        for (int i = 0; i < 16; ++i) dst[i] = v[i] + off;
        float gq = fmaxf(fmaxf(fabsf(qgain[lane]), fabsf(qgain[64 + lane])), fmaxf(fabsf(qgain[128 + lane]), fabsf(qgain[192 + lane]))), gk = fmaxf(fabsf(kgain[lane]), fabsf(kgain[64 + lane]));
        { gq = fmaxf(gq, lane_xor<1>(gq)); gq = fmaxf(gq, lane_xor<2>(gq)); gq = fmaxf(gq, lane_xor<4>(gq)); gq = fmaxf(gq, lane_xor<8>(gq)); gq = fmaxf(gq, lane_xor<16>(gq)); gq = lane_max_halves(gq);
          gk = fmaxf(gk, lane_xor<1>(gk)); gk = fmaxf(gk, lane_xor<2>(gk)); gk = fmaxf(gk, lane_xor<4>(gk)); gk = fmaxf(gk, lane_xor<8>(gk)); gk = fmaxf(gk, lane_xor<16>(gk)); gk = lane_max_halves(gk); }
        const float BL = (float)HD * gq * gk * 1.02f * 0.08838834764831845f, thr = 2.f * BL + 25.f;
        const float fend = v[15].w + off, ffirst = v[0].x + off; int myj = 0;
#pragma unroll
        for (int qb = 0; qb < SEQ / 256; ++qb) { const float fp0 = __uint_as_float((unsigned)__builtin_amdgcn_readlane((int)__float_as_uint(ffirst), 4 * qb)); const bool skip = (lane < 4 * qb) && (fend - fp0 >= thr);
            const int cnt = __popcll(__ballot(skip)); if (lane == qb) myj = cnt; }
#ifdef NO_STATIC_SKIP
        myj = 0;
#endif
        if (lane < SEQ / 256) JLO[bh * (SEQ / 256) + lane] = myj;
        if (lane == 0) ((float*)JLO)[BATCH * NH * (SEQ / 256) + grp] = BL * 1.4426950408889634f + 36.2f;
    }
}

constexpr int SG_NCH = GH / 128;
constexpr int SG_VT = 0, SG_STG = 65536, SG_STG_ROW = 144, SG_STG_WAVE = 32 * SG_STG_ROW, SG_MEAN = SG_STG + 8 * SG_STG_WAVE  , SG_RSTD = SG_MEAN + 512, SG_RED = SG_RSTD + 512, SG_MT = SG_RED + 4096  , SG_END = SG_MT + 8 * 384;
__device__ __forceinline__ void sg_phase(Frame& F, int layer, bf16* U, const bf16* V, const f32x2* vstat, const float* ln_g, const float* ln_b, const float* WSF, const float* bs, bool do_store) {
    PHASE_IDS
    const int wid = wave, r32 = lane & 31, hi = lane >> 5, wq = wid & 3, ch = wid >> 2;
    LAS unsigned char* lds = F.lds;
    LAS float* MEAN = (LAS float*)(lds + SG_MEAN); LAS float* RSTD = (LAS float*)(lds + SG_RSTD); LAS f32x2* RED = (LAS f32x2*)(lds + SG_RED);
    LAS float* MT = (LAS float*)(lds + SG_MT + wid * 384);
    const unsigned vbase = (unsigned)(uintptr_t)(lds + SG_VT) + (unsigned)att::v_rd_base(lane);
    LAS unsigned char* stg = lds + SG_STG + wid * SG_STG_WAVE;
    { const int nb = F.vcu;
        const int r0 = nb * GB;
        { const int row = tid & 127, part = tid >> 7; float s = 0.f, ss = 0.f; const f32x2* vp = vstat + (size_t)(part * 24) * M + r0 + row;
#pragma unroll 1
          for (int q0 = 0; q0 < 24; q0 += 8) { f32x2 p[8];
#pragma unroll
            for (int q = 0; q < 8; ++q) p[q] = vp[(size_t)(q0 + q) * M];
#pragma unroll
            for (int q = 0; q < 8; ++q) { s += p[q].x; ss += p[q].y; } }
          RED[part * 128 + row] = (f32x2){s, ss}; }
        __syncthreads();
        if (tid < 128) { const f32x2 a = RED[tid], b = RED[128 + tid], c = RED[256 + tid], d = RED[384 + tid];
            const float mean = ((a.x + b.x) + (c.x + d.x)) * (1.f / GH); const float var = ((a.y + b.y) + (c.y + d.y)) * (1.f / GH) - mean * mean;
            MEAN[tid] = mean; RSTD[tid] = 1.f / sqrtf(fmaxf(var, 0.f) + EPS); }
        __syncthreads();
        const unsigned char* Vt = (const unsigned char*)V + (size_t)nb * SG_NCH * 32768;
        unsigned char* Ut = (unsigned char*)U + (size_t)nb * SG_NCH * 32768 + (size_t)(32 * wq) * 256 + (size_t)(64 * ch) * 2;
        v4u vr[4], ur[2][4]; float lg[2][2], lb[2][2];
#define SG_VLOAD(t) do { _Pragma("unroll") for (int q = 0; q < 4; ++q) vr[q] = *(const GAS v4u*)(Vt + (size_t)(t) * 32768 + (size_t)(tid + 512 * q) * 16); } while (0)
#define SG_VWRITE(buf) do { _Pragma("unroll") for (int q = 0; q < 4; ++q) *(LAS v4u*)(lds + SG_VT + (buf) * 32768 + (tid + 512 * q) * 16) = vr[q]; } while (0)
#define SG_ULOAD(t, slot) do { _Pragma("unroll") for (int q = 0; q < 4; ++q) { const int p = lane + 64 * q; ur[slot][q] = *(const GAS v4u*)(Ut + (size_t)(t) * 32768 + (p >> 3) * 256 + (p & 7) * 16); } } while (0)
#define SG_GBLOAD(t, slot) do { _Pragma("unroll") for (int dd = 0; dd < 2; ++dd) { const int c = (t) * 128 + 64 * ch + 32 * dd + r32; lg[slot][dd] = ln_g[c]; lb[slot][dd] = ln_b[c]; } } while (0)
        SG_VLOAD(0); SG_ULOAD(0, 0); SG_GBLOAD(0, 0);
        SG_VWRITE(0);
        RAW_BAR();
#pragma unroll 1
        for (int g = 0; g < NG; ++g) {
            bf16x8 wf[2][4];
            { const float* wp = WSF + ((size_t)(layer * NG + g) * GB + 32 * wq + r32) * GB + 8 * hi; float msum = 0.f, ssum = 0.f;
#pragma unroll
              for (int jt = 0; jt < 2; ++jt)
#pragma unroll
                for (int ks = 0; ks < 4; ++ks) { const int j0 = 64 * jt + 16 * ks + 8 * hi; v4u w = {0u, 0u, 0u, 0u};
                    if (jt == 0 || wq >= 2) { const f32x4 w0 = *(const f32x4*)(wp + 64 * jt + 16 * ks), w1 = *(const f32x4*)(wp + 64 * jt + 16 * ks + 4);
                        const f32x4 r0v = *(const LAS f32x4*)(RSTD + j0), r1v = *(const LAS f32x4*)(RSTD + j0 + 4), m0v = *(const LAS f32x4*)(MEAN + j0), m1v = *(const LAS f32x4*)(MEAN + j0 + 4);
                        w.x = pk2(w0.x * r0v.x, w0.y * r0v.y); w.y = pk2(w0.z * r0v.z, w0.w * r0v.w); w.z = pk2(w1.x * r1v.x, w1.y * r1v.y); w.w = pk2(w1.z * r1v.z, w1.w * r1v.w);
                        msum += (bflo(w.x) * m0v.x + bfhi(w.x) * m0v.y) + (bflo(w.y) * m0v.z + bfhi(w.y) * m0v.w) + (bflo(w.z) * m1v.x + bfhi(w.z) * m1v.y) + (bflo(w.w) * m1v.z + bfhi(w.w) * m1v.w);
                        ssum += ((w0.x + w0.y) + (w0.z + w0.w)) + ((w1.x + w1.y) + (w1.z + w1.w)); }
                    wf[jt][ks] = __builtin_bit_cast(bf16x8, w); }
              msum = lane_sum_halves(msum); ssum = lane_sum_halves(ssum);
              if (hi == 0) { MT[r32] = -msum; MT[32 + r32] = ssum; MT[64 + r32] = bs[(size_t)(layer * NG + g) * GB + 32 * wq + r32]; }
              LDS_WAIT(); }
#define SG_TRRD(dst, off) asm volatile("ds_read_b64_tr_b16 %0, %1 offset:%2" : "=&v"(dst) : "v"(va), "i"(off) : "memory")
#define SG_PV(dd, jt, buf) do { const unsigned va = vbase + (unsigned)(((buf) * 2 + (jt)) * 16384 + (2 * ch + (dd)) * 512); s16x4 l0, l1, l2, l3, h0, h1, h2, h3; \
            SG_TRRD(l0, 0); SG_TRRD(h0, 2048); SG_TRRD(l1, 4096); SG_TRRD(h1, 6144); SG_TRRD(l2, 8192); SG_TRRD(h2, 10240); SG_TRRD(l3, 12288); SG_TRRD(h3, 14336); \
            asm volatile("s_waitcnt lgkmcnt(0)" ::: "memory"); __builtin_amdgcn_sched_barrier(0); \
            o[dd] = __builtin_amdgcn_mfma_f32_32x32x16_bf16(wf[jt][0], (bf16x8){l0[0], l0[1], l0[2], l0[3], h0[0], h0[1], h0[2], h0[3]}, o[dd], 0, 0, 0); \
            o[dd] = __builtin_amdgcn_mfma_f32_32x32x16_bf16(wf[jt][1], (bf16x8){l1[0], l1[1], l1[2], l1[3], h1[0], h1[1], h1[2], h1[3]}, o[dd], 0, 0, 0); \
            o[dd] = __builtin_amdgcn_mfma_f32_32x32x16_bf16(wf[jt][2], (bf16x8){l2[0], l2[1], l2[2], l2[3], h2[0], h2[1], h2[2], h2[3]}, o[dd], 0, 0, 0); \
            o[dd] = __builtin_amdgcn_mfma_f32_32x32x16_bf16(wf[jt][3], (bf16x8){l3[0], l3[1], l3[2], l3[3], h3[0], h3[1], h3[2], h3[3]}, o[dd], 0, 0, 0); } while (0)
#define SG_CHUNK(s) do { const int t = 6 * g + 2 * s2 + (s); \
            if (t + 1 < SG_NCH) { SG_VLOAD(t + 1); SG_ULOAD(t + 1, ((s) + 1) & 1); SG_GBLOAD(t + 1, ((s) + 1) & 1); } \
            asm volatile("" ::: "memory"); __builtin_amdgcn_sched_barrier(0); \
            f32x16 o[2] = {}; \
            SG_PV(0, 0, (s) & 1); SG_PV(1, 0, (s) & 1); \
            if (wq >= 2) { SG_PV(0, 1, (s) & 1); SG_PV(1, 1, (s) & 1); } \
            _Pragma("unroll") for (int dd = 0; dd < 2; ++dd) { const float gg = lg[(s) & 1][dd], bb = lb[(s) & 1][dd]; \
                _Pragma("unroll") for (int q = 0; q < 4; ++q) { const f32x4 Aq = *(const LAS f32x4*)(MT + 8 * q + 4 * hi), Bq = *(const LAS f32x4*)(MT + 32 + 8 * q + 4 * hi), Cq = *(const LAS f32x4*)(MT + 64 + 8 * q + 4 * hi); \
                  _Pragma("unroll") for (int e = 0; e < 4; ++e) { const int r = 4 * q + e; const float val = gg * (o[dd][r] + Aq[e]) + (bb * Bq[e] + Cq[e]); \
                    *(LAS unsigned short*)(stg + att::crow(r, hi) * SG_STG_ROW + (dd * 32 + r32) * 2) = (unsigned short)pk2(val, val); } } } \
            LDS_WAIT(); \
            _Pragma("unroll") for (int q = 0; q < 4; ++q) { const int p = lane + 64 * q; const v4u sv = *(const LAS v4u*)(stg + (p >> 3) * SG_STG_ROW + (p & 7) * 16); const v4u uu = ur[(s) & 1][q]; v4u w; \
                const pg8::f32x2 gx = pg8::gelu_pk((pg8::f32x2){bflo(uu.x), bfhi(uu.x)}), gy = pg8::gelu_pk((pg8::f32x2){bflo(uu.y), bfhi(uu.y)}), gz = pg8::gelu_pk((pg8::f32x2){bflo(uu.z), bfhi(uu.z)}), gw = pg8::gelu_pk((pg8::f32x2){bflo(uu.w), bfhi(uu.w)});     \
                w.x = pk2(gx.x * bflo(sv.x), gx.y * bfhi(sv.x)); w.y = pk2(gy.x * bflo(sv.y), gy.y * bfhi(sv.y)); \
                w.z = pk2(gz.x * bflo(sv.z), gz.y * bfhi(sv.z)); w.w = pk2(gw.x * bflo(sv.w), gw.y * bfhi(sv.w)); \
                if (do_store) *(GAS v4u*)(Ut + (size_t)t * 32768 + (p >> 3) * 256 + (p & 7) * 16) = w; } \
            asm volatile("" ::: "memory"); __builtin_amdgcn_sched_barrier(0); \
            if (t + 1 < SG_NCH) SG_VWRITE(((s) + 1) & 1); \
            RAW_BAR(); } while (0)
#pragma unroll 1
            for (int s2 = 0; s2 < 3; ++s2) { SG_CHUNK(0); SG_CHUNK(1); }
        }
#undef SG_VLOAD
#undef SG_VWRITE
#undef SG_ULOAD
#undef SG_GBLOAD
#undef SG_TRRD
#undef SG_PV
#undef SG_CHUNK
        __syncthreads();
    }
}


#ifdef SG_V1
constexpr int SG1_VT = 0, SG1_STG = 65536, SG1_STG_ROW = 144, SG1_STG_WAVE = 32 * SG1_STG_ROW, SG1_TAB = SG1_STG + 8 * SG1_STG_WAVE, SG1_RED = SG1_TAB + 1024;
__device__ __forceinline__ void sg_phase_v1(Frame& F, int layer, bf16* U, const bf16* V, const f32x2* vstat, const float* ln_g, const float* ln_b, const float* WSF, const float* bs) {
    PHASE_IDS
    const int wid = wave, r32 = lane & 31, hi = lane >> 5, wq = wid & 3, ch = wid >> 2;
    LAS unsigned char* lds = F.lds;
    LAS f32x2* TAB = (LAS f32x2*)(lds + SG1_TAB); LAS f32x2* RED = (LAS f32x2*)(lds + SG1_RED);
    const int sr = tid >> 4, sc = (tid & 15) * 8, vst0 = att::v_st(sr, sc), vst1 = att::v_st(32 + sr, sc);
    const unsigned vbase = (unsigned)(uintptr_t)(lds + SG1_VT) + (unsigned)att::v_rd_base(lane);
    LAS unsigned char* stg = lds + SG1_STG + wid * SG1_STG_WAVE;
    for (int nb = blockIdx.x; nb < M / GB; nb += F.G) {
        const int r0 = nb * GB;
        { const int row = tid & 127, part = tid >> 7; float s = 0.f, ss = 0.f;
#pragma unroll 8
          for (int q = 0; q < 24; ++q) { const f32x2 p = vstat[(size_t)(part * 24 + q) * M + r0 + row]; s += p.x; ss += p.y; }
          RED[part * 128 + row] = (f32x2){s, ss}; }
        __syncthreads();
        if (tid < 128) { const f32x2 a = RED[tid], b = RED[128 + tid], c = RED[256 + tid], d = RED[384 + tid];
            const float mean = ((a.x + b.x) + (c.x + d.x)) * (1.f / GH); const float var = ((a.y + b.y) + (c.y + d.y)) * (1.f / GH) - mean * mean;
            TAB[tid] = (f32x2){mean, 1.f / sqrtf(fmaxf(var, 0.f) + EPS)}; }
        __syncthreads();
        f32x2 st[4];
#pragma unroll
        for (int q = 0; q < 4; ++q) st[q] = TAB[(q >> 1) * 64 + (q & 1) * 32 + sr];
        const bf16* Vb = V + (size_t)r0 * GH; bf16* Ub = U + (size_t)r0 * GH;
        v4u vr[4], ur[4];
#define SG1_VLOAD(c0) do { _Pragma("unroll") for (int q = 0; q < 4; ++q) vr[q] = *(const GAS v4u*)(Vb + (size_t)((q >> 1) * 64 + (q & 1) * 32 + sr) * GH + (c0) + sc); } while (0)
#define SG1_VWRITE(c0, buf) do { const f32x4 g0 = *(const f32x4*)(ln_g + (c0) + sc), g1 = *(const f32x4*)(ln_g + (c0) + sc + 4), b0 = *(const f32x4*)(ln_b + (c0) + sc), b1 = *(const f32x4*)(ln_b + (c0) + sc + 4); \
        _Pragma("unroll") for (int q = 0; q < 4; ++q) { const float mu = st[q].x, rs = st[q].y; v4u o; \
            o.x = pk2((bflo(vr[q].x) - mu) * rs * g0.x + b0.x, (bfhi(vr[q].x) - mu) * rs * g0.y + b0.y); o.y = pk2((bflo(vr[q].y) - mu) * rs * g0.z + b0.z, (bfhi(vr[q].y) - mu) * rs * g0.w + b0.w); \
            o.z = pk2((bflo(vr[q].z) - mu) * rs * g1.x + b1.x, (bfhi(vr[q].z) - mu) * rs * g1.y + b1.y); o.w = pk2((bflo(vr[q].w) - mu) * rs * g1.z + b1.z, (bfhi(vr[q].w) - mu) * rs * g1.w + b1.w); \
            *(LAS v4u*)(lds + SG1_VT + ((buf) * 2 + (q >> 1)) * 16384 + ((q & 1) ? vst1 : vst0)) = o; } } while (0)
        SG1_VLOAD(0); SG1_VWRITE(0, 0);
        RAW_BAR();
        bf16x8 wf[2][4]; f32x4 bsv[4];
        for (int t = 0; t < GH / 128; ++t) {
            const int c0 = t * 128, buf = t & 1, g = t / 6;
#pragma unroll
            for (int q = 0; q < 4; ++q) { const int p = lane + 64 * q; ur[q] = *(const GAS v4u*)(Ub + (size_t)(32 * wq + (p >> 3)) * GH + c0 + 64 * ch + 8 * (p & 7)); }
            if (t + 1 < GH / 128) SG1_VLOAD(c0 + 128);
            if (t % 6 == 0) {
                const float* wp = WSF + ((size_t)(layer * NG + g) * GB + 32 * wq + r32) * GB + 8 * hi;
#pragma unroll
                for (int jt = 0; jt < 2; ++jt)
#pragma unroll
                    for (int ks = 0; ks < 4; ++ks) { const f32x4 w0 = *(const f32x4*)(wp + 64 * jt + 16 * ks), w1 = *(const f32x4*)(wp + 64 * jt + 16 * ks + 4); v4u w = {pk2(w0.x, w0.y), pk2(w0.z, w0.w), pk2(w1.x, w1.y), pk2(w1.z, w1.w)}; wf[jt][ks] = __builtin_bit_cast(bf16x8, w); }
                const float* bp = bs + (size_t)(layer * NG + g) * GB + 32 * wq + 4 * hi;
#pragma unroll
                for (int q = 0; q < 4; ++q) bsv[q] = *(const f32x4*)(bp + 8 * q);
            }
            f32x16 o[2] = {};
#define SG1_TRRD(dst, off) asm volatile("ds_read_b64_tr_b16 %0, %1 offset:%2" : "=&v"(dst) : "v"(va), "i"(off) : "memory")
#define SG1_PV(dd, jt) do { const unsigned va = vbase + (unsigned)((buf * 2 + (jt)) * 16384 + (2 * ch + (dd)) * 512); s16x4 l0, l1, l2, l3, h0, h1, h2, h3; \
            SG1_TRRD(l0, 0); SG1_TRRD(h0, 2048); SG1_TRRD(l1, 4096); SG1_TRRD(h1, 6144); SG1_TRRD(l2, 8192); SG1_TRRD(h2, 10240); SG1_TRRD(l3, 12288); SG1_TRRD(h3, 14336); \
            asm volatile("s_waitcnt lgkmcnt(0)" ::: "memory"); __builtin_amdgcn_sched_barrier(0); \
            o[dd] = __builtin_amdgcn_mfma_f32_32x32x16_bf16(wf[jt][0], (bf16x8){l0[0], l0[1], l0[2], l0[3], h0[0], h0[1], h0[2], h0[3]}, o[dd], 0, 0, 0); \
            o[dd] = __builtin_amdgcn_mfma_f32_32x32x16_bf16(wf[jt][1], (bf16x8){l1[0], l1[1], l1[2], l1[3], h1[0], h1[1], h1[2], h1[3]}, o[dd], 0, 0, 0); \
            o[dd] = __builtin_amdgcn_mfma_f32_32x32x16_bf16(wf[jt][2], (bf16x8){l2[0], l2[1], l2[2], l2[3], h2[0], h2[1], h2[2], h2[3]}, o[dd], 0, 0, 0); \
            o[dd] = __builtin_amdgcn_mfma_f32_32x32x16_bf16(wf[jt][3], (bf16x8){l3[0], l3[1], l3[2], l3[3], h3[0], h3[1], h3[2], h3[3]}, o[dd], 0, 0, 0); } while (0)
            SG1_PV(0, 0); SG1_PV(1, 0);
            if (wq >= 2) { SG1_PV(0, 1); SG1_PV(1, 1); }
#pragma unroll
            for (int dd = 0; dd < 2; ++dd)
#pragma unroll
                for (int r = 0; r < 16; ++r) { const float val = o[dd][r] + bsv[r >> 2][r & 3];
                    *(LAS unsigned short*)(stg + att::crow(r, hi) * SG1_STG_ROW + (dd * 32 + r32) * 2) = (unsigned short)f2bf(val); }
            LDS_WAIT();
#pragma unroll
            for (int q = 0; q < 4; ++q) { const int p = lane + 64 * q; const v4u sv = *(const LAS v4u*)(stg + (p >> 3) * SG1_STG_ROW + (p & 7) * 16); const v4u uu = ur[q]; v4u w;
                w.x = pk2(bflo(uu.x) * bflo(sv.x), bfhi(uu.x) * bfhi(sv.x)); w.y = pk2(bflo(uu.y) * bflo(sv.y), bfhi(uu.y) * bfhi(sv.y));
                w.z = pk2(bflo(uu.z) * bflo(sv.z), bfhi(uu.z) * bfhi(sv.z)); w.w = pk2(bflo(uu.w) * bflo(sv.w), bfhi(uu.w) * bfhi(sv.w));
                *(GAS v4u*)(Ub + (size_t)(32 * wq + (p >> 3)) * GH + c0 + 64 * ch + 8 * (p & 7)) = w; }
            if (t + 1 < GH / 128) SG1_VWRITE(c0 + 128, buf ^ 1);
            RAW_BAR();
        }
#undef SG1_VLOAD
#undef SG1_VWRITE
#undef SG1_TRRD
#undef SG1_PV
        __syncthreads();
    }
}


#endif

__device__ __forceinline__ att::BlockRef att_ref(unsigned k, int cls, const bf16* Q, const bf16* K, const bf16* V, bf16* O, const float* FB, const int* JLO) {
#ifndef ATT_QUADS
    const int h = k & 15, qb = 15 - (int)(k >> 4), b = cls, bh = b * NH + h;
#else
    const int r = k & 63, h = r >> 2, qb = 15 - 4 * (int)(k >> 6) - (r & 3), b = (cls - h) & 7, bh = b * NH + h;
#endif
    const size_t base = (size_t)b * SEQ * D + (size_t)h * HD, qoff = base + (size_t)qb * 256 * D;
    const int s0 = (JLO[bh * (SEQ / 256) + qb] >> 1) * 128;
    att::BlockRef rf; rf.Q = Q + qoff; rf.O = O + qoff; rf.K = K + base + (size_t)s0 * D; rf.V = V + base + (size_t)s0 * D; rf.P0 = qb * 256 - s0; rf.F = FB + (size_t)bh * SEQ + s0; return rf;
}
__device__ __forceinline__ void attn_phase(Frame& F, char* lds, const bf16* Q, const bf16* K, const bf16* V, bf16* O, const float* FB, const int* JLO, unsigned* qword) {
    constexpr unsigned NTK = 256;
    const int cls = blockIdx.x & 7; unsigned* qw = qword + 64 * cls;
    volatile LAS unsigned* TK = (volatile LAS unsigned*)(F.lds + att::LDS_BYTES);
    if (threadIdx.x == 0) { const unsigned t0 = __hip_atomic_fetch_add(qw, 1u, __ATOMIC_RELAXED, __HIP_MEMORY_SCOPE_AGENT), t1 = __hip_atomic_fetch_add(qw, 1u, __ATOMIC_RELAXED, __HIP_MEMORY_SCOPE_AGENT); TK[0] = t0; TK[1] = t1; }
    __syncthreads();
    unsigned cur_t = __builtin_amdgcn_readfirstlane(TK[0]), nxt_t = __builtin_amdgcn_readfirstlane(TK[1]);
    __syncthreads();
    if (cur_t >= NTK) return;
    att::BlockRef cur = att_ref(cur_t, cls, Q, K, V, O, FB, JLO);
    const float thr2 = ((const float*)JLO)[BATCH * NH * (SEQ / 256) + cls];
    att::Seam S;
    att::prime(cur, lds, S);
    for (;;) {
        const bool has_next = nxt_t < NTK;
        const att::BlockRef nxt = has_next ? att_ref(nxt_t, cls, Q, K, V, O, FB, JLO) : cur;
        att::block(cur, nxt, lds, S, thr2);
        if (threadIdx.x == 0 && has_next) TK[0] = __hip_atomic_fetch_add(qw, 1u, __ATOMIC_RELAXED, __HIP_MEMORY_SCOPE_AGENT);
        __syncthreads();
        if (!has_next) break;
        cur = nxt; cur_t = nxt_t; nxt_t = __builtin_amdgcn_readfirstlane(TK[0]);
        __syncthreads();
    }
}

#define ZBV(off_mib, per_batch_mib) (WS_Z + (size_t)(blockIdx.x & 7) * (size_t)(96 - (per_batch_mib)) * MiB + (size_t)(off_mib) * MiB)
#define ZB_U ZBV(0, 48)
#define ZB_V ZBV(48, 48)
#define ZB_HID ZBV(0, 64)
#define ZB_Q ZBV(0, 16)
#define ZB_O ZBV(16, 16)
#define ZB_HKV ZBV(32, 16)
#define ZB_KB ZBV(64, 16)
#define ZB_VB ZBV(80, 16)
#define ZB_D1A ZBV(64, 16)

#ifndef DUPMASK
#define DUPMASK 0
#endif
#ifndef EN_MASK
#define EN_MASK 0xFFFF
#endif
#define EN(k) ((EN_MASK >> (k)) & 1)
#ifndef GELU_PROBE
#define GELU_PROBE 0
#endif
#ifndef HID_TILED
#define HID_TILED true
#endif
#ifndef PG8_ALIGN_SET
#define PG8_ALIGN_SET true
#endif
#ifndef PG8_SP2_SET
#define PG8_SP2_SET true
#endif
#ifndef WGM_G1
#define WGM_G1 4
#endif
#ifndef WGM_QKV
#define WGM_QKV 4
#endif
#ifndef WGM_M1
#define WGM_M1 4
#endif
#ifndef WGM_RES
#define WGM_RES 4
#endif
#define NREP(c) (((DUPMASK >> (c)) & 1) ? 2 : 1)
__global__ void __launch_bounds__(NWAVES * 64, 2) yoco_fwd(Args args) {
    extern __shared__ __attribute__((aligned(16))) unsigned char lds[];
    Frame F;
    F.lds = (LAS unsigned char*)lds;
    F.G = gridDim.x; { const int bx = blockIdx.x; F.vcu = (F.G % 8 == 0) ? (bx % 8) * (F.G / 8) + bx / 8 : bx; }
    volatile LAS unsigned* MISC = (volatile LAS unsigned*)(F.lds + MISC_OFF);
    for (int u = threadIdx.x; u < (LDS_BYTES - LDSCTL_OFF) / 4; u += NWAVES * 64) ((LAS unsigned*)(F.lds + LDSCTL_OFF))[u] = 0u;
    __syncthreads();
    if (threadIdx.x < 25) { LAS unsigned long long* PT = (LAS unsigned long long*)(F.lds + LDSCTL_OFF); const int i = threadIdx.x;
        PT[i] = i < 23 ? (unsigned long long)args.in[i] : (i == 23 ? (unsigned long long)args.out : (unsigned long long)args.ws); }
    const int lo = args.ph_lo, hi = args.ph_hi;
    XcdBarrier gbar = xcd_barrier_post((unsigned*)(args.ws + WS_CTL) + CW_BAR, MISC + 8, gridDim.x);
    XcdBarrier bar = xcd_barrier_post((unsigned*)(args.ws + WS_CTL) + CW_BAR + (size_t)(1 + (blockIdx.x & 7)) * XCD_BAR_WORDS, MISC + 10, gridDim.x >> 3);
    __syncthreads();
    int ph = 0; int l_cur = 0;
#define RUN(c) (ph >= lo && ph < hi && EN(c))
#define SEAM() do { if (ph >= lo && ph + 1 < hi) xcd_barrier(bar); ++ph; } while (0)
#ifndef DUP_LMASK
#define DUP_LMASK 0xF
#endif
#define REPEAT(c) const int nrep_ = (NREP(c) == 2 && c != 0 && !((DUP_LMASK >> l_cur) & 1)) ? 1 : NREP(c); _Pragma("unroll 1") for (int rep = 0; rep < nrep_; ++rep)
#define REP_BAR() do { if (rep) xcd_barrier(bar); } while (0)
#define MODP(l) ((const float*)(ws + WS_MOD) + (size_t)(l) * BATCH * NMOD)

#ifdef TLB_WARM
    {
      const int rank = blockIdx.x >> 3, nrank = (int)gridDim.x >> 3; unsigned acc_ = 0;
      for (int bi = 0; bi < 25; ++bi) { const char* base = (const char*)ldptr<char>(F, bi); const size_t bytes = bi < 23 ? (size_t)args.nbytes[bi] : (bi == 23 ? (size_t)M * D * 4 : (size_t)WS_END);
          for (size_t off = ((size_t)rank * 512 + threadIdx.x) * (size_t)TLB_WARM; off < bytes; off += (size_t)nrank * 512 * (size_t)TLB_WARM) acc_ += *(const volatile unsigned*)(base + off); }
      if (acc_ == 0x12345678u) ((volatile unsigned*)(args.ws + WS_CTL))[64] = acc_; }
    __syncthreads();
#endif
#ifdef WARM_READ_MB
    {
      const float* xw = ldptr<const float>(F, I_X); f32x4 acc_ = {0.f, 0.f, 0.f, 0.f}; const size_t nv = (size_t)WARM_READ_MB * 65536;
      for (size_t i = (size_t)blockIdx.x * 512 + threadIdx.x; i < nv; i += (size_t)gridDim.x * 512) acc_ += ((const f32x4*)xw)[i];
      if (acc_.x + acc_.y + acc_.z + acc_.w == 1.2345e30f) ((volatile float*)(args.ws + WS_CTL))[65] = acc_.x; }
    __syncthreads();
#endif
#ifdef MFMA_PROBE_ITERS
    {
      typedef short pb8 __attribute__((ext_vector_type(8))); typedef float pf4 __attribute__((ext_vector_type(4)));
      const unsigned lid = threadIdx.x * 2654435761u; unsigned pw[4] = {lid | 0x3f803f80u, (lid >> 3) | 0x3f003f00u, (lid << 5) ^ 0x40004000u, (lid >> 7) | 0x3e803e80u};
      pb8 pa = __builtin_bit_cast(pb8, *(v4u*)pw), pbb = pa; pf4 c0 = {0,0,0,0}, c1 = c0, c2 = c0, c3 = c0;
      for (int it = 0; it < MFMA_PROBE_ITERS; ++it) {
#pragma unroll
        for (int q = 0; q < 16; ++q) { c0 = __builtin_amdgcn_mfma_f32_16x16x32_bf16(pa, pbb, c0, 0, 0, 0); c1 = __builtin_amdgcn_mfma_f32_16x16x32_bf16(pbb, pa, c1, 0, 0, 0);
            c2 = __builtin_amdgcn_mfma_f32_16x16x32_bf16(pa, pa, c2, 0, 0, 0); c3 = __builtin_amdgcn_mfma_f32_16x16x32_bf16(pbb, pbb, c3, 0, 0, 0); }
        c0 *= 0.5f; c1 *= 0.5f; c2 *= 0.5f; c3 *= 0.5f; }
      if (c0[0] + c1[1] + c2[2] + c3[3] == 1.2345e30f) ((volatile float*)(args.ws + WS_CTL))[66] = c0[0]; }
    __syncthreads();
#endif
#ifdef START_DELAY_US
    { const unsigned long long t0 = __builtin_amdgcn_s_memrealtime(); while (__builtin_amdgcn_s_memrealtime() - t0 < (unsigned long long)START_DELAY_US * 100ull) __builtin_amdgcn_s_sleep(32); }
#endif
#if defined(FIX_P0_US) || defined(FIX_A_US)
    const unsigned long long t_start = __builtin_amdgcn_s_memrealtime();
#endif
#ifdef P0_SPLIT
    p0_prologue(F, 1); xcd_barrier(gbar);
#ifdef FIX_A_US
    while (__builtin_amdgcn_s_memrealtime() - t_start < (unsigned long long)FIX_A_US * 100ull) __builtin_amdgcn_s_sleep(32);
#endif
    p0_prologue(F, 2);
#else
    if (RUN(0)) { REPEAT(0) { if (rep) xcd_barrier(gbar); p0_prologue(F); } }
#endif
    if (ph >= lo && ph + 1 < hi) xcd_barrier(gbar);
    ++ph;
#ifndef GROUP_STAGGER_MODE
#define GROUP_STAGGER_MODE 0
#endif
#ifdef GROUP_STAGGER_TICKS
    { const unsigned long long t0 = __builtin_amdgcn_s_memrealtime(), w = (unsigned long long)(GROUP_STAGGER_MODE == 1 ? (blockIdx.x & 1) : (blockIdx.x & 7)) * GROUP_STAGGER_TICKS; while (__builtin_amdgcn_s_memrealtime() - t0 < w) __builtin_amdgcn_s_sleep(8); }
#endif
#ifdef FIX_P0_US
    while (__builtin_amdgcn_s_memrealtime() - t_start < (unsigned long long)FIX_P0_US * 100ull) __builtin_amdgcn_s_sleep(32);
#endif
#ifdef EXTRA_BARS
    for (int eb = 0; eb < EXTRA_BARS; ++eb) xcd_barrier(gbar);
#endif
#pragma unroll 1
#define DEFER(slot) do { if (l == 0 && (int)(blockIdx.x & 7) == (slot)) p0_deferred(F); } while (0)
    for (int l = 0; l < DEPTH; ++l) { l_cur = l;
        if (l == 1 && lo == 0 && hi >= 31) xcd_barrier(gbar);
        DEFER(0);
#define D1P(ll) ((const bf16*)(ws + ((ll) < NA ? ZB_D1A : WS_DELTA)))
        if (RUN(1)) { unsigned char* ws = WSP(); const float* mod = MODP(l); bf16* xb = (bf16*)ldptr<float>(F, PT_OUT) + D;
              const bf16* d1 = (l == 0 || l - 1 >= NA) ? (const bf16*)nullptr : D1P(l - 1); const bf16* d2 = (l == 0) ? (const bf16*)nullptr : (const bf16*)(ws + WS_DELTA);
            if (l == NA) norm_phase<true, true>(F, (const float*)xb, d1, d2, xb, INP(I_NORMG) + (size_t)(2 * l) * D, mod, mod + D, NMOD, (bf16*)(ws + WS_H), INP(I_KVNG), (const float*)(ws + WS_KVMOD), (bf16*)(ws + ZB_HKV), INP(I_WF), INP(I_BF), (float*)(ws + WS_LOGF));
            else if (l <= 1) norm_phase<false, false>(F, INP(I_X), d1, d2, (l == 0) ? (bf16*)nullptr : xb, INP(I_NORMG) + (size_t)(2 * l) * D, mod, mod + D, NMOD, (bf16*)(ws + WS_H), nullptr, nullptr, nullptr, nullptr, nullptr, nullptr);
            else norm_phase<false, true>(F, (const float*)xb, d1, d2, xb, INP(I_NORMG) + (size_t)(2 * l) * D, mod, mod + D, NMOD, (bf16*)(ws + WS_H), nullptr, nullptr, nullptr, nullptr, nullptr, nullptr); }
        DEFER(1); SEAM();
        if (l < NA) {
            if (RUN(2)) { REPEAT(2) { REP_BAR(); unsigned char* ws = WSP();
                pg8::Gemm g{(const bf16*)(ws + WS_H), (const bf16*)(ws + WS_WT) + WT_WIN + (size_t)l * GN * D, M, GN, D, 0}; pg8::StaticOrder S; S.init(M, GN, F.G, (int)blockIdx.x, WGM_G1);
#ifdef SG_V1
                pg8::EpiBf16<1, true> E{(bf16*)(ws + ZB_U), GH, GH, (size_t)(ZB_V - ZB_U) / 2, (pg8::f32x2v*)(ws + WS_VSTAT), M};
                pg8::gemm_phase<pg8::EpiBf16<1, true>, pg8::StaticOrder, PG8_ALIGN_SET, PG8_SP2_SET>(F.lds, g, S, E); } }
#else
                pg8::EpiGmlpIn E{(bf16*)(ws + ZB_U), (bf16*)(ws + ZB_V), (pg8::f32x2v*)(ws + WS_VSTAT), M, GH, (GELU_PROBE && rep < nrep_ - 1) ? 0 : 1};
                pg8::gemm_phase<pg8::EpiGmlpIn, pg8::StaticOrder, PG8_ALIGN_SET, PG8_SP2_SET>(F.lds, g, S, E); } }
#endif
            DEFER(2); SEAM();
            if (RUN(3)) { REPEAT(3) { REP_BAR(); unsigned char* ws = WSP();
#ifdef SG_V1
                sg_phase_v1(F, l, (bf16*)(ws + ZB_U), (const bf16*)(ws + ZB_V), (const f32x2*)(ws + WS_VSTAT), INP(I_LNG) + (size_t)l * GH, INP(I_LNB) + (size_t)l * GH, (const float*)(ws + WS_WSM), INP(I_BS)); } }
#else
                sg_phase(F, l, (bf16*)(ws + ZB_U), (const bf16*)(ws + ZB_V), (const f32x2*)(ws + WS_VSTAT), INP(I_LNG) + (size_t)l * GH, INP(I_LNB) + (size_t)l * GH, (const float*)(ws + WS_WSM), INP(I_BS), rep == nrep_ - 1); } }
#endif
            DEFER(3); SEAM();
        } else {
            const int bl = l - NA;
            if (RUN(4)) { REPEAT(4) { REP_BAR(); unsigned char* ws = WSP();
                if (l == NA) cumsum_phase(F, (const float*)(ws + WS_LOGF), (float*)(ws + WS_FB), INP(I_QNG), INP(I_KNG), (int*)(ws + WS_JLO));
#pragma unroll 1
                for (int s = (l == NA ? 0 : 1); s < 2; ++s) {
                    pg8::Gemm g{(const bf16*)(ws + (s == 0 ? ZB_HKV : WS_H)), (const bf16*)(ws + WS_WT) + (s == 0 ? WT_WKV : WT_WQ + (size_t)bl * D * D), M, s == 0 ? 2 * D : D, D, 0};
                    pg8::StaticOrder S; S.init(M, g.N, F.G, (int)blockIdx.x, WGM_QKV);
                    pg8::EpiHeadNorm E{(bf16*)(ws + (s == 0 ? ZB_KB : ZB_Q)), D, s == 0 ? D : 0, (size_t)(ZB_VB - ZB_KB) / 2, 1, s == 0 ? INP(I_KNG) : INP(I_QNG) + bl * HD, EPS, (LAS float*)(F.lds + RING_BYTES), s == 0 ? 1.0f : att::SCALE * att::LOG2E};
                    pg8::gemm_phase<pg8::EpiHeadNorm, pg8::StaticOrder, true, PG8_SP2_SET>(F.lds, g, S, E);
                } } }
            SEAM();
            if (RUN(6)) { REPEAT(6) { REP_BAR(); unsigned char* ws = WSP();
                attn_phase(F, (char*)lds, (const bf16*)(ws + ZB_Q), (const bf16*)(ws + ZB_KB), (const bf16*)(ws + ZB_VB), (bf16*)(ws + ZB_O), (const float*)(ws + WS_FB), (const int*)(ws + WS_JLO),
                           (unsigned*)(ws + WS_CTL) + CW_QUEUE + 512 * (2 * bl + rep)); } }
            SEAM();
        }
        if (RUN(7)) { REPEAT(7) { REP_BAR(); unsigned char* ws = WSP();
            pg8::StaticOrder S; S.init(M, D, F.G, (int)blockIdx.x, WGM_RES);
            pg8::EpiDelta E{(bf16*)D1P(l), D, MODP(l) + 2 * D, NMOD, SEQ / 256};
            if (l < NA) { pg8::Gemm g{(const bf16*)(ws + ZB_U), (const bf16*)(ws + WS_WT) + WT_WOUT + (size_t)l * D * GH, M, D, GH, 1};
                pg8::gemm_phase<pg8::EpiDelta, pg8::StaticOrder, PG8_ALIGN_SET, PG8_SP2_SET>(F.lds, g, S, E); }
            else { pg8::Gemm g{(const bf16*)(ws + ZB_O), (const bf16*)(ws + WS_WT) + WT_WO + (size_t)(l - NA) * D * D, M, D, D, 0};
                pg8::gemm_phase<pg8::EpiDelta, pg8::StaticOrder, PG8_ALIGN_SET, PG8_SP2_SET>(F.lds, g, S, E); } } }
        DEFER(4); SEAM();
        if (RUN(8)) { unsigned char* ws = WSP(); const float* mod = MODP(l); bf16* xb = (bf16*)ldptr<float>(F, PT_OUT) + D;
            if (l == 0) norm_phase<false, false>(F, INP(I_X), D1P(l), nullptr, nullptr, INP(I_NORMG) + (size_t)(2 * l + 1) * D, mod + 3 * D, mod + 4 * D, NMOD, (bf16*)(ws + WS_H), nullptr, nullptr, nullptr, nullptr, nullptr, nullptr);
            else norm_phase<false, true>(F, (const float*)xb, D1P(l), nullptr, l < NA ? (bf16*)nullptr : xb, INP(I_NORMG) + (size_t)(2 * l + 1) * D, mod + 3 * D, mod + 4 * D, NMOD, (bf16*)(ws + WS_H), nullptr, nullptr, nullptr, nullptr, nullptr, nullptr); }
        DEFER(5); SEAM();
#ifdef CLOCK_PROBE
        const unsigned long long cp_c0 = __builtin_amdgcn_s_memtime(), cp_r0 = __builtin_amdgcn_s_memrealtime();
#endif
        if (RUN(9)) { REPEAT(9) { REP_BAR(); unsigned char* ws = WSP();
            pg8::Gemm g{(const bf16*)(ws + WS_H), (const bf16*)(ws + WS_WT) + WT_W1 + (size_t)l * FF * D, M, FF, D, 0}; pg8::StaticOrder S; S.init(M, FF, F.G, (int)blockIdx.x, WGM_M1);
            pg8::EpiBf16<2, false, HID_TILED> E{(bf16*)(ws + ZB_HID), FF, 0, 0, nullptr, M};
            pg8::gemm_phase<pg8::EpiBf16<2, false, HID_TILED>, pg8::StaticOrder, PG8_ALIGN_SET, PG8_SP2_SET>(F.lds, g, S, E); } }
#ifdef CLOCK_PROBE
        if (l == CLOCK_PROBE && blockIdx.x == 0) {
            const unsigned long long dc = __builtin_amdgcn_s_memtime() - cp_c0, dr = __builtin_amdgcn_s_memrealtime() - cp_r0;
            const unsigned long long mhz = dc * 100ull / dr; const unsigned long long wait_ticks = (mhz > 1000ull ? mhz - 1000ull : 0ull) * 100ull;
            const unsigned long long t0 = __builtin_amdgcn_s_memrealtime(); while (__builtin_amdgcn_s_memrealtime() - t0 < wait_ticks) __builtin_amdgcn_s_sleep(32); }
#endif
        DEFER(6); SEAM();
        if (RUN(10)) { REPEAT(10) { REP_BAR(); unsigned char* ws = WSP();
            pg8::Gemm g{(const bf16*)(ws + ZB_HID), (const bf16*)(ws + WS_WT) + WT_W2 + (size_t)l * D * FF, M, D, FF, HID_TILED ? 1 : 0}; pg8::StaticOrder S; S.init(M, D, F.G, (int)blockIdx.x, WGM_RES);
            pg8::EpiDelta E{(bf16*)(ws + WS_DELTA), D, MODP(l) + 5 * D, NMOD, SEQ / 256};
            pg8::gemm_phase<pg8::EpiDelta, pg8::StaticOrder, PG8_ALIGN_SET, PG8_SP2_SET>(F.lds, g, S, E); } }
        DEFER(7); SEAM();
    }
    if (RUN(11)) { l_cur = 0; REPEAT(11) { REP_BAR(); unsigned char* ws = WSP(); float* out = ldptr<float>(F, PT_OUT); resid_final(F, (const bf16*)out + D, rep == nrep_ - 1 ? out : (float*)(ws + WS_Z), (const bf16*)(ws + WS_DELTA)); } }
#undef RUN
#undef SEAM
}

extern "C" void kernel_launch(void* const* d_in, const int* in_sizes, int n_in, void* d_out, int out_size, void* d_ws, size_t ws_size, hipStream_t stream) {
    static int grid = 0;
    if (grid == 0) {
        if (n_in != 23 || in_sizes[0] != M * D || out_size != M * D || ws_size < WS_END) { fprintf(stderr, "kernel_launch: shape/workspace mismatch (n_in %d in0 %d out %d ws %zu, need %zu)\n", n_in, n_in > 0 ? in_sizes[0] : -1, out_size, ws_size, (size_t)WS_END); grid = -1; return; }
        int dev = 0, cus = 0, per_cu = 0;
        if (hipGetDevice(&dev) != hipSuccess || hipDeviceGetAttribute(&cus, hipDeviceAttributeMultiprocessorCount, dev) != hipSuccess) { grid = -1; return; }
        if (hipFuncSetAttribute((const void*)yoco_fwd, hipFuncAttributeMaxDynamicSharedMemorySize, LDS_BYTES) != hipSuccess) { fprintf(stderr, "kernel_launch: hipFuncSetAttribute failed\n"); grid = -1; return; }
        if (hipOccupancyMaxActiveBlocksPerMultiprocessor(&per_cu, (const void*)yoco_fwd, NWAVES * 64, LDS_BYTES) != hipSuccess || per_cu < 1) { fprintf(stderr, "kernel_launch: occupancy query says %d\n", per_cu); }
        (void)hipGetLastError();
        grid = cus;
        if (grid != M / GB) { fprintf(stderr, "kernel_launch: this kernel needs exactly %d CUs (got %d)\n", M / GB, cus); grid = -1; return; }
    }
    if (grid < 0) return;
    if (hipMemsetAsync((char*)d_ws + WS_CTL, 0, CTL_ZERO_BYTES, stream) != hipSuccess) return;
    Args a{};
    for (int i = 0; i < 23; ++i) { a.in[i] = (const float*)d_in[i]; a.nbytes[i] = (unsigned)in_sizes[i] * 4u; }
    a.out = (float*)d_out; a.ws = (unsigned char*)d_ws;
#if MK_N_LAUNCHES == 1
    a.ph_lo = 0; a.ph_hi = 1000; a.li = 0; a.pad = 0;
    hipLaunchKernelGGL(yoco_fwd, dim3(grid), dim3(NWAVES * 64), LDS_BYTES, stream, a);
#else
    for (int li = 0; li < 64; ++li) { a.ph_lo = li; a.ph_hi = li + 1; a.li = li; a.pad = 0;
        hipLaunchKernelGGL(yoco_fwd, dim3(grid), dim3(NWAVES * 64), LDS_BYTES, stream, a); }
#endif
}
```
